# Optimizing an MI355X kernel written in HIP

```python
import jax, jax.numpy as jnp
from jax import lax
import numpy as np

D_MODEL = 2048
BATCH = 4
SEQ = 2048
DEPTH = 4

GRID_W = 64
CTX_LEN = 256
NH_M = 4
DH_M = 256
D_M = NH_M * DH_M
NG_F = 4
DG_F = 128
D_F = NG_F * DG_F
D_C = 512
D_FF = 5632
CHUNK = 128
CONV_W = 3
EPS = 1e-6
N_BRANCH = 3

OFF_GATES = 2 * D_M
N_STATE_COLS = 2 * D_M + 4 * NH_M
OFF_Q = N_STATE_COLS
OFF_O = OFF_Q + D_M
OFF_F = OFF_O + D_M
OFF_C = OFF_F + D_F
OFF_G = OFF_C + 3 * D_C
N_IN = OFF_G + N_BRANCH * D_MODEL

kernel_name = "hybrid_mlstm_fourier_shortconv_dit_block"


def rmsnorm(x, w):
    xf = x.astype(jnp.float32)
    y = xf * lax.rsqrt(jnp.mean(xf * xf, axis=-1, keepdims=True) + EPS)
    return (y * w.astype(jnp.float32)).astype(x.dtype)


def modulation(cond, w_mod, b_mod):
    m = (jax.nn.silu(cond) @ w_mod + b_mod).reshape(-1, 1, 6 * D_MODEL)
    return jnp.split(m, 6, axis=-1)


def modulate(x, w, shift, scale):
    return rmsnorm(x, w) * (1.0 + scale) + shift


def dwconv3(x, w, axis):
    n = x.shape[axis]
    half = CONV_W // 2
    pad = [(0, 0)] * x.ndim
    pad[axis] = (half, half)
    xp = jnp.pad(x, pad)
    out = lax.slice_in_dim(xp, 0, n, axis=axis) * w[0]
    for j in range(1, CONV_W):
        out = out + lax.slice_in_dim(xp, j, j + n, axis=axis) * w[j]
    return out


def conv_mix(x, w, grid, grid_axis):
    if grid is None:
        return dwconv3(x, w, 1)
    B, T, C = x.shape
    return dwconv3(x.reshape(B, grid[0], grid[1], C), w, grid_axis).reshape(B, T, C)


def mlstm_scan(q, k, v, i_pre, f_pre, state):
    B, T, H, Dh = k.shape
    nc = T // CHUNK

    def chunks(a):
        a = a.astype(jnp.float32).reshape((B, nc, CHUNK) + a.shape[2:])
        return jnp.swapaxes(jnp.moveaxis(a, 1, 0), 2, 3)

    with_h = q is not None
    xs = (chunks(k), chunks(v), chunks(i_pre), chunks(jax.nn.log_sigmoid(f_pre.astype(jnp.float32))))
    if with_h:
        xs = xs + (chunks(q),)
    causal = jnp.tril(jnp.ones((CHUNK, CHUNK), dtype=bool))

    def step(carry, inp):
        C, n, m = carry
        kc, vc, ic, lfc = inp[:4]
        b = jnp.cumsum(lfc, axis=-1)
        b_end = b[..., -1]
        a_end = b_end[..., None] - b + ic
        m_new = jnp.maximum(b_end + m, jnp.max(a_end, axis=-1))
        w_end = jnp.exp(a_end - m_new[..., None])
        keep = jnp.exp(b_end + m - m_new)
        C_new = keep[..., None, None] * C + jnp.einsum("bhsk,bhsv->bhkv", kc * w_end[..., None], vc)
        n_new = keep[..., None] * n + jnp.einsum("bhsk,bhs->bhk", kc, w_end)
        if not with_h:
            return (C_new, n_new, m_new), None
        qc = inp[4]
        log_d = jnp.where(causal, b[..., :, None] - b[..., None, :] + ic[..., None, :], -jnp.inf)
        inter = b + m[..., None]
        m_t = jnp.maximum(inter, jnp.max(log_d, axis=-1))
        decay = jnp.exp(log_d - m_t[..., None])
        g_inter = jnp.exp(inter - m_t)
        s = jnp.einsum("bhtk,bhsk->bhts", qc, kc) * decay
        num = g_inter[..., None] * jnp.einsum("bhtk,bhkv->bhtv", qc, C) + jnp.einsum("bhts,bhsv->bhtv", s, vc)
        den = g_inter * jnp.einsum("bhtk,bhk->bht", qc, n) + jnp.sum(s, axis=-1)
        h = num / jnp.maximum(jnp.abs(den), jnp.exp(-m_t))[..., None]
        return (C_new, n_new, m_new), h

    state, h = lax.scan(step, state, xs)
    if with_h:
        h = jnp.transpose(h, (1, 0, 3, 2, 4)).reshape(B, T, H * Dh)
    return h, state


def bidir_mlstm(q, k, v, gates, init_states):
    B, T, H, Dh = k.shape
    if init_states is None:
        zero = (jnp.zeros((B, H, Dh, Dh), jnp.float32), jnp.zeros((B, H, Dh), jnp.float32),
                jnp.zeros((B, H), jnp.float32))
        init_states = (zero, zero)
    rev = lambda a: None if a is None else jnp.flip(a, axis=1)
    h_f, st_f = mlstm_scan(q, k, v, gates[:, :, 0], gates[:, :, 1], init_states[0])
    h_b, st_b = mlstm_scan(rev(q), rev(k), rev(v), rev(gates[:, :, 2]), rev(gates[:, :, 3]), init_states[1])
    h = None if q is None else h_f + rev(h_b)
    return h, (st_f, st_b)


def mlstm_inputs(p_state, conv_k_w):
    B, T, _ = p_state.shape
    k = jax.nn.silu(dwconv3(p_state[..., :D_M], conv_k_w, 1)).reshape(B, T, NH_M, DH_M)
    v = p_state[..., D_M:2 * D_M].reshape(B, T, NH_M, DH_M)
    gates = p_state[..., OFF_GATES:N_STATE_COLS].reshape(B, T, 4, NH_M)
    return k, v, gates


def fourier_mix(xf):
    B, T, _ = xf.shape
    a = xf.astype(jnp.float32).reshape(B, T, NG_F, DG_F)
    y = jnp.fft.fft2(a, axes=(1, 3), norm="ortho").real
    return y.reshape(B, T, D_F).astype(xf.dtype)


def mixer(xn, p, grid, init_states):
    B, T, _ = xn.shape
    proj = xn @ p["w_in"] + p["b_in"]
    k, v, gates = mlstm_inputs(proj[..., :N_STATE_COLS], p["conv_k_w"])
    q = jax.nn.silu(dwconv3(proj[..., OFF_Q:OFF_O], p["conv_q_w"], 1)).reshape(B, T, NH_M, DH_M) * (DH_M ** -0.5)
    o_gate = proj[..., OFF_O:OFF_F]
    xf = proj[..., OFF_F:OFF_C]
    cb = proj[..., OFF_C:OFF_C + D_C]
    cc = proj[..., OFF_C + D_C:OFF_C + 2 * D_C]
    cx = proj[..., OFF_C + 2 * D_C:OFF_G]
    gm = proj[..., OFF_G:]

    h, states = bidir_mlstm(q, k, v, gates, init_states)
    h = rmsnorm(h.astype(xn.dtype).reshape(B, T, NH_M, DH_M), p["mlstm_norm_w"].reshape(NH_M, DH_M)).reshape(B, T, D_M)
    y_m = (jax.nn.sigmoid(o_gate) * h) @ p["w_pm"]
    y_f = fourier_mix(xf) @ p["w_pf"]
    y_c = (cb * conv_mix(cc * cx, p["conv_c_w"], grid, 2)) @ p["w_pc"]
    g = jax.nn.sigmoid(gm).reshape(B, T, N_BRANCH, D_MODEL)
    merged = g[..., 0, :] * y_m + g[..., 1, :] * y_f + g[..., 2, :] * y_c
    return merged @ p["w_o"], states


def ctx_states(xn_c, p):
    p_state = xn_c @ p["w_in"][:, :N_STATE_COLS] + p["b_in"][:N_STATE_COLS]
    k, v, gates = mlstm_inputs(p_state, p["conv_k_w"])
    _, states = bidir_mlstm(None, k, v, gates, None)
    return states


def conv_ffn(xn, p, grid):
    u = xn @ p["w_up"]
    a = conv_mix(u[..., :D_FF], p["conv_ff_w"], grid, 1)
    return (jax.nn.silu(a) * u[..., D_FF:]) @ p["w_down"]


def setup_inputs(seed: int = 0) -> dict:
    key = jax.random.key(seed)
    ks = jax.random.split(key, 24)
    D = D_MODEL
    nrm = lambda k, shape, scale: scale * jax.random.normal(k, shape, jnp.float32)
    b_in = nrm(ks[9], (DEPTH, N_IN), 0.02)
    b_in = b_in.at[:, OFF_GATES + NH_M:OFF_GATES + 2 * NH_M].add(3.0)
    b_in = b_in.at[:, OFF_GATES + 3 * NH_M:OFF_GATES + 4 * NH_M].add(3.0)
    return {
        "x": nrm(ks[0], (BATCH, SEQ, D), 1.0),
        "c": nrm(ks[1], (BATCH, D), 1.0),
        "ctx": nrm(ks[2], (BATCH, CTX_LEN, D), 1.0),
        "c_ctx": nrm(ks[3], (D,), 1.0),
        "w_mod": nrm(ks[4], (DEPTH, D, 6 * D), 0.5 * D ** -0.5),
        "b_mod": nrm(ks[5], (DEPTH, 6 * D), 0.02),
        "norm1_w": 1.0 + nrm(ks[6], (DEPTH, D), 0.02),
        "norm2_w": 1.0 + nrm(ks[7], (DEPTH, D), 0.02),
        "w_in": nrm(ks[8], (DEPTH, D, N_IN), D ** -0.5),
        "b_in": b_in,
        "conv_q_w": nrm(ks[10], (DEPTH, CONV_W, D_M), CONV_W ** -0.5),
        "conv_k_w": nrm(ks[11], (DEPTH, CONV_W, D_M), CONV_W ** -0.5),
        "mlstm_norm_w": 1.0 + nrm(ks[12], (DEPTH, D_M), 0.02),
        "w_pm": nrm(ks[13], (DEPTH, D_M, D), D_M ** -0.5),
        "w_pf": nrm(ks[14], (DEPTH, D_F, D), D_F ** -0.5),
        "w_pc": nrm(ks[15], (DEPTH, D_C, D), D_C ** -0.5),
        "conv_c_w": nrm(ks[16], (DEPTH, CONV_W, D_C), CONV_W ** -0.5),
        "w_o": nrm(ks[17], (DEPTH, D, D), D ** -0.5),
        "w_up": nrm(ks[18], (DEPTH, D, 2 * D_FF), D ** -0.5),
        "conv_ff_w": nrm(ks[19], (DEPTH, CONV_W, D_FF), CONV_W ** -0.5),
        "w_down": nrm(ks[20], (DEPTH, D_FF, D), D_FF ** -0.5),
        "final_norm_w": 1.0 + nrm(ks[21], (D,), 0.02),
    }


def reference(x, c, ctx, c_ctx, w_mod, b_mod, norm1_w, norm2_w, w_in, b_in, conv_q_w, conv_k_w,
              mlstm_norm_w, w_pm, w_pf, w_pc, conv_c_w, w_o, w_up, conv_ff_w, w_down, final_norm_w):
    rows = x.shape[1] // GRID_W
    grid = (rows, GRID_W)
    h, hc = x, ctx
    for l in range(DEPTH):
        p = {"w_in": w_in[l], "b_in": b_in[l], "conv_q_w": conv_q_w[l], "conv_k_w": conv_k_w[l],
             "mlstm_norm_w": mlstm_norm_w[l], "w_pm": w_pm[l], "w_pf": w_pf[l], "w_pc": w_pc[l],
             "conv_c_w": conv_c_w[l], "w_o": w_o[l], "w_up": w_up[l], "conv_ff_w": conv_ff_w[l],
             "w_down": w_down[l]}
        sh1, sc1, g1, sh2, sc2, g2 = modulation(c, w_mod[l], b_mod[l])
        csh1, csc1, cg1, csh2, csc2, cg2 = modulation(c_ctx, w_mod[l], b_mod[l])
        xn_c = modulate(hc, norm1_w[l], csh1, csc1)
        if l == DEPTH - 1:
            states = ctx_states(xn_c, p)
        else:
            out_c, states = mixer(xn_c, p, None, None)
            hc = hc + cg1 * out_c
            hc = hc + cg2 * conv_ffn(modulate(hc, norm2_w[l], csh2, csc2), p, None)
        out, _ = mixer(modulate(h, norm1_w[l], sh1, sc1), p, grid, states)
        h = h + g1 * out
        h = h + g2 * conv_ffn(modulate(h, norm2_w[l], sh2, sc2), p, grid)
    return rmsnorm(h, final_norm_w)
```

```cpp
#include <hip/hip_runtime.h>
#include <cstdio>
#include <cstdint>

#define LAS __attribute__((address_space(3)))
typedef unsigned short bf16_t;
typedef short bf16x8 __attribute__((ext_vector_type(8)));
typedef float f32x4 __attribute__((ext_vector_type(4)));
typedef unsigned u32x4 __attribute__((ext_vector_type(4)));
typedef unsigned u32x2 __attribute__((ext_vector_type(2)));

constexpr int D = 2048, NB = 4, SEQ = 2048, DEPTH = 4, CTX = 256;
constexpr int DM = 1024, NH = 4, DH = 256, DF = 512, DC = 512, DFF = 5632, CHUNK = 128;
constexpr int NIN = 12304;
constexpr int RL = NB * SEQ, RC = NB * CTX, R = RL + RC;
constexpr int NP = 12288;
constexpr int NINP = 12544;
constexpr int PK = 0, PV = 1024, PQ = 2048, PO = 3072, PF = 4096, PCB = 4608, PCC = 5120, PCX = 5632, PGM = 6144;
constexpr int NCHUNK = 72;
constexpr int NUP = 2 * DFF;
constexpr float EPS = 1e-6f;

constexpr size_t al256(size_t x) { return (x + 255) & ~(size_t)255; }
constexpr size_t OFF_CTL = 0;
constexpr size_t OFF_WIN = 1u << 20;
constexpr size_t SZ_WIN = (size_t)NINP * D * 2;            constexpr size_t OFF_WPM = OFF_WIN + DEPTH * SZ_WIN;
constexpr size_t SZ_WPM = (size_t)D * DM * 2;              constexpr size_t OFF_WPF = OFF_WPM + DEPTH * SZ_WPM;
constexpr size_t SZ_WPF = (size_t)D * DF * 2;              constexpr size_t OFF_WPC = OFF_WPF + DEPTH * SZ_WPF;
constexpr size_t SZ_WPC = (size_t)D * DC * 2;              constexpr size_t OFF_WO = OFF_WPC + DEPTH * SZ_WPC;
constexpr size_t SZ_WO = (size_t)D * D * 2;                constexpr size_t OFF_WUP = OFF_WO + DEPTH * SZ_WO;
constexpr size_t SZ_WUP = (size_t)NUP * D * 2;             constexpr size_t OFF_WDN = OFF_WUP + DEPTH * SZ_WUP;
constexpr size_t SZ_WDN = (size_t)D * DFF * 2;             constexpr size_t OFF_BINR = OFF_WDN + DEPTH * SZ_WDN;
constexpr size_t OFF_CSL = al256(OFF_BINR + (size_t)DEPTH * NINP * 4);
constexpr size_t OFF_CSC = OFF_CSL + (size_t)2048 * 4096 * 2;
constexpr size_t OFF_FT = OFF_CSC + (size_t)256 * 512 * 2;
constexpr size_t OFF_MOD = OFF_FT + (size_t)256 * 128 * 2;
constexpr size_t OFF_H = al256(OFF_MOD + (size_t)DEPTH * 5 * 6 * D * 4);
constexpr size_t OFF_XN = OFF_H + (size_t)R * D * 4;
constexpr size_t OFF_P = OFF_XN + (size_t)R * D * 2;
constexpr size_t OFF_G = OFF_P + (size_t)R * NP * 2;
constexpr size_t OFF_BC = OFF_G + (size_t)R * 16 * 4;
constexpr size_t OFF_CC = OFF_BC + (size_t)R * 8 * 4;
constexpr size_t OFF_CM = OFF_CC + (size_t)R * 8 * 4;
constexpr size_t OFF_WT = OFF_CM + (size_t)R * 8 * 4;
constexpr size_t OFF_CHS = OFF_WT + (size_t)R * 8 * 4;
constexpr size_t OFF_MST = al256(OFF_CHS + (size_t)NCHUNK * 8 * 2 * 4);
constexpr size_t OFF_KC = al256(OFF_MST + (size_t)NCHUNK * 8 * 4);
constexpr size_t OFF_QC = OFF_KC + (size_t)R * DM * 2;
constexpr size_t OFF_KWF = OFF_QC + (size_t)R * DM * 2;
constexpr size_t OFF_KWB = OFF_KWF + (size_t)R * DM * 2;
constexpr size_t OFF_UT = OFF_KWB + (size_t)R * DM * 2;
constexpr size_t SZ_UT = (size_t)NCHUNK * NH * 2 * DH * DH * 2;
constexpr size_t OFF_CT = OFF_UT + SZ_UT;
constexpr size_t OFF_NV = OFF_CT + SZ_UT;
constexpr size_t OFF_NS = OFF_NV + (size_t)NCHUNK * NH * 2 * DH * 4;
constexpr size_t OFF_SR = OFF_NS + (size_t)NCHUNK * NH * 2 * DH * 4;
constexpr size_t OFF_PC = OFF_SR + (size_t)NCHUNK * NH * CHUNK * CHUNK * 4;
constexpr size_t OFF_RF = OFF_PC + (size_t)NCHUNK * NH * CHUNK * CHUNK * 2;
constexpr size_t OFF_HS = OFF_RF + (size_t)R * NH * 2 * 4;
constexpr size_t OFF_HM = OFF_HS + (size_t)R * DM * 4;
constexpr size_t OFF_ZTL = OFF_HM + (size_t)R * DM * 2;
constexpr size_t OFF_ZTC = OFF_ZTL + (size_t)2048 * 4096 * 2;
constexpr size_t OFF_YF = OFF_ZTC + (size_t)2048 * 512 * 2;
constexpr size_t OFF_YC = OFF_YF + (size_t)R * DF * 2;
constexpr size_t OFF_PM = OFF_YC + (size_t)R * DC * 2;
constexpr size_t OFF_MG = OFF_PM + (size_t)R * D * 4;
constexpr size_t OFF_ACT = OFF_MG + (size_t)R * D * 2;
constexpr size_t WS_END = OFF_ACT + (size_t)R * DFF * 2;
static_assert(WS_END <= (size_t)4 * DEPTH * D * NIN * 4, "workspace map exceeds the guaranteed d_ws size");
static_assert((size_t)R * NUP * 2 <= (size_t)R * NP * 2, "u overlays P");

struct Params {
    const float *x, *c, *ctx, *c_ctx, *w_mod, *b_mod, *norm1_w, *norm2_w, *w_in, *b_in, *conv_q_w, *conv_k_w, *mlstm_norm_w, *w_pm, *w_pf, *w_pc, *conv_c_w, *w_o, *w_up,
        *conv_ff_w, *w_down, *final_norm_w;
    float* out; unsigned char* ws;
};
#define WSP(T, off) ((T*)(p.ws + (off)))

__device__ __forceinline__ float bf2f(bf16_t v) { return __uint_as_float(((unsigned)v) << 16); }
__device__ __forceinline__ unsigned f2bf(float f) { unsigned u = __float_as_uint(f); return (u + 0x7fffu + ((u >> 16) & 1u)) >> 16; }
__device__ __forceinline__ unsigned pk2(float lo, float hi) { return f2bf(lo) | (f2bf(hi) << 16); }
__device__ __forceinline__ float sigmoidf_(float x) { return 1.f / (1.f + __expf(-x)); }
__device__ __forceinline__ float siluf_(float x) { return x / (1.f + __expf(-x)); }
__device__ __forceinline__ float wave_sum(float v) {
#pragma unroll
    for (int o = 1; o < 64; o <<= 1) v += __shfl_xor(v, o);
    return v;
}
__device__ __forceinline__ void unpack8(u32x4 w, float (&f)[8]) {
    f[0] = __uint_as_float(w.x << 16); f[1] = __uint_as_float(w.x & 0xffff0000u); f[2] = __uint_as_float(w.y << 16); f[3] = __uint_as_float(w.y & 0xffff0000u);
    f[4] = __uint_as_float(w.z << 16); f[5] = __uint_as_float(w.z & 0xffff0000u); f[6] = __uint_as_float(w.w << 16); f[7] = __uint_as_float(w.w & 0xffff0000u);
}
__device__ __forceinline__ u32x4 pack8(const float (&f)[8]) { u32x4 w; w.x = pk2(f[0], f[1]); w.y = pk2(f[2], f[3]); w.z = pk2(f[4], f[5]); w.w = pk2(f[6], f[7]); return w; }
__device__ __forceinline__ void rowinfo(int r, int& mj, int& t, int& T) { if (r < RL) { mj = r >> 11; t = r & (SEQ - 1); T = SEQ; } else { mj = 4; t = (r - RL) & (CTX - 1); T = CTX; } }
__device__ __forceinline__ int chunk_row0(int cidx) { return cidx < 64 ? (cidx >> 4) * SEQ + (cidx & 15) * CHUNK : RL + ((cidx - 64) >> 1) * CTX + ((cidx - 64) & 1) * CHUNK; }
__device__ __forceinline__ int scan_chunk(int b, int dir, int step) {
    if (step < 2) { const int j = dir ? 1 - step : step; return 64 + b * 2 + j; }
    const int jj = step - 2, j = dir ? 15 - jj : jj; return b * 16 + j;
}

namespace pg8 {
#define PG8_LAS __attribute__((address_space(3)))
constexpr int BM = 256, BK = 64, HALF = 128, HTB = HALF * BK * 2, STAGE_BYTES = 8 * HTB, NXCD = 8, WGM = 8;
__host__ __device__ __forceinline__ int lds_byte(int r, int c) { const int st = (r >> 4) * 2 + (c >> 5), rr = r & 15, cc = c & 31, ob = rr * 64 + cc * 2; return st * 1024 + (ob ^ (((ob >> 9) & 1) << 5)); }
__host__ __device__ __forceinline__ void stage_rc(int b, int& Rr, int& C) { const int st = b / 1024, sb = b % 1024, swz = sb ^ (((sb >> 9) & 1) << 5); Rr = (st >> 1) * 16 + swz / 64; C = (st & 1) * 32 + (swz % 64) / 2; }
__host__ __device__ __forceinline__ int perm32(int rho) { const int n = rho >> 4, i = rho & 15; return 8 * (i >> 2) + 4 * n + (i & 3); }
struct Unit { int pm, pn; };
struct Gemm { const bf16_t* A; const bf16_t* Bt; int M, N, K, lda, ldb, pad; };
struct StaticOrder {
    int nM, nN, nwg, G, c;
    __host__ __device__ void init(int M, int N, int G_, int c_) { nM = M / BM; nN = N / BM; nwg = nM * nN; G = G_; c = c_; }
    __host__ __device__ bool next(int i, Unit& u) const {
        const long L = (long)i * G + c; if (L >= nwg) return false;
        int wgid = (int)L; { const int q = nwg / NXCD, r = nwg % NXCD, xcd = wgid % NXCD, off = wgid / NXCD; wgid = (xcd < r ? xcd * (q + 1) : r * (q + 1) + (xcd - r) * q) + off; }
        const int nig = WGM * nN, gid = wgid / nig, fm = gid * WGM, gsz = (nM - fm) < WGM ? (nM - fm) : WGM;
        u.pm = fm + ((wgid % nig) % gsz); u.pn = (wgid % nig) / gsz; return true;
    }
    __device__ __forceinline__ void a_ready(const Unit&) const {}
    __device__ __forceinline__ void done(const Unit&) const {}
};

template <class Epi, class Sched, bool ALIGN_EPI = false, bool SP2 = false>
__device__ __forceinline__ void gemm_phase(PG8_LAS unsigned char* lds, const Gemm g, const Sched& S, const Epi& E) {
    const int tid = threadIdx.x, wid = __builtin_amdgcn_readfirstlane(tid >> 6), lane = tid & 63, wr = wid >> 2, wc = wid & 3, fr = lane & 15, fq = lane >> 4;
    const int K = g.K, nt = K / BK;
    unsigned voffA[2], voffB[2];
#pragma unroll
    for (int i = 0; i < 2; ++i) { int Rr, C; stage_rc(tid * 16 + i * 8192, Rr, C); const int Rb = Epi::PERM ? ((Rr & ~31) + perm32(Rr & 31)) : Rr;
        voffA[i] = (unsigned)(Rr * g.lda + C) * 2u; voffB[i] = (unsigned)(Rb * g.ldb + C) * 2u; }
    const size_t kstep = (size_t)(BK * 2);
    const size_t hstepA = (size_t)HALF * g.lda * 2, hstepB = (size_t)HALF * g.ldb * 2;
    const size_t tstepA = 2 * hstepA, tstepB = 2 * hstepB;
    const unsigned ldsw = (unsigned)wid * 1024u;
    const int aoff = lds_byte(wr * 64 + fr, fq * 8), boff = lds_byte(wc * 32 + fr, fq * 8);
#define PG8_SA(b, h) (((b) * 2 + (h)) * HTB)
#define PG8_SB(b, h) ((4 + (b) * 2 + (h)) * HTB)
#define PG8_STAGE(bufoff, gbase, voff) do { _Pragma("unroll") for (int _i = 0; _i < 2; ++_i) \
        __builtin_amdgcn_global_load_lds((const unsigned*)((const char*)(gbase) + (voff)[_i]), (PG8_LAS unsigned*)(lds + (bufoff) + ldsw + _i * 8192), 16, 0, 0); } while (0)
#define PG8_LDA(dst, b, h) do { _Pragma("unroll") for (int m = 0; m < 4; ++m) _Pragma("unroll") for (int k = 0; k < 2; ++k) dst[m][k] = *(const PG8_LAS bf16x8*)(lds + PG8_SA(b, h) + aoff + m * 2048 + k * 1024); } while (0)
#define PG8_LDB(dst, b, h) do { _Pragma("unroll") for (int n = 0; n < 2; ++n) _Pragma("unroll") for (int k = 0; k < 2; ++k) dst[n][k] = *(const PG8_LAS bf16x8*)(lds + PG8_SB(b, h) + boff + n * 2048 + k * 1024); } while (0)
#define PG8_MMA(ai, bj, At, Bt) do { __builtin_amdgcn_s_setprio(1); _Pragma("unroll") for (int m = 0; m < 4; ++m) _Pragma("unroll") for (int n = 0; n < 2; ++n) _Pragma("unroll") for (int k = 0; k < 2; ++k) \
        acc[ai][bj][m][n] = __builtin_amdgcn_mfma_f32_16x16x32_bf16(Bt[n][k], At[m][k], acc[ai][bj][m][n], 0, 0, 0); __builtin_amdgcn_s_setprio(0); } while (0)
#define PG8_WAIT_V(n) asm volatile("s_waitcnt vmcnt(" #n ")" ::: "memory")
#define PG8_WAIT_L(n) asm volatile("s_waitcnt lgkmcnt(" #n ")" ::: "memory")
#define PG8_BAR __builtin_amdgcn_s_barrier()
#define PG8_SCHED __builtin_amdgcn_sched_barrier(0)
    Unit cur, nxt; int ui = 0;
    if (!S.next(0, cur)) return;
    f32x4 acc[2][2][4][2];
#pragma unroll
    for (int a = 0; a < 2; ++a)
#pragma unroll
        for (int b = 0; b < 2; ++b)
#pragma unroll
            for (int m = 0; m < 4; ++m)
#pragma unroll
                for (int n = 0; n < 2; ++n) acc[a][b][m][n] = (f32x4){0.f, 0.f, 0.f, 0.f};
    bf16x8 At[4][2], B0[2][2], B1[2][2];
    const char* cA = (const char*)g.A + (size_t)cur.pm * tstepA; const char* cB = (const char*)g.Bt + (size_t)cur.pn * tstepB;
    S.a_ready(cur);
    if constexpr (SP2) {
        PG8_STAGE(PG8_SB(0, 0), cB, voffB); PG8_STAGE(PG8_SB(0, 1), cB + hstepB, voffB); PG8_STAGE(PG8_SA(0, 0), cA, voffA); PG8_STAGE(PG8_SA(0, 1), cA + hstepA, voffA);
        if (wr == 1) PG8_BAR;
        PG8_WAIT_V(2); PG8_BAR;
        PG8_STAGE(PG8_SB(1, 0), cB + kstep, voffB); PG8_STAGE(PG8_SA(1, 0), cA + kstep, voffA); PG8_STAGE(PG8_SB(1, 1), cB + hstepB + kstep, voffB);
        PG8_WAIT_V(6); PG8_BAR;
    } else {
        PG8_STAGE(PG8_SB(0, 0), cB, voffB); PG8_STAGE(PG8_SA(0, 0), cA, voffA); PG8_STAGE(PG8_SB(0, 1), cB + hstepB, voffB); PG8_STAGE(PG8_SA(0, 1), cA + hstepA, voffA);
        if (wr == 1) PG8_BAR;
        PG8_WAIT_V(4); PG8_BAR;
        PG8_STAGE(PG8_SB(1, 0), cB + kstep, voffB); PG8_STAGE(PG8_SA(1, 0), cA + kstep, voffA); PG8_STAGE(PG8_SB(1, 1), cB + hstepB + kstep, voffB);
        PG8_WAIT_V(6); PG8_BAR;
    }
    for (;;) {
        const bool has_next = S.next(ui + 1, nxt);
        const char* nA = has_next ? (const char*)g.A + (size_t)nxt.pm * tstepA : cA; const char* nB = has_next ? (const char*)g.Bt + (size_t)nxt.pn * tstepB : cB;
        for (int t = 0; t < nt; t += 2) {
            const bool last = (t == nt - 2);
            const char* a1 = cA + (size_t)(t + 1) * kstep;
            const char* a2 = last ? nA : cA + (size_t)(t + 2) * kstep; const char* b2 = last ? nB : cB + (size_t)(t + 2) * kstep;
            const char* a3 = a2 + kstep; const char* b3 = b2 + kstep;
            if (last && has_next) S.a_ready(nxt);
            if constexpr (SP2) {
            PG8_LDB(B0, 0, 0); PG8_LDB(B1, 0, 1); PG8_SCHED; PG8_LDA(At, 0, 0); PG8_STAGE(PG8_SA(1, 1), a1 + hstepA, voffA);
            PG8_WAIT_V(8); PG8_WAIT_L(0); PG8_BAR; PG8_MMA(0, 0, At, B0); PG8_MMA(0, 1, At, B1); PG8_BAR; PG8_SCHED;
            PG8_LDA(At, 0, 1); PG8_STAGE(PG8_SB(0, 0), b2, voffB); PG8_STAGE(PG8_SB(0, 1), b2 + hstepB, voffB); PG8_STAGE(PG8_SA(0, 0), a2, voffA);
            PG8_WAIT_V(8); PG8_WAIT_L(0); PG8_BAR; PG8_MMA(1, 0, At, B0); PG8_MMA(1, 1, At, B1); PG8_BAR; PG8_SCHED;
            PG8_LDB(B0, 1, 0); PG8_LDB(B1, 1, 1); PG8_SCHED; PG8_LDA(At, 1, 0); PG8_STAGE(PG8_SA(0, 1), a2 + hstepA, voffA);
            PG8_WAIT_V(8); PG8_WAIT_L(0); PG8_BAR; PG8_MMA(0, 0, At, B0); PG8_MMA(0, 1, At, B1); PG8_BAR; PG8_SCHED;
            PG8_LDA(At, 1, 1); PG8_STAGE(PG8_SB(1, 0), b3, voffB); PG8_STAGE(PG8_SB(1, 1), b3 + hstepB, voffB); PG8_STAGE(PG8_SA(1, 0), a3, voffA);
            PG8_WAIT_V(8); PG8_WAIT_L(0); PG8_BAR; PG8_MMA(1, 0, At, B0); PG8_MMA(1, 1, At, B1); PG8_BAR; PG8_SCHED;
            } else {
            PG8_LDB(B0, 0, 0); PG8_SCHED; PG8_LDA(At, 0, 0); PG8_STAGE(PG8_SA(1, 1), a1 + hstepA, voffA);
            PG8_WAIT_L(8); PG8_BAR; PG8_WAIT_L(0); PG8_MMA(0, 0, At, B0); PG8_BAR; PG8_SCHED;
            PG8_LDB(B1, 0, 1); PG8_STAGE(PG8_SB(0, 0), b2, voffB);
            PG8_BAR; PG8_WAIT_L(0); PG8_MMA(0, 1, At, B1); PG8_BAR;
            PG8_LDA(At, 0, 1); PG8_STAGE(PG8_SA(0, 0), a2, voffA);
            PG8_BAR; PG8_WAIT_L(0); PG8_MMA(1, 0, At, B0); PG8_BAR; PG8_SCHED;
            PG8_STAGE(PG8_SB(0, 1), b2 + hstepB, voffB);
            PG8_WAIT_V(6); PG8_BAR; PG8_MMA(1, 1, At, B1); PG8_BAR;
            PG8_LDB(B0, 1, 0); PG8_SCHED; PG8_LDA(At, 1, 0); PG8_STAGE(PG8_SA(0, 1), a2 + hstepA, voffA);
            PG8_WAIT_L(8); PG8_BAR; PG8_WAIT_L(0); PG8_MMA(0, 0, At, B0); PG8_BAR; PG8_SCHED;
            PG8_LDB(B1, 1, 1); PG8_STAGE(PG8_SB(1, 0), b3, voffB);
            PG8_BAR; PG8_WAIT_L(0); PG8_MMA(0, 1, At, B1); PG8_BAR;
            PG8_LDA(At, 1, 1); PG8_STAGE(PG8_SA(1, 0), a3, voffA);
            PG8_BAR; PG8_WAIT_L(0); PG8_MMA(1, 0, At, B0); PG8_BAR; PG8_SCHED;
            PG8_STAGE(PG8_SB(1, 1), b3 + hstepB, voffB);
            PG8_WAIT_V(6); PG8_BAR; PG8_MMA(1, 1, At, B1); PG8_BAR;
            }
        }
        if constexpr (ALIGN_EPI) { if (wr == 0) PG8_BAR; }
        E(acc, cur, wr, wc, fr, fq); S.done(cur);
        if (!has_next) break;
#pragma unroll
        for (int a = 0; a < 2; ++a)
#pragma unroll
            for (int b = 0; b < 2; ++b)
#pragma unroll
                for (int m = 0; m < 4; ++m)
#pragma unroll
                    for (int n = 0; n < 2; ++n) acc[a][b][m][n] = (f32x4){0.f, 0.f, 0.f, 0.f};
        cur = nxt; cA = nA; cB = nB; ++ui;
        if constexpr (ALIGN_EPI) { if (wr == 1) PG8_BAR; }
    }
    PG8_WAIT_V(0);
    if constexpr (!ALIGN_EPI) { if (wr == 0) PG8_BAR; }
    PG8_BAR;
#undef PG8_SA
#undef PG8_SB
#undef PG8_STAGE
#undef PG8_LDA
#undef PG8_LDB
#undef PG8_MMA
#undef PG8_WAIT_V
#undef PG8_WAIT_L
#undef PG8_BAR
#undef PG8_SCHED
}
}

template <class F> __device__ __forceinline__ void epi_foreach(const f32x4 (&acc)[2][2][4][2], const pg8::Unit& u, int wr, int wc, int fr, int fq, F&& f) {
    const int row0 = u.pm * 256 + wr * 64 + fr, col0 = u.pn * 256 + wc * 32 + 8 * fq;
#pragma unroll
    for (int ai = 0; ai < 2; ++ai)
#pragma unroll
        for (int m = 0; m < 4; ++m)
#pragma unroll
            for (int bj = 0; bj < 2; ++bj) f(row0 + ai * 128 + m * 16, col0 + bj * 128, acc[ai][bj][m][0], acc[ai][bj][m][1]);
}
__device__ __forceinline__ u32x4 pack8v(f32x4 v0, f32x4 v1) { u32x4 w; w.x = pk2(v0[0], v0[1]); w.y = pk2(v0[2], v0[3]); w.z = pk2(v1[0], v1[1]); w.w = pk2(v1[2], v1[3]); return w; }

struct EpiInProj {
    static constexpr bool PERM = true;
    bf16_t* P; float* G; const float* bias;
    __device__ __forceinline__ void operator()(const f32x4 (&acc)[2][2][4][2], const pg8::Unit& u, int wr, int wc, int fr, int fq) const {
        if (u.pn < 48) {
            epi_foreach(acc, u, wr, wc, fr, fq, [&](int row, int col, f32x4 v0, f32x4 v1) {
                const f32x4 b0 = *(const f32x4*)(bias + col), b1 = *(const f32x4*)(bias + col + 4);
                *(u32x4*)(P + (size_t)row * NP + col) = pack8v(v0 + b0, v1 + b1); });
        } else if (wc == 0 && fq < 2) {
            const int row0 = u.pm * 256 + wr * 64 + fr;
            const f32x4 b0 = *(const f32x4*)(bias + NP + 8 * fq), b1 = *(const f32x4*)(bias + NP + 8 * fq + 4);
#pragma unroll
            for (int ai = 0; ai < 2; ++ai)
#pragma unroll
                for (int m = 0; m < 4; ++m) { float* gp = G + (size_t)(row0 + ai * 128 + m * 16) * 16 + 8 * fq;
                    *(f32x4*)gp = acc[ai][0][m][0] + b0; *(f32x4*)(gp + 4) = acc[ai][0][m][1] + b1; }
        }
    }
};
struct EpiBf16 {
    static constexpr bool PERM = true;
    bf16_t* O; int ldc; int split_cols; size_t split_stride;
    __device__ __forceinline__ void operator()(const f32x4 (&acc)[2][2][4][2], const pg8::Unit& u, int wr, int wc, int fr, int fq) const {
        int colt = u.pn * 256; bf16_t* base = O;
        if (split_cols) { const int t = colt / split_cols; base += (size_t)t * split_stride; colt -= t * split_cols; }
        const int cshift = colt - u.pn * 256;
        epi_foreach(acc, u, wr, wc, fr, fq, [&](int row, int col, f32x4 v0, f32x4 v1) { *(u32x4*)(base + (size_t)row * ldc + col + cshift) = pack8v(v0, v1); });
    }
};
template <int BR> struct EpiMerge {
    static constexpr bool PERM = true;
    const bf16_t* P; float* Pm; bf16_t* MG;
    __device__ __forceinline__ void operator()(const f32x4 (&acc)[2][2][4][2], const pg8::Unit& u, int wr, int wc, int fr, int fq) const {
        epi_foreach(acc, u, wr, wc, fr, fq, [&](int row, int col, f32x4 v0, f32x4 v1) {
            float g[8]; unpack8(*(const u32x4*)(P + (size_t)row * NP + PGM + BR * D + col), g);
            f32x4 g0 = {sigmoidf_(g[0]), sigmoidf_(g[1]), sigmoidf_(g[2]), sigmoidf_(g[3])}, g1 = {sigmoidf_(g[4]), sigmoidf_(g[5]), sigmoidf_(g[6]), sigmoidf_(g[7])};
            float* pp = Pm + (size_t)row * D + col;
            f32x4 a0 = g0 * v0, a1 = g1 * v1;
            if (BR > 0) { a0 += *(const f32x4*)pp; a1 += *(const f32x4*)(pp + 4); }
            if (BR < 2) { *(f32x4*)pp = a0; *(f32x4*)(pp + 4) = a1; }
            else *(u32x4*)(MG + (size_t)row * D + col) = pack8v(a0, a1); });
    }
};
struct EpiResid {
    static constexpr bool PERM = true;
    float* H; const float* gate;
    __device__ __forceinline__ void operator()(const f32x4 (&acc)[2][2][4][2], const pg8::Unit& u, int wr, int wc, int fr, int fq) const {
        const float* gp = gate + (size_t)(u.pm < 32 ? (u.pm >> 3) : 4) * (6 * D);
        epi_foreach(acc, u, wr, wc, fr, fq, [&](int row, int col, f32x4 v0, f32x4 v1) {
            float* hp = H + (size_t)row * D + col;
            const f32x4 g0 = *(const f32x4*)(gp + col), g1 = *(const f32x4*)(gp + col + 4);
            *(f32x4*)hp = *(const f32x4*)hp + g0 * v0; *(f32x4*)(hp + 4) = *(const f32x4*)(hp + 4) + g1 * v1; });
    }
};

template <class Epi> __global__ __launch_bounds__(512, 2) void k_gemm(pg8::Gemm g, Epi E) {
    extern __shared__ __attribute__((aligned(16))) unsigned char dyn_lds[];
    pg8::StaticOrder S; S.init(g.M, g.N, (int)gridDim.x, (int)blockIdx.x);
    pg8::gemm_phase<Epi, pg8::StaticOrder, true, true>((PG8_LAS unsigned char*)dyn_lds, g, S, E);
}

__device__ __forceinline__ bf16x8 gather8(const bf16_t* p, size_t stride) {
    bf16x8 v;
#pragma unroll
    for (int j = 0; j < 8; ++j) v[j] = (short)p[(size_t)j * stride];
    return v;
}
template <bool AV, bool BV>
__device__ __forceinline__ void wave_mm32(const bf16_t* A, size_t sam, size_t sak, const bf16_t* B, size_t sbk, size_t sbn, int K, f32x4 (&acc)[2][2], int lane) {
    const int fr = lane & 15, fq = lane >> 4;
    for (int k0 = 0; k0 < K; k0 += 32) {
        bf16x8 a[2], b[2];
#pragma unroll
        for (int mi = 0; mi < 2; ++mi) { const bf16_t* q = A + (size_t)(16 * mi + fr) * sam + (size_t)(k0 + 8 * fq) * sak; a[mi] = AV ? *(const bf16x8*)q : gather8(q, sak); }
#pragma unroll
        for (int ni = 0; ni < 2; ++ni) { const bf16_t* q = B + (size_t)(16 * ni + fr) * sbn + (size_t)(k0 + 8 * fq) * sbk; b[ni] = BV ? *(const bf16x8*)q : gather8(q, sbk); }
#pragma unroll
        for (int mi = 0; mi < 2; ++mi)
#pragma unroll
            for (int ni = 0; ni < 2; ++ni) acc[mi][ni] = __builtin_amdgcn_mfma_f32_16x16x32_bf16(a[mi], b[ni], acc[mi][ni], 0, 0, 0);
    }
}
#define ZERO_ACC22(acc) do { _Pragma("unroll") for (int _a = 0; _a < 2; ++_a) _Pragma("unroll") for (int _b = 0; _b < 2; ++_b) acc[_a][_b] = (f32x4){0.f, 0.f, 0.f, 0.f}; } while (0)

__device__ __forceinline__ void transpose_item(const float* W, int N, int K, bf16_t* WT, int dst_row0, int src_col0, int nvalid, int k0, LAS float* scr, int lane) {
    const int j = lane & 31;
#pragma unroll 8
    for (int i = 0; i < 32; ++i) { const int kk = 2 * i + (lane >> 5); scr[kk * 33 + j] = j < nvalid ? W[(size_t)(k0 + kk) * N + src_col0 + j] : 0.f; }
    asm volatile("s_waitcnt lgkmcnt(0)" ::: "memory");
    const int c = lane & 7;
#pragma unroll
    for (int j4 = 0; j4 < 4; ++j4) { const int n = (lane >> 3) + 8 * j4; const LAS float* s = scr + (8 * c) * 33 + n;
        u32x4 o; o.x = pk2(s[0 * 33], s[1 * 33]); o.y = pk2(s[2 * 33], s[3 * 33]); o.z = pk2(s[4 * 33], s[5 * 33]); o.w = pk2(s[6 * 33], s[7 * 33]);
        *(u32x4*)(WT + (size_t)(dst_row0 + n) * K + k0 + 8 * c) = o; }
    asm volatile("s_waitcnt lgkmcnt(0)" ::: "memory");
}
constexpr int I_IN = (NINP / 32) * (D / 64), I_PM = (D / 32) * (DM / 64), I_PF = (D / 32) * (DF / 64), I_PC = (D / 32) * (DC / 64), I_O = (D / 32) * (D / 64),
              I_UP = (NUP / 32) * (D / 64), I_DN = (D / 32) * (DFF / 64), I_LAYER = I_IN + I_PM + I_PF + I_PC + I_O + I_UP + I_DN;
__global__ __launch_bounds__(256) void k_convert(Params p) {
    __shared__ float scr_all[4 * 64 * 33];
    const int lane = threadIdx.x & 63, wave = threadIdx.x >> 6;
    LAS float* scr = (LAS float*)scr_all + wave * 64 * 33;
    const int gw = blockIdx.x * 4 + wave, NGW = gridDim.x * 4;
    for (int it = gw; it < DEPTH * I_LAYER; it += NGW) {
        const int l = it / I_LAYER; int r = it % I_LAYER;
        if (r < I_IN) { const int nkb = D / 64, kb = r % nkb, grp = r / nkb, j0 = 32 * grp; int src0, nv;
            if (j0 < 2048) { src0 = j0; nv = 32; } else if (j0 < NP) { src0 = j0 + 16; nv = 32; } else if (j0 == NP) { src0 = 2048; nv = 16; } else { src0 = 0; nv = 0; }
            transpose_item(p.w_in + (size_t)l * D * NIN, NIN, D, WSP(bf16_t, OFF_WIN) + (size_t)l * NINP * D, j0, src0, nv, 64 * kb, scr, lane); continue; } r -= I_IN;
        if (r < I_PM) { const int nkb = DM / 64, kb = r % nkb, grp = r / nkb;
            transpose_item(p.w_pm + (size_t)l * DM * D, D, DM, WSP(bf16_t, OFF_WPM) + (size_t)l * D * DM, 32 * grp, 32 * grp, 32, 64 * kb, scr, lane); continue; } r -= I_PM;
        if (r < I_PF) { const int nkb = DF / 64, kb = r % nkb, grp = r / nkb;
            transpose_item(p.w_pf + (size_t)l * DF * D, D, DF, WSP(bf16_t, OFF_WPF) + (size_t)l * D * DF, 32 * grp, 32 * grp, 32, 64 * kb, scr, lane); continue; } r -= I_PF;
        if (r < I_PC) { const int nkb = DC / 64, kb = r % nkb, grp = r / nkb;
            transpose_item(p.w_pc + (size_t)l * DC * D, D, DC, WSP(bf16_t, OFF_WPC) + (size_t)l * D * DC, 32 * grp, 32 * grp, 32, 64 * kb, scr, lane); continue; } r -= I_PC;
        if (r < I_O) { const int nkb = D / 64, kb = r % nkb, grp = r / nkb;
            transpose_item(p.w_o + (size_t)l * D * D, D, D, WSP(bf16_t, OFF_WO) + (size_t)l * D * D, 32 * grp, 32 * grp, 32, 64 * kb, scr, lane); continue; } r -= I_O;
        if (r < I_UP) { const int nkb = D / 64, kb = r % nkb, grp = r / nkb;
            transpose_item(p.w_up + (size_t)l * D * NUP, NUP, D, WSP(bf16_t, OFF_WUP) + (size_t)l * NUP * D, 32 * grp, 32 * grp, 32, 64 * kb, scr, lane); continue; } r -= I_UP;
        { const int nkb = DFF / 64, kb = r % nkb, grp = r / nkb;
            transpose_item(p.w_down + (size_t)l * DFF * D, D, DFF, WSP(bf16_t, OFF_WDN) + (size_t)l * D * DFF, 32 * grp, 32 * grp, 32, 64 * kb, scr, lane); }
    }
}
__global__ __launch_bounds__(512) void k_tables(Params p) {
    const size_t gt = (size_t)blockIdx.x * 512 + threadIdx.x, NT = (size_t)gridDim.x * 512;
    bf16_t* csl = WSP(bf16_t, OFF_CSL);
    for (size_t i = gt; i < (size_t)2048 * 4096; i += NT) { const int tau = (int)(i >> 12), k = (int)(i & 4095), t = k & 2047; const int idx = (tau * t) & 2047;
        const float a = (float)idx * (1.0f / 1024.0f); const float v = (k < 2048 ? cospif(a) : -sinpif(a)) * (1.0f / 512.0f); csl[i] = (bf16_t)f2bf(v); }
    bf16_t* csc = WSP(bf16_t, OFF_CSC);
    for (size_t i = gt; i < (size_t)256 * 512; i += NT) { const int tau = (int)(i >> 9), k = (int)(i & 511), t = k & 255; const int idx = (tau * t) & 255;
        const float a = (float)idx * (1.0f / 128.0f); const float v = (k < 256 ? cospif(a) : -sinpif(a)) * 0.005524271728019903f  ; csc[i] = (bf16_t)f2bf(v); }
    bf16_t* ft = WSP(bf16_t, OFF_FT);
    for (size_t i = gt; i < (size_t)256 * 128; i += NT) { const int kp = (int)(i >> 7), c = (int)(i & 127), kap = kp & 127; const int idx = (c * kap) & 127;
        const float a = (float)idx * (1.0f / 64.0f); ft[i] = (bf16_t)f2bf(kp < 128 ? cospif(a) : sinpif(a)); }
    float* binr = WSP(float, OFF_BINR);
    for (size_t i = gt; i < (size_t)DEPTH * NINP; i += NT) { const int l = (int)(i / NINP), j = (int)(i % NINP);
        float v = 0.f; if (j < 2048) v = p.b_in[(size_t)l * NIN + j]; else if (j < NP) v = p.b_in[(size_t)l * NIN + j + 16]; else if (j < NP + 16) v = p.b_in[(size_t)l * NIN + 2048 + (j - NP)];
        binr[i] = v; }
    f32x4* h4 = WSP(f32x4, OFF_H);
    for (size_t i = gt; i < (size_t)R * D / 4; i += NT) h4[i] = i < (size_t)RL * D / 4 ? ((const f32x4*)p.x)[i] : ((const f32x4*)p.ctx)[i - (size_t)RL * D / 4];
}
__global__ __launch_bounds__(512) void k_mod(Params p) {
    __shared__ float sc[5][D];
    __shared__ f32x4 red[8][5][16];
    const int tid = threadIdx.x;
    for (int i = tid; i < 5 * D; i += 512) { const int j = i / D, k = i % D; const float v = j < 4 ? p.c[(size_t)j * D + k] : p.c_ctx[k]; sc[j][k] = siluf_(v); }
    __syncthreads();
    float* mod = WSP(float, OFF_MOD);
    const int cl = tid & 15, kg = tid >> 4;
    for (int unit = blockIdx.x; unit < DEPTH * (6 * D / 64); unit += gridDim.x) {
        const int l = unit / (6 * D / 64), n0 = (unit % (6 * D / 64)) * 64;
        f32x4 a[5];
#pragma unroll
        for (int j = 0; j < 5; ++j) a[j] = (f32x4){0.f, 0.f, 0.f, 0.f};
        const float* wp = p.w_mod + (size_t)l * D * 6 * D + n0 + 4 * cl;
        for (int k = kg; k < D; k += 32) { const f32x4 w = *(const f32x4*)(wp + (size_t)k * 6 * D);
#pragma unroll
            for (int j = 0; j < 5; ++j) a[j] += sc[j][k] * w; }
#pragma unroll
        for (int j = 0; j < 5; ++j) {
#pragma unroll
            for (int e = 0; e < 4; ++e) { float v = a[j][e]; v += __shfl_xor(v, 16); v += __shfl_xor(v, 32); a[j][e] = v; }
            if ((tid & 63) < 16) red[tid >> 6][j][cl] = a[j]; }
        __syncthreads();
        if (tid < 5 * 64) { const int j = tid / 64, cc = tid % 64; float s = 0.f;
            for (int g = 0; g < 8; ++g) s += ((const float*)&red[g][j][0])[cc];
            mod[((size_t)l * 5 + j) * 6 * D + n0 + cc] = s + p.b_mod[(size_t)l * 6 * D + n0 + cc]; }
        __syncthreads();
    }
}

__global__ __launch_bounds__(512) void k_norm(Params p, int l, int which) {
    const int lane = threadIdx.x & 63, gw = blockIdx.x * 8 + (threadIdx.x >> 6), NGW = gridDim.x * 8;
    const float* nw = (which ? p.norm2_w : p.norm1_w) + (size_t)l * D;
    const float* mod = WSP(float, OFF_MOD) + (size_t)l * 5 * 6 * D;
    const float* H = WSP(float, OFF_H); bf16_t* XN = WSP(bf16_t, OFF_XN);
    for (int r = gw; r < R; r += NGW) {
        int mj, t, T; rowinfo(r, mj, t, T);
        const float* sh = mod + (size_t)mj * 6 * D + (which ? 3 : 0) * D; const float* sc = sh + D;
        const f32x4* xr = (const f32x4*)(H + (size_t)r * D) + lane;
        f32x4 v[8]; float ss = 0.f;
#pragma unroll
        for (int j = 0; j < 8; ++j) { v[j] = xr[64 * j]; ss += (v[j][0] * v[j][0] + v[j][1] * v[j][1]) + (v[j][2] * v[j][2] + v[j][3] * v[j][3]); }
        const float rstd = rsqrtf(wave_sum(ss) * (1.f / D) + EPS);
        u32x2* o = (u32x2*)(XN + (size_t)r * D) + lane;
#pragma unroll
        for (int j = 0; j < 8; ++j) { const int col = 4 * (lane + 64 * j);
            const f32x4 w = *(const f32x4*)(nw + col), s = *(const f32x4*)(sc + col), b = *(const f32x4*)(sh + col);
            const f32x4 y = (v[j] * rstd * w) * (1.f + s) + b;
            u32x2 q; q.x = pk2(y[0], y[1]); q.y = pk2(y[2], y[3]); o[64 * j] = q; }
    }
}
__global__ __launch_bounds__(512) void k_final(Params p) {
    const int lane = threadIdx.x & 63, gw = blockIdx.x * 8 + (threadIdx.x >> 6), NGW = gridDim.x * 8;
    const float* H = WSP(float, OFF_H);
    for (int r = gw; r < RL; r += NGW) {
        const f32x4* xr = (const f32x4*)(H + (size_t)r * D) + lane;
        f32x4 v[8]; float ss = 0.f;
#pragma unroll
        for (int j = 0; j < 8; ++j) { v[j] = xr[64 * j]; ss += (v[j][0] * v[j][0] + v[j][1] * v[j][1]) + (v[j][2] * v[j][2] + v[j][3] * v[j][3]); }
        const float rstd = rsqrtf(wave_sum(ss) * (1.f / D) + EPS);
        f32x4* o = (f32x4*)(p.out + (size_t)r * D) + lane;
#pragma unroll
        for (int j = 0; j < 8; ++j) { const f32x4 w = *(const f32x4*)(p.final_norm_w + 4 * (lane + 64 * j)); o[64 * j] = v[j] * rstd * w; }
    }
}

__device__ __forceinline__ float wave_incl_sum(float v, int lane) {
#pragma unroll
    for (int o = 1; o < 64; o <<= 1) { const float t = __shfl_up(v, o); if (lane >= o) v += t; }
    return v;
}
__device__ __forceinline__ float wave_incl_max(float v, int lane) {
#pragma unroll
    for (int o = 1; o < 64; o <<= 1) { const float t = __shfl_up(v, o); if (lane >= o) v = fmaxf(v, t); }
    return v;
}
__device__ __forceinline__ float logsigmoidf_(float x) { return fminf(x, 0.f) - log1pf(__expf(-fabsf(x))); }
__global__ __launch_bounds__(512) void k_gateprep(Params p) {
    const int lane = threadIdx.x & 63, gw = blockIdx.x * 8 + (threadIdx.x >> 6), NGW = gridDim.x * 8;
    const float* G = WSP(float, OFF_G);
    float *BC = WSP(float, OFF_BC), *CC = WSP(float, OFF_CC), *CM = WSP(float, OFF_CM), *WT = WSP(float, OFF_WT), *CHS = WSP(float, OFF_CHS);
    for (int task = gw; task < NCHUNK * 8; task += NGW) {
        const int cidx = task >> 3, dh = task & 7, dir = dh >> 2, h = dh & 3, row0 = chunk_row0(cidx);
        const int s0 = dir ? 127 - lane : lane, s1 = dir ? 63 - lane : lane + 64;
        const float i0 = G[(size_t)(row0 + s0) * 16 + dir * 8 + h], f0 = G[(size_t)(row0 + s0) * 16 + dir * 8 + 4 + h];
        const float i1 = G[(size_t)(row0 + s1) * 16 + dir * 8 + h], f1 = G[(size_t)(row0 + s1) * 16 + dir * 8 + 4 + h];
        float b0 = wave_incl_sum(logsigmoidf_(f0), lane); const float tot0 = __shfl(b0, 63);
        float b1 = wave_incl_sum(logsigmoidf_(f1), lane) + tot0;
        const float c0 = i0 - b0, c1 = i1 - b1;
        float m0 = wave_incl_max(c0, lane); const float mx0 = __shfl(m0, 63);
        float m1 = fmaxf(wave_incl_max(c1, lane), mx0);
        const float bend = __shfl(b1, 63), cend = __shfl(m1, 63);
        const size_t o0 = (size_t)(row0 + s0) * 8 + dh, o1 = (size_t)(row0 + s1) * 8 + dh;
        BC[o0] = b0; BC[o1] = b1; CC[o0] = c0; CC[o1] = c1; CM[o0] = m0; CM[o1] = m1; WT[o0] = __expf(c0 - cend); WT[o1] = __expf(c1 - cend);
        if (lane == 0) { CHS[(size_t)task * 2] = bend; CHS[(size_t)task * 2 + 1] = bend + cend; }
    }
}
__global__ __launch_bounds__(512) void k_convs(Params p, int l) {
    const size_t gt = (size_t)blockIdx.x * 512 + threadIdx.x, NT = (size_t)gridDim.x * 512;
    const bf16_t* P = WSP(bf16_t, OFF_P); const float* WT = WSP(float, OFF_WT);
    bf16_t *KC = WSP(bf16_t, OFF_KC), *QC = WSP(bf16_t, OFF_QC), *KWF = WSP(bf16_t, OFF_KWF), *KWB = WSP(bf16_t, OFF_KWB), *YC = WSP(bf16_t, OFF_YC);
    const float *wk = p.conv_k_w + (size_t)l * 3 * DM, *wq = p.conv_q_w + (size_t)l * 3 * DM, *wc = p.conv_c_w + (size_t)l * 3 * DC;
    for (size_t i = gt; i < (size_t)R * 128; i += NT) {
        const int r = (int)(i >> 7), c = (int)(i & 127) * 8, h = c >> 8; int mj, t, T; rowinfo(r, mj, t, T);
        const bool hp = t > 0, hn = t < T - 1;
        const bf16_t* pr = P + (size_t)r * NP;
        float a0[8], a1[8], a2[8], o[8], o2[8], o3[8];
        unpack8(*(const u32x4*)(pr + PK + c), a1);
        if (hp) unpack8(*(const u32x4*)(pr - NP + PK + c), a0);
        if (hn) unpack8(*(const u32x4*)(pr + NP + PK + c), a2);
        const float wf = WT[(size_t)r * 8 + h], wb = WT[(size_t)r * 8 + 4 + h];
#pragma unroll
        for (int j = 0; j < 8; ++j) { float v = wk[DM + c + j] * a1[j]; if (hp) v += wk[c + j] * a0[j]; if (hn) v += wk[2 * DM + c + j] * a2[j]; v = siluf_(v); o[j] = v; o2[j] = v * wf; o3[j] = v * wb; }
        *(u32x4*)(KC + (size_t)r * DM + c) = pack8(o); *(u32x4*)(KWF + (size_t)r * DM + c) = pack8(o2); *(u32x4*)(KWB + (size_t)r * DM + c) = pack8(o3);
        unpack8(*(const u32x4*)(pr + PQ + c), a1);
        if (hp) unpack8(*(const u32x4*)(pr - NP + PQ + c), a0);
        if (hn) unpack8(*(const u32x4*)(pr + NP + PQ + c), a2);
#pragma unroll
        for (int j = 0; j < 8; ++j) { float v = wq[DM + c + j] * a1[j]; if (hp) v += wq[c + j] * a0[j]; if (hn) v += wq[2 * DM + c + j] * a2[j]; o[j] = siluf_(v) * 0.0625f; }
        *(u32x4*)(QC + (size_t)r * DM + c) = pack8(o);
        if (c < DC) {
            const bool cp = r < RL ? (t & 63) > 0 : t > 0, cn = r < RL ? (t & 63) < 63 : t < T - 1;
            float x0[8], x1[8], y0[8], y1[8], z0[8], z1[8], cb[8];
            unpack8(*(const u32x4*)(pr + PCC + c), x0); unpack8(*(const u32x4*)(pr + PCX + c), x1); unpack8(*(const u32x4*)(pr + PCB + c), cb);
            if (cp) { unpack8(*(const u32x4*)(pr - NP + PCC + c), y0); unpack8(*(const u32x4*)(pr - NP + PCX + c), y1); }
            if (cn) { unpack8(*(const u32x4*)(pr + NP + PCC + c), z0); unpack8(*(const u32x4*)(pr + NP + PCX + c), z1); }
#pragma unroll
            for (int j = 0; j < 8; ++j) { float v = wc[DC + c + j] * (x0[j] * x1[j]); if (cp) v += wc[c + j] * (y0[j] * y1[j]); if (cn) v += wc[2 * DC + c + j] * (z0[j] * z1[j]); o[j] = cb[j] * v; }
            *(u32x4*)(YC + (size_t)r * DC + c) = pack8(o);
        }
    }
}
__global__ __launch_bounds__(512) void k_fourier1(Params p) {
    const int lane = threadIdx.x & 63, gw = blockIdx.x * 8 + (threadIdx.x >> 6), NGW = gridDim.x * 8, fr = lane & 15, fq = lane >> 4;
    const bf16_t* P = WSP(bf16_t, OFF_P); const bf16_t* FT = WSP(bf16_t, OFF_FT);
    bf16_t *ZTL = WSP(bf16_t, OFF_ZTL), *ZTC = WSP(bf16_t, OFF_ZTC);
    for (int task = gw; task < (R / 32) * 4 * 8; task += NGW) {
        const int kb = task & 7, g = (task >> 3) & 3, rb = task >> 5, r0 = rb * 32;
        f32x4 acc[2][2]; ZERO_ACC22(acc);
        wave_mm32<true, true>(P + (size_t)r0 * NP + PF + g * 128, NP, 1, FT + (size_t)(kb * 32) * 128, 1, 128, 128, acc, lane);
#pragma unroll
        for (int mi = 0; mi < 2; ++mi)
#pragma unroll
            for (int ni = 0; ni < 2; ++ni) {
                const int r = r0 + 16 * mi + 4 * fq, kp = kb * 32 + 16 * ni + fr, comp = kp >> 7, kap = kp & 127;
                u32x2 w; w.x = pk2(acc[mi][ni][0], acc[mi][ni][1]); w.y = pk2(acc[mi][ni][2], acc[mi][ni][3]);
                if (r < RL) { const int b = r >> 11, t = r & 2047; *(u32x2*)(ZTL + (size_t)((b * 4 + g) * 128 + kap) * 4096 + comp * 2048 + t) = w; }
                else { const int q = r - RL, b = q >> 8, t = q & 255; *(u32x2*)(ZTC + (size_t)((b * 4 + g) * 128 + kap) * 512 + comp * 256 + t) = w; }
            }
    }
}
__global__ __launch_bounds__(512) void k_mlstm1(Params p) {
    const int lane = threadIdx.x & 63, gw = blockIdx.x * 8 + (threadIdx.x >> 6), NGW = gridDim.x * 8, fr = lane & 15, fq = lane >> 4;
    const bf16_t* P = WSP(bf16_t, OFF_P); bf16_t* UT = WSP(bf16_t, OFF_UT); float* NV = WSP(float, OFF_NV);
    for (int task = gw; task < NCHUNK * NH * 2 * 64; task += NGW) {
        const int tile = task & 63, dir = (task >> 6) & 1, h = (task >> 7) & 3, cidx = task >> 9, row0 = chunk_row0(cidx);
        const int vb = (tile >> 3) * 32, kb = (tile & 7) * 32;
        const bf16_t* KW = WSP(bf16_t, dir ? OFF_KWB : OFF_KWF);
        f32x4 acc[2][2]; ZERO_ACC22(acc);
        wave_mm32<false, false>(P + (size_t)row0 * NP + PV + h * DH + vb, 1, NP, KW + (size_t)row0 * DM + h * DH + kb, DM, 1, CHUNK, acc, lane);
        bf16_t* out = UT + ((size_t)(cidx * NH + h) * 2 + dir) * DH * DH;
#pragma unroll
        for (int mi = 0; mi < 2; ++mi)
#pragma unroll
            for (int ni = 0; ni < 2; ++ni)
#pragma unroll
                for (int rg = 0; rg < 4; ++rg) out[(size_t)(vb + 16 * mi + 4 * fq + rg) * DH + kb + 16 * ni + fr] = (bf16_t)f2bf(acc[mi][ni][rg]);
    }
    const size_t gt = (size_t)blockIdx.x * 512 + threadIdx.x, NT = (size_t)gridDim.x * 512;
    for (size_t i = gt; i < (size_t)NCHUNK * NH * 2 * DH; i += NT) {
        const int kd = (int)(i & 255), dir = (int)(i >> 8) & 1, h = (int)(i >> 9) & 3, cidx = (int)(i >> 11), row0 = chunk_row0(cidx);
        const bf16_t* KW = WSP(bf16_t, dir ? OFF_KWB : OFF_KWF) + (size_t)row0 * DM + h * DH + kd;
        float s = 0.f; for (int t = 0; t < CHUNK; ++t) s += bf2f(KW[(size_t)t * DM]);
        NV[i] = s;
    }
}
__global__ __launch_bounds__(512) void k_mlstm2(Params p) {
    const bf16_t* UT = WSP(bf16_t, OFF_UT); bf16_t* CT = WSP(bf16_t, OFF_CT);
    const float *NV = WSP(float, OFF_NV), *CHS = WSP(float, OFF_CHS); float *NS = WSP(float, OFF_NS), *MST = WSP(float, OFF_MST);
    for (int task = blockIdx.x; task < NB * NH * 2 * 17; task += gridDim.x) {
        const int part = task % 17, scan = task / 17, dir = scan & 1, h = (scan >> 1) & 3, b = scan >> 3, dh = dir * 4 + h;
        float m = 0.f;
        if (part < 16) {
            const size_t e0 = (size_t)part * 4096 + (size_t)threadIdx.x * 8;
            float C[8];
#pragma unroll
            for (int j = 0; j < 8; ++j) C[j] = 0.f;
            for (int step = 0; step < 18; ++step) {
                const int cidx = scan_chunk(b, dir, step); const size_t base = ((size_t)(cidx * NH + h) * 2 + dir) * DH * DH + e0;
                *(u32x4*)(CT + base) = pack8(C);
                const float bend = CHS[(size_t)(cidx * 8 + dh) * 2], mloc = CHS[(size_t)(cidx * 8 + dh) * 2 + 1];
                const float mn = fmaxf(bend + m, mloc), al = __expf(bend + m - mn), be = __expf(mloc - mn);
                float u[8]; unpack8(*(const u32x4*)(UT + base), u);
#pragma unroll
                for (int j = 0; j < 8; ++j) C[j] = al * C[j] + be * u[j];
                m = mn;
            }
        } else if (threadIdx.x < DH) {
            float n = 0.f;
            for (int step = 0; step < 18; ++step) {
                const int cidx = scan_chunk(b, dir, step); const size_t base = ((size_t)(cidx * NH + h) * 2 + dir) * DH + threadIdx.x;
                NS[base] = n; if (threadIdx.x == 0) MST[cidx * 8 + dh] = m;
                const float bend = CHS[(size_t)(cidx * 8 + dh) * 2], mloc = CHS[(size_t)(cidx * 8 + dh) * 2 + 1];
                const float mn = fmaxf(bend + m, mloc), al = __expf(bend + m - mn), be = __expf(mloc - mn);
                n = al * n + be * NV[base]; m = mn;
            }
        }
    }
}
__global__ __launch_bounds__(512) void k_mlstm3a(Params p) {
    const int lane = threadIdx.x & 63, gw = blockIdx.x * 8 + (threadIdx.x >> 6), NGW = gridDim.x * 8, fr = lane & 15, fq = lane >> 4;
    const bf16_t *QC = WSP(bf16_t, OFF_QC), *KC = WSP(bf16_t, OFF_KC); float* SR = WSP(float, OFF_SR);
    for (int task = gw; task < NCHUNK * NH * 16; task += NGW) {
        const int tile = task & 15, h = (task >> 4) & 3, cidx = task >> 6, row0 = chunk_row0(cidx), tb = (tile >> 2) * 32, sb = (tile & 3) * 32;
        f32x4 acc[2][2]; ZERO_ACC22(acc);
        wave_mm32<true, true>(QC + (size_t)(row0 + tb) * DM + h * DH, DM, 1, KC + (size_t)(row0 + sb) * DM + h * DH, 1, DM, DH, acc, lane);
        float* out = SR + (size_t)(cidx * NH + h) * CHUNK * CHUNK;
#pragma unroll
        for (int mi = 0; mi < 2; ++mi)
#pragma unroll
            for (int ni = 0; ni < 2; ++ni)
#pragma unroll
                for (int rg = 0; rg < 4; ++rg) out[(size_t)(tb + 16 * mi + 4 * fq + rg) * CHUNK + sb + 16 * ni + fr] = acc[mi][ni][rg];
    }
}
__global__ __launch_bounds__(512) void k_mlstm3b(Params p) {
    const int lane = threadIdx.x & 63, gw = blockIdx.x * 8 + (threadIdx.x >> 6), NGW = gridDim.x * 8;
    const float *SR = WSP(float, OFF_SR), *BC = WSP(float, OFF_BC), *CC = WSP(float, OFF_CC), *CM = WSP(float, OFF_CM), *MST = WSP(float, OFF_MST), *NS = WSP(float, OFF_NS);
    const bf16_t* QC = WSP(bf16_t, OFF_QC); bf16_t* PC = WSP(bf16_t, OFF_PC); float* RF = WSP(float, OFF_RF);
    for (int task = gw; task < NCHUNK * NH * CHUNK; task += NGW) {
        const int t = task & 127, h = (task >> 7) & 3, cidx = task >> 9, row0 = chunk_row0(cidx), r = row0 + t;
        const float mF = MST[cidx * 8 + h], mB = MST[cidx * 8 + 4 + h];
        const float MF = fmaxf(mF, CM[(size_t)r * 8 + h]), MB = fmaxf(mB, CM[(size_t)r * 8 + 4 + h]);
        const float gF = __expf(mF - MF), gB = __expf(mB - MB);
        const float flF = __expf(-(BC[(size_t)r * 8 + h] + MF)), flB = __expf(-(BC[(size_t)r * 8 + 4 + h] + MB));
        float qnF = 0.f, qnB = 0.f;
        { const bf16_t* q = QC + (size_t)r * DM + h * DH + 4 * lane; const float* nF = NS + ((size_t)(cidx * NH + h) * 2 + 0) * DH + 4 * lane; const float* nB = nF + DH;
#pragma unroll
          for (int j = 0; j < 4; ++j) { const float qv = bf2f(q[j]); qnF += qv * nF[j]; qnB += qv * nB[j]; } }
        qnF = wave_sum(qnF); qnB = wave_sum(qnB);
        const float* sr = SR + ((size_t)(cidx * NH + h) * CHUNK + t) * CHUNK;
        float pf[2], pb[2], sF = 0.f, sB = 0.f;
#pragma unroll
        for (int j = 0; j < 2; ++j) { const int s = lane + 64 * j; const float sv = sr[s];
            const float cF = CC[(size_t)(row0 + s) * 8 + h], cB = CC[(size_t)(row0 + s) * 8 + 4 + h];
            pf[j] = s <= t ? sv * __expf(cF - MF) : 0.f; pb[j] = s >= t ? sv * __expf(cB - MB) : 0.f; sF += pf[j]; sB += pb[j]; }
        sF = wave_sum(sF); sB = wave_sum(sB);
        const float DF_ = fmaxf(fabsf(gF * qnF + sF), flF), DB_ = fmaxf(fabsf(gB * qnB + sB), flB);
        const float iF = 1.f / DF_, iB = 1.f / DB_;
        bf16_t* pc = PC + ((size_t)(cidx * NH + h) * CHUNK + t) * CHUNK;
#pragma unroll
        for (int j = 0; j < 2; ++j) pc[lane + 64 * j] = (bf16_t)f2bf(pf[j] * iF + pb[j] * iB);
        if (lane == 0) { RF[((size_t)r * NH + h) * 2] = gF * iF; RF[((size_t)r * NH + h) * 2 + 1] = gB * iB; }
    }
}
__global__ __launch_bounds__(512) void k_mlstm3c(Params p) {
    const int lane = threadIdx.x & 63, gw = blockIdx.x * 8 + (threadIdx.x >> 6), NGW = gridDim.x * 8, fr = lane & 15, fq = lane >> 4;
    const bf16_t *QC = WSP(bf16_t, OFF_QC), *CT = WSP(bf16_t, OFF_CT), *PC = WSP(bf16_t, OFF_PC), *P = WSP(bf16_t, OFF_P);
    const float* RF = WSP(float, OFF_RF); float* HS = WSP(float, OFF_HS);
    for (int task = gw; task < NCHUNK * NH * 32; task += NGW) {
        const int tile = task & 31, h = (task >> 5) & 3, cidx = task >> 7, row0 = chunk_row0(cidx), tb = (tile >> 3) * 32, vb = (tile & 7) * 32;
        const bf16_t* qa = QC + (size_t)(row0 + tb) * DM + h * DH;
        f32x4 a1[2][2], a2[2][2], a3[2][2]; ZERO_ACC22(a1); ZERO_ACC22(a2); ZERO_ACC22(a3);
        const bf16_t* ctf = CT + ((size_t)(cidx * NH + h) * 2 + 0) * DH * DH + (size_t)vb * DH;
        wave_mm32<true, true>(qa, DM, 1, ctf, 1, DH, DH, a1, lane);
        wave_mm32<true, true>(qa, DM, 1, ctf + (size_t)DH * DH, 1, DH, DH, a2, lane);
        wave_mm32<true, false>(PC + ((size_t)(cidx * NH + h) * CHUNK + tb) * CHUNK, CHUNK, 1, P + (size_t)row0 * NP + PV + h * DH + vb, NP, 1, CHUNK, a3, lane);
#pragma unroll
        for (int mi = 0; mi < 2; ++mi)
#pragma unroll
            for (int rg = 0; rg < 4; ++rg) { const int r = row0 + tb + 16 * mi + 4 * fq + rg; const float rf = RF[((size_t)r * NH + h) * 2], rb = RF[((size_t)r * NH + h) * 2 + 1];
#pragma unroll
                for (int ni = 0; ni < 2; ++ni) HS[(size_t)r * DM + h * DH + vb + 16 * ni + fr] = rf * a1[mi][ni][rg] + rb * a2[mi][ni][rg] + a3[mi][ni][rg]; }
    }
}
__global__ __launch_bounds__(512) void k_headnorm(Params p, int l) {
    const int lane = threadIdx.x & 63, gw = blockIdx.x * 8 + (threadIdx.x >> 6), NGW = gridDim.x * 8;
    const float* HS = WSP(float, OFF_HS); const bf16_t* P = WSP(bf16_t, OFF_P); bf16_t* HM = WSP(bf16_t, OFF_HM);
    const float* nw = p.mlstm_norm_w + (size_t)l * DM;
    for (int task = gw; task < R * NH; task += NGW) {
        const int h = task & 3, r = task >> 2, c = h * DH + 4 * lane;
        const f32x4 v = *(const f32x4*)(HS + (size_t)r * DM + c);
        const float rstd = rsqrtf(wave_sum((v[0] * v[0] + v[1] * v[1]) + (v[2] * v[2] + v[3] * v[3])) * (1.f / DH) + EPS);
        const f32x4 w = *(const f32x4*)(nw + c);
        const u32x2 ow = *(const u32x2*)(P + (size_t)r * NP + PO + c);
        const float o0 = __uint_as_float(ow.x << 16), o1 = __uint_as_float(ow.x & 0xffff0000u), o2 = __uint_as_float(ow.y << 16), o3 = __uint_as_float(ow.y & 0xffff0000u);
        u32x2 q; q.x = pk2(sigmoidf_(o0) * (v[0] * rstd * w[0]), sigmoidf_(o1) * (v[1] * rstd * w[1])); q.y = pk2(sigmoidf_(o2) * (v[2] * rstd * w[2]), sigmoidf_(o3) * (v[3] * rstd * w[3]));
        *(u32x2*)(HM + (size_t)r * DM + c) = q;
    }
}
__global__ __launch_bounds__(512) void k_ffnact(Params p, int l) {
    const size_t gt = (size_t)blockIdx.x * 512 + threadIdx.x, NT = (size_t)gridDim.x * 512;
    const bf16_t* U = WSP(bf16_t, OFF_P); bf16_t* ACT = WSP(bf16_t, OFF_ACT);
    const float* wf = p.conv_ff_w + (size_t)l * 3 * DFF;
    for (size_t i = gt; i < (size_t)R * (DFF / 8); i += NT) {
        const int r = (int)(i / (DFF / 8)), c = (int)(i % (DFF / 8)) * 8; int mj, t, T; rowinfo(r, mj, t, T);
        const int st = r < RL ? 64 : 1; const bool hp = t >= st, hn = t + st < T;
        const bf16_t* ur = U + (size_t)r * NUP;
        float a0[8], a1[8], a2[8], g[8], o[8];
        unpack8(*(const u32x4*)(ur + c), a1); unpack8(*(const u32x4*)(ur + DFF + c), g);
        if (hp) unpack8(*(const u32x4*)(ur - (size_t)st * NUP + c), a0);
        if (hn) unpack8(*(const u32x4*)(ur + (size_t)st * NUP + c), a2);
#pragma unroll
        for (int j = 0; j < 8; ++j) { float v = wf[DFF + c + j] * a1[j]; if (hp) v += wf[c + j] * a0[j]; if (hn) v += wf[2 * DFF + c + j] * a2[j]; o[j] = siluf_(v) * g[j]; }
        *(u32x4*)(ACT + (size_t)r * DFF + c) = pack8(o);
    }
}

template <class Epi> static void launch_gemm(hipStream_t s, int grid, const bf16_t* A, int lda, const bf16_t* Bt, int ldb, int M, int N, int K, const Epi& E) {
    static bool attr_set = false;
    if (!attr_set) { (void)hipFuncSetAttribute((const void*)k_gemm<Epi>, hipFuncAttributeMaxDynamicSharedMemorySize, pg8::STAGE_BYTES); attr_set = true; }
    pg8::Gemm g{}; g.A = A; g.Bt = Bt; g.M = M; g.N = N; g.K = K; g.lda = lda; g.ldb = ldb; g.pad = 0;
    hipLaunchKernelGGL(k_gemm<Epi>, dim3(grid), dim3(512), pg8::STAGE_BYTES, s, g, E);
}

extern "C" void kernel_launch(void* const* d_in, const int* in_sizes, int n_in, void* d_out, int out_size, void* d_ws, size_t ws_size, hipStream_t stream) {
    if (n_in != 22 || ws_size < WS_END || out_size != RL * D) { fprintf(stderr, "kernel_launch: unexpected problem (n_in %d, ws %zu < %zu, out %d)\n", n_in, ws_size, (size_t)WS_END, out_size); return; }
    Params p{};
    const float** pp = (const float**)&p;
    for (int i = 0; i < 22; ++i) pp[i] = (const float*)d_in[i];
    p.out = (float*)d_out; p.ws = (unsigned char*)d_ws;
    unsigned char* ws = p.ws;
    const int G = 256, GE = 1024;
    hipLaunchKernelGGL(k_convert, dim3(2048), dim3(256), 0, stream, p);
    hipLaunchKernelGGL(k_tables, dim3(GE), dim3(512), 0, stream, p);
    hipLaunchKernelGGL(k_mod, dim3(768), dim3(512), 0, stream, p);
    bf16_t* XN = (bf16_t*)(ws + OFF_XN); bf16_t* P = (bf16_t*)(ws + OFF_P); float* Gt = (float*)(ws + OFF_G); float* H = (float*)(ws + OFF_H);
    for (int l = 0; l < DEPTH; ++l) {
        const float* mod = (const float*)(ws + OFF_MOD) + (size_t)l * 5 * 6 * D;
        hipLaunchKernelGGL(k_norm, dim3(GE), dim3(512), 0, stream, p, l, 0);
        { EpiInProj E{P, Gt, (const float*)(ws + OFF_BINR) + (size_t)l * NINP};
          launch_gemm(stream, G, XN, D, (const bf16_t*)(ws + OFF_WIN) + (size_t)l * NINP * D, D, R, NINP, D, E); }
        hipLaunchKernelGGL(k_gateprep, dim3(72), dim3(512), 0, stream, p);
        hipLaunchKernelGGL(k_convs, dim3(GE), dim3(512), 0, stream, p, l);
        hipLaunchKernelGGL(k_fourier1, dim3(GE), dim3(512), 0, stream, p);
        hipLaunchKernelGGL(k_mlstm1, dim3(GE), dim3(512), 0, stream, p);
        hipLaunchKernelGGL(k_mlstm2, dim3(544), dim3(512), 0, stream, p);
        hipLaunchKernelGGL(k_mlstm3a, dim3(576), dim3(512), 0, stream, p);
        hipLaunchKernelGGL(k_mlstm3b, dim3(GE), dim3(512), 0, stream, p);
        hipLaunchKernelGGL(k_mlstm3c, dim3(GE), dim3(512), 0, stream, p);
        hipLaunchKernelGGL(k_headnorm, dim3(GE), dim3(512), 0, stream, p, l);
        { EpiBf16 E{(bf16_t*)(ws + OFF_YF), DF, DF, (size_t)SEQ * DF};
          launch_gemm(stream, G, (const bf16_t*)(ws + OFF_CSL), 4096, (const bf16_t*)(ws + OFF_ZTL), 4096, 2048, 2048, 4096, E); }
        { EpiBf16 E{(bf16_t*)(ws + OFF_YF) + (size_t)RL * DF, DF, DF, (size_t)CTX * DF};
          launch_gemm(stream, G, (const bf16_t*)(ws + OFF_CSC), 512, (const bf16_t*)(ws + OFF_ZTC), 512, 256, 2048, 512, E); }
        { EpiMerge<0> E{P, (float*)(ws + OFF_PM), (bf16_t*)(ws + OFF_MG)};
          launch_gemm(stream, G, (const bf16_t*)(ws + OFF_HM), DM, (const bf16_t*)(ws + OFF_WPM) + (size_t)l * D * DM, DM, R, D, DM, E); }
        { EpiMerge<1> E{P, (float*)(ws + OFF_PM), (bf16_t*)(ws + OFF_MG)};
          launch_gemm(stream, G, (const bf16_t*)(ws + OFF_YF), DF, (const bf16_t*)(ws + OFF_WPF) + (size_t)l * D * DF, DF, R, D, DF, E); }
        { EpiMerge<2> E{P, (float*)(ws + OFF_PM), (bf16_t*)(ws + OFF_MG)};
          launch_gemm(stream, G, (const bf16_t*)(ws + OFF_YC), DC, (const bf16_t*)(ws + OFF_WPC) + (size_t)l * D * DC, DC, R, D, DC, E); }
        { EpiResid E{H, mod + 2 * D};
          launch_gemm(stream, G, (const bf16_t*)(ws + OFF_MG), D, (const bf16_t*)(ws + OFF_WO) + (size_t)l * D * D, D, R, D, D, E); }
        hipLaunchKernelGGL(k_norm, dim3(GE), dim3(512), 0, stream, p, l, 1);
        { EpiBf16 E{P, NUP, 0, 0};
          launch_gemm(stream, G, XN, D, (const bf16_t*)(ws + OFF_WUP) + (size_t)l * NUP * D, D, R, NUP, D, E); }
        hipLaunchKernelGGL(k_ffnact, dim3(GE), dim3(512), 0, stream, p, l);
        { EpiResid E{H, mod + 5 * D};
          launch_gemm(stream, G, (const bf16_t*)(ws + OFF_ACT), DFF, (const bf16_t*)(ws + OFF_WDN) + (size_t)l * D * DFF, DFF, R, D, DFF, E); }
    }
    hipLaunchKernelGGL(k_final, dim3(GE), dim3(512), 0, stream, p);
}
```

```cpp
#include <hip/hip_runtime.h>
#include <cstdio>
#include <cstdint>
#include <type_traits>

#define LAS __attribute__((address_space(3)))
typedef unsigned short bf16_t;
typedef short bf16x8 __attribute__((ext_vector_type(8)));
typedef float f32x4 __attribute__((ext_vector_type(4)));
typedef unsigned u32x4 __attribute__((ext_vector_type(4)));
typedef unsigned u32x2 __attribute__((ext_vector_type(2)));

constexpr int D = 2048, NB = 4, SEQ = 2048, DEPTH = 4, CTX = 256;
constexpr int DM = 1024, NH = 4, DH = 256, DF = 512, DC = 512, DFF = 5632, CHUNK = 128;
constexpr int NIN = 12304;
constexpr int RL = NB * SEQ, RC = NB * CTX, R = RL + RC;
constexpr int NP = 12288;
constexpr int NINP = 12544;
constexpr int PK = 0, PV = 1024, PQ = 2048, PO = 3072, PF = 4096, PCB = 4608, PCC = 5120, PCX = 5632, PGM = 6144;
constexpr int NCHUNK = 72;
constexpr int NUP = 2 * DFF;
constexpr float EPS = 1e-6f;

constexpr size_t al256(size_t x) { return (x + 255) & ~(size_t)255; }
constexpr size_t OFF_CTL = 0;
constexpr size_t OFF_WIN = 1u << 20;
constexpr size_t SZ_WIN = (size_t)NINP * D * 2;            constexpr size_t OFF_WPM = OFF_WIN + DEPTH * SZ_WIN;
constexpr size_t SZ_WPM = (size_t)D * D * 2;               constexpr size_t OFF_WO = OFF_WPM + DEPTH * SZ_WPM;
constexpr size_t SZ_WO = (size_t)D * D * 2;                constexpr size_t OFF_WUP = OFF_WO + DEPTH * SZ_WO;
constexpr size_t SZ_WUP = (size_t)NUP * D * 2;             constexpr size_t OFF_WDN = OFF_WUP + DEPTH * SZ_WUP;
constexpr size_t SZ_WDN = (size_t)D * DFF * 2;             constexpr size_t OFF_BINR = OFF_WDN + DEPTH * SZ_WDN;
constexpr size_t OFF_MA = al256(OFF_BINR + (size_t)DEPTH * NINP * 4);
constexpr size_t OFF_MC = OFF_MA + (size_t)64 * 64 * 2;
constexpr size_t OFF_CSC = OFF_MC + (size_t)32 * 64 * 128 * 2;
constexpr size_t OFF_FT = OFF_CSC + (size_t)256 * 512 * 2;
constexpr size_t OFF_MOD = OFF_FT + (size_t)256 * 128 * 2;
constexpr size_t OFF_H = al256(OFF_MOD + (size_t)DEPTH * 5 * 6 * D * 4);
constexpr size_t OFF_XN = OFF_H + (size_t)R * D * 4;
constexpr size_t OFF_P = OFF_XN + (size_t)R * D * 2;
constexpr size_t OFF_G = OFF_P + (size_t)R * NP * 2;
constexpr size_t OFF_CHS = OFF_G + (size_t)R * 16 * 4;
constexpr size_t OFF_MST = al256(OFF_CHS + (size_t)NCHUNK * 8 * 2 * 4);
constexpr size_t OFF_UT = al256(OFF_MST + (size_t)NCHUNK * 8 * 4);
constexpr size_t SZ_UT = (size_t)NCHUNK * NH * 2 * DH * DH * 2;
constexpr size_t OFF_CT = OFF_UT + SZ_UT;
constexpr size_t OFF_NV = OFF_CT + SZ_UT;
constexpr size_t OFF_NS = OFF_NV + (size_t)NCHUNK * NH * 2 * DH * 4;
constexpr size_t OFF_HM = OFF_NS + (size_t)NCHUNK * NH * 2 * DH * 4;
constexpr size_t OFF_ZTC = OFF_HM + (size_t)R * D * 2;
constexpr size_t OFF_MG = OFF_ZTC + (size_t)2048 * 512 * 2;
constexpr size_t OFF_ACT = OFF_MG + (size_t)R * D * 2;
constexpr size_t OFF_SLAB = OFF_ACT + (size_t)R * DFF * 2;
constexpr size_t OFF_XS = OFF_SLAB + (size_t)4 * RC * NUP * 4;
constexpr size_t WS_END = OFF_XS + (size_t)8 * RL * 32 * 4;
constexpr int CNTW = 4096;
constexpr int CTL_ZERO_WORDS = CNTW + 8 * 32 * 64;
static_assert(WS_END <= (size_t)4 * DEPTH * D * NIN * 4, "workspace map exceeds the guaranteed d_ws size");
static_assert((size_t)R * NUP * 2 <= (size_t)R * NP * 2, "u overlays P");

struct Params {
    const float *x, *c, *ctx, *c_ctx, *w_mod, *b_mod, *norm1_w, *norm2_w, *w_in, *b_in, *conv_q_w, *conv_k_w, *mlstm_norm_w, *w_pm, *w_pf, *w_pc, *conv_c_w, *w_o, *w_up,
        *conv_ff_w, *w_down, *final_norm_w;
    float* out; unsigned char* ws;
};
#define WSP(T, off) ((T*)(wsb + (off)))
typedef const __attribute__((address_space(4))) Params CParams;
__device__ __forceinline__ CParams* okp() { CParams* k = (CParams*)__builtin_amdgcn_kernarg_segment_ptr(); asm volatile("" : "+s"(k)); return k; }

#define GAS __attribute__((address_space(1)))
template <class T> __device__ __forceinline__ T gld(const void* base, unsigned byte_off) { return *(const GAS T*)((const GAS unsigned char*)base + byte_off); }
template <class T> __device__ __forceinline__ void gst(void* base, unsigned byte_off, T v) { *(GAS T*)((GAS unsigned char*)base + byte_off) = v; }
__device__ __forceinline__ int otid(int wv) { int t; asm volatile("v_mbcnt_lo_u32_b32 %0, -1, 0\n\tv_mbcnt_hi_u32_b32 %0, -1, %0" : "=v"(t)); return (wv << 6) | t; }
__device__ __forceinline__ int olaunder(int v) { asm volatile("" : "+v"(v)); return v; }
__device__ __forceinline__ f32x4 zero4() { float a, b, c, d; asm volatile("v_mov_b32 %0, 0\n\tv_mov_b32 %1, 0\n\tv_mov_b32 %2, 0\n\tv_mov_b32 %3, 0" : "=v"(a), "=v"(b), "=v"(c), "=v"(d)); return (f32x4){a, b, c, d}; }
__device__ __forceinline__ int obid() { int b = blockIdx.x; asm volatile("" : "+s"(b)); return b; }
__device__ __forceinline__ float bf2f(bf16_t v) { return __uint_as_float(((unsigned)v) << 16); }
__device__ __forceinline__ unsigned f2bf(float f) { unsigned u = __float_as_uint(f); return (u + 0x7fffu + ((u >> 16) & 1u)) >> 16; }
__device__ __forceinline__ unsigned pk2(float lo, float hi) { return f2bf(lo) | (f2bf(hi) << 16); }
__device__ __forceinline__ float sigmoidf_(float x) { return 1.f / (1.f + __expf(-x)); }
__device__ __forceinline__ float siluf_(float x) { return x / (1.f + __expf(-x)); }
__device__ __forceinline__ float shx(float v, int k, int lane) { return __int_as_float(__builtin_amdgcn_ds_bpermute((lane ^ k) << 2, __float_as_int(v))); }
__device__ __forceinline__ float shl_(float v, int src) { return __int_as_float(__builtin_amdgcn_ds_bpermute(src << 2, __float_as_int(v))); }
__device__ __forceinline__ unsigned char* ows(unsigned char* w) { asm volatile("" : "+s"(w)); return w; }
__device__ __forceinline__ float wave_sum(float v, int lane) {
#pragma unroll
    for (int o = 1; o < 64; o <<= 1) v += shx(v, o, lane);
    return v;
}
__device__ __forceinline__ void unpack8(u32x4 w, float (&f)[8]) {
    f[0] = __uint_as_float(w.x << 16); f[1] = __uint_as_float(w.x & 0xffff0000u); f[2] = __uint_as_float(w.y << 16); f[3] = __uint_as_float(w.y & 0xffff0000u);
    f[4] = __uint_as_float(w.z << 16); f[5] = __uint_as_float(w.z & 0xffff0000u); f[6] = __uint_as_float(w.w << 16); f[7] = __uint_as_float(w.w & 0xffff0000u);
}
__device__ __forceinline__ u32x4 pack8(const float (&f)[8]) { u32x4 w; w.x = pk2(f[0], f[1]); w.y = pk2(f[2], f[3]); w.z = pk2(f[4], f[5]); w.w = pk2(f[6], f[7]); return w; }
__device__ __forceinline__ void rowinfo(int r, int& mj, int& t, int& T) { const int c = r >= RL ? 1 : 0; mj = r >> 11; T = SEQ >> (3 * c); t = r & (T - 1); }
__device__ __forceinline__ int chunk_row0(int cidx) { return cidx < 64 ? (cidx >> 4) * SEQ + (cidx & 15) * CHUNK : RL + ((cidx - 64) >> 1) * CTX + ((cidx - 64) & 1) * CHUNK; }
__device__ __forceinline__ int scan_chunk(int b, int dir, int step) {
    if (step < 2) { const int j = dir ? 1 - step : step; return 64 + b * 2 + j; }
    const int jj = step - 2, j = dir ? 15 - jj : jj; return b * 16 + j;
}

namespace pg8 {
#define PG8_LAS __attribute__((address_space(3)))
constexpr int BM = 256, BK = 64, HALF = 128, HTB = HALF * BK * 2, STAGE_BYTES = 8 * HTB, NXCD = 8, WGM = 8;
__host__ __device__ __forceinline__ int lds_byte(int r, int c) { const int st = (r >> 4) * 2 + (c >> 5), rr = r & 15, cc = c & 31, ob = rr * 64 + cc * 2; return st * 1024 + (ob ^ (((ob >> 9) & 1) << 5)); }
__host__ __device__ __forceinline__ void stage_rc(int b, int& Rr, int& C) { const int st = b / 1024, sb = b % 1024, swz = sb ^ (((sb >> 9) & 1) << 5); Rr = (st >> 1) * 16 + swz / 64; C = (st & 1) * 32 + (swz % 64) / 2; }
__host__ __device__ __forceinline__ int perm32(int rho) { const int n = rho >> 4, i = rho & 15; return 8 * (i >> 2) + 4 * n + (i & 3); }
struct Unit { int pm, pn, k0, nt, ks; };
struct Gemm { const bf16_t* A; const bf16_t* Bt; int M, N, K, lda, ldb, pad; };
__host__ __device__ __forceinline__ void tile_of(int wgid, int nM, int nN, int& pm, int& pn) {
    const int nwg = nM * nN; { const int q = nwg / NXCD, r = nwg % NXCD, xcd = wgid % NXCD, off = wgid / NXCD; wgid = (xcd < r ? xcd * (q + 1) : r * (q + 1) + (xcd - r) * q) + off; }
    const int nig = WGM * nN, gid = wgid / nig, fm = gid * WGM, gsz = (nM - fm) < WGM ? (nM - fm) : WGM;
    pm = fm + ((wgid % nig) % gsz); pn = (wgid % nig) / gsz;
}
struct StaticOrder {
    int nM, nN, nwg, G, c, K;
    __host__ __device__ void init(int M, int N, int K_, int G_, int c_) { nM = M / BM; nN = N / BM; nwg = nM * nN; G = G_; c = c_; K = K_; }
    __host__ __device__ bool next(int i, Unit& u) const {
        const long L = (long)i * G + c; if (L >= nwg) return false;
        tile_of((int)L, nM, nN, u.pm, u.pn); u.k0 = 0; u.nt = K / BK; u.ks = -1; return true;
    }
    __device__ __forceinline__ void a_ready(const Unit&) const {}
    __device__ __forceinline__ void done(const Unit&) const {}
};
struct TailOrder {
    int nN, G, c, K, nLat, nWhole, nTot, nsl;
    __host__ __device__ void init(int N, int K_, int G_, int c_, int nCtxTiles, int nCtxWhole, int nsl_) { nN = N / BM; G = G_; c = c_; K = K_; nLat = 32 * nN; nWhole = nLat + nCtxWhole; nTot = nLat + nCtxTiles; nsl = nsl_; }
    __host__ __device__ bool next(int i, Unit& u) const {
        const long L = (long)i * G + c; if (L >= (long)nWhole + (long)(nTot - nWhole) * nsl) return false;
        int tile, ks; if (L < nWhole) { tile = (int)L; ks = -1; } else { const int Lp = (int)L - nWhole; tile = nWhole + Lp / nsl; ks = Lp % nsl; }
        if (tile < nLat) tile_of(tile, 32, nN, u.pm, u.pn); else { const int tp = tile - nLat; u.pm = 32 + (tp & 3); u.pn = tp >> 2; }
        if (ks < 0) { u.k0 = 0; u.nt = K / BK; } else { const int n128 = K / 128, base = n128 / nsl, rem = n128 % nsl; u.k0 = 128 * (ks * base + (ks < rem ? ks : rem)); u.nt = 2 * (base + (ks < rem ? 1 : 0)); }
        u.ks = ks; return true;
    }
    __device__ __forceinline__ void a_ready(const Unit&) const {}
    __device__ __forceinline__ void done(const Unit&) const {}
};
template <bool AMAP> __device__ __forceinline__ void a_geom(const Gemm& g, const Unit& u, int R0, int C0, int R1, int C1, size_t& base, size_t& hstep, unsigned (&vo)[2]) {
    if (AMAP && u.pm < 32) { base = (size_t)((u.pm >> 3) * 2048 + (u.pm & 7) * 8) * g.lda * 2; hstep = (size_t)4 * g.lda * 2;
        vo[0] = (unsigned)(((R0 & 31) * 64 + (R0 >> 5)) * g.lda + C0) * 2u; vo[1] = (unsigned)(((R1 & 31) * 64 + (R1 >> 5)) * g.lda + C1) * 2u; }
    else { base = (size_t)u.pm * 256 * g.lda * 2; hstep = (size_t)HALF * g.lda * 2; vo[0] = (unsigned)(R0 * g.lda + C0) * 2u; vo[1] = (unsigned)(R1 * g.lda + C1) * 2u; }
}
template <class Epi, class Sched, bool AMAP = false>
__device__ __forceinline__ void gemm_phase(PG8_LAS unsigned char* lds, const Gemm g, const Sched& S, const Epi& E) {
    const int tid = otid(g.pad), wid = __builtin_amdgcn_readfirstlane(tid >> 6), lane = tid & 63, wr = wid >> 2, wc = wid & 3, fr = lane & 15, fq = lane >> 4;
    int R0, C0, R1, C1; stage_rc(tid * 16, R0, C0); stage_rc(tid * 16 + 8192, R1, C1);
    unsigned voffB[2];
    { const int Rb0 = Epi::PERM ? ((R0 & ~31) + perm32(R0 & 31)) : R0, Rb1 = Epi::PERM ? ((R1 & ~31) + perm32(R1 & 31)) : R1;
      voffB[0] = (unsigned)(Rb0 * g.ldb + C0) * 2u; voffB[1] = (unsigned)(Rb1 * g.ldb + C1) * 2u; }
    const size_t kstep = (size_t)(BK * 2);
    const size_t hstepB = (size_t)HALF * g.ldb * 2, tstepB = 2 * hstepB;
    const unsigned ldsw = (unsigned)wid * 1024u;
    const int aoff = lds_byte(wr * 64 + fr, fq * 8), boff = lds_byte(wc * 32 + fr, fq * 8);
#define PG8_SA(b, h) (((b) * 2 + (h)) * HTB)
#define PG8_SB(b, h) ((4 + (b) * 2 + (h)) * HTB)
#define PG8_STAGE(bufoff, gbase, voff) do { _Pragma("unroll") for (int _i = 0; _i < 2; ++_i) \
        __builtin_amdgcn_global_load_lds((const unsigned*)((const char*)(gbase) + (voff)[_i]), (PG8_LAS unsigned*)(lds + (bufoff) + ldsw + _i * 8192), 16, 0, 0); } while (0)
#define PG8_LDA(dst, b, h) do { _Pragma("unroll") for (int m = 0; m < 4; ++m) _Pragma("unroll") for (int k = 0; k < 2; ++k) dst[m][k] = *(const PG8_LAS bf16x8*)(lds + PG8_SA(b, h) + aoff + m * 2048 + k * 1024); } while (0)
#define PG8_LDB(dst, b, h) do { _Pragma("unroll") for (int n = 0; n < 2; ++n) _Pragma("unroll") for (int k = 0; k < 2; ++k) dst[n][k] = *(const PG8_LAS bf16x8*)(lds + PG8_SB(b, h) + boff + n * 2048 + k * 1024); } while (0)
#define PG8_MMA(ai, bj, At, Bt) do { __builtin_amdgcn_s_setprio(1); _Pragma("unroll") for (int m = 0; m < 4; ++m) _Pragma("unroll") for (int n = 0; n < 2; ++n) _Pragma("unroll") for (int k = 0; k < 2; ++k) \
        acc[ai][bj][m][n] = __builtin_amdgcn_mfma_f32_16x16x32_bf16(Bt[n][k], At[m][k], acc[ai][bj][m][n], 0, 0, 0); __builtin_amdgcn_s_setprio(0); } while (0)
#define PG8_WAIT_V(n) asm volatile("s_waitcnt vmcnt(" #n ")" ::: "memory")
#define PG8_WAIT_L(n) asm volatile("s_waitcnt lgkmcnt(" #n ")" ::: "memory")
#define PG8_BAR __builtin_amdgcn_s_barrier()
#define PG8_SCHED __builtin_amdgcn_sched_barrier(0)
    Unit cur, nxt; int ui = 0;
    if (!S.next(0, cur)) return;
    f32x4 acc[2][2][4][2];
#pragma unroll
    for (int a = 0; a < 2; ++a)
#pragma unroll
        for (int b = 0; b < 2; ++b)
#pragma unroll
            for (int m = 0; m < 4; ++m)
#pragma unroll
                for (int n = 0; n < 2; ++n) acc[a][b][m][n] = zero4();
    bf16x8 At[4][2], B0[2][2], B1[2][2];
    size_t baseC, hsC; unsigned voC[2]; a_geom<AMAP>(g, cur, R0, C0, R1, C1, baseC, hsC, voC);
    const char* cA = (const char*)g.A + baseC + (size_t)cur.k0 * 2; const char* cB = (const char*)g.Bt + (size_t)cur.pn * tstepB + (size_t)cur.k0 * 2;
    S.a_ready(cur);
    PG8_STAGE(PG8_SB(0, 0), cB, voffB); PG8_STAGE(PG8_SB(0, 1), cB + hstepB, voffB); PG8_STAGE(PG8_SA(0, 0), cA, voC); PG8_STAGE(PG8_SA(0, 1), cA + hsC, voC);
    if (wr == 1) PG8_BAR;
    PG8_WAIT_V(2); PG8_BAR;
    PG8_STAGE(PG8_SB(1, 0), cB + kstep, voffB); PG8_STAGE(PG8_SA(1, 0), cA + kstep, voC); PG8_STAGE(PG8_SB(1, 1), cB + hstepB + kstep, voffB);
    PG8_WAIT_V(6); PG8_BAR;
    for (;;) {
        const bool has_next = S.next(ui + 1, nxt);
        size_t baseN = baseC, hsN = hsC; unsigned voN[2] = {voC[0], voC[1]};
        if (AMAP && has_next) a_geom<AMAP>(g, nxt, R0, C0, R1, C1, baseN, hsN, voN); else if (has_next) baseN = (size_t)nxt.pm * 256 * g.lda * 2;
        const char* nA = has_next ? (const char*)g.A + baseN + (size_t)nxt.k0 * 2 : cA; const char* nB = has_next ? (const char*)g.Bt + (size_t)nxt.pn * tstepB + (size_t)nxt.k0 * 2 : cB;
        const int nt = cur.nt;
        for (int t = 0; t < nt; t += 2) {
            if constexpr (Epi::HOOK) E.hook(acc, cur, t, wr, wc, fr, fq);
            const bool last = (t == nt - 2);
            const char* a1 = cA + (size_t)(t + 1) * kstep;
            const char* a2 = last ? nA : cA + (size_t)(t + 2) * kstep; const char* b2 = last ? nB : cB + (size_t)(t + 2) * kstep;
            const char* a3 = a2 + kstep; const char* b3 = b2 + kstep;
            const size_t hs2 = (AMAP && last) ? hsN : hsC; unsigned vo2[2] = {(AMAP && last) ? voN[0] : voC[0], (AMAP && last) ? voN[1] : voC[1]};
            if (last && has_next) S.a_ready(nxt);
            PG8_LDB(B0, 0, 0); PG8_LDB(B1, 0, 1); PG8_SCHED; PG8_LDA(At, 0, 0); PG8_STAGE(PG8_SA(1, 1), a1 + hsC, voC);
            PG8_WAIT_V(8); PG8_WAIT_L(0); PG8_BAR; PG8_MMA(0, 0, At, B0); PG8_MMA(0, 1, At, B1); PG8_BAR; PG8_SCHED;
            PG8_LDA(At, 0, 1); PG8_STAGE(PG8_SB(0, 0), b2, voffB); PG8_STAGE(PG8_SB(0, 1), b2 + hstepB, voffB); PG8_STAGE(PG8_SA(0, 0), a2, vo2);
            PG8_WAIT_V(8); PG8_WAIT_L(0); PG8_BAR; PG8_MMA(1, 0, At, B0); PG8_MMA(1, 1, At, B1); PG8_BAR; PG8_SCHED;
            PG8_LDB(B0, 1, 0); PG8_LDB(B1, 1, 1); PG8_SCHED; PG8_LDA(At, 1, 0); PG8_STAGE(PG8_SA(0, 1), a2 + hs2, vo2);
            PG8_WAIT_V(8); PG8_WAIT_L(0); PG8_BAR; PG8_MMA(0, 0, At, B0); PG8_MMA(0, 1, At, B1); PG8_BAR; PG8_SCHED;
            PG8_LDA(At, 1, 1); PG8_STAGE(PG8_SB(1, 0), b3, voffB); PG8_STAGE(PG8_SB(1, 1), b3 + hstepB, voffB); PG8_STAGE(PG8_SA(1, 0), a3, vo2);
            PG8_WAIT_V(8); PG8_WAIT_L(0); PG8_BAR; PG8_MMA(1, 0, At, B0); PG8_MMA(1, 1, At, B1); PG8_BAR; PG8_SCHED;
        }
        if (wr == 0) PG8_BAR;
        E(acc, cur, wr, wc, fr, fq); S.done(cur);
        if (!has_next) break;
#pragma unroll
        for (int a = 0; a < 2; ++a)
#pragma unroll
            for (int b = 0; b < 2; ++b)
#pragma unroll
                for (int m = 0; m < 4; ++m)
#pragma unroll
                    for (int n = 0; n < 2; ++n) acc[a][b][m][n] = zero4();
        cur = nxt; cA = nA; cB = nB; ++ui;
        if constexpr (AMAP) { hsC = hsN; voC[0] = voN[0]; voC[1] = voN[1]; }
        if (wr == 1) PG8_BAR;
    }
    PG8_WAIT_V(0);
    PG8_BAR;
#undef PG8_SA
#undef PG8_SB
#undef PG8_STAGE
#undef PG8_LDA
#undef PG8_LDB
#undef PG8_MMA
#undef PG8_WAIT_V
#undef PG8_WAIT_L
#undef PG8_BAR
#undef PG8_SCHED
}
}

template <class F> __device__ __forceinline__ void epi_foreach(const f32x4 (&acc)[2][2][4][2], const pg8::Unit& u, int wr, int wc, int fr, int fq, F&& f) {
    const int row0 = u.pm * 256 + wr * 64 + fr, col0 = u.pn * 256 + wc * 32 + 8 * fq;
#pragma unroll
    for (int ai = 0; ai < 2; ++ai)
#pragma unroll
        for (int m = 0; m < 4; ++m)
#pragma unroll
            for (int bj = 0; bj < 2; ++bj) f(row0 + ai * 128 + m * 16, col0 + bj * 128, acc[ai][bj][m][0], acc[ai][bj][m][1]);
}
__device__ __forceinline__ u32x4 pack8v(f32x4 v0, f32x4 v1) { u32x4 w; w.x = pk2(v0[0], v0[1]); w.y = pk2(v0[2], v0[3]); w.z = pk2(v1[0], v1[1]); w.w = pk2(v1[2], v1[3]); return w; }

struct EpiInProj {
    static constexpr bool PERM = true, HOOK = false;
    bf16_t* P; float* G; const float* bias;
    __device__ __forceinline__ void operator()(const f32x4 (&acc)[2][2][4][2], const pg8::Unit& u, int wr, int wc, int fr, int fq) const {
        if (u.pn < 48) {
            epi_foreach(acc, u, wr, wc, fr, fq, [&](int row, int col, f32x4 v0, f32x4 v1) {
                const f32x4 b0 = gld<f32x4>(bias, (unsigned)col * 4u), b1 = gld<f32x4>(bias, (unsigned)col * 4u + 16);
                f32x4 o0 = v0 + b0, o1 = v1 + b1;
                if (u.pn >= PGM / 256) {
#pragma unroll
                    for (int j = 0; j < 4; ++j) { o0[j] = 1.f + __expf(-fminf(fmaxf(o0[j], -30.f), 30.f)); o1[j] = 1.f + __expf(-fminf(fmaxf(o1[j], -30.f), 30.f)); } }
                gst<u32x4>(P, (unsigned)(row * NP + col) * 2u, pack8v(o0, o1)); });
        } else if (wc == 0 && fq < 2) {
            const int row0 = u.pm * 256 + wr * 64 + fr;
            const f32x4 b0 = gld<f32x4>(bias, (unsigned)(NP + 8 * fq) * 4u), b1 = gld<f32x4>(bias, (unsigned)(NP + 8 * fq) * 4u + 16);
#pragma unroll
            for (int ai = 0; ai < 2; ++ai)
#pragma unroll
                for (int m = 0; m < 4; ++m) { const unsigned go = (unsigned)((row0 + ai * 128 + m * 16) * 16 + 8 * fq) * 4u;
                    gst<f32x4>(G, go, acc[ai][0][m][0] + b0); gst<f32x4>(G, go + 16, acc[ai][0][m][1] + b1); }
        }
    }
};
struct EpiBf16 {
    static constexpr bool PERM = true, HOOK = false;
    bf16_t* O; int ldc; int split_cols; unsigned split_stride; int pad; float* slab;
    __device__ __forceinline__ void operator()(const f32x4 (&acc)[2][2][4][2], const pg8::Unit& u, int wr, int wc, int fr, int fq) const {
        if (u.ks >= 0) { const unsigned sb = (unsigned)u.ks * (unsigned)(RC * ldc);
            epi_foreach(acc, u, wr, wc, fr, fq, [&](int row, int col, f32x4 v0, f32x4 v1) { const unsigned o = (sb + (unsigned)((row - RL) * ldc + col)) * 4u; gst<f32x4>(slab, o, v0); gst<f32x4>(slab, o + 16, v1); });
            return; }
        int colt = u.pn * 256; unsigned base = 0;
        if (split_cols) { const int t = colt / split_cols; base = (unsigned)t * split_stride; colt -= t * split_cols; }
        const int cshift = colt - u.pn * 256;
        epi_foreach(acc, u, wr, wc, fr, fq, [&](int row, int col, f32x4 v0, f32x4 v1) { gst<u32x4>(O, (base + (unsigned)(row * ldc + col + cshift)) * 2u, pack8v(v0, v1)); });
    }
};
struct EpiMerge {
    static constexpr bool PERM = true, HOOK = true;
    const bf16_t* P; bf16_t* MG;
    __device__ __forceinline__ void hook(f32x4 (&acc)[2][2][4][2], const pg8::Unit& u, int t, int wr, int wc, int fr, int fq) const {
        if (t != 16 && t != 24) return;
        const int b = t == 16 ? 0 : 1;
        const int row0 = u.pm * 256 + wr * 64 + fr, col0 = u.pn * 256 + wc * 32 + 8 * fq;
#pragma unroll
        for (int ai = 0; ai < 2; ++ai)
#pragma unroll
            for (int m = 0; m < 4; ++m)
#pragma unroll
                for (int bj = 0; bj < 2; ++bj) {
                    const unsigned o = (unsigned)((row0 + ai * 128 + m * 16) * NP + PGM + b * D + col0 + bj * 128) * 2u;
                    float xa[8], xb[8]; unpack8(gld<u32x4>(P, o), xa); unpack8(gld<u32x4>(P, o + D * 2), xb);
#pragma unroll
                    for (int j = 0; j < 8; ++j) acc[ai][bj][m][j >> 2][j & 3] *= xb[j] * __builtin_amdgcn_rcpf(xa[j]);
                }
    }
    __device__ __forceinline__ void operator()(const f32x4 (&acc)[2][2][4][2], const pg8::Unit& u, int wr, int wc, int fr, int fq) const {
        epi_foreach(acc, u, wr, wc, fr, fq, [&](int row, int col, f32x4 v0, f32x4 v1) {
            float g[8]; unpack8(gld<u32x4>(P, (unsigned)(row * NP + PGM + 2 * D + col) * 2u), g);
            const f32x4 g0 = {__builtin_amdgcn_rcpf(g[0]), __builtin_amdgcn_rcpf(g[1]), __builtin_amdgcn_rcpf(g[2]), __builtin_amdgcn_rcpf(g[3])},
                        g1 = {__builtin_amdgcn_rcpf(g[4]), __builtin_amdgcn_rcpf(g[5]), __builtin_amdgcn_rcpf(g[6]), __builtin_amdgcn_rcpf(g[7])};
            gst<u32x4>(MG, (unsigned)(row * D + col) * 2u, pack8v(g0 * v0, g1 * v1)); });
    }
};
struct EpiUp {
    static constexpr bool PERM = true, HOOK = false;
    bf16_t* U; float* slab; bf16_t* ACT; const float* wf;
    __device__ __forceinline__ void operator()(const f32x4 (&acc)[2][2][4][2], const pg8::Unit& u, int wr, int wc, int fr, int fq) const {
        if (u.ks >= 0) { const unsigned sb = (unsigned)u.ks * (unsigned)(RC * NUP);
            epi_foreach(acc, u, wr, wc, fr, fq, [&](int row, int col, f32x4 v0, f32x4 v1) { const unsigned o = (sb + (unsigned)((row - RL) * NUP + col)) * 4u; gst<f32x4>(slab, o, v0); gst<f32x4>(slab, o + 16, v1); });
            return; }
        if (u.pm >= 32) { epi_foreach(acc, u, wr, wc, fr, fq, [&](int row, int col, f32x4 v0, f32x4 v1) { gst<u32x4>(U, (unsigned)(row * NUP + col) * 2u, pack8v(v0, v1)); }); return; }
        const int c0 = 128 * u.pn + 32 * wc + 8 * fq, lane = fq * 16 + fr;
        const int lprev = ((lane & 48) | ((fr - 1) & 15)), lnext = ((lane & 48) | ((fr + 1) & 15));
        float w0[8], w1[8], w2[8];
        { const f32x4 a0 = gld<f32x4>(wf, (unsigned)c0 * 4u), a1 = gld<f32x4>(wf, (unsigned)c0 * 4u + 16), b0 = gld<f32x4>(wf, (unsigned)(DFF + c0) * 4u), b1 = gld<f32x4>(wf, (unsigned)(DFF + c0) * 4u + 16),
                      d0 = gld<f32x4>(wf, (unsigned)(2 * DFF + c0) * 4u), d1 = gld<f32x4>(wf, (unsigned)(2 * DFF + c0) * 4u + 16);
#pragma unroll
          for (int j = 0; j < 4; ++j) { w0[j] = a0[j]; w0[4 + j] = a1[j]; w1[j] = b0[j]; w1[4 + j] = b1[j]; w2[j] = d0[j]; w2[4 + j] = d1[j]; } }
        const unsigned rowb = (unsigned)((u.pm >> 3) * 2048 + (u.pm & 7) * 8 + 2 * wr);
#pragma unroll
        for (int ai = 0; ai < 2; ++ai)
#pragma unroll
            for (int m = 0; m < 4; ++m) {
                float o[8];
#pragma unroll
                for (int n = 0; n < 2; ++n)
#pragma unroll
                    for (int e = 0; e < 4; ++e) {
                        const float a = acc[ai][0][m][n][e];
                        const float oprev = (m & 1) ? acc[ai][0][m - 1 < 0 ? 0 : m - 1][n][e] : 0.f, onext = (m & 1) ? 0.f : acc[ai][0][m + 1 > 3 ? 3 : m + 1][n][e];
                        const float pv = shl_(fr == 15 ? oprev : a, lprev), nx = shl_(fr == 0 ? onext : a, lnext);
                        o[4 * n + e] = siluf_(w0[4 * n + e] * pv + w1[4 * n + e] * a + w2[4 * n + e] * nx) * acc[ai][1][m][n][e];
                    }
                const unsigned row = rowb + (unsigned)((16 * (m & 1) + fr) * 64 + 4 * ai + (m >> 1));
                gst<u32x4>(ACT, (row * (unsigned)DFF + (unsigned)c0) * 2u, pack8(o));
            }
    }
};
struct EpiResid {
    static constexpr bool PERM = true, HOOK = false;
    int l, which, fuse; float scale;
    __device__ __forceinline__ void operator()(f32x4 (&acc)[2][2][4][2], const pg8::Unit& u, int wr, int wc, int fr, int fq) const {
        CParams& p = *okp(); unsigned char* const ws = ows(p.ws);
        float* H = (float*)(ws + OFF_H); const float* Hin = (l == 0 && which == 0) ? p.x : H;
        const float* mod = (const float*)(ws + OFF_MOD) + (size_t)l * 5 * 6 * D; const float* gate = mod + (which ? 5 : 2) * D;
        if (u.ks >= 0) { float* slab = (float*)(ws + OFF_SLAB); const unsigned sb = (unsigned)u.ks * (unsigned)(RC * D);
            epi_foreach(acc, u, wr, wc, fr, fq, [&](int row, int col, f32x4 v0, f32x4 v1) { const unsigned o = (sb + (unsigned)((row - RL) * D + col)) * 4u; gst<f32x4>(slab, o, v0); gst<f32x4>(slab, o + 16, v1); });
            return; }
        const unsigned gb = (unsigned)(u.pm < 32 ? (u.pm >> 3) : 4) * (6 * D) * 4u;
        if (!fuse || u.pm >= 32) {
            epi_foreach(acc, u, wr, wc, fr, fq, [&](int row, int col, f32x4 v0, f32x4 v1) {
                const unsigned ho = (unsigned)(row * D + col) * 4u;
                const f32x4 g0 = gld<f32x4>(gate, gb + (unsigned)col * 4u), g1 = gld<f32x4>(gate, gb + (unsigned)col * 4u + 16);
                gst<f32x4>(H, ho, gld<f32x4>(Hin, ho) + g0 * v0 * scale); gst<f32x4>(H, ho + 16, gld<f32x4>(Hin, ho + 16) + g1 * v1 * scale); });
            return; }
        bf16_t* XN = (bf16_t*)(ws + OFF_XN); const float* nw = fuse == 2 ? p.final_norm_w : which ? p.norm1_w + (size_t)(l + 1) * D : p.norm2_w + (size_t)l * D;
        const float* nmod = which ? mod + 5 * 6 * D : mod + 3 * D;
        float* xs = (float*)(ws + OFF_XS) + (size_t)(2 * l + which) * RL * 32; unsigned* cnt = (unsigned*)(ws + OFF_CTL) + CNTW + (2 * l + which) * 32 * 64;
        float* Hw = fuse == 2 ? p.out : H;
        int lane; asm volatile("v_mbcnt_lo_u32_b32 %0, -1, 0\n\tv_mbcnt_hi_u32_b32 %0, -1, %0" : "=v"(lane));
        { const int fr2 = lane & 15, fq2 = lane >> 4, row0 = u.pm * 256 + wr * 64 + fr2, col0 = u.pn * 256 + wc * 32 + 8 * fq2;
          f32x4 gv[2][2];
#pragma unroll
          for (int bj = 0; bj < 2; ++bj) { gv[bj][0] = gld<f32x4>(gate, gb + (unsigned)(col0 + bj * 128) * 4u) * scale; gv[bj][1] = gld<f32x4>(gate, gb + (unsigned)(col0 + bj * 128) * 4u + 16) * scale; }
#pragma unroll
          for (int ai = 0; ai < 2; ++ai)
#pragma unroll
            for (int m = 0; m < 4; ++m) { const int row = row0 + ai * 128 + m * 16; float ss = 0.f;
#pragma unroll
                for (int bj = 0; bj < 2; ++bj) { const unsigned ho = (unsigned)(row * D + col0 + bj * 128) * 4u;
                    const f32x4 h0 = gld<f32x4>(Hin, ho) + gv[bj][0] * acc[ai][bj][m][0], h1 = gld<f32x4>(Hin, ho + 16) + gv[bj][1] * acc[ai][bj][m][1];
                    gst<f32x4>(Hw, ho, h0); gst<f32x4>(Hw, ho + 16, h1);
                    ss += (h0[0] * h0[0] + h0[1] * h0[1]) + (h0[2] * h0[2] + h0[3] * h0[3]) + (h1[0] * h1[0] + h1[1] * h1[1]) + (h1[2] * h1[2] + h1[3] * h1[3]); }
                ss += shx(ss, 16, lane); ss += shx(ss, 32, lane);
                if (fq2 == 0) __hip_atomic_store((GAS float*)xs + (row * 32 + u.pn * 4 + wc), ss, __ATOMIC_RELAXED, __HIP_MEMORY_SCOPE_AGENT);
            } }
        asm volatile("s_waitcnt vmcnt(0)" ::: "memory");
        __builtin_amdgcn_s_barrier();
        if (lane == 0 && wr == 0 && wc == 0) {
            GAS unsigned* pc = (GAS unsigned*)cnt + 64 * u.pm;
            (void)__hip_atomic_fetch_add(pc, 1u, __ATOMIC_RELAXED, __HIP_MEMORY_SCOPE_AGENT);
            unsigned spins = 0;
            while (__hip_atomic_load(pc, __ATOMIC_RELAXED, __HIP_MEMORY_SCOPE_AGENT) < 8u && ++spins < (1u << 22)) __builtin_amdgcn_s_sleep(1);
        }
        __builtin_amdgcn_s_barrier();
        __builtin_amdgcn_fence(__ATOMIC_ACQUIRE, "agent");
        { const int hl = lane & 31, row0 = u.pm * 256 + (wr * 4 + wc) * 32 + (lane >> 5), col = u.pn * 256 + hl * 8;
          const unsigned mo = (unsigned)(u.pm >> 3) * (6 * D) * 4u, co = (unsigned)col * 4u;
          const f32x4 w0 = gld<f32x4>(nw, co), w1 = gld<f32x4>(nw, co + 16);
          if (fuse == 2) { float* out = p.out;
#pragma unroll 4
            for (int it = 0; it < 16; ++it) { const int row = row0 + 2 * it;
                float tot = gld<float>(xs, (unsigned)(row * 32 + hl) * 4u);
                const unsigned ho = (unsigned)(row * D + col) * 4u;
                const f32x4 h0 = gld<f32x4>(out, ho), h1 = gld<f32x4>(out, ho + 16);
#pragma unroll
                for (int o = 1; o < 32; o <<= 1) tot += shx(tot, o, lane);
                const float rstd = rsqrtf(tot * (1.f / D) + EPS);
                gst<f32x4>(out, ho, h0 * rstd * w0); gst<f32x4>(out, ho + 16, h1 * rstd * w1); }
            return; }
          const f32x4 sh0 = gld<f32x4>(nmod, mo + co), sh1 = gld<f32x4>(nmod, mo + co + 16);
          const f32x4 sc0 = gld<f32x4>(nmod, mo + D * 4 + co) + 1.f, sc1 = gld<f32x4>(nmod, mo + D * 4 + co + 16) + 1.f;
#pragma unroll 4
          for (int it = 0; it < 16; ++it) { const int row = row0 + 2 * it;
              float tot = gld<float>(xs, (unsigned)(row * 32 + hl) * 4u);
              const unsigned ho = (unsigned)(row * D + col) * 4u;
              const f32x4 h0 = gld<f32x4>(H, ho), h1 = gld<f32x4>(H, ho + 16);
#pragma unroll
              for (int o = 1; o < 32; o <<= 1) tot += shx(tot, o, lane);
              const float rstd = rsqrtf(tot * (1.f / D) + EPS);
              const f32x4 y0 = (h0 * rstd * w0) * sc0 + sh0, y1 = (h1 * rstd * w1) * sc1 + sh1;
              gst<u32x4>(XN, (unsigned)(row * D + col) * 2u, pack8v(y0, y1)); } }
    }
};

__device__ __forceinline__ bf16x8 gather8(const bf16_t* p, size_t stride) {
    bf16x8 v;
#pragma unroll
    for (int j = 0; j < 8; ++j) v[j] = (short)p[(size_t)j * stride];
    return v;
}
template <bool AV, bool BV>
__device__ __forceinline__ void wave_mm32(const bf16_t* A, size_t sam, size_t sak, const bf16_t* B, size_t sbk, size_t sbn, int K, f32x4 (&acc)[2][2], int lane) {
    const int fr = lane & 15, fq = lane >> 4;
    for (int k0 = 0; k0 < K; k0 += 32) {
        bf16x8 a[2], b[2];
#pragma unroll
        for (int mi = 0; mi < 2; ++mi) { const bf16_t* q = A + (size_t)(16 * mi + fr) * sam + (size_t)(k0 + 8 * fq) * sak; a[mi] = AV ? *(const bf16x8*)q : gather8(q, sak); }
#pragma unroll
        for (int ni = 0; ni < 2; ++ni) { const bf16_t* q = B + (size_t)(16 * ni + fr) * sbn + (size_t)(k0 + 8 * fq) * sbk; b[ni] = BV ? *(const bf16x8*)q : gather8(q, sbk); }
#pragma unroll
        for (int mi = 0; mi < 2; ++mi)
#pragma unroll
            for (int ni = 0; ni < 2; ++ni) acc[mi][ni] = __builtin_amdgcn_mfma_f32_16x16x32_bf16(a[mi], b[ni], acc[mi][ni], 0, 0, 0);
    }
}
#define ZERO_ACC22(acc) do { _Pragma("unroll") for (int _a = 0; _a < 2; ++_a) _Pragma("unroll") for (int _b = 0; _b < 2; ++_b) acc[_a][_b] = (f32x4){0.f, 0.f, 0.f, 0.f}; } while (0)

__device__ __forceinline__ void transpose_item(const float* W, int N, int pitch, int kdst0, bf16_t* WT, int dst_row0, int src_col0, int nvalid, int k0, LAS float* scr, int lane) {
    const int n4 = (lane & 15) * 4, kq = lane >> 4;
    f32x4 v[16];
#pragma unroll
    for (int i = 0; i < 16; ++i) v[i] = n4 < nvalid ? gld<f32x4>(W, (unsigned)((k0 + 4 * i + kq) * N + src_col0 + n4) * 4u) : (f32x4){0.f, 0.f, 0.f, 0.f};
#pragma unroll
    for (int i = 0; i < 16; ++i) { LAS float* d = scr + (4 * i + kq) * 65 + n4; d[0] = v[i][0]; d[1] = v[i][1]; d[2] = v[i][2]; d[3] = v[i][3]; }
    asm volatile("s_waitcnt lgkmcnt(0)" ::: "memory");
    const int c = lane & 7;
#pragma unroll
    for (int j8 = 0; j8 < 8; ++j8) { const int n = (lane >> 3) + 8 * j8; const LAS float* sp = scr + (8 * c) * 65 + n;
        u32x4 o; o.x = pk2(sp[0 * 65], sp[1 * 65]); o.y = pk2(sp[2 * 65], sp[3 * 65]); o.z = pk2(sp[4 * 65], sp[5 * 65]); o.w = pk2(sp[6 * 65], sp[7 * 65]);
        gst<u32x4>(WT, (unsigned)((dst_row0 + n) * pitch + kdst0 + k0 + 8 * c) * 2u, o); }
    asm volatile("s_waitcnt lgkmcnt(0)" ::: "memory");
}
constexpr int I_IN = (NINP / 64) * (D / 64), I_PM = (D / 64) * (DM / 64), I_PF = (D / 64) * (DF / 64), I_PC = (D / 64) * (DC / 64), I_O = (D / 64) * (D / 64),
              I_UP = (NUP / 64) * (D / 64), I_DN = (D / 64) * (DFF / 64), I_LAYER = I_IN + I_PM + I_PF + I_PC + I_O + I_UP + I_DN;
__device__ __forceinline__ void ph_convert(int wv, LAS unsigned char* lds, int l, int widx, int nwg, int it_lo, int it_hi) {
    CParams& p = *okp();
    unsigned char* const wsb = ows(p.ws);
    const int TIDX = otid(wv);
    const int lane = TIDX & 63, wave = wv;
    LAS float* scr = (LAS float*)lds + wave * 64 * 65;
    const int gw = widx * 8 + wave, NGW = nwg * 8;
    for (int it = it_lo + gw; it < it_hi; it += NGW) {
        int r = it;
        if (r < I_IN) { const int nkb = D / 64, kb = r % nkb, grp = r / nkb, j0 = 64 * grp; int src0, nv;
            if (j0 < 2048) { src0 = j0; nv = 64; } else if (j0 < NP) { src0 = j0 + 16; nv = 64; } else if (j0 == NP) { src0 = 2048; nv = 16; } else { src0 = 0; nv = 0; }
            transpose_item(p.w_in + (size_t)l * D * NIN, NIN, D, 0, WSP(bf16_t, OFF_WIN) + (size_t)l * NINP * D, j0, src0, nv, 64 * kb, scr, lane); continue; } r -= I_IN;
        if (r < I_PM) { const int nkb = DM / 64, kb = r % nkb, grp = r / nkb;
            transpose_item(p.w_pm + (size_t)l * DM * D, D, D, 0, WSP(bf16_t, OFF_WPM) + (size_t)l * D * D, 64 * grp, 64 * grp, 64, 64 * kb, scr, lane); continue; } r -= I_PM;
        if (r < I_PF) { const int nkb = DF / 64, kb = r % nkb, grp = r / nkb;
            transpose_item(p.w_pf + (size_t)l * DF * D, D, D, DM, WSP(bf16_t, OFF_WPM) + (size_t)l * D * D, 64 * grp, 64 * grp, 64, 64 * kb, scr, lane); continue; } r -= I_PF;
        if (r < I_PC) { const int nkb = DC / 64, kb = r % nkb, grp = r / nkb;
            transpose_item(p.w_pc + (size_t)l * DC * D, D, D, DM + DF, WSP(bf16_t, OFF_WPM) + (size_t)l * D * D, 64 * grp, 64 * grp, 64, 64 * kb, scr, lane); continue; } r -= I_PC;
        if (r < I_O) { const int nkb = D / 64, kb = r % nkb, grp = r / nkb;
            transpose_item(p.w_o + (size_t)l * D * D, D, D, 0, WSP(bf16_t, OFF_WO) + (size_t)l * D * D, 64 * grp, 64 * grp, 64, 64 * kb, scr, lane); continue; } r -= I_O;
        if (r < I_UP) { const int nkb = D / 64, kb = r % nkb, grp = r / nkb, j0 = 64 * grp, tile = j0 >> 8, w0 = j0 & 255;
            transpose_item(p.w_up + (size_t)l * D * NUP, NUP, D, 0, WSP(bf16_t, OFF_WUP) + (size_t)l * NUP * D, j0, w0 < 128 ? 128 * tile + w0 : DFF + 128 * tile + (w0 - 128), 64, 64 * kb, scr, lane); continue; } r -= I_UP;
        { const int nkb = DFF / 64, kb = r % nkb, grp = r / nkb;
            transpose_item(p.w_down + (size_t)l * DFF * D, D, DFF, 0, WSP(bf16_t, OFF_WDN) + (size_t)l * D * DFF, 64 * grp, 64 * grp, 64, 64 * kb, scr, lane); }
    }
}
__device__ __forceinline__ void ph_tables(int wv) {
    CParams& p = *okp();
    unsigned char* const wsb = ows(p.ws);
    const int TIDX = otid(wv), BIDX = obid(); (void)TIDX; (void)BIDX;
    const size_t gt = (size_t)BIDX * 512 + TIDX, NT = (size_t)gridDim.x * 512;
    bf16_t* ma = WSP(bf16_t, OFF_MA);
    for (size_t i = gt; i < (size_t)64 * 64; i += NT) { const int row = (int)(i >> 6), col = (int)(i & 63), ro = row >> 5, tau1 = row & 31, ri = col >> 5, t1 = col & 31;
        const float a = (float)((t1 * tau1) & 31) * (1.0f / 16.0f); const float cv = cospif(a), sv = sinpif(a);
        ma[i] = (bf16_t)f2bf(ro == ri ? cv : (ro == 0 ? sv : -sv)); }
    bf16_t* mc = WSP(bf16_t, OFF_MC);
    for (size_t i = gt; i < (size_t)32 * 64 * 128; i += NT) { const int k = (int)(i & 127), tau2 = (int)(i >> 7) & 63, tau1 = (int)(i >> 13), ri = k >> 6, t2 = k & 63, tau = tau1 + 32 * tau2;
        const float a = (float)((t2 * tau) & 2047) * (1.0f / 1024.0f); mc[i] = (bf16_t)f2bf((ri ? sinpif(a) : cospif(a)) * (1.0f / 512.0f)); }
    bf16_t* csc = WSP(bf16_t, OFF_CSC);
    for (size_t i = gt; i < (size_t)256 * 512; i += NT) { const int tau = (int)(i >> 9), k = (int)(i & 511), t = k & 255; const int idx = (tau * t) & 255;
        const float a = (float)idx * (1.0f / 128.0f); const float v = (k < 256 ? cospif(a) : -sinpif(a)) * 0.005524271728019903f  ; csc[i] = (bf16_t)f2bf(v); }
    bf16_t* ft = WSP(bf16_t, OFF_FT);
    for (size_t i = gt; i < (size_t)256 * 128; i += NT) { const int kp = (int)(i >> 7), c = (int)(i & 127), kap = kp & 127; const int idx = (c * kap) & 127;
        const float a = (float)idx * (1.0f / 64.0f); ft[i] = (bf16_t)f2bf(kp < 128 ? cospif(a) : sinpif(a)); }
    float* binr = WSP(float, OFF_BINR);
    for (size_t i = gt; i < (size_t)DEPTH * NINP; i += NT) { const int l = (int)(i / NINP), j = (int)(i % NINP);
        float v = 0.f; if (j < 2048) v = p.b_in[(size_t)l * NIN + j]; else if (j < NP) v = p.b_in[(size_t)l * NIN + j + 16]; else if (j < NP + 16) v = p.b_in[(size_t)l * NIN + 2048 + (j - NP)];
        binr[i] = v; }

}
__device__ __forceinline__ void ph_mod(int wv, LAS unsigned char* lds, int l0, int l1, int widx, int nwg) {
    CParams& p = *okp();
    unsigned char* const wsb = ows(p.ws);
    const int TIDX = otid(wv), BIDX = obid(); (void)TIDX; (void)BIDX;
    typedef float sc_row_t[D]; typedef f32x4 red_t[5][16];
    LAS sc_row_t* sc = (LAS sc_row_t*)lds; LAS red_t* red = (LAS red_t*)(lds + 5 * D * 4);
    const int tid = TIDX;
    for (int i = tid; i < 5 * D; i += 512) { const int j = i / D, k = i % D; const float v = j < 4 ? p.c[(size_t)j * D + k] : p.c_ctx[k]; sc[j][k] = siluf_(v); }
    __syncthreads();
    float* mod = WSP(float, OFF_MOD);
    const int cl = tid & 15, kg = tid >> 4;
    for (int unit = widx; unit < (l1 - l0) * (6 * D / 64); unit += nwg) {
        const int l = l0 + unit / (6 * D / 64), n0 = (unit % (6 * D / 64)) * 64;
        f32x4 a[5];
#pragma unroll
        for (int j = 0; j < 5; ++j) a[j] = (f32x4){0.f, 0.f, 0.f, 0.f};
        const float* wp = p.w_mod + (size_t)l * D * 6 * D + n0 + 4 * cl;
        for (int k = kg; k < D; k += 32) { const f32x4 w = *(const f32x4*)(wp + (size_t)k * 6 * D);
#pragma unroll
            for (int j = 0; j < 5; ++j) a[j] += sc[j][k] * w; }
#pragma unroll
        for (int j = 0; j < 5; ++j) {
#pragma unroll
            for (int e = 0; e < 4; ++e) { float v = a[j][e]; v += shx(v, 16, tid & 63); v += shx(v, 32, tid & 63); a[j][e] = v; }
            if ((tid & 63) < 16) red[tid >> 6][j][cl] = a[j]; }
        __syncthreads();
        if (tid < 5 * 64) { const int j = tid / 64, cc = tid % 64; float s = 0.f;
            for (int g = 0; g < 8; ++g) s += ((const LAS float*)&red[g][j][0])[cc];
            mod[((size_t)l * 5 + j) * 6 * D + n0 + cc] = s + p.b_mod[(size_t)l * 6 * D + n0 + cc]; }
        __syncthreads();
    }
}

__device__ __forceinline__ void ph_norm(int wv, int l, int which, const float* fixgate, int row_lo, int nrows, const float* hlat, const float* hctx) {
    CParams& p = *okp();
    unsigned char* const wsb = ows(p.ws);
    const int TIDX = otid(wv), BIDX = obid();
    const int lane = TIDX & 63, gw = BIDX * 8 + (TIDX >> 6), NGW = gridDim.x * 8;
    const float* nw = (which ? p.norm2_w : p.norm1_w) + (size_t)l * D;
    const float* mod = WSP(float, OFF_MOD) + (size_t)l * 5 * 6 * D;
    float* H = WSP(float, OFF_H); bf16_t* XN = WSP(bf16_t, OFF_XN); const float* SL = WSP(float, OFF_SLAB);
    for (int r = row_lo + gw; r < nrows; r += NGW) {
        int mj, t, T; rowinfo(r, mj, t, T);
        const unsigned so = (unsigned)(mj * 6 * D + (which ? 3 : 0) * D) * 4u;
        const unsigned ho = (unsigned)(r * D + 4 * lane) * 4u;
        const float* rd = r < RL ? hlat : hctx; const unsigned ro = (unsigned)((r < RL ? r : r - RL) * D + 4 * lane) * 4u;
        f32x4 v[8]; float ss = 0.f;
#pragma unroll
        for (int j = 0; j < 8; ++j) v[j] = gld<f32x4>(rd, ro + (unsigned)j * 1024u);
        if (fixgate != nullptr && r >= RL) {
#pragma unroll
            for (int j = 0; j < 8; ++j) { f32x4 a = gld<f32x4>(SL, (unsigned)((r - RL) * D + 4 * lane + 256 * j) * 4u);
#pragma unroll
                for (int sl = 1; sl < 8; ++sl) a += gld<f32x4>(SL, (unsigned)((sl * RC + (r - RL)) * D + 4 * lane + 256 * j) * 4u);
                v[j] += gld<f32x4>(fixgate, (unsigned)(4 * lane + 256 * j) * 4u) * a;
                gst<f32x4>(H, ho + (unsigned)j * 1024u, v[j]); }
        }
#pragma unroll
        for (int j = 0; j < 8; ++j) ss += (v[j][0] * v[j][0] + v[j][1] * v[j][1]) + (v[j][2] * v[j][2] + v[j][3] * v[j][3]);
        const float rstd = rsqrtf(wave_sum(ss, lane) * (1.f / D) + EPS);
#pragma unroll
        for (int j = 0; j < 8; ++j) { const unsigned co = (unsigned)(4 * (lane + 64 * j)) * 4u;
            const f32x4 w = gld<f32x4>(nw, co), sc = gld<f32x4>(mod, so + D * 4 + co), sh = gld<f32x4>(mod, so + co);
            const f32x4 y = (v[j] * rstd * w) * (1.f + sc) + sh;
            u32x2 q; q.x = pk2(y[0], y[1]); q.y = pk2(y[2], y[3]); gst<u32x2>(XN, (unsigned)(r * D + 4 * (lane + 64 * j)) * 2u, q); }
    }
}
__device__ __forceinline__ void ph_final(int wv) {
    CParams& p = *okp();
    unsigned char* const wsb = ows(p.ws);
    const int TIDX = otid(wv), BIDX = obid(); (void)TIDX; (void)BIDX;
    const int lane = TIDX & 63, gw = BIDX * 8 + (TIDX >> 6), NGW = gridDim.x * 8;
    const float* H = WSP(float, OFF_H);
    for (int r = gw; r < RL; r += NGW) {
        const f32x4* xr = (const f32x4*)(H + (size_t)r * D) + lane;
        f32x4 v[8]; float ss = 0.f;
#pragma unroll
        for (int j = 0; j < 8; ++j) { v[j] = xr[64 * j]; ss += (v[j][0] * v[j][0] + v[j][1] * v[j][1]) + (v[j][2] * v[j][2] + v[j][3] * v[j][3]); }
        const float rstd = rsqrtf(wave_sum(ss, lane) * (1.f / D) + EPS);
        f32x4* o = (f32x4*)(p.out + (size_t)r * D) + lane;
#pragma unroll
        for (int j = 0; j < 8; ++j) { const f32x4 w = *(const f32x4*)(p.final_norm_w + 4 * (lane + 64 * j)); o[64 * j] = v[j] * rstd * w; }
    }
}

__device__ __forceinline__ float wave_incl_sum(float v, int lane) {
#pragma unroll
    for (int o = 1; o < 64; o <<= 1) { const float t = shl_(v, lane >= o ? lane - o : lane); if (lane >= o) v += t; }
    return v;
}
__device__ __forceinline__ float wave_incl_max(float v, int lane) {
#pragma unroll
    for (int o = 1; o < 64; o <<= 1) { const float t = shl_(v, lane >= o ? lane - o : lane); if (lane >= o) v = fmaxf(v, t); }
    return v;
}
__device__ __forceinline__ float logsigmoidf_(float x) { return fminf(x, 0.f) - log1pf(__expf(-fabsf(x))); }
struct GateV { float b0, b1, c0, c1, m0, m1, bend, cend; int s0, s1; };
__device__ __forceinline__ GateV gate_vectors(const float* G, int row0, int h, int dir, int lane) {
    GateV g; g.s0 = dir ? 127 - lane : lane; g.s1 = dir ? 63 - lane : lane + 64;
    const unsigned o0 = (unsigned)((row0 + g.s0) * 16 + dir * 8 + h) * 4u, o1 = (unsigned)((row0 + g.s1) * 16 + dir * 8 + h) * 4u;
    const float i0 = gld<float>(G, o0), f0 = gld<float>(G, o0 + 16), i1 = gld<float>(G, o1), f1 = gld<float>(G, o1 + 16);
    g.b0 = wave_incl_sum(logsigmoidf_(f0), lane); const float tot0 = shl_(g.b0, 63 + (lane & 0));
    g.b1 = wave_incl_sum(logsigmoidf_(f1), lane) + tot0;
    g.c0 = i0 - g.b0; g.c1 = i1 - g.b1;
    g.m0 = wave_incl_max(g.c0, lane); const float mx0 = shl_(g.m0, 63 + (lane & 0));
    g.m1 = fmaxf(wave_incl_max(g.c1, lane), mx0);
    g.bend = shl_(g.b1, 63 + (lane & 0)); g.cend = shl_(g.m1, 63 + (lane & 0));
    return g;
}
__device__ __forceinline__ void ph_convc(int wv, int l, int nrows, int widx, int nwg) {
    CParams& p = *okp();
    unsigned char* const wsb = ows(p.ws);
    const unsigned gt = (unsigned)widx * 512u + otid(wv), NT = (unsigned)nwg * 512u;
    const bf16_t* P = WSP(bf16_t, OFF_P); bf16_t* YC = WSP(bf16_t, OFF_HM) + (DM + DF);
    const float* wc = p.conv_c_w + (size_t)l * 3 * DC;
    for (unsigned i = gt; i < (unsigned)nrows * 64u; i += NT) {
        const int r = (int)(i >> 6), c = (int)(i & 63) * 8; int mj, t, T; rowinfo(r, mj, t, T);
        const unsigned pr = (unsigned)(r * NP) * 2u;
        const bool cp = r < RL ? (t & 63) > 0 : t > 0, cn = r < RL ? (t & 63) < 63 : t < T - 1;
        float x0[8], x1[8], y0[8], y1[8], z0[8], z1[8], cb[8], o[8];
        unpack8(gld<u32x4>(P, pr + (PCC + c) * 2), x0); unpack8(gld<u32x4>(P, pr + (PCX + c) * 2), x1); unpack8(gld<u32x4>(P, pr + (PCB + c) * 2), cb);
        const unsigned pp = cp ? pr - NP * 2 : pr, pn = cn ? pr + NP * 2 : pr;
        unpack8(gld<u32x4>(P, pp + (PCC + c) * 2), y0); unpack8(gld<u32x4>(P, pp + (PCX + c) * 2), y1);
        unpack8(gld<u32x4>(P, pn + (PCC + c) * 2), z0); unpack8(gld<u32x4>(P, pn + (PCX + c) * 2), z1);
        const f32x4 w00 = gld<f32x4>(wc, (unsigned)c * 4u), w01 = gld<f32x4>(wc, (unsigned)c * 4u + 16), w10 = gld<f32x4>(wc, (unsigned)(DC + c) * 4u), w11 = gld<f32x4>(wc, (unsigned)(DC + c) * 4u + 16),
                    w20 = gld<f32x4>(wc, (unsigned)(2 * DC + c) * 4u), w21 = gld<f32x4>(wc, (unsigned)(2 * DC + c) * 4u + 16);
#pragma unroll
        for (int j = 0; j < 8; ++j) { const float w0 = j < 4 ? w00[j & 3] : w01[j & 3], w1 = j < 4 ? w10[j & 3] : w11[j & 3], w2 = j < 4 ? w20[j & 3] : w21[j & 3];
            float v = w1 * (x0[j] * x1[j]); if (cp) v += w0 * (y0[j] * y1[j]); if (cn) v += w2 * (z0[j] * z1[j]); o[j] = cb[j] * v; }
        gst<u32x4>(YC, (unsigned)(r * D + c) * 2u, pack8(o));
    }
}
__device__ __forceinline__ void ph_fourier1(int wv, int widx, int nwg) {
    CParams& p = *okp();
    unsigned char* const wsb = ows(p.ws);
    const int TIDX = otid(wv), BIDX = obid(); (void)TIDX; (void)BIDX;
    const int lane = TIDX & 63, gw = widx * 8 + (TIDX >> 6), NGW = nwg * 8, fr = lane & 15, fq = lane >> 4;
    const bf16_t* P = WSP(bf16_t, OFF_P); const bf16_t* FT = WSP(bf16_t, OFF_FT);
    bf16_t* ZTC = WSP(bf16_t, OFF_ZTC);
    for (int task = gw; task < (RC / 32) * 4 * 8; task += NGW) {
        const int kb = task & 7, g = (task >> 3) & 3, rb = task >> 5, r0 = RL + rb * 32;
        f32x4 acc[2][2]; ZERO_ACC22(acc);
        wave_mm32<true, true>(P + (size_t)r0 * NP + PF + g * 128, NP, 1, FT + (size_t)(kb * 32) * 128, 1, 128, 128, acc, lane);
#pragma unroll
        for (int mi = 0; mi < 2; ++mi)
#pragma unroll
            for (int ni = 0; ni < 2; ++ni) {
                const int r = r0 + 16 * mi + 4 * fq, kp = kb * 32 + 16 * ni + fr, comp = kp >> 7, kap = kp & 127;
                u32x2 w; w.x = pk2(acc[mi][ni][0], acc[mi][ni][1]); w.y = pk2(acc[mi][ni][2], acc[mi][ni][3]);
                { const int q = r - RL, b = q >> 8, t = q & 255; *(u32x2*)(ZTC + (size_t)((b * 4 + g) * 128 + kap) * 512 + comp * 256 + t) = w; }
            }
    }
}
template <bool FIRST> __device__ __forceinline__ f32x4 mma16(bf16x8 a, bf16x8 b, f32x4 c) {
    if constexpr (FIRST) return __builtin_amdgcn_mfma_f32_16x16x32_bf16(a, b, (f32x4){0.f, 0.f, 0.f, 0.f}, 0, 0, 0);
    else return __builtin_amdgcn_mfma_f32_16x16x32_bf16(a, b, c, 0, 0, 0);
}
typedef short s16x4 __attribute__((ext_vector_type(4)));
constexpr int PIT_T = 544;
constexpr int PIT_R = 528;
constexpr int PIT_P = 272;
__device__ __forceinline__ bf16x8 tr_frag(LAS unsigned char* img, int pitchB, int r0, int c0, int lane) {
    const int g = lane >> 4, q = (lane & 15) >> 2, pp = lane & 3;
    LAS unsigned char* a = img + (r0 + 8 * g + q) * pitchB + (c0 + 4 * pp) * 2;
    const s16x4 lo = __builtin_amdgcn_ds_read_tr16_b64_v4i16((LAS s16x4*)a);
    const s16x4 hi = __builtin_amdgcn_ds_read_tr16_b64_v4i16((LAS s16x4*)(a + 4 * pitchB));
    return (bf16x8){lo[0], lo[1], lo[2], lo[3], hi[0], hi[1], hi[2], hi[3]};
}
template <class F> __device__ __forceinline__ void conv_silu_rows(const u32x4 (&raw)[10], const float (&w0)[8], const float (&w1)[8], const float (&w2)[8], F&& f) {
    float a[8], b[8], c[8];
    unpack8(raw[0], a); unpack8(raw[1], b);
#pragma unroll
    for (int i = 0; i < 8; ++i) {
        unpack8(raw[i + 2], c);
        float o[8];
#pragma unroll
        for (int j = 0; j < 8; ++j) o[j] = siluf_(w0[j] * a[j] + w1[j] * b[j] + w2[j] * c[j]);
        f(i, o);
#pragma unroll
        for (int j = 0; j < 8; ++j) { a[j] = b[j]; b[j] = c[j]; }
    }
}
constexpr int FPIT = 2336;
__device__ __forceinline__ void ph_fft(int wv, LAS unsigned char* lds, int u0, int ustride) {
    CParams& p = *okp();
    unsigned char* const wsb = ows(p.ws);
    const bf16_t* P = WSP(bf16_t, OFF_P); const bf16_t* FT = WSP(bf16_t, OFF_FT); const bf16_t* MA = WSP(bf16_t, OFF_MA); const bf16_t* MC = WSP(bf16_t, OFF_MC); bf16_t* HM = WSP(bf16_t, OFF_HM);
    LAS unsigned char* IMG = lds;
    const int wave = wv;
    for (int unit = u0; unit < NB * 4 * 8; unit += ustride) {
        const int kb = unit & 7, g = (unit >> 3) & 3, b = unit >> 5, kap0 = 16 * kb;
        {
            const int tid = otid(wv), lane = tid & 63, fr = lane & 15, fq = lane >> 4;
            bf16x8 fb[2][4];
#pragma unroll
            for (int ni = 0; ni < 2; ++ni)
#pragma unroll
                for (int ks = 0; ks < 4; ++ks) fb[ni][ks] = gld<bf16x8>(FT, (unsigned)((ni * 128 + kap0 + fr) * 128 + 32 * ks + 8 * fq) * 2u);
#pragma unroll 1
            for (int mi8 = 0; mi8 < 2; ++mi8) {
                bf16x8 xa[8][4];
#pragma unroll
                for (int m = 0; m < 8; ++m)
#pragma unroll
                    for (int ks = 0; ks < 4; ++ks) xa[m][ks] = gld<bf16x8>(P, (unsigned)((b * 2048 + 256 * wave + 16 * (8 * mi8 + m) + fr) * NP + PF + g * 128 + 32 * ks + 8 * fq) * 2u);
#pragma unroll
                for (int m = 0; m < 8; ++m) {
                    f32x4 zr = mma16<true>(xa[m][0], fb[0][0], zr), zi = mma16<true>(xa[m][0], fb[1][0], zi);
#pragma unroll
                    for (int ks = 1; ks < 4; ++ks) { zr = mma16<false>(xa[m][ks], fb[0][ks], zr); zi = mma16<false>(xa[m][ks], fb[1][ks], zi); }
                    const int tb = 256 * wave + 16 * (8 * mi8 + m) + 4 * fq, t1 = tb >> 6, t2 = tb & 63;
                    u32x2 wr_, wi_; wr_.x = pk2(zr[0], zr[1]); wr_.y = pk2(zr[2], zr[3]); wi_.x = pk2(-zi[0], -zi[1]); wi_.y = pk2(-zi[2], -zi[3]);
                    *(LAS u32x2*)(IMG + t1 * FPIT + fr * 144 + t2 * 2) = wr_;
                    *(LAS u32x2*)(IMG + (32 + t1) * FPIT + fr * 144 + t2 * 2) = wi_;
                }
            }
        }
        __syncthreads();
        {
            const int tid = otid(wv), lane = tid & 63, fr = lane & 15, fq = lane >> 4;
            bf16x8 ya[4][2];
#pragma unroll
            for (int mt = 0; mt < 4; ++mt)
#pragma unroll
                for (int ks = 0; ks < 2; ++ks) ya[mt][ks] = gld<bf16x8>(MA, (unsigned)((16 * mt + fr) * 64 + 32 * ks + 8 * fq) * 2u);
#pragma unroll 2
            for (int j = 0; j < 8; ++j) {
                const int grp = 8 * wave + j, c0 = (grp >> 2) * 72 + (grp & 3) * 16;
                const bf16x8 x0 = tr_frag(IMG, FPIT, 0, c0, lane), x1 = tr_frag(IMG, FPIT, 32, c0, lane);
                f32x4 d[4];
#pragma unroll
                for (int mt = 0; mt < 4; ++mt) { d[mt] = mma16<true>(x0, ya[mt][0], d[mt]); d[mt] = mma16<false>(x1, ya[mt][1], d[mt]); }
#pragma unroll
                for (int mt = 0; mt < 4; ++mt) { u32x2 w; w.x = pk2(d[mt][0], d[mt][1]); w.y = pk2(d[mt][2], d[mt][3]);
                    *(LAS u32x2*)(IMG + (16 * mt + fr) * FPIT + (c0 + 4 * fq) * 2) = w; }
            }
        }
        __syncthreads();
        {
            const int tid = otid(wv), lane = tid & 63, fr = lane & 15, fq = lane >> 4;
            bf16x8 y[4][4];
#pragma unroll
            for (int mt = 0; mt < 4; ++mt)
#pragma unroll
                for (int ks = 0; ks < 4; ++ks) y[mt][ks] = gld<bf16x8>(MC, (unsigned)((4 * wave * 64 + 16 * mt + fr) * 128 + 32 * ks + 8 * fq) * 2u);
#pragma unroll 1
            for (int q = 0; q < 4; ++q) {
                const int tau1 = 4 * wave + q, tn = q < 3 ? tau1 + 1 : tau1;
                bf16x8 yn[4][4];
#pragma unroll
                for (int mt = 0; mt < 4; ++mt)
#pragma unroll
                    for (int ks = 0; ks < 4; ++ks) yn[mt][ks] = gld<bf16x8>(MC, (unsigned)((tn * 64 + 16 * mt + fr) * 128 + 32 * ks + 8 * fq) * 2u);
                f32x4 acc[4];
#pragma unroll
                for (int ks = 0; ks < 4; ++ks) { const bf16x8 x = *(const LAS bf16x8*)(IMG + ((ks >> 1) * 32 + tau1) * FPIT + fr * 144 + (32 * (ks & 1) + 8 * fq) * 2);
#pragma unroll
                    for (int mt = 0; mt < 4; ++mt) { if (ks == 0) acc[mt] = mma16<true>(x, y[mt][ks], acc[mt]); else acc[mt] = mma16<false>(x, y[mt][ks], acc[mt]); } }
#pragma unroll
                for (int mt = 0; mt < 4; ++mt) { const int tau = tau1 + 32 * (16 * mt + fr);
                    u32x2 w; w.x = pk2(acc[mt][0], acc[mt][1]); w.y = pk2(acc[mt][2], acc[mt][3]);
                    gst<u32x2>(HM, (unsigned)((b * 2048 + tau) * D + DM + g * 128 + kap0 + 4 * fq) * 2u, w); }
#pragma unroll
                for (int mt = 0; mt < 4; ++mt)
#pragma unroll
                    for (int ks = 0; ks < 4; ++ks) y[mt][ks] = yn[mt][ks];
            }
        }
        __syncthreads();
    }
}
__device__ __forceinline__ void ph_mlstm1(int wv, int l, LAS unsigned char* lds) {
    CParams& p = *okp();
    unsigned char* const wsb = ows(p.ws);
    const int wave = wv;
    LAS unsigned char* KWs = lds; LAS unsigned char* Vs = lds + 128 * PIT_T; LAS float* vW = (LAS float*)(lds + 2 * 128 * PIT_T);
    const bf16_t* P = WSP(bf16_t, OFF_P); const float* G = WSP(float, OFF_G);
    bf16_t* UT = WSP(bf16_t, OFF_UT); float* NV = WSP(float, OFF_NV); float* CHS = WSP(float, OFF_CHS);
    const float* wk = p.conv_k_w + (size_t)l * 3 * DM;
    for (int unit = obid(); unit < NCHUNK * NH * 2; unit += gridDim.x) {
        const int tid = otid(wv), lane = tid & 63, fr = lane & 15, fq = lane >> 4, dg = tid & 31, sg = tid >> 5;
        const int dir = unit & 1, h = (unit >> 1) & 3, cidx = unit >> 3, row0 = chunk_row0(cidx);
        const bool first = cidx < 64 ? (cidx & 15) == 0 : ((cidx - 64) & 1) == 0, last = cidx < 64 ? (cidx & 15) == 15 : ((cidx - 64) & 1) == 1;
        const bf16_t* kp = P + (size_t)(row0 + 8 * sg) * NP + PK + h * DH + 8 * dg;
        u32x4 kr[10], vr[8];
#pragma unroll
        for (int i = 0; i < 10; ++i) { const int s = 8 * sg - 1 + i; const bool ok = (s >= 0 || !first) && (s < CHUNK || !last);
            kr[i] = ok ? *(const u32x4*)(kp + (ptrdiff_t)(i - 1) * NP) : (u32x4){0u, 0u, 0u, 0u}; }
#pragma unroll
        for (int i = 0; i < 8; ++i) vr[i] = *(const u32x4*)(kp + (PV - PK) + (size_t)i * NP);
        float w0[8], w1[8], w2[8];
#pragma unroll
        for (int j = 0; j < 8; ++j) { w0[j] = wk[h * DH + 8 * dg + j]; w1[j] = wk[DM + h * DH + 8 * dg + j]; w2[j] = wk[2 * DM + h * DH + 8 * dg + j]; }
        if (wave == 0)     { const GateV g = gate_vectors(G, row0, h, dir, lane); vW[g.s0] = __expf(g.c0 - g.cend); vW[g.s1] = __expf(g.c1 - g.cend);
            if (lane == 0) { CHS[(size_t)(cidx * 8 + dir * 4 + h) * 2] = g.bend; CHS[(size_t)(cidx * 8 + dir * 4 + h) * 2 + 1] = g.bend + g.cend; } }
        __syncthreads();
        conv_silu_rows(kr, w0, w1, w2, [&](int i, float (&o)[8]) { const float ws = vW[8 * sg + i];
#pragma unroll
            for (int j = 0; j < 8; ++j) o[j] *= ws;
            *(LAS u32x4*)(KWs + (8 * sg + i) * PIT_T + dg * 16) = pack8(o); });
#pragma unroll
        for (int i = 0; i < 8; ++i) *(LAS u32x4*)(Vs + (8 * sg + i) * PIT_T + dg * 16) = vr[i];
        __syncthreads();
        f32x4 acc[2][16];
        auto kstep1 = [&](int k0, auto first) {
            bf16x8 fv[2];
#pragma unroll
            for (int mi = 0; mi < 2; ++mi) fv[mi] = tr_frag(Vs, PIT_T, k0, 32 * wave + 16 * mi, lane);
#pragma unroll
            for (int ni = 0; ni < 16; ++ni) { const bf16x8 fk = tr_frag(KWs, PIT_T, k0, 16 * ni, lane);
#pragma unroll
                for (int mi = 0; mi < 2; ++mi) acc[mi][ni] = mma16<decltype(first)::value>(fk, fv[mi], acc[mi][ni]); }
        };
        kstep1(0, std::true_type{});
#pragma unroll 1
        for (int k0 = 32; k0 < CHUNK; k0 += 32) kstep1(k0, std::false_type{});
        bf16_t* out = UT + ((size_t)(cidx * NH + h) * 2 + dir) * DH * DH;
#pragma unroll
        for (int mi = 0; mi < 2; ++mi)
#pragma unroll
            for (int ni = 0; ni < 16; ++ni) { u32x2 w; w.x = pk2(acc[mi][ni][0], acc[mi][ni][1]); w.y = pk2(acc[mi][ni][2], acc[mi][ni][3]);
                *(u32x2*)(out + (size_t)(32 * wave + 16 * mi + fr) * DH + 16 * ni + 4 * fq) = w; }
        if (tid < DH) { float sum = 0.f;
#pragma unroll 8
            for (int s2 = 0; s2 < CHUNK; ++s2) sum += bf2f(*(const LAS bf16_t*)(KWs + s2 * PIT_T + tid * 2));
            NV[((size_t)(cidx * NH + h) * 2 + dir) * DH + tid] = sum; }
        __syncthreads();
    }
}
__device__ __forceinline__ void ph_mlstm2(int wv) {
    CParams& p = *okp();
    unsigned char* const wsb = ows(p.ws);
    const int tid = otid(wv);
    const bf16_t* UT = WSP(bf16_t, OFF_UT); bf16_t* CT = WSP(bf16_t, OFF_CT);
    const float *NV = WSP(float, OFF_NV), *CHS = WSP(float, OFF_CHS); float *NS = WSP(float, OFF_NS), *MST = WSP(float, OFF_MST);
    for (int task = obid(); task < NB * NH * 2 * 16; task += gridDim.x) {
        const int part = task & 15, scan = task >> 4, dir = scan & 1, h = (scan >> 1) & 3, b = scan >> 3, dh = dir * 4 + h;
        const unsigned e0 = (unsigned)(part * 4096 + olaunder(tid) * 8) * 2u;
        u32x4 u[18];
#pragma unroll
        for (int step = 0; step < 18; ++step) { const int cidx = scan_chunk(b, dir, step); u[step] = gld<u32x4>(UT, (unsigned)(((cidx * NH + h) * 2 + dir) * DH * DH) * 2u + e0); }
        float C[8], m = 0.f;
        { const f32x4 z0 = zero4(), z1 = zero4();
#pragma unroll
          for (int j = 0; j < 4; ++j) { C[j] = z0[j]; C[4 + j] = z1[j]; } }
#pragma unroll
        for (int step = 0; step < 18; ++step) {
            const int cidx = scan_chunk(b, dir, step);
            gst<u32x4>(CT, (unsigned)(((cidx * NH + h) * 2 + dir) * DH * DH) * 2u + e0, pack8(C));
            const float bend = CHS[(cidx * 8 + dh) * 2], mloc = CHS[(cidx * 8 + dh) * 2 + 1];
            const float mn = fmaxf(bend + m, mloc), al = __expf(bend + m - mn), be = __expf(mloc - mn);
            float uu[8]; unpack8(u[step], uu);
#pragma unroll
            for (int j = 0; j < 8; ++j) C[j] = al * C[j] + be * uu[j];
            m = mn;
        }
        if (part == 0 && tid < DH) {
            float n = 0.f; m = 0.f;
            for (int step = 0; step < 18; ++step) {
                const int cidx = scan_chunk(b, dir, step); const unsigned base = (unsigned)(((cidx * NH + h) * 2 + dir) * DH + tid) * 4u;
                gst<float>(NS, base, n); if (tid == 0) MST[cidx * 8 + dh] = m;
                const float bend = CHS[(cidx * 8 + dh) * 2], mloc = CHS[(cidx * 8 + dh) * 2 + 1];
                const float mn = fmaxf(bend + m, mloc), al = __expf(bend + m - mn), be = __expf(mloc - mn);
                n = al * n + be * gld<float>(NV, base); m = mn;
            }
        }
    }
}
#define SECTION_LANES() const int tid = otid(wv), lane = tid & 63, fr = lane & 15, fq = lane >> 4; (void)fr; (void)fq; __builtin_amdgcn_sched_barrier(0)
__device__ __forceinline__ void ph_mlstm3(int wv, int l, LAS unsigned char* lds, int nunits) {
    CParams& p = *okp();
    unsigned char* const wsb = ows(p.ws);
    const int wave = wv;
    LAS unsigned char* Qs = lds;
    LAS unsigned char* Ks = lds + 128 * PIT_T;
    LAS unsigned char* Vs = Qs; LAS unsigned char* Ps = Ks;
    LAS float* vec = (LAS float*)(lds + 2 * 128 * PIT_T);
    LAS float *vB = vec, *vC = vec + 256, *vM = vec + 512, *nS = vec + 768, *rS = vec + 1280, *ssq = vec + 1536;
    const bf16_t* P = WSP(bf16_t, OFF_P); const float* G = WSP(float, OFF_G); const bf16_t* CT = WSP(bf16_t, OFF_CT);
    const float *NS = WSP(float, OFF_NS), *MST = WSP(float, OFF_MST); bf16_t* HM = WSP(bf16_t, OFF_HM);
    const float *wk = p.conv_k_w + (size_t)l * 3 * DM, *wq = p.conv_q_w + (size_t)l * 3 * DM, *nw = p.mlstm_norm_w + (size_t)l * DM;
    for (int unit = obid(); unit < nunits; unit += gridDim.x) {
        const int h = unit & 3, cidx = unit >> 2, row0 = chunk_row0(cidx);
        const bool first = cidx < 64 ? (cidx & 15) == 0 : ((cidx - 64) & 1) == 0, last = cidx < 64 ? (cidx & 15) == 15 : ((cidx - 64) & 1) == 1;
        {
            SECTION_LANES(); const int dg = tid & 31, sg = tid >> 5;
            nS[tid] = gld<float>(NS, (unsigned)((cidx * NH + h) * 2 * DH + tid) * 4u);
            const unsigned kp = (unsigned)((row0 + 8 * sg - 1) * NP + PK + h * DH + 8 * dg) * 2u;
            u32x4 raw[10], rawq[10]; float w0[8], w1[8], w2[8];
#pragma unroll
            for (int i = 0; i < 10; ++i) { const int s = 8 * sg - 1 + i; const bool ok = (s >= 0 || !first) && (s < CHUNK || !last);
                raw[i] = gld<u32x4>(P, ok ? kp + (unsigned)i * (NP * 2) : kp + (unsigned)(NP * 2)); if (!ok) raw[i] = (u32x4){0u, 0u, 0u, 0u}; }
#pragma unroll
            for (int i = 0; i < 10; ++i) { const int s = 8 * sg - 1 + i; const bool ok = (s >= 0 || !first) && (s < CHUNK || !last);
                rawq[i] = gld<u32x4>(P, (ok ? kp + (unsigned)i * (NP * 2) : kp + (unsigned)(NP * 2)) + (PQ - PK) * 2); if (!ok) rawq[i] = (u32x4){0u, 0u, 0u, 0u}; }
            { const unsigned wo = (unsigned)(h * DH + 8 * dg) * 4u;
              const f32x4 a0 = gld<f32x4>(wk, wo), a1 = gld<f32x4>(wk, wo + 16), b0 = gld<f32x4>(wk, wo + DM * 4), b1 = gld<f32x4>(wk, wo + DM * 4 + 16), c0 = gld<f32x4>(wk, wo + 2 * DM * 4), c1 = gld<f32x4>(wk, wo + 2 * DM * 4 + 16);
#pragma unroll
              for (int j = 0; j < 4; ++j) { w0[j] = a0[j]; w0[4 + j] = a1[j]; w1[j] = b0[j]; w1[4 + j] = b1[j]; w2[j] = c0[j]; w2[4 + j] = c1[j]; } }
            if (wave < 2) { const GateV g = gate_vectors(G, row0, h, wave, lane);
                vB[wave * 128 + g.s0] = g.b0; vB[wave * 128 + g.s1] = g.b1; vC[wave * 128 + g.s0] = g.c0; vC[wave * 128 + g.s1] = g.c1; vM[wave * 128 + g.s0] = g.m0; vM[wave * 128 + g.s1] = g.m1; }
            conv_silu_rows(raw, w0, w1, w2, [&](int i, float (&o)[8]) { *(LAS u32x4*)(Ks + (8 * sg + i) * PIT_R + dg * 16) = pack8(o); });
            { const unsigned wo = (unsigned)(h * DH + 8 * dg) * 4u;
              const f32x4 a0 = gld<f32x4>(wq, wo), a1 = gld<f32x4>(wq, wo + 16), b0 = gld<f32x4>(wq, wo + DM * 4), b1 = gld<f32x4>(wq, wo + DM * 4 + 16), c0 = gld<f32x4>(wq, wo + 2 * DM * 4), c1 = gld<f32x4>(wq, wo + 2 * DM * 4 + 16);
#pragma unroll
              for (int j = 0; j < 4; ++j) { w0[j] = a0[j]; w0[4 + j] = a1[j]; w1[j] = b0[j]; w1[4 + j] = b1[j]; w2[j] = c0[j]; w2[4 + j] = c1[j]; } }
            conv_silu_rows(rawq, w0, w1, w2, [&](int i, float (&o)[8]) {
#pragma unroll
                for (int j = 0; j < 8; ++j) o[j] *= 0.0625f;
                *(LAS u32x4*)(Qs + (8 * sg + i) * PIT_R + dg * 16) = pack8(o); });
        }
        __syncthreads();
        {
            SECTION_LANES();
            f32x4 sacc[8];
            auto kstepS = [&](int k0, auto first) {
                const bf16x8 yq = *(const LAS bf16x8*)(Qs + (16 * wave + fr) * PIT_R + (k0 + 8 * fq) * 2);
#pragma unroll
                for (int ni = 0; ni < 8; ++ni) { const bf16x8 xk = *(const LAS bf16x8*)(Ks + (16 * ni + fr) * PIT_R + (k0 + 8 * fq) * 2);
                    sacc[ni] = mma16<decltype(first)::value>(xk, yq, sacc[ni]); }
            };
            kstepS(0, std::true_type{});
#pragma unroll 1
            for (int k0 = 32; k0 < DH; k0 += 32) kstepS(k0, std::false_type{});
            const int t = 16 * wave + fr;
            const float mF = gld<float>(MST, (unsigned)(cidx * 8 + h) * 4u), mB = gld<float>(MST, (unsigned)(cidx * 8 + 4 + h) * 4u);
            const float MF = fmaxf(mF, vM[t]), MB = fmaxf(mB, vM[128 + t]);
            const float gF = __expf(mF - MF), gB = __expf(mB - MB);
            const float flF = __expf(-(vB[t] + MF)), flB = __expf(-(vB[128 + t] + MB));
            float qnF = 0.f, qnB = 0.f;
#pragma unroll
            for (int c8 = 0; c8 < 8; ++c8) { float q8[8]; unpack8(*(const LAS u32x4*)(Qs + t * PIT_R + (64 * fq + 8 * c8) * 2), q8);
                const f32x4 a0 = *(const LAS f32x4*)(nS + 64 * fq + 8 * c8), a1 = *(const LAS f32x4*)(nS + 64 * fq + 8 * c8 + 4);
                const f32x4 b0 = *(const LAS f32x4*)(nS + 256 + 64 * fq + 8 * c8), b1 = *(const LAS f32x4*)(nS + 256 + 64 * fq + 8 * c8 + 4);
#pragma unroll
                for (int j = 0; j < 4; ++j) { qnF += q8[j] * a0[j] + q8[4 + j] * a1[j]; qnB += q8[j] * b0[j] + q8[4 + j] * b1[j]; } }
            qnF += shx(qnF, 16, lane); qnF += shx(qnF, 32, lane); qnB += shx(qnB, 16, lane); qnB += shx(qnB, 32, lane);
            float sF = 0.f, sB = 0.f;
#pragma unroll
            for (int ni = 0; ni < 8; ++ni) { const f32x4 cF = *(const LAS f32x4*)(vC + 16 * ni + 4 * fq), cB = *(const LAS f32x4*)(vC + 128 + 16 * ni + 4 * fq);
#pragma unroll
                for (int rg = 0; rg < 4; ++rg) { const int s = 16 * ni + 4 * fq + rg;
                    sF += s <= t ? sacc[ni][rg] * __expf(cF[rg] - MF) : 0.f; sB += s >= t ? sacc[ni][rg] * __expf(cB[rg] - MB) : 0.f; }
                asm volatile("" : "+v"(sF), "+v"(sB)); }
            sF += shx(sF, 16, lane); sF += shx(sF, 32, lane); sB += shx(sB, 16, lane); sB += shx(sB, 32, lane);
            const float iF = 1.f / fmaxf(fabsf(gF * qnF + sF), flF), iB = 1.f / fmaxf(fabsf(gB * qnB + sB), flB);
            __syncthreads();
#pragma unroll
            for (int ni = 0; ni < 8; ++ni) { const f32x4 cF = *(const LAS f32x4*)(vC + 16 * ni + 4 * fq), cB = *(const LAS f32x4*)(vC + 128 + 16 * ni + 4 * fq);
                float pc[4];
#pragma unroll
                for (int rg = 0; rg < 4; ++rg) { const int s = 16 * ni + 4 * fq + rg;
                    pc[rg] = (s <= t ? sacc[ni][rg] * __expf(cF[rg] - MF) * iF : 0.f) + (s >= t ? sacc[ni][rg] * __expf(cB[rg] - MB) * iB : 0.f); }
                u32x2 w; w.x = pk2(pc[0], pc[1]); w.y = pk2(pc[2], pc[3]);
                *(LAS u32x2*)(Ps + t * PIT_P + (16 * ni + 4 * fq) * 2) = w; }
            if (fq == 0) { rS[t] = gF * iF; rS[128 + t] = gB * iB; }
        }
        __syncthreads();
        f32x4 tot[2][8];
        u32x4 vr[8];
        {
            SECTION_LANES();
#pragma unroll
            for (int ni = 0; ni < 2; ++ni) {
                if (ni == 1) { const int s8 = lane & 15, vq = lane >> 4; const unsigned vp = (unsigned)((row0 + 8 * s8) * NP + PV + h * DH + 32 * wave + 8 * vq) * 2u;
#pragma unroll
                    for (int i = 0; i < 8; ++i) vr[i] = gld<u32x4>(P, vp + (unsigned)i * (NP * 2)); }
                f32x4 a1[8];
                const unsigned ctf = (unsigned)((cidx * NH + h) * 2 * DH * DH + (32 * wave + 16 * ni + fr) * DH + 8 * fq) * 2u;
                bf16x8 xf = gld<bf16x8>(CT, ctf), xb = gld<bf16x8>(CT, ctf + (unsigned)(DH * DH) * 2u);
                auto kstepQ = [&](int k0, auto first) {
                    const unsigned kn = (unsigned)(k0 + 32 < DH ? k0 + 32 : k0);
                    const bf16x8 xfn = gld<bf16x8>(CT, ctf + kn * 2u), xbn = gld<bf16x8>(CT, ctf + (unsigned)(DH * DH) * 2u + kn * 2u);
#pragma unroll
                    for (int mi = 0; mi < 8; ++mi) { const bf16x8 yq = *(const LAS bf16x8*)(Qs + (16 * mi + fr) * PIT_R + (k0 + 8 * fq) * 2);
                        tot[ni][mi] = mma16<decltype(first)::value>(xf, yq, tot[ni][mi]);
                        a1[mi] = mma16<decltype(first)::value>(xb, yq, a1[mi]); }
                    xf = xfn; xb = xbn;
                };
                kstepQ(0, std::true_type{});
#pragma unroll 1
                for (int k0 = 32; k0 < DH; k0 += 32) kstepQ(k0, std::false_type{});
#pragma unroll
                for (int mi = 0; mi < 8; ++mi) { const float rf = rS[16 * mi + fr], rb = rS[128 + 16 * mi + fr]; tot[ni][mi] = rf * tot[ni][mi] + rb * a1[mi]; }
            }
        }
        __syncthreads();
        {
            SECTION_LANES();
            { const int s8 = lane & 15, vq = lane >> 4;
#pragma unroll
              for (int i = 0; i < 8; ++i) *(LAS u32x4*)(Vs + (8 * s8 + i) * PIT_T + (32 * wave + 8 * vq) * 2) = vr[i]; }
            asm volatile("s_waitcnt lgkmcnt(0)" ::: "memory");
#pragma unroll 1
            for (int k0 = 0; k0 < CHUNK; k0 += 32) {
                bf16x8 xv[2];
#pragma unroll
                for (int ni = 0; ni < 2; ++ni) xv[ni] = tr_frag(Vs, PIT_T, k0, 32 * wave + 16 * ni, lane);
#pragma unroll
                for (int mi = 0; mi < 8; ++mi) { const bf16x8 yp = *(const LAS bf16x8*)(Ps + (16 * mi + fr) * PIT_P + (k0 + 8 * fq) * 2);
#pragma unroll
                    for (int ni = 0; ni < 2; ++ni) tot[ni][mi] = __builtin_amdgcn_mfma_f32_16x16x32_bf16(xv[ni], yp, tot[ni][mi], 0, 0, 0); }
            }
        }
        {
            SECTION_LANES();
#pragma unroll
            for (int mi = 0; mi < 8; ++mi) { float ss = 0.f;
#pragma unroll
                for (int ni = 0; ni < 2; ++ni) ss += (tot[ni][mi][0] * tot[ni][mi][0] + tot[ni][mi][1] * tot[ni][mi][1]) + (tot[ni][mi][2] * tot[ni][mi][2] + tot[ni][mi][3] * tot[ni][mi][3]);
                ss += shx(ss, 16, lane); ss += shx(ss, 32, lane);
                if (fq == 0) ssq[wave * 128 + 16 * mi + fr] = ss; }
            __syncthreads();
#pragma unroll
            for (int mi = 0; mi < 8; ++mi) { const int tt = 16 * mi + fr; float ss = 0.f;
#pragma unroll
                for (int w8 = 0; w8 < 8; ++w8) ss += ssq[w8 * 128 + tt];
                const float rstd = rsqrtf(ss * (1.f / DH) + EPS);
#pragma unroll
                for (int ni = 0; ni < 2; ++ni) { const int vd = 32 * wave + 16 * ni + 4 * fq;
                    const u32x2 ow = gld<u32x2>(P, (unsigned)((row0 + tt) * NP + PO + h * DH + vd) * 2u); const f32x4 w4 = gld<f32x4>(nw, (unsigned)(h * DH + vd) * 4u);
                    const float o0 = __uint_as_float(ow.x << 16), o1 = __uint_as_float(ow.x & 0xffff0000u), o2 = __uint_as_float(ow.y << 16), o3 = __uint_as_float(ow.y & 0xffff0000u);
                    u32x2 q; q.x = pk2(sigmoidf_(o0) * (tot[ni][mi][0] * rstd * w4[0]), sigmoidf_(o1) * (tot[ni][mi][1] * rstd * w4[1]));
                    q.y = pk2(sigmoidf_(o2) * (tot[ni][mi][2] * rstd * w4[2]), sigmoidf_(o3) * (tot[ni][mi][3] * rstd * w4[3]));
                    gst<u32x2>(HM, (unsigned)((row0 + tt) * D + h * DH + vd) * 2u, q); }
                __builtin_amdgcn_sched_barrier(0); }
        }
        __syncthreads();
    }
}
__device__ __forceinline__ void ph_ffnact(int wv, int l) {
    CParams& p = *okp();
    unsigned char* const wsb = ows(p.ws);
    const int TIDX = otid(wv), BIDX = obid();
    const unsigned gt = (unsigned)BIDX * 512u + TIDX, NT = gridDim.x * 512u;
    const bf16_t* U = WSP(bf16_t, OFF_P); bf16_t* ACT = WSP(bf16_t, OFF_ACT); const float* SL = WSP(float, OFF_SLAB);
    const float* wf = p.conv_ff_w + (size_t)l * 3 * DFF;
    auto ldu = [&](int r, int col, float (&o)[8]) {
        if (col >= 32 * 256) { f32x4 g0 = {0.f, 0.f, 0.f, 0.f}, g1 = {0.f, 0.f, 0.f, 0.f};
#pragma unroll
            for (int sl = 0; sl < 4; ++sl) { const unsigned o4 = (unsigned)((sl * RC + (r - RL)) * NUP + col) * 4u; g0 += gld<f32x4>(SL, o4); g1 += gld<f32x4>(SL, o4 + 16); }
#pragma unroll
            for (int j = 0; j < 4; ++j) { o[j] = g0[j]; o[4 + j] = g1[j]; } }
        else unpack8(gld<u32x4>(U, (unsigned)(r * NUP + col) * 2u), o);
    };
    for (unsigned i = gt; i < (unsigned)RC * (DFF / 8); i += NT) {
        const int r = RL + (int)(i / (DFF / 8)), c = (int)(i % (DFF / 8)) * 8, t = (r - RL) & (CTX - 1);
        const int ca = 256 * (c >> 7) + (c & 127);
        const bool hp = t > 0, hn = t < CTX - 1;
        float a0[8], a1[8], a2[8], g[8], o[8];
        ldu(r, ca, a1); ldu(r, ca + 128, g); ldu(hp ? r - 1 : r, ca, a0); ldu(hn ? r + 1 : r, ca, a2);
        const f32x4 w00 = gld<f32x4>(wf, (unsigned)c * 4u), w01 = gld<f32x4>(wf, (unsigned)c * 4u + 16), w10 = gld<f32x4>(wf, (unsigned)(DFF + c) * 4u), w11 = gld<f32x4>(wf, (unsigned)(DFF + c) * 4u + 16),
                    w20 = gld<f32x4>(wf, (unsigned)(2 * DFF + c) * 4u), w21 = gld<f32x4>(wf, (unsigned)(2 * DFF + c) * 4u + 16);
#pragma unroll
        for (int j = 0; j < 8; ++j) { const float w0 = j < 4 ? w00[j & 3] : w01[j & 3], w1 = j < 4 ? w10[j & 3] : w11[j & 3], w2 = j < 4 ? w20[j & 3] : w21[j & 3];
            float v = w1 * a1[j]; if (hp) v += w0 * a0[j]; if (hn) v += w2 * a2[j]; o[j] = siluf_(v) * g[j]; }
        gst<u32x4>(ACT, (unsigned)(r * DFF + c) * 2u, pack8(o));
    }
}

#define XB_TMO      128
#define XB_XCNT(j)  (256  + 64 * (j))
#define XB_XSUB(j)  (1280 + 64 * (j))
#define XB_XGEN(j)  (2304 + 64 * (j))
#define XB_TOP      3328
#define XB_TOPGEN   3392
#define XCD_BAR_WORDS 3456
#define XB_SPIN_CAP (1u << 18)
__device__ __forceinline__ unsigned xb_ld(unsigned* p)              { return __hip_atomic_load(p, __ATOMIC_RELAXED, __HIP_MEMORY_SCOPE_AGENT); }
__device__ __forceinline__ unsigned xb_add(unsigned* p, unsigned v) { return __hip_atomic_fetch_add(p, v, __ATOMIC_RELAXED, __HIP_MEMORY_SCOPE_AGENT); }
__device__ __forceinline__ unsigned xb_xcc_id() { return (unsigned)__builtin_amdgcn_s_getreg((3 << 11) | 20) & 0xFu; }
#define XB_SPIN(cond, bar) do { unsigned _sp = 0; while (cond) { __builtin_amdgcn_s_sleep(1); \
    if ((++_sp & 255u) == 0u) { if (xb_ld(&(bar)[XB_TMO])) break; if (_sp > XB_SPIN_CAP) { atomicAdd(&(bar)[XB_TMO], 1u); break; } } } } while (0)
struct XcdBarrier { unsigned* bar; unsigned x; volatile LAS unsigned* st; };
__device__ __forceinline__ XcdBarrier xcd_barrier_post(unsigned* bar, volatile LAS unsigned* st) {
    XcdBarrier b; b.bar = bar; b.x = xb_xcc_id(); b.st = st;
    if (threadIdx.x == 0) (void)xb_add(&bar[XB_XCNT(b.x)], 1u);
    return b;
}
__device__ __forceinline__ void xcd_barrier_complete(unsigned* bar, unsigned x, unsigned& nloc, unsigned& nx) {
    const unsigned G = gridDim.x * gridDim.y * gridDim.z;
    unsigned sum, cnt, mine, sp = 0u;
    for (;;) {
        sum = 0u; cnt = 0u; mine = 0u;
#pragma unroll
        for (unsigned j = 0; j < 16; ++j) { const unsigned c = xb_ld(&bar[XB_XCNT(j)]); sum += c; cnt += (c > 0u) ? 1u : 0u; mine = (j == x) ? c : mine; }
        if (sum == G) break;
        __builtin_amdgcn_s_sleep(1);
        if ((++sp & 255u) == 0u) { if (xb_ld(&bar[XB_TMO])) break; if (sp > XB_SPIN_CAP) { atomicAdd(&bar[XB_TMO], 1u); break; } }
    }
    nloc = mine > 0u ? mine : 1u; nx = cnt > 0u ? cnt : 1u;
}
__device__ __forceinline__ void xcd_barrier(const XcdBarrier& b, int wv) {
    asm volatile("s_waitcnt vmcnt(0)" ::: "memory");
    __syncthreads();
    if (otid(wv) == 0) {
        unsigned long long bw = (unsigned long long)b.bar; asm volatile("" : "+s"(bw));
        unsigned* bar = (unsigned*)bw;
        __builtin_amdgcn_s_waitcnt(0);
        unsigned nloc = b.st[0], nx = b.st[1];
        if (nloc == 0u) { xcd_barrier_complete(bar, b.x, nloc, nx); b.st[0] = nloc; b.st[1] = nx; }
        const unsigned old = xb_add(&bar[XB_XSUB(b.x)], 1u);
        const unsigned gen = old / nloc;
        if (old + 1u == (gen + 1u) * nloc) {
            __builtin_amdgcn_fence(__ATOMIC_RELEASE, "agent");
            asm volatile("s_waitcnt vmcnt(0)" ::: "memory");
            const unsigned og = xb_add(&bar[XB_TOP], 1u);
            const unsigned tg = og / nx;
            if (og + 1u == (tg + 1u) * nx) xb_add(&bar[XB_TOPGEN], 1u);
            else XB_SPIN(xb_ld(&bar[XB_TOPGEN]) == tg, bar);
            __builtin_amdgcn_fence(__ATOMIC_ACQUIRE, "agent");
            xb_add(&bar[XB_XGEN(b.x)], 1u);
            asm volatile("s_waitcnt vmcnt(0)" ::: "memory");
        } else {
            XB_SPIN(xb_ld(&bar[XB_XGEN(b.x)]) == gen, bar);
            __builtin_amdgcn_fence(__ATOMIC_ACQUIRE, "agent");
            asm volatile("s_waitcnt vmcnt(0)" ::: "memory");
        }
    }
    __syncthreads();
}

constexpr int I_CUT = (I_LAYER * 2 / 5 / 64) * 64;
#define REPW 3456
#define REPN(k) (1 + __builtin_amdgcn_readfirstlane(((const int*)(okp()->ws + OFF_CTL))[REPW + (k)]))
constexpr int LDS_BYTES = 163840;
constexpr int MISC_OFF = 163840 - 256;
template <class Epi, class Sched, bool AMAP = false> __device__ __forceinline__ void run_gemm(int wv, LAS unsigned char* lds, const bf16_t* A, int lda, const bf16_t* Bt, int ldb, int K, const Sched& S, const Epi& E) {
    pg8::Gemm g; g.A = A; g.Bt = Bt; g.M = 0; g.N = 0; g.K = K; g.lda = lda; g.ldb = ldb; g.pad = wv;
    pg8::gemm_phase<Epi, Sched, AMAP>((PG8_LAS unsigned char*)lds, g, S, E);
}
__global__ void __launch_bounds__(512, 2) mega_fwd(Params p_kernarg) {
    extern __shared__ __attribute__((aligned(16))) unsigned char dyn_lds[];
    LAS unsigned char* lds = (LAS unsigned char*)dyn_lds;
    const int wv = __builtin_amdgcn_readfirstlane(threadIdx.x >> 6);
    volatile LAS unsigned* MISC = (volatile LAS unsigned*)(lds + MISC_OFF);
    if (threadIdx.x < 32) MISC[threadIdx.x] = 0u;
    __syncthreads();
    (void)xcd_barrier_post((unsigned*)(okp()->ws + OFF_CTL), MISC + 8);
#define GRID_BAR() for (int rpb = 0, nrpb = REPN(10); rpb < nrpb; ++rpb) { XcdBarrier bar_; bar_.bar = (unsigned*)(okp()->ws + OFF_CTL); bar_.x = xb_xcc_id(); bar_.st = (volatile LAS unsigned*)(lds + MISC_OFF) + 8; xcd_barrier(bar_, wv); }
    for (int rp = 0, nrp = REPN(13); rp < nrp; ++rp) { ph_convert(wv, lds, 0, obid(), (int)gridDim.x, 0, I_LAYER); __syncthreads(); }
    for (int rp = 0, nrp = REPN(0); rp < nrp; ++rp) { ph_tables(wv); __syncthreads(); ph_mod(wv, lds, 0, 1, obid(), (int)gridDim.x); __syncthreads(); }
    GRID_BAR();
    for (int l = 0; l < DEPTH; ++l) {
        unsigned char* ws = ows(okp()->ws);
        const int G = (int)gridDim.x;
        const int fz = G >= 256 ? 1 : 0;
        const bool lastl = (l == DEPTH - 1);
        bf16_t* XN = (bf16_t*)(ws + OFF_XN); bf16_t* P = (bf16_t*)(ws + OFF_P); float* Gt = (float*)(ws + OFF_G); float* H = (float*)(ws + OFF_H); float* SLB = (float*)(ws + OFF_SLAB);
        const float* mod = (const float*)(ws + OFF_MOD) + (size_t)l * 5 * 6 * D;
        ph_norm(wv, l, 0, l > 0 ? mod - 5 * 6 * D + 4 * 6 * D + 5 * D : nullptr, (l > 0 && fz) ? RL : 0, R, l > 0 ? H : okp()->x, l > 0 ? H + (size_t)RL * D : okp()->ctx);
        GRID_BAR();
        for (int rp = 0, nrp = REPN(1); rp < nrp; ++rp) { EpiInProj E{P, Gt, (const float*)(ws + OFF_BINR) + (size_t)l * NINP};
          pg8::StaticOrder S; S.init(R, NINP, D, G, obid());
          run_gemm(wv, lds, XN, D, (const bf16_t*)(ws + OFF_WIN) + (size_t)l * NINP * D, D, D, S, E); }
        GRID_BAR();
        for (int rp = 0, nrp = REPN(2); rp < nrp; ++rp) ph_mlstm1(wv, l, lds);
        { const int f0 = G / 4, fn = G / 2;
          for (int rp = 0, nrp = REPN(9); rp < nrp; ++rp) if (obid() >= f0 && obid() < f0 + fn) ph_fft(wv, lds, obid() - f0, fn);
          for (int rp = 0, nrp = REPN(3); rp < nrp; ++rp) if (obid() < f0 || obid() >= f0 + fn) { const int wi = obid() < f0 ? obid() : obid() - fn;
              if (!lastl) ph_fourier1(wv, wi, G - fn); ph_convc(wv, l, lastl ? RL : R, wi, G - fn); } }
        GRID_BAR();
        for (int rp = 0, nrp = REPN(4); rp < nrp; ++rp) ph_mlstm2(wv);
        GRID_BAR();
        for (int rp = 0, nrp = REPN(5); rp < nrp; ++rp) ph_mlstm3(wv, l, lds, lastl ? 64 * NH : NCHUNK * NH);
        if (!lastl && obid() >= 32) { EpiBf16 E{(bf16_t*)(ws + OFF_HM) + (size_t)RL * D + DM, D, DF, (unsigned)(CTX * D), 0, SLB};
          pg8::StaticOrder S; S.init(256, 2048, 512, G - 32, obid() - 32);
          run_gemm(wv, lds, (const bf16_t*)(ws + OFF_CSC), 512, (const bf16_t*)(ws + OFF_ZTC), 512, 512, S, E); }
        if (!lastl && obid() >= 32) { ph_convert(wv, lds, l + 1, obid() - 32, G - 32, 0, I_CUT); }
        GRID_BAR();
        for (int rp = 0, nrp = REPN(8); rp < nrp; ++rp) { EpiMerge E{P, (bf16_t*)(ws + OFF_MG)}; pg8::StaticOrder S; S.init(lastl ? RL : R, D, D, G, obid());
          run_gemm(wv, lds, (const bf16_t*)(ws + OFF_HM), D, (const bf16_t*)(ws + OFF_WPM) + (size_t)l * D * D, D, D, S, E); }
        if (!lastl && obid() >= 32) { ph_convert(wv, lds, l + 1, obid() - 32, G - 32, I_CUT, I_LAYER); __syncthreads(); ph_mod(wv, lds, l + 1, l + 2, obid() - 32, G - 32); }
        GRID_BAR();
        for (int rp = 0, nrp = REPN(11); rp < nrp; ++rp) { EpiResid E{l, 0, fz, rp == 0 ? 1.f : 0.f};
          pg8::TailOrder S; S.init(D, D, G, obid(), lastl ? 0 : 32, 0, 8);
          run_gemm(wv, lds, (const bf16_t*)(ws + OFF_MG), D, (const bf16_t*)(ws + OFF_WO) + (size_t)l * D * D, D, D, S, E); }
        GRID_BAR();
        if (!lastl || !fz) { ph_norm(wv, l, 1, lastl ? nullptr : mod + 4 * 6 * D + 2 * D, fz ? RL : 0, lastl ? RL : R, H, l > 0 ? H + (size_t)RL * D : okp()->ctx);
          GRID_BAR(); }
        for (int rp = 0, nrp = REPN(7); rp < nrp; ++rp) { EpiUp E{P, SLB, (bf16_t*)(ws + OFF_ACT), okp()->conv_ff_w + (size_t)l * 3 * DFF};
          pg8::TailOrder S; S.init(NUP, D, G, obid(), lastl ? 0 : 176, lastl ? 0 : 128, 4);
          run_gemm<EpiUp, pg8::TailOrder, true>(wv, lds, XN, D, (const bf16_t*)(ws + OFF_WUP) + (size_t)l * NUP * D, D, D, S, E); }
        GRID_BAR();
        if (!lastl) { for (int rp = 0, nrp = REPN(6); rp < nrp; ++rp) ph_ffnact(wv, l);
          GRID_BAR(); }
        for (int rp = 0, nrp = REPN(12); rp < nrp; ++rp) { EpiResid E{l, 1, lastl ? 2 * fz : fz, rp == 0 ? 1.f : 0.f};
          pg8::TailOrder S; S.init(D, DFF, G, obid(), lastl ? 0 : 32, 0, 8);
          run_gemm(wv, lds, (const bf16_t*)(ws + OFF_ACT), DFF, (const bf16_t*)(ws + OFF_WDN) + (size_t)l * D * DFF, DFF, DFF, S, E); }
        if (!(lastl && fz)) { GRID_BAR(); }
    }
    if (gridDim.x < 256) ph_final(wv);
}

extern "C" void kernel_launch(void* const* d_in, const int* in_sizes, int n_in, void* d_out, int out_size, void* d_ws, size_t ws_size, hipStream_t stream) {
    static int grid = 0;
    if (grid == 0) {
        if (n_in != 22 || ws_size < WS_END || out_size != RL * D) { fprintf(stderr, "kernel_launch: unexpected problem (n_in %d, ws %zu < %zu, out %d)\n", n_in, ws_size, (size_t)WS_END, out_size); grid = -1; return; }
        int dev = 0, cus = 0, per_cu = 0;
        if (hipGetDevice(&dev) != hipSuccess || hipDeviceGetAttribute(&cus, hipDeviceAttributeMultiprocessorCount, dev) != hipSuccess) { grid = -1; return; }
        if (hipFuncSetAttribute((const void*)mega_fwd, hipFuncAttributeMaxDynamicSharedMemorySize, LDS_BYTES) != hipSuccess) { fprintf(stderr, "kernel_launch: hipFuncSetAttribute failed\n"); grid = -1; return; }
        if (hipOccupancyMaxActiveBlocksPerMultiprocessor(&per_cu, (const void*)mega_fwd, 512, LDS_BYTES) != hipSuccess || per_cu < 1) { fprintf(stderr, "kernel_launch: occupancy query says %d\n", per_cu); per_cu = 1; }
        (void)hipGetLastError();
        grid = cus;
    }
    if (grid < 0) return;
    Params p{};
    const float** pp = (const float**)&p;
    for (int i = 0; i < 22; ++i) pp[i] = (const float*)d_in[i];
    p.out = (float*)d_out; p.ws = (unsigned char*)d_ws;
    (void)hipMemsetAsync((char*)d_ws + OFF_CTL, 0, (size_t)CTL_ZERO_WORDS * sizeof(unsigned), stream);
    hipLaunchKernelGGL(mega_fwd, dim3(grid), dim3(512), LDS_BYTES, stream, p);
}
```

```cpp
#include <hip/hip_runtime.h>
#include <cstdio>
#include <cstdint>
#include <type_traits>

#define LAS __attribute__((address_space(3)))
typedef unsigned short bf16_t;
typedef short bf16x8 __attribute__((ext_vector_type(8)));
typedef float f32x4 __attribute__((ext_vector_type(4)));
typedef unsigned u32x4 __attribute__((ext_vector_type(4)));
typedef unsigned u32x2 __attribute__((ext_vector_type(2)));

constexpr int D = 2048, NB = 4, SEQ = 2048, DEPTH = 4, CTX = 256;
constexpr int DM = 1024, NH = 4, DH = 256, DF = 512, DC = 512, DFF = 5632, CHUNK = 128;
constexpr int NIN = 12304;
constexpr int RL = NB * SEQ, RC = NB * CTX, R = RL + RC;
constexpr int NP = 12288;
constexpr int NINP = 12544;
constexpr int PK = 0, PV = 1024, PQ = 2048, PO = 3072, PF = 4096, PCB = 4608, PCC = 5120, PCX = 5632, PGM = 6144;
constexpr int NCHUNK = 72;
constexpr int NUP = 2 * DFF;
constexpr float EPS = 1e-6f;

constexpr size_t al256(size_t x) { return (x + 255) & ~(size_t)255; }
constexpr size_t OFF_CTL = 0;
constexpr size_t OFF_WIN = 1u << 20;
constexpr size_t SZ_WIN = (size_t)NINP * D * 2;            constexpr size_t OFF_WPM = OFF_WIN + DEPTH * SZ_WIN;
constexpr size_t SZ_WPM = (size_t)D * D * 2;               constexpr size_t OFF_WO = OFF_WPM + DEPTH * SZ_WPM;
constexpr size_t SZ_WO = (size_t)D * D * 2;                constexpr size_t OFF_WUP = OFF_WO + DEPTH * SZ_WO;
constexpr size_t SZ_WUP = (size_t)NUP * D * 2;             constexpr size_t OFF_WDN = OFF_WUP + DEPTH * SZ_WUP;
constexpr size_t SZ_WDN = (size_t)D * DFF * 2;             constexpr size_t OFF_BINR = OFF_WDN + DEPTH * SZ_WDN;
constexpr size_t OFF_MA = al256(OFF_BINR + (size_t)DEPTH * NINP * 4);
constexpr size_t OFF_MC = OFF_MA + (size_t)64 * 64 * 2;
constexpr size_t OFF_CSC = OFF_MC + (size_t)32 * 64 * 128 * 2;
constexpr size_t OFF_FT = OFF_CSC + (size_t)256 * 512 * 2;
constexpr size_t OFF_MOD = OFF_FT + (size_t)256 * 128 * 2;
constexpr size_t OFF_H = al256(OFF_MOD + (size_t)DEPTH * 5 * 6 * D * 4);
constexpr size_t OFF_XN = OFF_H + (size_t)R * D * 4;
constexpr size_t OFF_P = OFF_XN + (size_t)R * D * 2;
constexpr size_t OFF_G = OFF_P + (size_t)R * NP * 2;
constexpr size_t OFF_CHS = OFF_G + (size_t)R * 16 * 4;
constexpr size_t OFF_MST = al256(OFF_CHS + (size_t)NCHUNK * 8 * 2 * 4);
constexpr size_t OFF_UT = al256(OFF_MST + (size_t)NCHUNK * 8 * 4);
constexpr size_t SZ_UT = (size_t)NCHUNK * NH * 2 * DH * DH * 2;
constexpr size_t OFF_CT = OFF_UT + SZ_UT;
constexpr size_t OFF_NV = OFF_CT + SZ_UT;
constexpr size_t OFF_NS = OFF_NV + (size_t)NCHUNK * NH * 2 * DH * 4;
constexpr size_t OFF_HM = OFF_NS + (size_t)NCHUNK * NH * 2 * DH * 4;
constexpr size_t OFF_ZTC = OFF_HM + (size_t)R * D * 2;
constexpr size_t OFF_MG = OFF_ZTC + (size_t)2048 * 512 * 2;
constexpr size_t OFF_ACT = OFF_MG + (size_t)R * D * 2;
constexpr size_t OFF_SLAB = OFF_ACT + (size_t)R * DFF * 2;
constexpr size_t OFF_XS = OFF_SLAB + (size_t)4 * RC * NUP * 4;
constexpr size_t WS_END = OFF_XS + (size_t)8 * RL * 32 * 4;
constexpr int CNTW = 4096;
constexpr int CTL_ZERO_WORDS = CNTW + 8 * 32 * 64;
static_assert(WS_END <= (size_t)4 * DEPTH * D * NIN * 4, "workspace map exceeds the guaranteed d_ws size");
static_assert((size_t)R * NUP * 2 <= (size_t)R * NP * 2, "u overlays P");

struct Params {
    const float *x, *c, *ctx, *c_ctx, *w_mod, *b_mod, *norm1_w, *norm2_w, *w_in, *b_in, *conv_q_w, *conv_k_w, *mlstm_norm_w, *w_pm, *w_pf, *w_pc, *conv_c_w, *w_o, *w_up,
        *conv_ff_w, *w_down, *final_norm_w;
    float* out; unsigned char* ws;
};
#define WSP(T, off) ((T*)(wsb + (off)))
typedef const __attribute__((address_space(4))) Params CParams;
__device__ __forceinline__ CParams* okp() { CParams* k = (CParams*)__builtin_amdgcn_kernarg_segment_ptr(); asm volatile("" : "+s"(k)); return k; }

#define GAS __attribute__((address_space(1)))
template <class T> __device__ __forceinline__ T gld(const void* base, unsigned byte_off) { return *(const GAS T*)((const GAS unsigned char*)base + byte_off); }
template <class T> __device__ __forceinline__ void gst(void* base, unsigned byte_off, T v) { *(GAS T*)((GAS unsigned char*)base + byte_off) = v; }
__device__ __forceinline__ int otid(int wv) { int t; asm volatile("v_mbcnt_lo_u32_b32 %0, -1, 0\n\tv_mbcnt_hi_u32_b32 %0, -1, %0" : "=v"(t)); return (wv << 6) | t; }
__device__ __forceinline__ int olaunder(int v) { asm volatile("" : "+v"(v)); return v; }
__device__ __forceinline__ f32x4 zero4() { float a, b, c, d; asm volatile("v_mov_b32 %0, 0\n\tv_mov_b32 %1, 0\n\tv_mov_b32 %2, 0\n\tv_mov_b32 %3, 0" : "=v"(a), "=v"(b), "=v"(c), "=v"(d)); return (f32x4){a, b, c, d}; }
__device__ __forceinline__ int obid() { int b = blockIdx.x; asm volatile("" : "+s"(b)); return b; }
__device__ __forceinline__ float bf2f(bf16_t v) { return __uint_as_float(((unsigned)v) << 16); }
__device__ __forceinline__ unsigned f2bf(float f) { unsigned u = __float_as_uint(f); return (u + 0x7fffu + ((u >> 16) & 1u)) >> 16; }
__device__ __forceinline__ unsigned pk2(float lo, float hi) { return f2bf(lo) | (f2bf(hi) << 16); }
__device__ __forceinline__ float sigmoidf_(float x) { return 1.f / (1.f + __expf(-x)); }
__device__ __forceinline__ float siluf_(float x) { return x / (1.f + __expf(-x)); }
__device__ __forceinline__ float shx(float v, int k, int lane) { return __int_as_float(__builtin_amdgcn_ds_bpermute((lane ^ k) << 2, __float_as_int(v))); }
__device__ __forceinline__ float shl_(float v, int src) { return __int_as_float(__builtin_amdgcn_ds_bpermute(src << 2, __float_as_int(v))); }
__device__ __forceinline__ unsigned char* ows(unsigned char* w) { asm volatile("" : "+s"(w)); return w; }
__device__ __forceinline__ float wave_sum(float v, int lane) {
#pragma unroll
    for (int o = 1; o < 64; o <<= 1) v += shx(v, o, lane);
    return v;
}
__device__ __forceinline__ void unpack8(u32x4 w, float (&f)[8]) {
    f[0] = __uint_as_float(w.x << 16); f[1] = __uint_as_float(w.x & 0xffff0000u); f[2] = __uint_as_float(w.y << 16); f[3] = __uint_as_float(w.y & 0xffff0000u);
    f[4] = __uint_as_float(w.z << 16); f[5] = __uint_as_float(w.z & 0xffff0000u); f[6] = __uint_as_float(w.w << 16); f[7] = __uint_as_float(w.w & 0xffff0000u);
}
__device__ __forceinline__ u32x4 pack8(const float (&f)[8]) { u32x4 w; w.x = pk2(f[0], f[1]); w.y = pk2(f[2], f[3]); w.z = pk2(f[4], f[5]); w.w = pk2(f[6], f[7]); return w; }
__device__ __forceinline__ void rowinfo(int r, int& mj, int& t, int& T) { const int c = r >= RL ? 1 : 0; mj = r >> 11; T = SEQ >> (3 * c); t = r & (T - 1); }
__device__ __forceinline__ int chunk_row0(int cidx) { return cidx < 64 ? (cidx >> 4) * SEQ + (cidx & 15) * CHUNK : RL + ((cidx - 64) >> 1) * CTX + ((cidx - 64) & 1) * CHUNK; }
__device__ __forceinline__ int scan_chunk(int b, int dir, int step) {
    if (step < 2) { const int j = dir ? 1 - step : step; return 64 + b * 2 + j; }
    const int jj = step - 2, j = dir ? 15 - jj : jj; return b * 16 + j;
}

namespace pg8 {
#define PG8_LAS __attribute__((address_space(3)))
constexpr int BM = 256, BK = 64, HALF = 128, HTB = HALF * BK * 2, STAGE_BYTES = 8 * HTB, NXCD = 8, WGM = 8;
__host__ __device__ __forceinline__ int lds_byte(int r, int c) { const int st = (r >> 4) * 2 + (c >> 5), rr = r & 15, cc = c & 31, ob = rr * 64 + cc * 2; return st * 1024 + (ob ^ (((ob >> 9) & 1) << 5)); }
__host__ __device__ __forceinline__ void stage_rc(int b, int& Rr, int& C) { const int st = b / 1024, sb = b % 1024, swz = sb ^ (((sb >> 9) & 1) << 5); Rr = (st >> 1) * 16 + swz / 64; C = (st & 1) * 32 + (swz % 64) / 2; }
__host__ __device__ __forceinline__ int perm32(int rho) { const int n = rho >> 4, i = rho & 15; return 8 * (i >> 2) + 4 * n + (i & 3); }
struct Unit { int pm, pn, k0, nt, ks; };
struct Gemm { const bf16_t* A; const bf16_t* Bt; int M, N, K, lda, ldb, pad; };
__host__ __device__ __forceinline__ void tile_of(int wgid, int nM, int nN, int& pm, int& pn) {
    const int nwg = nM * nN; { const int q = nwg / NXCD, r = nwg % NXCD, xcd = wgid % NXCD, off = wgid / NXCD; wgid = (xcd < r ? xcd * (q + 1) : r * (q + 1) + (xcd - r) * q) + off; }
    const int nig = WGM * nN, gid = wgid / nig, fm = gid * WGM, gsz = (nM - fm) < WGM ? (nM - fm) : WGM;
    pm = fm + ((wgid % nig) % gsz); pn = (wgid % nig) / gsz;
}
struct StaticOrder {
    int nM, nN, nwg, G, c, K;
    __host__ __device__ void init(int M, int N, int K_, int G_, int c_) { nM = M / BM; nN = N / BM; nwg = nM * nN; G = G_; c = c_; K = K_; }
    __host__ __device__ bool next(int i, Unit& u) const {
        const long L = (long)i * G + c; if (L >= nwg) return false;
        tile_of((int)L, nM, nN, u.pm, u.pn); u.k0 = 0; u.nt = K / BK; u.ks = -1; return true;
    }
    __device__ __forceinline__ void a_ready(const Unit&) const {}
    __device__ __forceinline__ void done(const Unit&) const {}
};
struct TailOrder {
    int nN, G, c, K, nLat, nWhole, nTot, nsl;
    __host__ __device__ void init(int N, int K_, int G_, int c_, int nCtxTiles, int nCtxWhole, int nsl_) { nN = N / BM; G = G_; c = c_; K = K_; nLat = 32 * nN; nWhole = nLat + nCtxWhole; nTot = nLat + nCtxTiles; nsl = nsl_; }
    __host__ __device__ bool next(int i, Unit& u) const {
        const long L = (long)i * G + c; if (L >= (long)nWhole + (long)(nTot - nWhole) * nsl) return false;
        int tile, ks; if (L < nWhole) { tile = (int)L; ks = -1; } else { const int Lp = (int)L - nWhole; tile = nWhole + Lp / nsl; ks = Lp % nsl; }
        if (tile < nLat) tile_of(tile, 32, nN, u.pm, u.pn); else { const int tp = tile - nLat; u.pm = 32 + (tp & 3); u.pn = tp >> 2; }
        if (ks < 0) { u.k0 = 0; u.nt = K / BK; } else { const int n128 = K / 128, base = n128 / nsl, rem = n128 % nsl; u.k0 = 128 * (ks * base + (ks < rem ? ks : rem)); u.nt = 2 * (base + (ks < rem ? 1 : 0)); }
        u.ks = ks; return true;
    }
    __device__ __forceinline__ void a_ready(const Unit&) const {}
    __device__ __forceinline__ void done(const Unit&) const {}
};
template <bool AMAP> __device__ __forceinline__ void a_geom(const Gemm& g, const Unit& u, int R0, int C0, int R1, int C1, size_t& base, size_t& hstep, unsigned (&vo)[2]) {
    if (AMAP && u.pm < 32) { base = (size_t)((u.pm >> 3) * 2048 + (u.pm & 7) * 8) * g.lda * 2; hstep = (size_t)4 * g.lda * 2;
        vo[0] = (unsigned)(((R0 & 31) * 64 + (R0 >> 5)) * g.lda + C0) * 2u; vo[1] = (unsigned)(((R1 & 31) * 64 + (R1 >> 5)) * g.lda + C1) * 2u; }
    else { base = (size_t)u.pm * 256 * g.lda * 2; hstep = (size_t)HALF * g.lda * 2; vo[0] = (unsigned)(R0 * g.lda + C0) * 2u; vo[1] = (unsigned)(R1 * g.lda + C1) * 2u; }
}
template <class Epi, class Sched, bool AMAP = false>
__device__ __forceinline__ void gemm_phase(PG8_LAS unsigned char* lds, const Gemm g, const Sched& S, const Epi& E) {
    const int tid = otid(g.pad), wid = __builtin_amdgcn_readfirstlane(tid >> 6), lane = tid & 63, wr = wid >> 2, wc = wid & 3, fr = lane & 15, fq = lane >> 4;
    int R0, C0, R1, C1; stage_rc(tid * 16, R0, C0); stage_rc(tid * 16 + 8192, R1, C1);
    unsigned voffB[2];
    { const int Rb0 = Epi::PERM ? ((R0 & ~31) + perm32(R0 & 31)) : R0, Rb1 = Epi::PERM ? ((R1 & ~31) + perm32(R1 & 31)) : R1;
      voffB[0] = (unsigned)(Rb0 * g.ldb + C0) * 2u; voffB[1] = (unsigned)(Rb1 * g.ldb + C1) * 2u; }
    const size_t kstep = (size_t)(BK * 2);
    const size_t hstepB = (size_t)HALF * g.ldb * 2, tstepB = 2 * hstepB;
    const unsigned ldsw = (unsigned)wid * 1024u;
    const int aoff = lds_byte(wr * 64 + fr, fq * 8), boff = lds_byte(wc * 32 + fr, fq * 8);
#define PG8_SA(b, h) (((b) * 2 + (h)) * HTB)
#define PG8_SB(b, h) ((4 + (b) * 2 + (h)) * HTB)
#define PG8_STAGE(bufoff, gbase, voff) do { _Pragma("unroll") for (int _i = 0; _i < 2; ++_i) \
        __builtin_amdgcn_global_load_lds((const unsigned*)((const char*)(gbase) + (voff)[_i]), (PG8_LAS unsigned*)(lds + (bufoff) + ldsw + _i * 8192), 16, 0, 0); } while (0)
#define PG8_LDA(dst, b, h) do { _Pragma("unroll") for (int m = 0; m < 4; ++m) _Pragma("unroll") for (int k = 0; k < 2; ++k) dst[m][k] = *(const PG8_LAS bf16x8*)(lds + PG8_SA(b, h) + aoff + m * 2048 + k * 1024); } while (0)
#define PG8_LDB(dst, b, h) do { _Pragma("unroll") for (int n = 0; n < 2; ++n) _Pragma("unroll") for (int k = 0; k < 2; ++k) dst[n][k] = *(const PG8_LAS bf16x8*)(lds + PG8_SB(b, h) + boff + n * 2048 + k * 1024); } while (0)
#define PG8_MMA(ai, bj, At, Bt) do { __builtin_amdgcn_s_setprio(1); _Pragma("unroll") for (int m = 0; m < 4; ++m) _Pragma("unroll") for (int n = 0; n < 2; ++n) _Pragma("unroll") for (int k = 0; k < 2; ++k) \
        acc[ai][bj][m][n] = __builtin_amdgcn_mfma_f32_16x16x32_bf16(Bt[n][k], At[m][k], acc[ai][bj][m][n], 0, 0, 0); __builtin_amdgcn_s_setprio(0); } while (0)
#define PG8_WAIT_V(n) asm volatile("s_waitcnt vmcnt(" #n ")" ::: "memory")
#define PG8_WAIT_L(n) asm volatile("s_waitcnt lgkmcnt(" #n ")" ::: "memory")
#define PG8_BAR __builtin_amdgcn_s_barrier()
#define PG8_SCHED __builtin_amdgcn_sched_barrier(0)
    Unit cur, nxt; int ui = 0;
    if (!S.next(0, cur)) return;
    f32x4 acc[2][2][4][2];
#pragma unroll
    for (int a = 0; a < 2; ++a)
#pragma unroll
        for (int b = 0; b < 2; ++b)
#pragma unroll
            for (int m = 0; m < 4; ++m)
#pragma unroll
                for (int n = 0; n < 2; ++n) acc[a][b][m][n] = zero4();
    bf16x8 At[4][2], B0[2][2], B1[2][2];
    size_t baseC, hsC; unsigned voC[2]; a_geom<AMAP>(g, cur, R0, C0, R1, C1, baseC, hsC, voC);
    const char* cA = (const char*)g.A + baseC + (size_t)cur.k0 * 2; const char* cB = (const char*)g.Bt + (size_t)cur.pn * tstepB + (size_t)cur.k0 * 2;
    S.a_ready(cur);
    PG8_STAGE(PG8_SB(0, 0), cB, voffB); PG8_STAGE(PG8_SB(0, 1), cB + hstepB, voffB); PG8_STAGE(PG8_SA(0, 0), cA, voC); PG8_STAGE(PG8_SA(0, 1), cA + hsC, voC);
    if (wr == 1) PG8_BAR;
    PG8_WAIT_V(2); PG8_BAR;
    PG8_STAGE(PG8_SB(1, 0), cB + kstep, voffB); PG8_STAGE(PG8_SA(1, 0), cA + kstep, voC); PG8_STAGE(PG8_SB(1, 1), cB + hstepB + kstep, voffB);
    PG8_WAIT_V(6); PG8_BAR;
    for (;;) {
        const bool has_next = S.next(ui + 1, nxt);
        size_t baseN = baseC, hsN = hsC; unsigned voN[2] = {voC[0], voC[1]};
        if (AMAP && has_next) a_geom<AMAP>(g, nxt, R0, C0, R1, C1, baseN, hsN, voN); else if (has_next) baseN = (size_t)nxt.pm * 256 * g.lda * 2;
        const char* nA = has_next ? (const char*)g.A + baseN + (size_t)nxt.k0 * 2 : cA; const char* nB = has_next ? (const char*)g.Bt + (size_t)nxt.pn * tstepB + (size_t)nxt.k0 * 2 : cB;
        const int nt = cur.nt;
        for (int t = 0; t < nt; t += 2) {
            if constexpr (Epi::HOOK) E.hook(acc, cur, t, wr, wc, fr, fq, At, B0, B1);
            const bool last = (t == nt - 2);
            const char* a1 = cA + (size_t)(t + 1) * kstep;
            const char* a2 = last ? nA : cA + (size_t)(t + 2) * kstep; const char* b2 = last ? nB : cB + (size_t)(t + 2) * kstep;
            const char* a3 = a2 + kstep; const char* b3 = b2 + kstep;
            const size_t hs2 = (AMAP && last) ? hsN : hsC; unsigned vo2[2] = {(AMAP && last) ? voN[0] : voC[0], (AMAP && last) ? voN[1] : voC[1]};
            if (last && has_next) S.a_ready(nxt);
            PG8_LDB(B0, 0, 0); PG8_LDB(B1, 0, 1); PG8_SCHED; PG8_LDA(At, 0, 0); PG8_STAGE(PG8_SA(1, 1), a1 + hsC, voC);
            PG8_WAIT_V(8); PG8_WAIT_L(0); PG8_BAR; PG8_MMA(0, 0, At, B0); PG8_MMA(0, 1, At, B1); PG8_BAR; PG8_SCHED;
            PG8_LDA(At, 0, 1); PG8_STAGE(PG8_SB(0, 0), b2, voffB); PG8_STAGE(PG8_SB(0, 1), b2 + hstepB, voffB); PG8_STAGE(PG8_SA(0, 0), a2, vo2);
            PG8_WAIT_V(8); PG8_WAIT_L(0); PG8_BAR; PG8_MMA(1, 0, At, B0); PG8_MMA(1, 1, At, B1); PG8_BAR; PG8_SCHED;
            PG8_LDB(B0, 1, 0); PG8_LDB(B1, 1, 1); PG8_SCHED; PG8_LDA(At, 1, 0); PG8_STAGE(PG8_SA(0, 1), a2 + hs2, vo2);
            PG8_WAIT_V(8); PG8_WAIT_L(0); PG8_BAR; PG8_MMA(0, 0, At, B0); PG8_MMA(0, 1, At, B1); PG8_BAR; PG8_SCHED;
            PG8_LDA(At, 1, 1); PG8_STAGE(PG8_SB(1, 0), b3, voffB); PG8_STAGE(PG8_SB(1, 1), b3 + hstepB, voffB); PG8_STAGE(PG8_SA(1, 0), a3, vo2);
            PG8_WAIT_V(8); PG8_WAIT_L(0); PG8_BAR; PG8_MMA(1, 0, At, B0); PG8_MMA(1, 1, At, B1); PG8_BAR; PG8_SCHED;
        }
        if (wr == 0) PG8_BAR;
        E(acc, cur, wr, wc, fr, fq); S.done(cur);
        if (!has_next) break;
#pragma unroll
        for (int a = 0; a < 2; ++a)
#pragma unroll
            for (int b = 0; b < 2; ++b)
#pragma unroll
                for (int m = 0; m < 4; ++m)
#pragma unroll
                    for (int n = 0; n < 2; ++n) acc[a][b][m][n] = zero4();
        cur = nxt; cA = nA; cB = nB; ++ui;
        if constexpr (AMAP) { hsC = hsN; voC[0] = voN[0]; voC[1] = voN[1]; }
        if (wr == 1) PG8_BAR;
    }
    PG8_WAIT_V(0);
    PG8_BAR;
#undef PG8_SA
#undef PG8_SB
#undef PG8_STAGE
#undef PG8_LDA
#undef PG8_LDB
#undef PG8_MMA
#undef PG8_WAIT_V
#undef PG8_WAIT_L
#undef PG8_BAR
#undef PG8_SCHED
}
}

template <class F> __device__ __forceinline__ void epi_foreach(const f32x4 (&acc)[2][2][4][2], const pg8::Unit& u, int wr, int wc, int fr, int fq, F&& f) {
    const int row0 = u.pm * 256 + wr * 64 + fr, col0 = u.pn * 256 + wc * 32 + 8 * fq;
#pragma unroll
    for (int ai = 0; ai < 2; ++ai)
#pragma unroll
        for (int m = 0; m < 4; ++m)
#pragma unroll
            for (int bj = 0; bj < 2; ++bj) f(row0 + ai * 128 + m * 16, col0 + bj * 128, acc[ai][bj][m][0], acc[ai][bj][m][1]);
}
__device__ __forceinline__ u32x4 pack8v(f32x4 v0, f32x4 v1) { u32x4 w; w.x = pk2(v0[0], v0[1]); w.y = pk2(v0[2], v0[3]); w.z = pk2(v1[0], v1[1]); w.w = pk2(v1[2], v1[3]); return w; }

struct EpiInProj {
    static constexpr bool PERM = true, HOOK = false;
    bf16_t* P; float* G; const float* bias;
    __device__ __forceinline__ void operator()(const f32x4 (&acc)[2][2][4][2], const pg8::Unit& u, int wr, int wc, int fr, int fq) const {
        if (u.pn < 48) {
            epi_foreach(acc, u, wr, wc, fr, fq, [&](int row, int col, f32x4 v0, f32x4 v1) {
                const f32x4 b0 = gld<f32x4>(bias, (unsigned)col * 4u), b1 = gld<f32x4>(bias, (unsigned)col * 4u + 16);
                f32x4 o0 = v0 + b0, o1 = v1 + b1;
                if (u.pn >= PGM / 256) {
#pragma unroll
                    for (int j = 0; j < 4; ++j) { o0[j] = 1.f + __expf(-fminf(fmaxf(o0[j], -30.f), 30.f)); o1[j] = 1.f + __expf(-fminf(fmaxf(o1[j], -30.f), 30.f)); } }
                gst<u32x4>(P, (unsigned)(row * NP + col) * 2u, pack8v(o0, o1)); });
        } else if (wc == 0 && fq < 2) {
            const int row0 = u.pm * 256 + wr * 64 + fr;
            const f32x4 b0 = gld<f32x4>(bias, (unsigned)(NP + 8 * fq) * 4u), b1 = gld<f32x4>(bias, (unsigned)(NP + 8 * fq) * 4u + 16);
#pragma unroll
            for (int ai = 0; ai < 2; ++ai)
#pragma unroll
                for (int m = 0; m < 4; ++m) { const unsigned go = (unsigned)((row0 + ai * 128 + m * 16) * 16 + 8 * fq) * 4u;
                    gst<f32x4>(G, go, acc[ai][0][m][0] + b0); gst<f32x4>(G, go + 16, acc[ai][0][m][1] + b1); }
        }
    }
};
struct EpiBf16 {
    static constexpr bool PERM = true, HOOK = false;
    bf16_t* O; int ldc; int split_cols; unsigned split_stride; int pad; float* slab;
    __device__ __forceinline__ void operator()(const f32x4 (&acc)[2][2][4][2], const pg8::Unit& u, int wr, int wc, int fr, int fq) const {
        if (u.ks >= 0) { const unsigned sb = (unsigned)u.ks * (unsigned)(RC * ldc);
            epi_foreach(acc, u, wr, wc, fr, fq, [&](int row, int col, f32x4 v0, f32x4 v1) { const unsigned o = (sb + (unsigned)((row - RL) * ldc + col)) * 4u; gst<f32x4>(slab, o, v0); gst<f32x4>(slab, o + 16, v1); });
            return; }
        int colt = u.pn * 256; unsigned base = 0;
        if (split_cols) { const int t = colt / split_cols; base = (unsigned)t * split_stride; colt -= t * split_cols; }
        const int cshift = colt - u.pn * 256;
        epi_foreach(acc, u, wr, wc, fr, fq, [&](int row, int col, f32x4 v0, f32x4 v1) { gst<u32x4>(O, (base + (unsigned)(row * ldc + col + cshift)) * 2u, pack8v(v0, v1)); });
    }
};
struct EpiMerge {
    static constexpr bool PERM = true, HOOK = true;
    const bf16_t* P; bf16_t* MG;
    __device__ __forceinline__ void hook(f32x4 (&acc)[2][2][4][2], const pg8::Unit& u, int t, int wr, int wc, int fr, int fq, bf16x8 (&At)[4][2], bf16x8 (&B0)[2][2], bf16x8 (&B1)[2][2]) const {
        if (t != 16 && t != 24) return;
        const int b = t == 16 ? 0 : 1;
        const unsigned o0 = (unsigned)((u.pm * 256 + wr * 64 + fr) * NP + PGM + b * D + u.pn * 256 + wc * 32 + 8 * fq) * 2u;
#pragma unroll
        for (int ai = 0; ai < 2; ++ai) {
#pragma unroll
            for (int m = 0; m < 4; ++m) { const unsigned o = o0 + (unsigned)((ai * 128 + m * 16) * NP) * 2u;
                At[m][0] = gld<bf16x8>(P, o); At[m][1] = gld<bf16x8>(P, o + 256u);
                if (m < 2) { B0[m][0] = gld<bf16x8>(P, o + D * 2); B0[m][1] = gld<bf16x8>(P, o + D * 2 + 256u); }
                else { B1[m - 2][0] = gld<bf16x8>(P, o + D * 2); B1[m - 2][1] = gld<bf16x8>(P, o + D * 2 + 256u); } }
#pragma unroll
            for (int m = 0; m < 4; ++m)
#pragma unroll
                for (int bj = 0; bj < 2; ++bj) { float xa[8], xb[8]; unpack8(__builtin_bit_cast(u32x4, At[m][bj]), xa); unpack8(__builtin_bit_cast(u32x4, m < 2 ? B0[m][bj] : B1[m - 2][bj]), xb);
#pragma unroll
                    for (int j = 0; j < 8; ++j) acc[ai][bj][m][j >> 2][j & 3] *= xb[j] * __builtin_amdgcn_rcpf(xa[j]); }
        }
    }
    __device__ __forceinline__ void operator()(const f32x4 (&acc)[2][2][4][2], const pg8::Unit& u, int wr, int wc, int fr, int fq) const {
        const int row0 = u.pm * 256 + wr * 64 + fr, col0 = u.pn * 256 + wc * 32 + 8 * fq;
#pragma unroll
        for (int ai = 0; ai < 2; ++ai) { u32x4 gr[4][2];
#pragma unroll
            for (int m = 0; m < 4; ++m)
#pragma unroll
                for (int bj = 0; bj < 2; ++bj) gr[m][bj] = gld<u32x4>(P, (unsigned)((row0 + ai * 128 + m * 16) * NP + PGM + 2 * D + col0 + bj * 128) * 2u);
#pragma unroll
            for (int m = 0; m < 4; ++m)
#pragma unroll
                for (int bj = 0; bj < 2; ++bj) { float g[8]; unpack8(gr[m][bj], g);
                    const f32x4 g0 = {__builtin_amdgcn_rcpf(g[0]), __builtin_amdgcn_rcpf(g[1]), __builtin_amdgcn_rcpf(g[2]), __builtin_amdgcn_rcpf(g[3])},
                                g1 = {__builtin_amdgcn_rcpf(g[4]), __builtin_amdgcn_rcpf(g[5]), __builtin_amdgcn_rcpf(g[6]), __builtin_amdgcn_rcpf(g[7])};
                    gst<u32x4>(MG, (unsigned)((row0 + ai * 128 + m * 16) * D + col0 + bj * 128) * 2u, pack8v(g0 * acc[ai][bj][m][0], g1 * acc[ai][bj][m][1])); }
        }
    }
};
struct EpiUp {
    static constexpr bool PERM = true, HOOK = false;
    bf16_t* U; float* slab; bf16_t* ACT; const float* wf;
    __device__ __forceinline__ void operator()(const f32x4 (&acc)[2][2][4][2], const pg8::Unit& u, int wr, int wc, int fr, int fq) const {
        if (u.ks >= 0) { const unsigned sb = (unsigned)u.ks * (unsigned)(RC * NUP);
            epi_foreach(acc, u, wr, wc, fr, fq, [&](int row, int col, f32x4 v0, f32x4 v1) { const unsigned o = (sb + (unsigned)((row - RL) * NUP + col)) * 4u; gst<f32x4>(slab, o, v0); gst<f32x4>(slab, o + 16, v1); });
            return; }
        if (u.pm >= 32) { epi_foreach(acc, u, wr, wc, fr, fq, [&](int row, int col, f32x4 v0, f32x4 v1) { gst<u32x4>(U, (unsigned)(row * NUP + col) * 2u, pack8v(v0, v1)); }); return; }
        const int c0 = 128 * u.pn + 32 * wc + 8 * fq, lane = fq * 16 + fr;
        const int lprev = ((lane & 48) | ((fr - 1) & 15)), lnext = ((lane & 48) | ((fr + 1) & 15));
        float w0[8], w1[8], w2[8];
        { const f32x4 a0 = gld<f32x4>(wf, (unsigned)c0 * 4u), a1 = gld<f32x4>(wf, (unsigned)c0 * 4u + 16), b0 = gld<f32x4>(wf, (unsigned)(DFF + c0) * 4u), b1 = gld<f32x4>(wf, (unsigned)(DFF + c0) * 4u + 16),
                      d0 = gld<f32x4>(wf, (unsigned)(2 * DFF + c0) * 4u), d1 = gld<f32x4>(wf, (unsigned)(2 * DFF + c0) * 4u + 16);
#pragma unroll
          for (int j = 0; j < 4; ++j) { w0[j] = a0[j]; w0[4 + j] = a1[j]; w1[j] = b0[j]; w1[4 + j] = b1[j]; w2[j] = d0[j]; w2[4 + j] = d1[j]; } }
        const unsigned rowb = (unsigned)((u.pm >> 3) * 2048 + (u.pm & 7) * 8 + 2 * wr);
#pragma unroll
        for (int ai = 0; ai < 2; ++ai)
#pragma unroll
            for (int m = 0; m < 4; ++m) {
                float o[8];
#pragma unroll
                for (int n = 0; n < 2; ++n)
#pragma unroll
                    for (int e = 0; e < 4; ++e) {
                        const float a = acc[ai][0][m][n][e];
                        const float oprev = (m & 1) ? acc[ai][0][m - 1 < 0 ? 0 : m - 1][n][e] : 0.f, onext = (m & 1) ? 0.f : acc[ai][0][m + 1 > 3 ? 3 : m + 1][n][e];
                        const float pv = shl_(fr == 15 ? oprev : a, lprev), nx = shl_(fr == 0 ? onext : a, lnext);
                        o[4 * n + e] = siluf_(w0[4 * n + e] * pv + w1[4 * n + e] * a + w2[4 * n + e] * nx) * acc[ai][1][m][n][e];
                    }
                const unsigned row = rowb + (unsigned)((16 * (m & 1) + fr) * 64 + 4 * ai + (m >> 1));
                gst<u32x4>(ACT, (row * (unsigned)DFF + (unsigned)c0) * 2u, pack8(o));
            }
    }
};
struct EpiResid {
    static constexpr bool PERM = true, HOOK = false;
    int l, which, fuse; float scale;
    __device__ __forceinline__ void operator()(f32x4 (&acc)[2][2][4][2], const pg8::Unit& u, int wr, int wc, int fr, int fq) const {
        CParams& p = *okp(); unsigned char* const ws = ows(p.ws);
        float* H = (float*)(ws + OFF_H); const float* Hin = (l == 0 && which == 0) ? p.x : H;
        const float* mod = (const float*)(ws + OFF_MOD) + (size_t)l * 5 * 6 * D; const float* gate = mod + (which ? 5 : 2) * D;
        if (u.ks >= 0) { float* slab = (float*)(ws + OFF_SLAB); const unsigned sb = (unsigned)u.ks * (unsigned)(RC * D);
            epi_foreach(acc, u, wr, wc, fr, fq, [&](int row, int col, f32x4 v0, f32x4 v1) { const unsigned o = (sb + (unsigned)((row - RL) * D + col)) * 4u; gst<f32x4>(slab, o, v0); gst<f32x4>(slab, o + 16, v1); });
            return; }
        const unsigned gb = (unsigned)(u.pm < 32 ? (u.pm >> 3) : 4) * (6 * D) * 4u;
        if (!fuse || u.pm >= 32) {
            epi_foreach(acc, u, wr, wc, fr, fq, [&](int row, int col, f32x4 v0, f32x4 v1) {
                const unsigned ho = (unsigned)(row * D + col) * 4u;
                const f32x4 g0 = gld<f32x4>(gate, gb + (unsigned)col * 4u), g1 = gld<f32x4>(gate, gb + (unsigned)col * 4u + 16);
                gst<f32x4>(H, ho, gld<f32x4>(Hin, ho) + g0 * v0 * scale); gst<f32x4>(H, ho + 16, gld<f32x4>(Hin, ho + 16) + g1 * v1 * scale); });
            return; }
        bf16_t* XN = (bf16_t*)(ws + OFF_XN); const float* nw = fuse == 2 ? p.final_norm_w : which ? p.norm1_w + (size_t)(l + 1) * D : p.norm2_w + (size_t)l * D;
        const float* nmod = which ? mod + 5 * 6 * D : mod + 3 * D;
        float* xs = (float*)(ws + OFF_XS) + (size_t)(2 * l + which) * RL * 32; unsigned* cnt = (unsigned*)(ws + OFF_CTL) + CNTW + (2 * l + which) * 32 * 64;
        int lane; asm volatile("v_mbcnt_lo_u32_b32 %0, -1, 0\n\tv_mbcnt_hi_u32_b32 %0, -1, %0" : "=v"(lane));
        { const int fr2 = lane & 15, fq2 = lane >> 4, row0 = u.pm * 256 + wr * 64 + fr2, col0 = u.pn * 256 + wc * 32 + 8 * fq2;
          f32x4 gv[2][2];
#pragma unroll
          for (int bj = 0; bj < 2; ++bj) { gv[bj][0] = gld<f32x4>(gate, gb + (unsigned)(col0 + bj * 128) * 4u) * scale; gv[bj][1] = gld<f32x4>(gate, gb + (unsigned)(col0 + bj * 128) * 4u + 16) * scale; }
#pragma unroll
          for (int ai = 0; ai < 2; ++ai)
#pragma unroll
            for (int m = 0; m < 4; ++m) { const int row = row0 + ai * 128 + m * 16; float ss = 0.f;
#pragma unroll
                for (int bj = 0; bj < 2; ++bj) { const unsigned ho = (unsigned)(row * D + col0 + bj * 128) * 4u;
                    const f32x4 h0 = gld<f32x4>(Hin, ho) + gv[bj][0] * acc[ai][bj][m][0], h1 = gld<f32x4>(Hin, ho + 16) + gv[bj][1] * acc[ai][bj][m][1];
                    gst<f32x4>(H, ho, h0); gst<f32x4>(H, ho + 16, h1);
                    ss += (h0[0] * h0[0] + h0[1] * h0[1]) + (h0[2] * h0[2] + h0[3] * h0[3]) + (h1[0] * h1[0] + h1[1] * h1[1]) + (h1[2] * h1[2] + h1[3] * h1[3]); }
                ss += shx(ss, 16, lane); ss += shx(ss, 32, lane);
                if (fq2 == 0) __hip_atomic_store((GAS float*)xs + (row * 32 + u.pn * 4 + wc), ss, __ATOMIC_RELAXED, __HIP_MEMORY_SCOPE_AGENT);
            } }
        asm volatile("s_waitcnt vmcnt(0)" ::: "memory");
        __builtin_amdgcn_s_barrier();
        if (lane == 0 && wr == 0 && wc == 0) {
            GAS unsigned* pc = (GAS unsigned*)cnt + 64 * u.pm;
            (void)__hip_atomic_fetch_add(pc, 1u, __ATOMIC_RELAXED, __HIP_MEMORY_SCOPE_AGENT);
            unsigned spins = 0;
            while (__hip_atomic_load(pc, __ATOMIC_RELAXED, __HIP_MEMORY_SCOPE_AGENT) < 8u && ++spins < (1u << 22)) __builtin_amdgcn_s_sleep(1);
        }
        __builtin_amdgcn_s_barrier();
        __builtin_amdgcn_fence(__ATOMIC_ACQUIRE, "agent");
        { const int hl = lane & 31, row0 = u.pm * 256 + (wr * 4 + wc) * 32 + (lane >> 5), col = u.pn * 256 + hl * 8;
          const unsigned mo = (unsigned)(u.pm >> 3) * (6 * D) * 4u, co = (unsigned)col * 4u;
          const f32x4 w0 = gld<f32x4>(nw, co), w1 = gld<f32x4>(nw, co + 16);
          if (fuse == 2) { float* out = p.out;
#pragma unroll 4
            for (int it = 0; it < 16; ++it) { const int row = row0 + 2 * it;
                float tot = gld<float>(xs, (unsigned)(row * 32 + hl) * 4u);
                const unsigned ho = (unsigned)(row * D + col) * 4u;
                const f32x4 h0 = gld<f32x4>(H, ho), h1 = gld<f32x4>(H, ho + 16);
#pragma unroll
                for (int o = 1; o < 32; o <<= 1) tot += shx(tot, o, lane);
                const float rstd = rsqrtf(tot * (1.f / D) + EPS);
                gst<f32x4>(out, ho, h0 * rstd * w0); gst<f32x4>(out, ho + 16, h1 * rstd * w1); }
            return; }
          const f32x4 sh0 = gld<f32x4>(nmod, mo + co), sh1 = gld<f32x4>(nmod, mo + co + 16);
          const f32x4 sc0 = gld<f32x4>(nmod, mo + D * 4 + co) + 1.f, sc1 = gld<f32x4>(nmod, mo + D * 4 + co + 16) + 1.f;
#pragma unroll 4
          for (int it = 0; it < 16; ++it) { const int row = row0 + 2 * it;
              float tot = gld<float>(xs, (unsigned)(row * 32 + hl) * 4u);
              const unsigned ho = (unsigned)(row * D + col) * 4u;
              const f32x4 h0 = gld<f32x4>(H, ho), h1 = gld<f32x4>(H, ho + 16);
#pragma unroll
              for (int o = 1; o < 32; o <<= 1) tot += shx(tot, o, lane);
              const float rstd = rsqrtf(tot * (1.f / D) + EPS);
              const f32x4 y0 = (h0 * rstd * w0) * sc0 + sh0, y1 = (h1 * rstd * w1) * sc1 + sh1;
              gst<u32x4>(XN, (unsigned)(row * D + col) * 2u, pack8v(y0, y1)); } }
    }
};

__device__ __forceinline__ bf16x8 gather8(const bf16_t* p, size_t stride) {
    bf16x8 v;
#pragma unroll
    for (int j = 0; j < 8; ++j) v[j] = (short)p[(size_t)j * stride];
    return v;
}
template <bool AV, bool BV>
__device__ __forceinline__ void wave_mm32(const bf16_t* A, size_t sam, size_t sak, const bf16_t* B, size_t sbk, size_t sbn, int K, f32x4 (&acc)[2][2], int lane) {
    const int fr = lane & 15, fq = lane >> 4;
    for (int k0 = 0; k0 < K; k0 += 32) {
        bf16x8 a[2], b[2];
#pragma unroll
        for (int mi = 0; mi < 2; ++mi) { const bf16_t* q = A + (size_t)(16 * mi + fr) * sam + (size_t)(k0 + 8 * fq) * sak; a[mi] = AV ? *(const bf16x8*)q : gather8(q, sak); }
#pragma unroll
        for (int ni = 0; ni < 2; ++ni) { const bf16_t* q = B + (size_t)(16 * ni + fr) * sbn + (size_t)(k0 + 8 * fq) * sbk; b[ni] = BV ? *(const bf16x8*)q : gather8(q, sbk); }
#pragma unroll
        for (int mi = 0; mi < 2; ++mi)
#pragma unroll
            for (int ni = 0; ni < 2; ++ni) acc[mi][ni] = __builtin_amdgcn_mfma_f32_16x16x32_bf16(a[mi], b[ni], acc[mi][ni], 0, 0, 0);
    }
}
#define ZERO_ACC22(acc) do { _Pragma("unroll") for (int _a = 0; _a < 2; ++_a) _Pragma("unroll") for (int _b = 0; _b < 2; ++_b) acc[_a][_b] = (f32x4){0.f, 0.f, 0.f, 0.f}; } while (0)

__device__ __forceinline__ void transpose_item(const float* W, int N, int pitch, int kdst0, bf16_t* WT, int dst_row0, int src_col0, int nvalid, int k0, LAS float* scr, int lane) {
    const int n4 = (lane & 15) * 4, kq = lane >> 4;
    f32x4 v[16];
#pragma unroll
    for (int i = 0; i < 16; ++i) v[i] = n4 < nvalid ? gld<f32x4>(W, (unsigned)((k0 + 4 * i + kq) * N + src_col0 + n4) * 4u) : (f32x4){0.f, 0.f, 0.f, 0.f};
#pragma unroll
    for (int i = 0; i < 16; ++i) { LAS float* d = scr + (4 * i + kq) * 65 + n4; d[0] = v[i][0]; d[1] = v[i][1]; d[2] = v[i][2]; d[3] = v[i][3]; }
    asm volatile("s_waitcnt lgkmcnt(0)" ::: "memory");
    const int c = lane & 7;
#pragma unroll
    for (int j8 = 0; j8 < 8; ++j8) { const int n = (lane >> 3) + 8 * j8; const LAS float* sp = scr + (8 * c) * 65 + n;
        u32x4 o; o.x = pk2(sp[0 * 65], sp[1 * 65]); o.y = pk2(sp[2 * 65], sp[3 * 65]); o.z = pk2(sp[4 * 65], sp[5 * 65]); o.w = pk2(sp[6 * 65], sp[7 * 65]);
        gst<u32x4>(WT, (unsigned)((dst_row0 + n) * pitch + kdst0 + k0 + 8 * c) * 2u, o); }
    asm volatile("s_waitcnt lgkmcnt(0)" ::: "memory");
}
constexpr int I_IN = (NINP / 64) * (D / 64), I_PM = (D / 64) * (DM / 64), I_PF = (D / 64) * (DF / 64), I_PC = (D / 64) * (DC / 64), I_O = (D / 64) * (D / 64),
              I_UP = (NUP / 64) * (D / 64), I_DN = (D / 64) * (DFF / 64), I_LAYER = I_IN + I_PM + I_PF + I_PC + I_O + I_UP + I_DN;
__device__ __forceinline__ void ph_convert(int wv, LAS unsigned char* lds, int l, int widx, int nwg, int it_lo, int it_hi) {
    CParams& p = *okp();
    unsigned char* const wsb = ows(p.ws);
    const int TIDX = otid(wv);
    const int lane = TIDX & 63, wave = wv;
    LAS float* scr = (LAS float*)lds + wave * 64 * 65;
    const int gw = widx * 8 + wave, NGW = nwg * 8;
    for (int it = it_lo + gw; it < it_hi; it += NGW) {
        int r = it;
        if (r < I_IN) { const int nkb = D / 64, kb = r % nkb, grp = r / nkb, j0 = 64 * grp; int src0, nv;
            if (j0 < 2048) { src0 = j0; nv = 64; } else if (j0 < NP) { src0 = j0 + 16; nv = 64; } else if (j0 == NP) { src0 = 2048; nv = 16; } else { src0 = 0; nv = 0; }
            transpose_item(p.w_in + (size_t)l * D * NIN, NIN, D, 0, WSP(bf16_t, OFF_WIN) + (size_t)l * NINP * D, j0, src0, nv, 64 * kb, scr, lane); continue; } r -= I_IN;
        if (r < I_PM) { const int nkb = DM / 64, kb = r % nkb, grp = r / nkb;
            transpose_item(p.w_pm + (size_t)l * DM * D, D, D, 0, WSP(bf16_t, OFF_WPM) + (size_t)l * D * D, 64 * grp, 64 * grp, 64, 64 * kb, scr, lane); continue; } r -= I_PM;
        if (r < I_PF) { const int nkb = DF / 64, kb = r % nkb, grp = r / nkb;
            transpose_item(p.w_pf + (size_t)l * DF * D, D, D, DM, WSP(bf16_t, OFF_WPM) + (size_t)l * D * D, 64 * grp, 64 * grp, 64, 64 * kb, scr, lane); continue; } r -= I_PF;
        if (r < I_PC) { const int nkb = DC / 64, kb = r % nkb, grp = r / nkb;
            transpose_item(p.w_pc + (size_t)l * DC * D, D, D, DM + DF, WSP(bf16_t, OFF_WPM) + (size_t)l * D * D, 64 * grp, 64 * grp, 64, 64 * kb, scr, lane); continue; } r -= I_PC;
        if (r < I_O) { const int nkb = D / 64, kb = r % nkb, grp = r / nkb;
            transpose_item(p.w_o + (size_t)l * D * D, D, D, 0, WSP(bf16_t, OFF_WO) + (size_t)l * D * D, 64 * grp, 64 * grp, 64, 64 * kb, scr, lane); continue; } r -= I_O;
        if (r < I_UP) { const int nkb = D / 64, kb = r % nkb, grp = r / nkb, j0 = 64 * grp, tile = j0 >> 8, w0 = j0 & 255;
            transpose_item(p.w_up + (size_t)l * D * NUP, NUP, D, 0, WSP(bf16_t, OFF_WUP) + (size_t)l * NUP * D, j0, w0 < 128 ? 128 * tile + w0 : DFF + 128 * tile + (w0 - 128), 64, 64 * kb, scr, lane); continue; } r -= I_UP;
        { const int nkb = DFF / 64, kb = r % nkb, grp = r / nkb;
            transpose_item(p.w_down + (size_t)l * DFF * D, D, DFF, 0, WSP(bf16_t, OFF_WDN) + (size_t)l * D * DFF, 64 * grp, 64 * grp, 64, 64 * kb, scr, lane); }
    }
}
__device__ __forceinline__ void ph_tables(int wv) {
    CParams& p = *okp();
    unsigned char* const wsb = ows(p.ws);
    const int TIDX = otid(wv), BIDX = obid(); (void)TIDX; (void)BIDX;
    const size_t gt = (size_t)BIDX * 512 + TIDX, NT = (size_t)gridDim.x * 512;
    bf16_t* ma = WSP(bf16_t, OFF_MA);
    for (size_t i = gt; i < (size_t)64 * 64; i += NT) { const int row = (int)(i >> 6), col = (int)(i & 63), ro = row >> 5, tau1 = row & 31, ri = col >> 5, t1 = col & 31;
        const float a = (float)((t1 * tau1) & 31) * (1.0f / 16.0f); const float cv = cospif(a), sv = sinpif(a);
        ma[i] = (bf16_t)f2bf(ro == ri ? cv : (ro == 0 ? sv : -sv)); }
    bf16_t* mc = WSP(bf16_t, OFF_MC);
    for (size_t i = gt; i < (size_t)32 * 64 * 128; i += NT) { const int k = (int)(i & 127), tau2 = (int)(i >> 7) & 63, tau1 = (int)(i >> 13), ri = k >> 6, t2 = k & 63, tau = tau1 + 32 * tau2;
        const float a = (float)((t2 * tau) & 2047) * (1.0f / 1024.0f); mc[i] = (bf16_t)f2bf((ri ? sinpif(a) : cospif(a)) * (1.0f / 512.0f)); }
    bf16_t* csc = WSP(bf16_t, OFF_CSC);
    for (size_t i = gt; i < (size_t)256 * 512; i += NT) { const int tau = (int)(i >> 9), k = (int)(i & 511), t = k & 255; const int idx = (tau * t) & 255;
        const float a = (float)idx * (1.0f / 128.0f); const float v = (k < 256 ? cospif(a) : -sinpif(a)) * 0.005524271728019903f  ; csc[i] = (bf16_t)f2bf(v); }
    bf16_t* ft = WSP(bf16_t, OFF_FT);
    for (size_t i = gt; i < (size_t)256 * 128; i += NT) { const int kp = (int)(i >> 7), c = (int)(i & 127), kap = kp & 127; const int idx = (c * kap) & 127;
        const float a = (float)idx * (1.0f / 64.0f); ft[i] = (bf16_t)f2bf(kp < 128 ? cospif(a) : sinpif(a)); }
    float* binr = WSP(float, OFF_BINR);
    for (size_t i = gt; i < (size_t)DEPTH * NINP; i += NT) { const int l = (int)(i / NINP), j = (int)(i % NINP);
        float v = 0.f; if (j < 2048) v = p.b_in[(size_t)l * NIN + j]; else if (j < NP) v = p.b_in[(size_t)l * NIN + j + 16]; else if (j < NP + 16) v = p.b_in[(size_t)l * NIN + 2048 + (j - NP)];
        binr[i] = v; }

}
__device__ __forceinline__ void ph_mod(int wv, LAS unsigned char* lds, int l0, int l1, int widx, int nwg) {
    CParams& p = *okp();
    unsigned char* const wsb = ows(p.ws);
    const int TIDX = otid(wv), BIDX = obid(); (void)TIDX; (void)BIDX;
    typedef float sc_row_t[D]; typedef f32x4 red_t[5][16];
    LAS sc_row_t* sc = (LAS sc_row_t*)lds; LAS red_t* red = (LAS red_t*)(lds + 5 * D * 4);
    const int tid = TIDX;
    for (int i = tid; i < 5 * D; i += 512) { const int j = i / D, k = i % D; const float v = j < 4 ? p.c[(size_t)j * D + k] : p.c_ctx[k]; sc[j][k] = siluf_(v); }
    __syncthreads();
    float* mod = WSP(float, OFF_MOD);
    const int cl = tid & 15, kg = tid >> 4;
    for (int unit = widx; unit < (l1 - l0) * (6 * D / 64); unit += nwg) {
        const int l = l0 + unit / (6 * D / 64), n0 = (unit % (6 * D / 64)) * 64;
        f32x4 a[5];
#pragma unroll
        for (int j = 0; j < 5; ++j) a[j] = (f32x4){0.f, 0.f, 0.f, 0.f};
        const float* wp = p.w_mod + (size_t)l * D * 6 * D + n0 + 4 * cl;
        for (int k = kg; k < D; k += 32) { const f32x4 w = *(const f32x4*)(wp + (size_t)k * 6 * D);
#pragma unroll
            for (int j = 0; j < 5; ++j) a[j] += sc[j][k] * w; }
#pragma unroll
        for (int j = 0; j < 5; ++j) {
#pragma unroll
            for (int e = 0; e < 4; ++e) { float v = a[j][e]; v += shx(v, 16, tid & 63); v += shx(v, 32, tid & 63); a[j][e] = v; }
            if ((tid & 63) < 16) red[tid >> 6][j][cl] = a[j]; }
        __syncthreads();
        if (tid < 5 * 64) { const int j = tid / 64, cc = tid % 64; float s = 0.f;
            for (int g = 0; g < 8; ++g) s += ((const LAS float*)&red[g][j][0])[cc];
            mod[((size_t)l * 5 + j) * 6 * D + n0 + cc] = s + p.b_mod[(size_t)l * 6 * D + n0 + cc]; }
        __syncthreads();
    }
}

__device__ __forceinline__ void ph_norm(int wv, int l, int which, const float* fixgate, int row_lo, int nrows, const float* hlat, const float* hctx) {
    CParams& p = *okp();
    unsigned char* const wsb = ows(p.ws);
    const int TIDX = otid(wv), BIDX = obid();
    const int lane = TIDX & 63, gw = BIDX * 8 + (TIDX >> 6), NGW = gridDim.x * 8;
    const float* nw = (which ? p.norm2_w : p.norm1_w) + (size_t)l * D;
    const float* mod = WSP(float, OFF_MOD) + (size_t)l * 5 * 6 * D;
    float* H = WSP(float, OFF_H); bf16_t* XN = WSP(bf16_t, OFF_XN); const float* SL = WSP(float, OFF_SLAB);
    for (int r = row_lo + gw; r < nrows; r += NGW) {
        int mj, t, T; rowinfo(r, mj, t, T);
        const unsigned so = (unsigned)(mj * 6 * D + (which ? 3 : 0) * D) * 4u;
        const unsigned ho = (unsigned)(r * D + 4 * lane) * 4u;
        const float* rd = r < RL ? hlat : hctx; const unsigned ro = (unsigned)((r < RL ? r : r - RL) * D + 4 * lane) * 4u;
        f32x4 v[8]; float ss = 0.f;
#pragma unroll
        for (int j = 0; j < 8; ++j) v[j] = gld<f32x4>(rd, ro + (unsigned)j * 1024u);
        if (fixgate != nullptr && r >= RL) {
#pragma unroll
            for (int j = 0; j < 8; ++j) { f32x4 a = gld<f32x4>(SL, (unsigned)((r - RL) * D + 4 * lane + 256 * j) * 4u);
#pragma unroll
                for (int sl = 1; sl < 8; ++sl) a += gld<f32x4>(SL, (unsigned)((sl * RC + (r - RL)) * D + 4 * lane + 256 * j) * 4u);
                v[j] += gld<f32x4>(fixgate, (unsigned)(4 * lane + 256 * j) * 4u) * a;
                gst<f32x4>(H, ho + (unsigned)j * 1024u, v[j]); }
        }
#pragma unroll
        for (int j = 0; j < 8; ++j) ss += (v[j][0] * v[j][0] + v[j][1] * v[j][1]) + (v[j][2] * v[j][2] + v[j][3] * v[j][3]);
        const float rstd = rsqrtf(wave_sum(ss, lane) * (1.f / D) + EPS);
#pragma unroll
        for (int j = 0; j < 8; ++j) { const unsigned co = (unsigned)(4 * (lane + 64 * j)) * 4u;
            const f32x4 w = gld<f32x4>(nw, co), sc = gld<f32x4>(mod, so + D * 4 + co), sh = gld<f32x4>(mod, so + co);
            const f32x4 y = (v[j] * rstd * w) * (1.f + sc) + sh;
            u32x2 q; q.x = pk2(y[0], y[1]); q.y = pk2(y[2], y[3]); gst<u32x2>(XN, (unsigned)(r * D + 4 * (lane + 64 * j)) * 2u, q); }
    }
}
__device__ __forceinline__ void ph_final(int wv) {
    CParams& p = *okp();
    unsigned char* const wsb = ows(p.ws);
    const int TIDX = otid(wv), BIDX = obid(); (void)TIDX; (void)BIDX;
    const int lane = TIDX & 63, gw = BIDX * 8 + (TIDX >> 6), NGW = gridDim.x * 8;
    const float* H = WSP(float, OFF_H);
    for (int r = gw; r < RL; r += NGW) {
        const f32x4* xr = (const f32x4*)(H + (size_t)r * D) + lane;
        f32x4 v[8]; float ss = 0.f;
#pragma unroll
        for (int j = 0; j < 8; ++j) { v[j] = xr[64 * j]; ss += (v[j][0] * v[j][0] + v[j][1] * v[j][1]) + (v[j][2] * v[j][2] + v[j][3] * v[j][3]); }
        const float rstd = rsqrtf(wave_sum(ss, lane) * (1.f / D) + EPS);
        f32x4* o = (f32x4*)(p.out + (size_t)r * D) + lane;
#pragma unroll
        for (int j = 0; j < 8; ++j) { const f32x4 w = *(const f32x4*)(p.final_norm_w + 4 * (lane + 64 * j)); o[64 * j] = v[j] * rstd * w; }
    }
}

__device__ __forceinline__ float wave_incl_sum(float v, int lane) {
#pragma unroll
    for (int o = 1; o < 64; o <<= 1) { const float t = shl_(v, lane >= o ? lane - o : lane); if (lane >= o) v += t; }
    return v;
}
__device__ __forceinline__ float wave_incl_max(float v, int lane) {
#pragma unroll
    for (int o = 1; o < 64; o <<= 1) { const float t = shl_(v, lane >= o ? lane - o : lane); if (lane >= o) v = fmaxf(v, t); }
    return v;
}
__device__ __forceinline__ float logsigmoidf_(float x) { return fminf(x, 0.f) - log1pf(__expf(-fabsf(x))); }
struct GateV { float b0, b1, c0, c1, m0, m1, bend, cend; int s0, s1; };
__device__ __forceinline__ GateV gate_vectors(const float* G, int row0, int h, int dir, int lane) {
    GateV g; g.s0 = dir ? 127 - lane : lane; g.s1 = dir ? 63 - lane : lane + 64;
    const unsigned o0 = (unsigned)((row0 + g.s0) * 16 + dir * 8 + h) * 4u, o1 = (unsigned)((row0 + g.s1) * 16 + dir * 8 + h) * 4u;
    const float i0 = gld<float>(G, o0), f0 = gld<float>(G, o0 + 16), i1 = gld<float>(G, o1), f1 = gld<float>(G, o1 + 16);
    g.b0 = wave_incl_sum(logsigmoidf_(f0), lane); const float tot0 = shl_(g.b0, 63 + (lane & 0));
    g.b1 = wave_incl_sum(logsigmoidf_(f1), lane) + tot0;
    g.c0 = i0 - g.b0; g.c1 = i1 - g.b1;
    g.m0 = wave_incl_max(g.c0, lane); const float mx0 = shl_(g.m0, 63 + (lane & 0));
    g.m1 = fmaxf(wave_incl_max(g.c1, lane), mx0);
    g.bend = shl_(g.b1, 63 + (lane & 0)); g.cend = shl_(g.m1, 63 + (lane & 0));
    return g;
}
__device__ __forceinline__ void ph_convc(int wv, int l, int nrows, int widx, int nwg) {
    CParams& p = *okp();
    unsigned char* const wsb = ows(p.ws);
    const unsigned gt = (unsigned)widx * 512u + otid(wv), NT = (unsigned)nwg * 512u;
    const bf16_t* P = WSP(bf16_t, OFF_P); bf16_t* YC = WSP(bf16_t, OFF_HM) + (DM + DF);
    const float* wc = p.conv_c_w + (size_t)l * 3 * DC;
    for (unsigned i = gt; i < (unsigned)nrows * 64u; i += NT) {
        const int r = (int)(i >> 6), c = (int)(i & 63) * 8; int mj, t, T; rowinfo(r, mj, t, T);
        const unsigned pr = (unsigned)(r * NP) * 2u;
        const bool cp = r < RL ? (t & 63) > 0 : t > 0, cn = r < RL ? (t & 63) < 63 : t < T - 1;
        float x0[8], x1[8], y0[8], y1[8], z0[8], z1[8], cb[8], o[8];
        unpack8(gld<u32x4>(P, pr + (PCC + c) * 2), x0); unpack8(gld<u32x4>(P, pr + (PCX + c) * 2), x1); unpack8(gld<u32x4>(P, pr + (PCB + c) * 2), cb);
        const unsigned pp = cp ? pr - NP * 2 : pr, pn = cn ? pr + NP * 2 : pr;
        unpack8(gld<u32x4>(P, pp + (PCC + c) * 2), y0); unpack8(gld<u32x4>(P, pp + (PCX + c) * 2), y1);
        unpack8(gld<u32x4>(P, pn + (PCC + c) * 2), z0); unpack8(gld<u32x4>(P, pn + (PCX + c) * 2), z1);
        const f32x4 w00 = gld<f32x4>(wc, (unsigned)c * 4u), w01 = gld<f32x4>(wc, (unsigned)c * 4u + 16), w10 = gld<f32x4>(wc, (unsigned)(DC + c) * 4u), w11 = gld<f32x4>(wc, (unsigned)(DC + c) * 4u + 16),
                    w20 = gld<f32x4>(wc, (unsigned)(2 * DC + c) * 4u), w21 = gld<f32x4>(wc, (unsigned)(2 * DC + c) * 4u + 16);
#pragma unroll
        for (int j = 0; j < 8; ++j) { const float w0 = j < 4 ? w00[j & 3] : w01[j & 3], w1 = j < 4 ? w10[j & 3] : w11[j & 3], w2 = j < 4 ? w20[j & 3] : w21[j & 3];
            float v = w1 * (x0[j] * x1[j]); if (cp) v += w0 * (y0[j] * y1[j]); if (cn) v += w2 * (z0[j] * z1[j]); o[j] = cb[j] * v; }
        gst<u32x4>(YC, (unsigned)(r * D + c) * 2u, pack8(o));
    }
}
__device__ __forceinline__ void ph_fourier1(int wv, int widx, int nwg) {
    CParams& p = *okp();
    unsigned char* const wsb = ows(p.ws);
    const int TIDX = otid(wv), BIDX = obid(); (void)TIDX; (void)BIDX;
    const int lane = TIDX & 63, gw = widx * 8 + (TIDX >> 6), NGW = nwg * 8, fr = lane & 15, fq = lane >> 4;
    const bf16_t* P = WSP(bf16_t, OFF_P); const bf16_t* FT = WSP(bf16_t, OFF_FT);
    bf16_t* ZTC = WSP(bf16_t, OFF_ZTC);
    for (int task = gw; task < (RC / 32) * 4 * 8; task += NGW) {
        const int kb = task & 7, g = (task >> 3) & 3, rb = task >> 5, r0 = RL + rb * 32;
        f32x4 acc[2][2]; ZERO_ACC22(acc);
        wave_mm32<true, true>(P + (size_t)r0 * NP + PF + g * 128, NP, 1, FT + (size_t)(kb * 32) * 128, 1, 128, 128, acc, lane);
#pragma unroll
        for (int mi = 0; mi < 2; ++mi)
#pragma unroll
            for (int ni = 0; ni < 2; ++ni) {
                const int r = r0 + 16 * mi + 4 * fq, kp = kb * 32 + 16 * ni + fr, comp = kp >> 7, kap = kp & 127;
                u32x2 w; w.x = pk2(acc[mi][ni][0], acc[mi][ni][1]); w.y = pk2(acc[mi][ni][2], acc[mi][ni][3]);
                { const int q = r - RL, b = q >> 8, t = q & 255; *(u32x2*)(ZTC + (size_t)((b * 4 + g) * 128 + kap) * 512 + comp * 256 + t) = w; }
            }
    }
}
template <bool FIRST> __device__ __forceinline__ f32x4 mma16(bf16x8 a, bf16x8 b, f32x4 c) {
    if constexpr (FIRST) return __builtin_amdgcn_mfma_f32_16x16x32_bf16(a, b, (f32x4){0.f, 0.f, 0.f, 0.f}, 0, 0, 0);
    else return __builtin_amdgcn_mfma_f32_16x16x32_bf16(a, b, c, 0, 0, 0);
}
typedef short s16x4 __attribute__((ext_vector_type(4)));
constexpr int PIT_T = 544;
constexpr int PIT_R = 528;
constexpr int PIT_P = 272;
__device__ __forceinline__ bf16x8 tr_frag(LAS unsigned char* img, int pitchB, int r0, int c0, int lane) {
    const int g = lane >> 4, q = (lane & 15) >> 2, pp = lane & 3;
    LAS unsigned char* a = img + (r0 + 8 * g + q) * pitchB + (c0 + 4 * pp) * 2;
    const s16x4 lo = __builtin_amdgcn_ds_read_tr16_b64_v4i16((LAS s16x4*)a);
    const s16x4 hi = __builtin_amdgcn_ds_read_tr16_b64_v4i16((LAS s16x4*)(a + 4 * pitchB));
    return (bf16x8){lo[0], lo[1], lo[2], lo[3], hi[0], hi[1], hi[2], hi[3]};
}
template <class F> __device__ __forceinline__ void conv_silu_rows(const u32x4 (&raw)[10], const float (&w0)[8], const float (&w1)[8], const float (&w2)[8], F&& f) {
    float a[8], b[8], c[8];
    unpack8(raw[0], a); unpack8(raw[1], b);
#pragma unroll
    for (int i = 0; i < 8; ++i) {
        unpack8(raw[i + 2], c);
        float o[8];
#pragma unroll
        for (int j = 0; j < 8; ++j) o[j] = siluf_(w0[j] * a[j] + w1[j] * b[j] + w2[j] * c[j]);
        f(i, o);
#pragma unroll
        for (int j = 0; j < 8; ++j) { a[j] = b[j]; b[j] = c[j]; }
    }
}
constexpr int FPIT = 2336;
__device__ __forceinline__ void ph_fft(int wv, LAS unsigned char* lds, int u0, int ustride) {
    CParams& p = *okp();
    unsigned char* const wsb = ows(p.ws);
    const bf16_t* P = WSP(bf16_t, OFF_P); const bf16_t* FT = WSP(bf16_t, OFF_FT); const bf16_t* MA = WSP(bf16_t, OFF_MA); const bf16_t* MC = WSP(bf16_t, OFF_MC); bf16_t* HM = WSP(bf16_t, OFF_HM);
    LAS unsigned char* IMG = lds;
    const int wave = wv;
    for (int unit = u0; unit < NB * 4 * 8; unit += ustride) {
        const int kb = unit & 7, g = (unit >> 3) & 3, b = unit >> 5, kap0 = 16 * kb;
        {
            const int tid = otid(wv), lane = tid & 63, fr = lane & 15, fq = lane >> 4;
            bf16x8 fb[2][4];
#pragma unroll
            for (int ni = 0; ni < 2; ++ni)
#pragma unroll
                for (int ks = 0; ks < 4; ++ks) fb[ni][ks] = gld<bf16x8>(FT, (unsigned)((ni * 128 + kap0 + fr) * 128 + 32 * ks + 8 * fq) * 2u);
#pragma unroll 1
            for (int mi8 = 0; mi8 < 2; ++mi8) {
                bf16x8 xa[8][4];
#pragma unroll
                for (int m = 0; m < 8; ++m)
#pragma unroll
                    for (int ks = 0; ks < 4; ++ks) xa[m][ks] = gld<bf16x8>(P, (unsigned)((b * 2048 + 256 * wave + 16 * (8 * mi8 + m) + fr) * NP + PF + g * 128 + 32 * ks + 8 * fq) * 2u);
#pragma unroll
                for (int m = 0; m < 8; ++m) {
                    f32x4 zr = mma16<true>(xa[m][0], fb[0][0], zr), zi = mma16<true>(xa[m][0], fb[1][0], zi);
#pragma unroll
                    for (int ks = 1; ks < 4; ++ks) { zr = mma16<false>(xa[m][ks], fb[0][ks], zr); zi = mma16<false>(xa[m][ks], fb[1][ks], zi); }
                    const int tb = 256 * wave + 16 * (8 * mi8 + m) + 4 * fq, t1 = tb >> 6, t2 = tb & 63;
                    u32x2 wr_, wi_; wr_.x = pk2(zr[0], zr[1]); wr_.y = pk2(zr[2], zr[3]); wi_.x = pk2(-zi[0], -zi[1]); wi_.y = pk2(-zi[2], -zi[3]);
                    *(LAS u32x2*)(IMG + t1 * FPIT + fr * 144 + t2 * 2) = wr_;
                    *(LAS u32x2*)(IMG + (32 + t1) * FPIT + fr * 144 + t2 * 2) = wi_;
                }
            }
        }
        __syncthreads();
        {
            const int tid = otid(wv), lane = tid & 63, fr = lane & 15, fq = lane >> 4;
            bf16x8 ya[4][2];
#pragma unroll
            for (int mt = 0; mt < 4; ++mt)
#pragma unroll
                for (int ks = 0; ks < 2; ++ks) ya[mt][ks] = gld<bf16x8>(MA, (unsigned)((16 * mt + fr) * 64 + 32 * ks + 8 * fq) * 2u);
#pragma unroll 2
            for (int j = 0; j < 8; ++j) {
                const int grp = 8 * wave + j, c0 = (grp >> 2) * 72 + (grp & 3) * 16;
                const bf16x8 x0 = tr_frag(IMG, FPIT, 0, c0, lane), x1 = tr_frag(IMG, FPIT, 32, c0, lane);
                f32x4 d[4];
#pragma unroll
                for (int mt = 0; mt < 4; ++mt) { d[mt] = mma16<true>(x0, ya[mt][0], d[mt]); d[mt] = mma16<false>(x1, ya[mt][1], d[mt]); }
#pragma unroll
                for (int mt = 0; mt < 4; ++mt) { u32x2 w; w.x = pk2(d[mt][0], d[mt][1]); w.y = pk2(d[mt][2], d[mt][3]);
                    *(LAS u32x2*)(IMG + (16 * mt + fr) * FPIT + (c0 + 4 * fq) * 2) = w; }
            }
        }
        __syncthreads();
        {
            const int tid = otid(wv), lane = tid & 63, fr = lane & 15, fq = lane >> 4;
            bf16x8 y[4][4];
#pragma unroll
            for (int mt = 0; mt < 4; ++mt)
#pragma unroll
                for (int ks = 0; ks < 4; ++ks) y[mt][ks] = gld<bf16x8>(MC, (unsigned)((4 * wave * 64 + 16 * mt + fr) * 128 + 32 * ks + 8 * fq) * 2u);
#pragma unroll 1
            for (int q = 0; q < 4; ++q) {
                const int tau1 = 4 * wave + q, tn = q < 3 ? tau1 + 1 : tau1;
                bf16x8 yn[4][4];
#pragma unroll
                for (int mt = 0; mt < 4; ++mt)
#pragma unroll
                    for (int ks = 0; ks < 4; ++ks) yn[mt][ks] = gld<bf16x8>(MC, (unsigned)((tn * 64 + 16 * mt + fr) * 128 + 32 * ks + 8 * fq) * 2u);
                f32x4 acc[4];
#pragma unroll
                for (int ks = 0; ks < 4; ++ks) { const bf16x8 x = *(const LAS bf16x8*)(IMG + ((ks >> 1) * 32 + tau1) * FPIT + fr * 144 + (32 * (ks & 1) + 8 * fq) * 2);
#pragma unroll
                    for (int mt = 0; mt < 4; ++mt) { if (ks == 0) acc[mt] = mma16<true>(x, y[mt][ks], acc[mt]); else acc[mt] = mma16<false>(x, y[mt][ks], acc[mt]); } }
#pragma unroll
                for (int mt = 0; mt < 4; ++mt) { const int tau = tau1 + 32 * (16 * mt + fr);
                    u32x2 w; w.x = pk2(acc[mt][0], acc[mt][1]); w.y = pk2(acc[mt][2], acc[mt][3]);
                    gst<u32x2>(HM, (unsigned)((b * 2048 + tau) * D + DM + g * 128 + kap0 + 4 * fq) * 2u, w); }
#pragma unroll
                for (int mt = 0; mt < 4; ++mt)
#pragma unroll
                    for (int ks = 0; ks < 4; ++ks) y[mt][ks] = yn[mt][ks];
            }
        }
        __syncthreads();
    }
}
__device__ __forceinline__ void ph_mlstm1(int wv, int l, LAS unsigned char* lds) {
    CParams& p = *okp();
    unsigned char* const wsb = ows(p.ws);
    const int wave = wv;
    LAS unsigned char* KWs = lds; LAS unsigned char* Vs = lds + 128 * PIT_T; LAS float* vW = (LAS float*)(lds + 2 * 128 * PIT_T);
    const bf16_t* P = WSP(bf16_t, OFF_P); const float* G = WSP(float, OFF_G);
    bf16_t* UT = WSP(bf16_t, OFF_UT); float* NV = WSP(float, OFF_NV); float* CHS = WSP(float, OFF_CHS);
    const float* wk = p.conv_k_w + (size_t)l * 3 * DM;
    for (int unit = obid(); unit < NCHUNK * NH * 2; unit += gridDim.x) {
        const int tid = otid(wv), lane = tid & 63, fr = lane & 15, fq = lane >> 4, dg = tid & 31, sg = tid >> 5;
        const int dir = unit & 1, h = (unit >> 1) & 3, cidx = unit >> 3, row0 = chunk_row0(cidx);
        const bool first = cidx < 64 ? (cidx & 15) == 0 : ((cidx - 64) & 1) == 0, last = cidx < 64 ? (cidx & 15) == 15 : ((cidx - 64) & 1) == 1;
        const bf16_t* kp = P + (size_t)(row0 + 8 * sg) * NP + PK + h * DH + 8 * dg;
        u32x4 kr[10], vr[8];
#pragma unroll
        for (int i = 0; i < 10; ++i) { const int s = 8 * sg - 1 + i; const bool ok = (s >= 0 || !first) && (s < CHUNK || !last);
            kr[i] = ok ? *(const u32x4*)(kp + (ptrdiff_t)(i - 1) * NP) : (u32x4){0u, 0u, 0u, 0u}; }
#pragma unroll
        for (int i = 0; i < 8; ++i) vr[i] = *(const u32x4*)(kp + (PV - PK) + (size_t)i * NP);
        float w0[8], w1[8], w2[8];
#pragma unroll
        for (int j = 0; j < 8; ++j) { w0[j] = wk[h * DH + 8 * dg + j]; w1[j] = wk[DM + h * DH + 8 * dg + j]; w2[j] = wk[2 * DM + h * DH + 8 * dg + j]; }
        if (wave == 0)     { const GateV g = gate_vectors(G, row0, h, dir, lane); vW[g.s0] = __expf(g.c0 - g.cend); vW[g.s1] = __expf(g.c1 - g.cend);
            if (lane == 0) { CHS[(size_t)(cidx * 8 + dir * 4 + h) * 2] = g.bend; CHS[(size_t)(cidx * 8 + dir * 4 + h) * 2 + 1] = g.bend + g.cend; } }
        __syncthreads();
        conv_silu_rows(kr, w0, w1, w2, [&](int i, float (&o)[8]) { const float ws = vW[8 * sg + i];
#pragma unroll
            for (int j = 0; j < 8; ++j) o[j] *= ws;
            *(LAS u32x4*)(KWs + (8 * sg + i) * PIT_T + dg * 16) = pack8(o); });
#pragma unroll
        for (int i = 0; i < 8; ++i) *(LAS u32x4*)(Vs + (8 * sg + i) * PIT_T + dg * 16) = vr[i];
        __syncthreads();
        f32x4 acc[2][16];
        auto kstep1 = [&](int k0, auto first) {
            bf16x8 fv[2];
#pragma unroll
            for (int mi = 0; mi < 2; ++mi) fv[mi] = tr_frag(Vs, PIT_T, k0, 32 * wave + 16 * mi, lane);
#pragma unroll
            for (int ni = 0; ni < 16; ++ni) { const bf16x8 fk = tr_frag(KWs, PIT_T, k0, 16 * ni, lane);
#pragma unroll
                for (int mi = 0; mi < 2; ++mi) acc[mi][ni] = mma16<decltype(first)::value>(fk, fv[mi], acc[mi][ni]); }
        };
        kstep1(0, std::true_type{});
#pragma unroll 1
        for (int k0 = 32; k0 < CHUNK; k0 += 32) kstep1(k0, std::false_type{});
        bf16_t* out = UT + ((size_t)(cidx * NH + h) * 2 + dir) * DH * DH;
#pragma unroll
        for (int mi = 0; mi < 2; ++mi)
#pragma unroll
            for (int ni = 0; ni < 16; ++ni) { u32x2 w; w.x = pk2(acc[mi][ni][0], acc[mi][ni][1]); w.y = pk2(acc[mi][ni][2], acc[mi][ni][3]);
                *(u32x2*)(out + (size_t)(32 * wave + 16 * mi + fr) * DH + 16 * ni + 4 * fq) = w; }
        if (tid < DH) { float sum = 0.f;
#pragma unroll 8
            for (int s2 = 0; s2 < CHUNK; ++s2) sum += bf2f(*(const LAS bf16_t*)(KWs + s2 * PIT_T + tid * 2));
            NV[((size_t)(cidx * NH + h) * 2 + dir) * DH + tid] = sum; }
        __syncthreads();
    }
}
__device__ __forceinline__ void ph_mlstm2(int wv) {
    CParams& p = *okp();
    unsigned char* const wsb = ows(p.ws);
    const int tid = otid(wv);
    const bf16_t* UT = WSP(bf16_t, OFF_UT); bf16_t* CT = WSP(bf16_t, OFF_CT);
    const float *NV = WSP(float, OFF_NV), *CHS = WSP(float, OFF_CHS); float *NS = WSP(float, OFF_NS), *MST = WSP(float, OFF_MST);
    for (int task = obid(); task < NB * NH * 2 * 16; task += gridDim.x) {
        const int part = task & 15, scan = task >> 4, dir = scan & 1, h = (scan >> 1) & 3, b = scan >> 3, dh = dir * 4 + h;
        const unsigned e0 = (unsigned)(part * 4096 + olaunder(tid) * 8) * 2u;
        u32x4 u[18];
#pragma unroll
        for (int step = 0; step < 18; ++step) { const int cidx = scan_chunk(b, dir, step); u[step] = gld<u32x4>(UT, (unsigned)(((cidx * NH + h) * 2 + dir) * DH * DH) * 2u + e0); }
        float C[8], m = 0.f;
        { const f32x4 z0 = zero4(), z1 = zero4();
#pragma unroll
          for (int j = 0; j < 4; ++j) { C[j] = z0[j]; C[4 + j] = z1[j]; } }
#pragma unroll
        for (int step = 0; step < 18; ++step) {
            const int cidx = scan_chunk(b, dir, step);
            gst<u32x4>(CT, (unsigned)(((cidx * NH + h) * 2 + dir) * DH * DH) * 2u + e0, pack8(C));
            const float bend = CHS[(cidx * 8 + dh) * 2], mloc = CHS[(cidx * 8 + dh) * 2 + 1];
            const float mn = fmaxf(bend + m, mloc), al = __expf(bend + m - mn), be = __expf(mloc - mn);
            float uu[8]; unpack8(u[step], uu);
#pragma unroll
            for (int j = 0; j < 8; ++j) C[j] = al * C[j] + be * uu[j];
            m = mn;
        }
        if (part == 0 && tid < DH) {
            float n = 0.f; m = 0.f;
            for (int step = 0; step < 18; ++step) {
                const int cidx = scan_chunk(b, dir, step); const unsigned base = (unsigned)(((cidx * NH + h) * 2 + dir) * DH + tid) * 4u;
                gst<float>(NS, base, n); if (tid == 0) MST[cidx * 8 + dh] = m;
                const float bend = CHS[(cidx * 8 + dh) * 2], mloc = CHS[(cidx * 8 + dh) * 2 + 1];
                const float mn = fmaxf(bend + m, mloc), al = __expf(bend + m - mn), be = __expf(mloc - mn);
                n = al * n + be * gld<float>(NV, base); m = mn;
            }
        }
    }
}
#define SECTION_LANES() const int tid = otid(wv), lane = tid & 63, fr = lane & 15, fq = lane >> 4; (void)fr; (void)fq; __builtin_amdgcn_sched_barrier(0)
__device__ __forceinline__ void ph_mlstm3(int wv, int l, LAS unsigned char* lds, int nunits) {
    CParams& p = *okp();
    unsigned char* const wsb = ows(p.ws);
    const int wave = wv;
    LAS unsigned char* Qs = lds;
    LAS unsigned char* Ks = lds + 128 * PIT_T;
    LAS unsigned char* Vs = Qs; LAS unsigned char* Ps = Ks;
    LAS float* vec = (LAS float*)(lds + 2 * 128 * PIT_T);
    LAS float *vB = vec, *vC = vec + 256, *vM = vec + 512, *nS = vec + 768, *rS = vec + 1280, *ssq = vec + 1536;
    const bf16_t* P = WSP(bf16_t, OFF_P); const float* G = WSP(float, OFF_G); const bf16_t* CT = WSP(bf16_t, OFF_CT);
    const float *NS = WSP(float, OFF_NS), *MST = WSP(float, OFF_MST); bf16_t* HM = WSP(bf16_t, OFF_HM);
    const float *wk = p.conv_k_w + (size_t)l * 3 * DM, *wq = p.conv_q_w + (size_t)l * 3 * DM, *nw = p.mlstm_norm_w + (size_t)l * DM;
    for (int unit = obid(); unit < nunits; unit += gridDim.x) {
        const int h = unit & 3, cidx = unit >> 2, row0 = chunk_row0(cidx);
        const bool first = cidx < 64 ? (cidx & 15) == 0 : ((cidx - 64) & 1) == 0, last = cidx < 64 ? (cidx & 15) == 15 : ((cidx - 64) & 1) == 1;
        {
            SECTION_LANES(); const int dg = tid & 31, sg = tid >> 5;
            nS[tid] = gld<float>(NS, (unsigned)((cidx * NH + h) * 2 * DH + tid) * 4u);
            const unsigned kp = (unsigned)((row0 + 8 * sg - 1) * NP + PK + h * DH + 8 * dg) * 2u;
            u32x4 raw[10], rawq[10]; float w0[8], w1[8], w2[8];
#pragma unroll
            for (int i = 0; i < 10; ++i) { const int s = 8 * sg - 1 + i; const bool ok = (s >= 0 || !first) && (s < CHUNK || !last);
                raw[i] = gld<u32x4>(P, ok ? kp + (unsigned)i * (NP * 2) : kp + (unsigned)(NP * 2)); if (!ok) raw[i] = (u32x4){0u, 0u, 0u, 0u}; }
#pragma unroll
            for (int i = 0; i < 10; ++i) { const int s = 8 * sg - 1 + i; const bool ok = (s >= 0 || !first) && (s < CHUNK || !last);
                rawq[i] = gld<u32x4>(P, (ok ? kp + (unsigned)i * (NP * 2) : kp + (unsigned)(NP * 2)) + (PQ - PK) * 2); if (!ok) rawq[i] = (u32x4){0u, 0u, 0u, 0u}; }
            { const unsigned wo = (unsigned)(h * DH + 8 * dg) * 4u;
              const f32x4 a0 = gld<f32x4>(wk, wo), a1 = gld<f32x4>(wk, wo + 16), b0 = gld<f32x4>(wk, wo + DM * 4), b1 = gld<f32x4>(wk, wo + DM * 4 + 16), c0 = gld<f32x4>(wk, wo + 2 * DM * 4), c1 = gld<f32x4>(wk, wo + 2 * DM * 4 + 16);
#pragma unroll
              for (int j = 0; j < 4; ++j) { w0[j] = a0[j]; w0[4 + j] = a1[j]; w1[j] = b0[j]; w1[4 + j] = b1[j]; w2[j] = c0[j]; w2[4 + j] = c1[j]; } }
            if (wave < 2) { const GateV g = gate_vectors(G, row0, h, wave, lane);
                vB[wave * 128 + g.s0] = g.b0; vB[wave * 128 + g.s1] = g.b1; vC[wave * 128 + g.s0] = g.c0; vC[wave * 128 + g.s1] = g.c1; vM[wave * 128 + g.s0] = g.m0; vM[wave * 128 + g.s1] = g.m1; }
            conv_silu_rows(raw, w0, w1, w2, [&](int i, float (&o)[8]) { *(LAS u32x4*)(Ks + (8 * sg + i) * PIT_R + dg * 16) = pack8(o); });
            { const unsigned wo = (unsigned)(h * DH + 8 * dg) * 4u;
              const f32x4 a0 = gld<f32x4>(wq, wo), a1 = gld<f32x4>(wq, wo + 16), b0 = gld<f32x4>(wq, wo + DM * 4), b1 = gld<f32x4>(wq, wo + DM * 4 + 16), c0 = gld<f32x4>(wq, wo + 2 * DM * 4), c1 = gld<f32x4>(wq, wo + 2 * DM * 4 + 16);
#pragma unroll
              for (int j = 0; j < 4; ++j) { w0[j] = a0[j]; w0[4 + j] = a1[j]; w1[j] = b0[j]; w1[4 + j] = b1[j]; w2[j] = c0[j]; w2[4 + j] = c1[j]; } }
            conv_silu_rows(rawq, w0, w1, w2, [&](int i, float (&o)[8]) {
#pragma unroll
                for (int j = 0; j < 8; ++j) o[j] *= 0.0625f;
                *(LAS u32x4*)(Qs + (8 * sg + i) * PIT_R + dg * 16) = pack8(o); });
        }
        __syncthreads();
        {
            SECTION_LANES();
            f32x4 sacc[8];
            auto kstepS = [&](int k0, auto first) {
                const bf16x8 yq = *(const LAS bf16x8*)(Qs + (16 * wave + fr) * PIT_R + (k0 + 8 * fq) * 2);
#pragma unroll
                for (int ni = 0; ni < 8; ++ni) { const bf16x8 xk = *(const LAS bf16x8*)(Ks + (16 * ni + fr) * PIT_R + (k0 + 8 * fq) * 2);
                    sacc[ni] = mma16<decltype(first)::value>(xk, yq, sacc[ni]); }
            };
            kstepS(0, std::true_type{});
#pragma unroll 1
            for (int k0 = 32; k0 < DH; k0 += 32) kstepS(k0, std::false_type{});
            const int t = 16 * wave + fr;
            const float mF = gld<float>(MST, (unsigned)(cidx * 8 + h) * 4u), mB = gld<float>(MST, (unsigned)(cidx * 8 + 4 + h) * 4u);
            const float MF = fmaxf(mF, vM[t]), MB = fmaxf(mB, vM[128 + t]);
            const float gF = __expf(mF - MF), gB = __expf(mB - MB);
            const float flF = __expf(-(vB[t] + MF)), flB = __expf(-(vB[128 + t] + MB));
            float qnF = 0.f, qnB = 0.f;
#pragma unroll
            for (int c8 = 0; c8 < 8; ++c8) { float q8[8]; unpack8(*(const LAS u32x4*)(Qs + t * PIT_R + (64 * fq + 8 * c8) * 2), q8);
                const f32x4 a0 = *(const LAS f32x4*)(nS + 64 * fq + 8 * c8), a1 = *(const LAS f32x4*)(nS + 64 * fq + 8 * c8 + 4);
                const f32x4 b0 = *(const LAS f32x4*)(nS + 256 + 64 * fq + 8 * c8), b1 = *(const LAS f32x4*)(nS + 256 + 64 * fq + 8 * c8 + 4);
#pragma unroll
                for (int j = 0; j < 4; ++j) { qnF += q8[j] * a0[j] + q8[4 + j] * a1[j]; qnB += q8[j] * b0[j] + q8[4 + j] * b1[j]; } }
            qnF += shx(qnF, 16, lane); qnF += shx(qnF, 32, lane); qnB += shx(qnB, 16, lane); qnB += shx(qnB, 32, lane);
            float sF = 0.f, sB = 0.f;
#pragma unroll
            for (int ni = 0; ni < 8; ++ni) { const f32x4 cF = *(const LAS f32x4*)(vC + 16 * ni + 4 * fq), cB = *(const LAS f32x4*)(vC + 128 + 16 * ni + 4 * fq);
#pragma unroll
                for (int rg = 0; rg < 4; ++rg) { const int s = 16 * ni + 4 * fq + rg;
                    sF += s <= t ? sacc[ni][rg] * __expf(cF[rg] - MF) : 0.f; sB += s >= t ? sacc[ni][rg] * __expf(cB[rg] - MB) : 0.f; }
                asm volatile("" : "+v"(sF), "+v"(sB)); }
            sF += shx(sF, 16, lane); sF += shx(sF, 32, lane); sB += shx(sB, 16, lane); sB += shx(sB, 32, lane);
            const float iF = 1.f / fmaxf(fabsf(gF * qnF + sF), flF), iB = 1.f / fmaxf(fabsf(gB * qnB + sB), flB);
            __syncthreads();
#pragma unroll
            for (int ni = 0; ni < 8; ++ni) { const f32x4 cF = *(const LAS f32x4*)(vC + 16 * ni + 4 * fq), cB = *(const LAS f32x4*)(vC + 128 + 16 * ni + 4 * fq);
                float pc[4];
#pragma unroll
                for (int rg = 0; rg < 4; ++rg) { const int s = 16 * ni + 4 * fq + rg;
                    pc[rg] = (s <= t ? sacc[ni][rg] * __expf(cF[rg] - MF) * iF : 0.f) + (s >= t ? sacc[ni][rg] * __expf(cB[rg] - MB) * iB : 0.f); }
                u32x2 w; w.x = pk2(pc[0], pc[1]); w.y = pk2(pc[2], pc[3]);
                *(LAS u32x2*)(Ps + t * PIT_P + (16 * ni + 4 * fq) * 2) = w; }
            if (fq == 0) { rS[t] = gF * iF; rS[128 + t] = gB * iB; }
        }
        __syncthreads();
        f32x4 tot[2][8];
        u32x4 vr[8];
        {
            SECTION_LANES();
#pragma unroll
            for (int ni = 0; ni < 2; ++ni) {
                if (ni == 1) { const int s8 = lane & 15, vq = lane >> 4; const unsigned vp = (unsigned)((row0 + 8 * s8) * NP + PV + h * DH + 32 * wave + 8 * vq) * 2u;
#pragma unroll
                    for (int i = 0; i < 8; ++i) vr[i] = gld<u32x4>(P, vp + (unsigned)i * (NP * 2)); }
                f32x4 a1[8];
                const unsigned ctf = (unsigned)((cidx * NH + h) * 2 * DH * DH + (32 * wave + 16 * ni + fr) * DH + 8 * fq) * 2u;
                bf16x8 xf = gld<bf16x8>(CT, ctf), xb = gld<bf16x8>(CT, ctf + (unsigned)(DH * DH) * 2u);
                auto kstepQ = [&](int k0, auto first) {
                    const unsigned kn = (unsigned)(k0 + 32 < DH ? k0 + 32 : k0);
                    const bf16x8 xfn = gld<bf16x8>(CT, ctf + kn * 2u), xbn = gld<bf16x8>(CT, ctf + (unsigned)(DH * DH) * 2u + kn * 2u);
#pragma unroll
                    for (int mi = 0; mi < 8; ++mi) { const bf16x8 yq = *(const LAS bf16x8*)(Qs + (16 * mi + fr) * PIT_R + (k0 + 8 * fq) * 2);
                        tot[ni][mi] = mma16<decltype(first)::value>(xf, yq, tot[ni][mi]);
                        a1[mi] = mma16<decltype(first)::value>(xb, yq, a1[mi]); }
                    xf = xfn; xb = xbn;
                };
                kstepQ(0, std::true_type{});
#pragma unroll 1
                for (int k0 = 32; k0 < DH; k0 += 32) kstepQ(k0, std::false_type{});
#pragma unroll
                for (int mi = 0; mi < 8; ++mi) { const float rf = rS[16 * mi + fr], rb = rS[128 + 16 * mi + fr]; tot[ni][mi] = rf * tot[ni][mi] + rb * a1[mi]; }
            }
        }
        __syncthreads();
        {
            SECTION_LANES();
            { const int s8 = lane & 15, vq = lane >> 4;
#pragma unroll
              for (int i = 0; i < 8; ++i) *(LAS u32x4*)(Vs + (8 * s8 + i) * PIT_T + (32 * wave + 8 * vq) * 2) = vr[i]; }
            asm volatile("s_waitcnt lgkmcnt(0)" ::: "memory");
#pragma unroll 1
            for (int k0 = 0; k0 < CHUNK; k0 += 32) {
                bf16x8 xv[2];
#pragma unroll
                for (int ni = 0; ni < 2; ++ni) xv[ni] = tr_frag(Vs, PIT_T, k0, 32 * wave + 16 * ni, lane);
#pragma unroll
                for (int mi = 0; mi < 8; ++mi) { const bf16x8 yp = *(const LAS bf16x8*)(Ps + (16 * mi + fr) * PIT_P + (k0 + 8 * fq) * 2);
#pragma unroll
                    for (int ni = 0; ni < 2; ++ni) tot[ni][mi] = __builtin_amdgcn_mfma_f32_16x16x32_bf16(xv[ni], yp, tot[ni][mi], 0, 0, 0); }
            }
        }
        {
            SECTION_LANES();
#pragma unroll
            for (int mi = 0; mi < 8; ++mi) { float ss = 0.f;
#pragma unroll
                for (int ni = 0; ni < 2; ++ni) ss += (tot[ni][mi][0] * tot[ni][mi][0] + tot[ni][mi][1] * tot[ni][mi][1]) + (tot[ni][mi][2] * tot[ni][mi][2] + tot[ni][mi][3] * tot[ni][mi][3]);
                ss += shx(ss, 16, lane); ss += shx(ss, 32, lane);
                if (fq == 0) ssq[wave * 128 + 16 * mi + fr] = ss; }
            __syncthreads();
#pragma unroll
            for (int mi = 0; mi < 8; ++mi) { const int tt = 16 * mi + fr; float ss = 0.f;
#pragma unroll
                for (int w8 = 0; w8 < 8; ++w8) ss += ssq[w8 * 128 + tt];
                const float rstd = rsqrtf(ss * (1.f / DH) + EPS);
#pragma unroll
                for (int ni = 0; ni < 2; ++ni) { const int vd = 32 * wave + 16 * ni + 4 * fq;
                    const u32x2 ow = gld<u32x2>(P, (unsigned)((row0 + tt) * NP + PO + h * DH + vd) * 2u); const f32x4 w4 = gld<f32x4>(nw, (unsigned)(h * DH + vd) * 4u);
                    const float o0 = __uint_as_float(ow.x << 16), o1 = __uint_as_float(ow.x & 0xffff0000u), o2 = __uint_as_float(ow.y << 16), o3 = __uint_as_float(ow.y & 0xffff0000u);
                    u32x2 q; q.x = pk2(sigmoidf_(o0) * (tot[ni][mi][0] * rstd * w4[0]), sigmoidf_(o1) * (tot[ni][mi][1] * rstd * w4[1]));
                    q.y = pk2(sigmoidf_(o2) * (tot[ni][mi][2] * rstd * w4[2]), sigmoidf_(o3) * (tot[ni][mi][3] * rstd * w4[3]));
                    gst<u32x2>(HM, (unsigned)((row0 + tt) * D + h * DH + vd) * 2u, q); }
                __builtin_amdgcn_sched_barrier(0); }
        }
        __syncthreads();
    }
}
__device__ __forceinline__ void ph_ffnact(int wv, int l) {
    CParams& p = *okp();
    unsigned char* const wsb = ows(p.ws);
    const int TIDX = otid(wv), BIDX = obid();
    const unsigned gt = (unsigned)BIDX * 512u + TIDX, NT = gridDim.x * 512u;
    const bf16_t* U = WSP(bf16_t, OFF_P); bf16_t* ACT = WSP(bf16_t, OFF_ACT); const float* SL = WSP(float, OFF_SLAB);
    const float* wf = p.conv_ff_w + (size_t)l * 3 * DFF;
    auto ldu = [&](int r, int col, float (&o)[8]) {
        if (col >= 32 * 256) { f32x4 g0 = {0.f, 0.f, 0.f, 0.f}, g1 = {0.f, 0.f, 0.f, 0.f};
#pragma unroll
            for (int sl = 0; sl < 4; ++sl) { const unsigned o4 = (unsigned)((sl * RC + (r - RL)) * NUP + col) * 4u; g0 += gld<f32x4>(SL, o4); g1 += gld<f32x4>(SL, o4 + 16); }
#pragma unroll
            for (int j = 0; j < 4; ++j) { o[j] = g0[j]; o[4 + j] = g1[j]; } }
        else unpack8(gld<u32x4>(U, (unsigned)(r * NUP + col) * 2u), o);
    };
    for (unsigned i = gt; i < (unsigned)RC * (DFF / 8); i += NT) {
        const int r = RL + (int)(i / (DFF / 8)), c = (int)(i % (DFF / 8)) * 8, t = (r - RL) & (CTX - 1);
        const int ca = 256 * (c >> 7) + (c & 127);
        const bool hp = t > 0, hn = t < CTX - 1;
        float a0[8], a1[8], a2[8], g[8], o[8];
        ldu(r, ca, a1); ldu(r, ca + 128, g); ldu(hp ? r - 1 : r, ca, a0); ldu(hn ? r + 1 : r, ca, a2);
        const f32x4 w00 = gld<f32x4>(wf, (unsigned)c * 4u), w01 = gld<f32x4>(wf, (unsigned)c * 4u + 16), w10 = gld<f32x4>(wf, (unsigned)(DFF + c) * 4u), w11 = gld<f32x4>(wf, (unsigned)(DFF + c) * 4u + 16),
                    w20 = gld<f32x4>(wf, (unsigned)(2 * DFF + c) * 4u), w21 = gld<f32x4>(wf, (unsigned)(2 * DFF + c) * 4u + 16);
#pragma unroll
        for (int j = 0; j < 8; ++j) { const float w0 = j < 4 ? w00[j & 3] : w01[j & 3], w1 = j < 4 ? w10[j & 3] : w11[j & 3], w2 = j < 4 ? w20[j & 3] : w21[j & 3];
            float v = w1 * a1[j]; if (hp) v += w0 * a0[j]; if (hn) v += w2 * a2[j]; o[j] = siluf_(v) * g[j]; }
        gst<u32x4>(ACT, (unsigned)(r * DFF + c) * 2u, pack8(o));
    }
}

#define XB_TMO      128
#define XB_XCNT(j)  (256  + 64 * (j))
#define XB_XSUB(j)  (1280 + 64 * (j))
#define XB_XGEN(j)  (2304 + 64 * (j))
#define XB_TOP      3328
#define XB_TOPGEN   3392
#define XCD_BAR_WORDS 3456
#define XB_SPIN_CAP (1u << 18)
__device__ __forceinline__ unsigned xb_ld(unsigned* p)              { return __hip_atomic_load(p, __ATOMIC_RELAXED, __HIP_MEMORY_SCOPE_AGENT); }
__device__ __forceinline__ unsigned xb_add(unsigned* p, unsigned v) { return __hip_atomic_fetch_add(p, v, __ATOMIC_RELAXED, __HIP_MEMORY_SCOPE_AGENT); }
__device__ __forceinline__ unsigned xb_xcc_id() { return (unsigned)__builtin_amdgcn_s_getreg((3 << 11) | 20) & 0xFu; }
#define XB_SPIN(cond, bar) do { unsigned _sp = 0; while (cond) { __builtin_amdgcn_s_sleep(1); \
    if ((++_sp & 255u) == 0u) { if (xb_ld(&(bar)[XB_TMO])) break; if (_sp > XB_SPIN_CAP) { atomicAdd(&(bar)[XB_TMO], 1u); break; } } } } while (0)
struct XcdBarrier { unsigned* bar; unsigned x; volatile LAS unsigned* st; };
__device__ __forceinline__ XcdBarrier xcd_barrier_post(unsigned* bar, volatile LAS unsigned* st) {
    XcdBarrier b; b.bar = bar; b.x = xb_xcc_id(); b.st = st;
    if (threadIdx.x == 0) (void)xb_add(&bar[XB_XCNT(b.x)], 1u);
    return b;
}
__device__ __forceinline__ void xcd_barrier_complete(unsigned* bar, unsigned x, unsigned& nloc, unsigned& nx) {
    const unsigned G = gridDim.x * gridDim.y * gridDim.z;
    unsigned sum, cnt, mine, sp = 0u;
    for (;;) {
        sum = 0u; cnt = 0u; mine = 0u;
#pragma unroll
        for (unsigned j = 0; j < 16; ++j) { const unsigned c = xb_ld(&bar[XB_XCNT(j)]); sum += c; cnt += (c > 0u) ? 1u : 0u; mine = (j == x) ? c : mine; }
        if (sum == G) break;
        __builtin_amdgcn_s_sleep(1);
        if ((++sp & 255u) == 0u) { if (xb_ld(&bar[XB_TMO])) break; if (sp > XB_SPIN_CAP) { atomicAdd(&bar[XB_TMO], 1u); break; } }
    }
    nloc = mine > 0u ? mine : 1u; nx = cnt > 0u ? cnt : 1u;
}
__device__ __forceinline__ void xcd_barrier(const XcdBarrier& b, int wv) {
    asm volatile("s_waitcnt vmcnt(0)" ::: "memory");
    __syncthreads();
    if (otid(wv) == 0) {
        unsigned long long bw = (unsigned long long)b.bar; asm volatile("" : "+s"(bw));
        unsigned* bar = (unsigned*)bw;
        __builtin_amdgcn_s_waitcnt(0);
        unsigned nloc = b.st[0], nx = b.st[1];
        if (nloc == 0u) { xcd_barrier_complete(bar, b.x, nloc, nx); b.st[0] = nloc; b.st[1] = nx; }
        const unsigned old = xb_add(&bar[XB_XSUB(b.x)], 1u);
        const unsigned gen = old / nloc;
        if (old + 1u == (gen + 1u) * nloc) {
            __builtin_amdgcn_fence(__ATOMIC_RELEASE, "agent");
            asm volatile("s_waitcnt vmcnt(0)" ::: "memory");
            const unsigned og = xb_add(&bar[XB_TOP], 1u);
            const unsigned tg = og / nx;
            if (og + 1u == (tg + 1u) * nx) xb_add(&bar[XB_TOPGEN], 1u);
            else XB_SPIN(xb_ld(&bar[XB_TOPGEN]) == tg, bar);
            __builtin_amdgcn_fence(__ATOMIC_ACQUIRE, "agent");
            xb_add(&bar[XB_XGEN(b.x)], 1u);
            asm volatile("s_waitcnt vmcnt(0)" ::: "memory");
        } else {
            XB_SPIN(xb_ld(&bar[XB_XGEN(b.x)]) == gen, bar);
            __builtin_amdgcn_fence(__ATOMIC_ACQUIRE, "agent");
            asm volatile("s_waitcnt vmcnt(0)" ::: "memory");
        }
    }
    __syncthreads();
}

constexpr int I_CUT = (I_LAYER * 2 / 5 / 64) * 64;
#define REPW 3456
#define REPN(k) (1 + __builtin_amdgcn_readfirstlane(((const int*)(okp()->ws + OFF_CTL))[REPW + (k)]))
constexpr int LDS_BYTES = 163840;
constexpr int MISC_OFF = 163840 - 256;
template <class Epi, class Sched, bool AMAP = false> __device__ __forceinline__ void run_gemm(int wv, LAS unsigned char* lds, const bf16_t* A, int lda, const bf16_t* Bt, int ldb, int K, const Sched& S, const Epi& E) {
    pg8::Gemm g; g.A = A; g.Bt = Bt; g.M = 0; g.N = 0; g.K = K; g.lda = lda; g.ldb = ldb; g.pad = wv;
    pg8::gemm_phase<Epi, Sched, AMAP>((PG8_LAS unsigned char*)lds, g, S, E);
}
__global__ void __launch_bounds__(512, 2) mega_fwd(Params p_kernarg) {
    extern __shared__ __attribute__((aligned(16))) unsigned char dyn_lds[];
    LAS unsigned char* lds = (LAS unsigned char*)dyn_lds;
    const int wv = __builtin_amdgcn_readfirstlane(threadIdx.x >> 6);
    volatile LAS unsigned* MISC = (volatile LAS unsigned*)(lds + MISC_OFF);
    if (threadIdx.x < 32) MISC[threadIdx.x] = 0u;
    __syncthreads();
    (void)xcd_barrier_post((unsigned*)(okp()->ws + OFF_CTL), MISC + 8);
#define GRID_BAR() for (int rpb = 0, nrpb = REPN(10); rpb < nrpb; ++rpb) { XcdBarrier bar_; bar_.bar = (unsigned*)(okp()->ws + OFF_CTL); bar_.x = xb_xcc_id(); bar_.st = (volatile LAS unsigned*)(lds + MISC_OFF) + 8; xcd_barrier(bar_, wv); }
    for (int rp = 0, nrp = REPN(13); rp < nrp; ++rp) { ph_convert(wv, lds, 0, obid(), (int)gridDim.x, 0, I_LAYER); __syncthreads(); }
    for (int rp = 0, nrp = REPN(0); rp < nrp; ++rp) { ph_tables(wv); __syncthreads(); ph_mod(wv, lds, 0, 1, obid(), (int)gridDim.x); __syncthreads(); }
    GRID_BAR();
    for (int l = 0; l < DEPTH; ++l) {
        unsigned char* ws = ows(okp()->ws);
        const int G = (int)gridDim.x;
        const int fz = G >= 256 ? 1 : 0;
        const bool lastl = (l == DEPTH - 1);
        bf16_t* XN = (bf16_t*)(ws + OFF_XN); bf16_t* P = (bf16_t*)(ws + OFF_P); float* Gt = (float*)(ws + OFF_G); float* H = (float*)(ws + OFF_H); float* SLB = (float*)(ws + OFF_SLAB);
        const float* mod = (const float*)(ws + OFF_MOD) + (size_t)l * 5 * 6 * D;
        ph_norm(wv, l, 0, l > 0 ? mod - 5 * 6 * D + 4 * 6 * D + 5 * D : nullptr, (l > 0 && fz) ? RL : 0, R, l > 0 ? H : okp()->x, l > 0 ? H + (size_t)RL * D : okp()->ctx);
        GRID_BAR();
        for (int rp = 0, nrp = REPN(1); rp < nrp; ++rp) { EpiInProj E{P, Gt, (const float*)(ws + OFF_BINR) + (size_t)l * NINP};
          pg8::StaticOrder S; S.init(R, NINP, D, G, obid());
          run_gemm(wv, lds, XN, D, (const bf16_t*)(ws + OFF_WIN) + (size_t)l * NINP * D, D, D, S, E); }
        GRID_BAR();
        for (int rp = 0, nrp = REPN(2); rp < nrp; ++rp) ph_mlstm1(wv, l, lds);
        { const int f0 = G / 4, fn = G / 2;
          for (int rp = 0, nrp = REPN(9); rp < nrp; ++rp) if (obid() >= f0 && obid() < f0 + fn) ph_fft(wv, lds, obid() - f0, fn);
          for (int rp = 0, nrp = REPN(3); rp < nrp; ++rp) if (obid() < f0 || obid() >= f0 + fn) { const int wi = obid() < f0 ? obid() : obid() - fn;
              if (!lastl) ph_fourier1(wv, wi, G - fn); ph_convc(wv, l, lastl ? RL : R, wi, G - fn); } }
        GRID_BAR();
        for (int rp = 0, nrp = REPN(4); rp < nrp; ++rp) ph_mlstm2(wv);
        GRID_BAR();
        for (int rp = 0, nrp = REPN(5); rp < nrp; ++rp) ph_mlstm3(wv, l, lds, lastl ? 64 * NH : NCHUNK * NH);
        if (!lastl && obid() >= 32) { EpiBf16 E{(bf16_t*)(ws + OFF_HM) + (size_t)RL * D + DM, D, DF, (unsigned)(CTX * D), 0, SLB};
          pg8::StaticOrder S; S.init(256, 2048, 512, G - 32, obid() - 32);
          run_gemm(wv, lds, (const bf16_t*)(ws + OFF_CSC), 512, (const bf16_t*)(ws + OFF_ZTC), 512, 512, S, E); }
        if (!lastl && obid() >= 32) { ph_convert(wv, lds, l + 1, obid() - 32, G - 32, 0, I_CUT); }
        GRID_BAR();
        for (int rp = 0, nrp = REPN(8); rp < nrp; ++rp) { EpiMerge E{P, (bf16_t*)(ws + OFF_MG)}; pg8::StaticOrder S; S.init(lastl ? RL : R, D, D, G, obid());
          run_gemm(wv, lds, (const bf16_t*)(ws + OFF_HM), D, (const bf16_t*)(ws + OFF_WPM) + (size_t)l * D * D, D, D, S, E); }
        if (!lastl && obid() >= 32) { ph_convert(wv, lds, l + 1, obid() - 32, G - 32, I_CUT, I_LAYER); __syncthreads(); ph_mod(wv, lds, l + 1, l + 2, obid() - 32, G - 32); }
        GRID_BAR();
        for (int rp = 0, nrp = REPN(11); rp < nrp; ++rp) { EpiResid E{l, 0, fz, rp == 0 ? 1.f : 0.f};
          pg8::TailOrder S; S.init(D, D, G, obid(), lastl ? 0 : 32, 0, 8);
          run_gemm(wv, lds, (const bf16_t*)(ws + OFF_MG), D, (const bf16_t*)(ws + OFF_WO) + (size_t)l * D * D, D, D, S, E); }
        GRID_BAR();
        if (!lastl || !fz) { ph_norm(wv, l, 1, lastl ? nullptr : mod + 4 * 6 * D + 2 * D, fz ? RL : 0, lastl ? RL : R, H, l > 0 ? H + (size_t)RL * D : okp()->ctx);
          GRID_BAR(); }
        for (int rp = 0, nrp = REPN(7); rp < nrp; ++rp) { EpiUp E{P, SLB, (bf16_t*)(ws + OFF_ACT), okp()->conv_ff_w + (size_t)l * 3 * DFF};
          pg8::TailOrder S; S.init(NUP, D, G, obid(), lastl ? 0 : 176, lastl ? 0 : 128, 4);
          run_gemm<EpiUp, pg8::TailOrder, true>(wv, lds, XN, D, (const bf16_t*)(ws + OFF_WUP) + (size_t)l * NUP * D, D, D, S, E); }
        GRID_BAR();
        if (!lastl) { for (int rp = 0, nrp = REPN(6); rp < nrp; ++rp) ph_ffnact(wv, l);
          GRID_BAR(); }
        for (int rp = 0, nrp = REPN(12); rp < nrp; ++rp) { EpiResid E{l, 1, lastl ? 2 * fz : fz, rp == 0 ? 1.f : 0.f};
          pg8::TailOrder S; S.init(D, DFF, G, obid(), lastl ? 0 : 32, 0, 8);
          run_gemm(wv, lds, (const bf16_t*)(ws + OFF_ACT), DFF, (const bf16_t*)(ws + OFF_WDN) + (size_t)l * D * DFF, DFF, DFF, S, E); }
        if (!(lastl && fz)) { GRID_BAR(); }
    }
    if (gridDim.x < 256) ph_final(wv);
}

extern "C" void kernel_launch(void* const* d_in, const int* in_sizes, int n_in, void* d_out, int out_size, void* d_ws, size_t ws_size, hipStream_t stream) {
    static int grid = 0;
    if (grid == 0) {
        if (n_in != 22 || ws_size < WS_END || out_size != RL * D) { fprintf(stderr, "kernel_launch: unexpected problem (n_in %d, ws %zu < %zu, out %d)\n", n_in, ws_size, (size_t)WS_END, out_size); grid = -1; return; }
        int dev = 0, cus = 0, per_cu = 0;
        if (hipGetDevice(&dev) != hipSuccess || hipDeviceGetAttribute(&cus, hipDeviceAttributeMultiprocessorCount, dev) != hipSuccess) { grid = -1; return; }
        if (hipFuncSetAttribute((const void*)mega_fwd, hipFuncAttributeMaxDynamicSharedMemorySize, LDS_BYTES) != hipSuccess) { fprintf(stderr, "kernel_launch: hipFuncSetAttribute failed\n"); grid = -1; return; }
        if (hipOccupancyMaxActiveBlocksPerMultiprocessor(&per_cu, (const void*)mega_fwd, 512, LDS_BYTES) != hipSuccess || per_cu < 1) { fprintf(stderr, "kernel_launch: occupancy query says %d\n", per_cu); per_cu = 1; }
        (void)hipGetLastError();
        grid = cus;
    }
    if (grid < 0) return;
    Params p{};
    const float** pp = (const float**)&p;
    for (int i = 0; i < 22; ++i) pp[i] = (const float*)d_in[i];
    p.out = (float*)d_out; p.ws = (unsigned char*)d_ws;
    (void)hipMemsetAsync((char*)d_ws + OFF_CTL, 0, (size_t)CTL_ZERO_WORDS * sizeof(unsigned), stream);
    hipLaunchKernelGGL(mega_fwd, dim3(grid), dim3(512), LDS_BYTES, stream, p);
}
```

```cpp
#include <hip/hip_runtime.h>
#include <cstdio>
#include <cstdint>
#include <type_traits>

#define LAS __attribute__((address_space(3)))
typedef unsigned short bf16_t;
typedef short bf16x8 __attribute__((ext_vector_type(8)));
typedef float f32x4 __attribute__((ext_vector_type(4)));
typedef unsigned u32x4 __attribute__((ext_vector_type(4)));
typedef unsigned u32x2 __attribute__((ext_vector_type(2)));
typedef float f32x2 __attribute__((ext_vector_type(2)));

constexpr int D = 2048, NB = 4, SEQ = 2048, DEPTH = 4, CTX = 256;
constexpr int DM = 1024, NH = 4, DH = 256, DF = 512, DC = 512, DFF = 5632, CHUNK = 128;
constexpr int NIN = 12304;
constexpr int RL = NB * SEQ, RC = NB * CTX, R = RL + RC;
constexpr int NP = 12288;
constexpr int NINP = 12544;
constexpr int PK = 0, PV = 1024, PQ = 2048, PO = 3072, PF = 4096, PCB = 4608, PCC = 5120, PCX = 5632, PGM = 6144;
constexpr int NCHUNK = 72;
constexpr int NUP = 2 * DFF;
constexpr float EPS = 1e-6f;

constexpr size_t al256(size_t x) { return (x + 255) & ~(size_t)255; }
constexpr size_t OFF_CTL = 0;
constexpr size_t OFF_WIN = 1u << 20;
constexpr size_t SZ_WIN = (size_t)NINP * D * 2;            constexpr size_t OFF_WPM = OFF_WIN + DEPTH * SZ_WIN;
constexpr size_t SZ_WPM = (size_t)D * D * 2;               constexpr size_t OFF_WO = OFF_WPM + DEPTH * SZ_WPM;
constexpr size_t SZ_WO = (size_t)D * D * 2;                constexpr size_t OFF_WUP = OFF_WO + DEPTH * SZ_WO;
constexpr size_t SZ_WUP = (size_t)NUP * D * 2;             constexpr size_t OFF_WDN = OFF_WUP + DEPTH * SZ_WUP;
constexpr size_t SZ_WDN = (size_t)D * DFF * 2;             constexpr size_t OFF_BINR = OFF_WDN + DEPTH * SZ_WDN;
constexpr size_t OFF_MA = al256(OFF_BINR + (size_t)DEPTH * NINP * 4);
constexpr size_t OFF_MC = OFF_MA + (size_t)64 * 64 * 2;
constexpr size_t OFF_CSC = OFF_MC + (size_t)32 * 64 * 128 * 2;
constexpr size_t OFF_FT = OFF_CSC + (size_t)256 * 512 * 2;
constexpr size_t OFF_MOD = OFF_FT + (size_t)256 * 128 * 2;
constexpr size_t OFF_H = al256(OFF_MOD + (size_t)DEPTH * 5 * 6 * D * 4);
constexpr size_t OFF_XN = OFF_H + (size_t)R * D * 4;
constexpr size_t OFF_P = OFF_XN + (size_t)R * D * 2;
constexpr size_t OFF_G = OFF_P + (size_t)R * NP * 2;
constexpr size_t OFF_CHS = OFF_G + (size_t)R * 16 * 4;
constexpr size_t OFF_MST = al256(OFF_CHS + (size_t)NCHUNK * 8 * 2 * 4);
constexpr size_t OFF_UT = al256(OFF_MST + (size_t)NCHUNK * 8 * 4);
constexpr size_t SZ_UT = (size_t)NCHUNK * NH * 2 * DH * DH * 2;
constexpr size_t OFF_CT = OFF_UT + SZ_UT;
constexpr size_t OFF_NV = OFF_CT + SZ_UT;
constexpr size_t OFF_NS = OFF_NV + (size_t)NCHUNK * NH * 2 * DH * 4;
constexpr size_t OFF_HM = OFF_NS + (size_t)NCHUNK * NH * 2 * DH * 4;
constexpr size_t OFF_ZTC = OFF_HM + (size_t)R * D * 2;
constexpr size_t OFF_MG = OFF_ZTC + (size_t)2048 * 512 * 2;
constexpr size_t OFF_ACT = OFF_MG + (size_t)R * D * 2;
constexpr size_t OFF_SLAB = OFF_ACT + (size_t)R * DFF * 2;
constexpr size_t OFF_XS = OFF_SLAB + (size_t)4 * RC * NUP * 4;
constexpr size_t WS_END = OFF_XS + (size_t)8 * RL * 32 * 4;
constexpr int CNTW = 4096;
constexpr int CTL_ZERO_WORDS = CNTW + 8 * 32 * 64;
static_assert(WS_END <= (size_t)4 * DEPTH * D * NIN * 4, "workspace map exceeds the guaranteed d_ws size");
static_assert((size_t)R * NUP * 2 <= (size_t)R * NP * 2, "u overlays P");

struct Params {
    const float *x, *c, *ctx, *c_ctx, *w_mod, *b_mod, *norm1_w, *norm2_w, *w_in, *b_in, *conv_q_w, *conv_k_w, *mlstm_norm_w, *w_pm, *w_pf, *w_pc, *conv_c_w, *w_o, *w_up,
        *conv_ff_w, *w_down, *final_norm_w;
    float* out; unsigned char* ws;
};
#define WSP(T, off) ((T*)(wsb + (off)))
typedef const __attribute__((address_space(4))) Params CParams;
__device__ __forceinline__ CParams* okp() { CParams* k = (CParams*)__builtin_amdgcn_kernarg_segment_ptr(); asm volatile("" : "+s"(k)); return k; }

#define GAS __attribute__((address_space(1)))
template <class T> __device__ __forceinline__ T gld(const void* base, unsigned byte_off) { return *(const GAS T*)((const GAS unsigned char*)base + byte_off); }
template <class T> __device__ __forceinline__ void gst(void* base, unsigned byte_off, T v) { *(GAS T*)((GAS unsigned char*)base + byte_off) = v; }
__device__ __forceinline__ int otid(int wv) { int t; asm volatile("v_mbcnt_lo_u32_b32 %0, -1, 0\n\tv_mbcnt_hi_u32_b32 %0, -1, %0" : "=v"(t)); return (wv << 6) | t; }
__device__ __forceinline__ int olaunder(int v) { asm volatile("" : "+v"(v)); return v; }
__device__ __forceinline__ f32x4 zero4() { float a, b, c, d; asm volatile("v_mov_b32 %0, 0\n\tv_mov_b32 %1, 0\n\tv_mov_b32 %2, 0\n\tv_mov_b32 %3, 0" : "=v"(a), "=v"(b), "=v"(c), "=v"(d)); return (f32x4){a, b, c, d}; }
__device__ __forceinline__ int obid() { int b = blockIdx.x; asm volatile("" : "+s"(b)); return b; }
__device__ __forceinline__ float bf2f(bf16_t v) { return __uint_as_float(((unsigned)v) << 16); }
__device__ __forceinline__ unsigned f2bf(float f) { unsigned u = __float_as_uint(f); return (u + 0x7fffu + ((u >> 16) & 1u)) >> 16; }
__device__ __forceinline__ unsigned pk2(float lo, float hi) { return f2bf(lo) | (f2bf(hi) << 16); }
__device__ __forceinline__ float sigmoidf_(float x) { return 1.f / (1.f + __expf(-x)); }
__device__ __forceinline__ float siluf_(float x) { return x / (1.f + __expf(-x)); }
__device__ __forceinline__ float shx(float v, int k, int lane) { return __int_as_float(__builtin_amdgcn_ds_bpermute((lane ^ k) << 2, __float_as_int(v))); }
__device__ __forceinline__ float shl_(float v, int src) { return __int_as_float(__builtin_amdgcn_ds_bpermute(src << 2, __float_as_int(v))); }
__device__ __forceinline__ unsigned char* ows(unsigned char* w) { asm volatile("" : "+s"(w)); return w; }
__device__ __forceinline__ float wave_sum(float v, int lane) {
#pragma unroll
    for (int o = 1; o < 64; o <<= 1) v += shx(v, o, lane);
    return v;
}
__device__ __forceinline__ void unpack8(u32x4 w, float (&f)[8]) {
    f[0] = __uint_as_float(w.x << 16); f[1] = __uint_as_float(w.x & 0xffff0000u); f[2] = __uint_as_float(w.y << 16); f[3] = __uint_as_float(w.y & 0xffff0000u);
    f[4] = __uint_as_float(w.z << 16); f[5] = __uint_as_float(w.z & 0xffff0000u); f[6] = __uint_as_float(w.w << 16); f[7] = __uint_as_float(w.w & 0xffff0000u);
}
__device__ __forceinline__ u32x4 pack8(const float (&f)[8]) { u32x4 w; w.x = pk2(f[0], f[1]); w.y = pk2(f[2], f[3]); w.z = pk2(f[4], f[5]); w.w = pk2(f[6], f[7]); return w; }
__device__ __forceinline__ void rowinfo(int r, int& mj, int& t, int& T) { const int c = r >= RL ? 1 : 0; mj = r >> 11; T = SEQ >> (3 * c); t = r & (T - 1); }
__device__ __forceinline__ int chunk_row0(int cidx) { return cidx < 64 ? (cidx >> 4) * SEQ + (cidx & 15) * CHUNK : RL + ((cidx - 64) >> 1) * CTX + ((cidx - 64) & 1) * CHUNK; }
__device__ __forceinline__ int scan_chunk(int b, int dir, int step) {
    if (step < 2) { const int j = dir ? 1 - step : step; return 64 + b * 2 + j; }
    const int jj = step - 2, j = dir ? 15 - jj : jj; return b * 16 + j;
}

namespace pg8 {
#define PG8_LAS __attribute__((address_space(3)))
constexpr int BM = 256, BK = 64, HALF = 128, HTB = HALF * BK * 2, STAGE_BYTES = 8 * HTB, NXCD = 8, WGM = 8;
__host__ __device__ __forceinline__ int lds_byte(int r, int c) { const int st = (r >> 4) * 2 + (c >> 5), rr = r & 15, cc = c & 31, ob = rr * 64 + cc * 2; return st * 1024 + (ob ^ (((ob >> 9) & 1) << 5)); }
__host__ __device__ __forceinline__ void stage_rc(int b, int& Rr, int& C) { const int st = b / 1024, sb = b % 1024, swz = sb ^ (((sb >> 9) & 1) << 5); Rr = (st >> 1) * 16 + swz / 64; C = (st & 1) * 32 + (swz % 64) / 2; }
__host__ __device__ __forceinline__ int perm32(int rho) { const int n = rho >> 4, i = rho & 15; return 8 * (i >> 2) + 4 * n + (i & 3); }
struct Unit { int pm, pn, k0, nt, ks; };
struct Gemm { const bf16_t* A; const bf16_t* Bt; int M, N, K, lda, ldb, pad; };
__host__ __device__ __forceinline__ void tile_of(int wgid, int nM, int nN, int& pm, int& pn) {
    const int nwg = nM * nN; { const int q = nwg / NXCD, r = nwg % NXCD, xcd = wgid % NXCD, off = wgid / NXCD; wgid = (xcd < r ? xcd * (q + 1) : r * (q + 1) + (xcd - r) * q) + off; }
    const int nig = WGM * nN, gid = wgid / nig, fm = gid * WGM, gsz = (nM - fm) < WGM ? (nM - fm) : WGM;
    pm = fm + ((wgid % nig) % gsz); pn = (wgid % nig) / gsz;
}
struct StaticOrder {
    int nM, nN, nwg, G, c, K;
    __host__ __device__ void init(int M, int N, int K_, int G_, int c_) { nM = M / BM; nN = N / BM; nwg = nM * nN; G = G_; c = c_; K = K_; }
    __host__ __device__ bool next(int i, Unit& u) const {
        const long L = (long)i * G + c; if (L >= nwg) return false;
        tile_of((int)L, nM, nN, u.pm, u.pn); u.k0 = 0; u.nt = K / BK; u.ks = -1; return true;
    }
    __device__ __forceinline__ void a_ready(const Unit&) const {}
    __device__ __forceinline__ void done(const Unit&) const {}
};
struct TailOrder {
    int nN, G, c, K, nLat, nWhole, nTot, nsl;
    __host__ __device__ void init(int N, int K_, int G_, int c_, int nCtxTiles, int nCtxWhole, int nsl_) { nN = N / BM; G = G_; c = c_; K = K_; nLat = 32 * nN; nWhole = nLat + nCtxWhole; nTot = nLat + nCtxTiles; nsl = nsl_; }
    __host__ __device__ bool next(int i, Unit& u) const {
        const long L = (long)i * G + c; if (L >= (long)nWhole + (long)(nTot - nWhole) * nsl) return false;
        int tile, ks; if (L < nWhole) { tile = (int)L; ks = -1; } else { const int Lp = (int)L - nWhole; tile = nWhole + Lp / nsl; ks = Lp % nsl; }
        if (tile < nLat) tile_of(tile, 32, nN, u.pm, u.pn); else { const int tp = tile - nLat; u.pm = 32 + (tp & 3); u.pn = tp >> 2; }
        if (ks < 0) { u.k0 = 0; u.nt = K / BK; } else { const int n128 = K / 128, base = n128 / nsl, rem = n128 % nsl; u.k0 = 128 * (ks * base + (ks < rem ? ks : rem)); u.nt = 2 * (base + (ks < rem ? 1 : 0)); }
        u.ks = ks; return true;
    }
    __device__ __forceinline__ void a_ready(const Unit&) const {}
    __device__ __forceinline__ void done(const Unit&) const {}
};
template <bool AMAP> __device__ __forceinline__ void a_geom(const Gemm& g, const Unit& u, int R0, int C0, int R1, int C1, size_t& base, size_t& hstep, unsigned (&vo)[2]) {
    if (AMAP && u.pm < 32) { base = (size_t)((u.pm >> 3) * 2048 + (u.pm & 7) * 8) * g.lda * 2; hstep = (size_t)4 * g.lda * 2;
        vo[0] = (unsigned)(((R0 & 31) * 64 + (R0 >> 5)) * g.lda + C0) * 2u; vo[1] = (unsigned)(((R1 & 31) * 64 + (R1 >> 5)) * g.lda + C1) * 2u; }
    else { base = (size_t)u.pm * 256 * g.lda * 2; hstep = (size_t)HALF * g.lda * 2; vo[0] = (unsigned)(R0 * g.lda + C0) * 2u; vo[1] = (unsigned)(R1 * g.lda + C1) * 2u; }
}
template <class Epi, class Sched, bool AMAP = false>
__device__ __forceinline__ void gemm_phase(PG8_LAS unsigned char* lds, const Gemm g, const Sched& S, const Epi& E) {
    const int tid = otid(g.pad), wid = __builtin_amdgcn_readfirstlane(tid >> 6), lane = tid & 63, wr = wid >> 2, wc = wid & 3, fr = lane & 15, fq = lane >> 4;
    int R0, C0, R1, C1; stage_rc(tid * 16, R0, C0); stage_rc(tid * 16 + 8192, R1, C1);
    unsigned voffB[2];
    { const int Rb0 = Epi::PERM ? ((R0 & ~31) + perm32(R0 & 31)) : R0, Rb1 = Epi::PERM ? ((R1 & ~31) + perm32(R1 & 31)) : R1;
      voffB[0] = (unsigned)(Rb0 * g.ldb + C0) * 2u; voffB[1] = (unsigned)(Rb1 * g.ldb + C1) * 2u; }
    const size_t kstep = (size_t)(BK * 2);
    const size_t hstepB = (size_t)HALF * g.ldb * 2, tstepB = 2 * hstepB;
    const unsigned ldsw = (unsigned)wid * 1024u;
    const int aoff = lds_byte(wr * 64 + fr, fq * 8), boff = lds_byte(wc * 32 + fr, fq * 8);
#define PG8_SA(b, h) (((b) * 2 + (h)) * HTB)
#define PG8_SB(b, h) ((4 + (b) * 2 + (h)) * HTB)
#define PG8_STAGE(bufoff, gbase, voff) do { _Pragma("unroll") for (int _i = 0; _i < 2; ++_i) \
        __builtin_amdgcn_global_load_lds((const unsigned*)((const char*)(gbase) + (voff)[_i]), (PG8_LAS unsigned*)(lds + (bufoff) + ldsw + _i * 8192), 16, 0, 0); } while (0)
#define PG8_LDA(dst, b, h) do { _Pragma("unroll") for (int m = 0; m < 4; ++m) _Pragma("unroll") for (int k = 0; k < 2; ++k) dst[m][k] = *(const PG8_LAS bf16x8*)(lds + PG8_SA(b, h) + aoff + m * 2048 + k * 1024); } while (0)
#define PG8_LDB(dst, b, h) do { _Pragma("unroll") for (int n = 0; n < 2; ++n) _Pragma("unroll") for (int k = 0; k < 2; ++k) dst[n][k] = *(const PG8_LAS bf16x8*)(lds + PG8_SB(b, h) + boff + n * 2048 + k * 1024); } while (0)
#define PG8_MMA(ai, bj, At, Bt) do { __builtin_amdgcn_s_setprio(1); _Pragma("unroll") for (int m = 0; m < 4; ++m) _Pragma("unroll") for (int n = 0; n < 2; ++n) _Pragma("unroll") for (int k = 0; k < 2; ++k) \
        acc[ai][bj][m][n] = __builtin_amdgcn_mfma_f32_16x16x32_bf16(Bt[n][k], At[m][k], acc[ai][bj][m][n], 0, 0, 0); __builtin_amdgcn_s_setprio(0); } while (0)
#define PG8_WAIT_V(n) asm volatile("s_waitcnt vmcnt(" #n ")" ::: "memory")
#define PG8_WAIT_L(n) asm volatile("s_waitcnt lgkmcnt(" #n ")" ::: "memory")
#define PG8_BAR __builtin_amdgcn_s_barrier()
#define PG8_SCHED __builtin_amdgcn_sched_barrier(0)
    Unit cur, nxt; int ui = 0;
    if (!S.next(0, cur)) return;
    f32x4 acc[2][2][4][2];
#pragma unroll
    for (int a = 0; a < 2; ++a)
#pragma unroll
        for (int b = 0; b < 2; ++b)
#pragma unroll
            for (int m = 0; m < 4; ++m)
#pragma unroll
                for (int n = 0; n < 2; ++n) acc[a][b][m][n] = zero4();
    bf16x8 At[4][2], B0[2][2], B1[2][2];
    size_t baseC, hsC; unsigned voC[2]; a_geom<AMAP>(g, cur, R0, C0, R1, C1, baseC, hsC, voC);
    const char* cA = (const char*)g.A + baseC + (size_t)cur.k0 * 2; const char* cB = (const char*)g.Bt + (size_t)cur.pn * tstepB + (size_t)cur.k0 * 2;
    S.a_ready(cur);
    PG8_STAGE(PG8_SB(0, 0), cB, voffB); PG8_STAGE(PG8_SB(0, 1), cB + hstepB, voffB); PG8_STAGE(PG8_SA(0, 0), cA, voC); PG8_STAGE(PG8_SA(0, 1), cA + hsC, voC);
    if (wr == 1) PG8_BAR;
    PG8_WAIT_V(2); PG8_BAR;
    PG8_STAGE(PG8_SB(1, 0), cB + kstep, voffB); PG8_STAGE(PG8_SA(1, 0), cA + kstep, voC); PG8_STAGE(PG8_SB(1, 1), cB + hstepB + kstep, voffB);
    PG8_WAIT_V(6); PG8_BAR;
    for (;;) {
        const bool has_next = S.next(ui + 1, nxt);
        size_t baseN = baseC, hsN = hsC; unsigned voN[2] = {voC[0], voC[1]};
        if (AMAP && has_next) a_geom<AMAP>(g, nxt, R0, C0, R1, C1, baseN, hsN, voN); else if (has_next) baseN = (size_t)nxt.pm * 256 * g.lda * 2;
        const char* nA = has_next ? (const char*)g.A + baseN + (size_t)nxt.k0 * 2 : cA; const char* nB = has_next ? (const char*)g.Bt + (size_t)nxt.pn * tstepB + (size_t)nxt.k0 * 2 : cB;
        const int nt = cur.nt;
        for (int t = 0; t < nt; t += 2) {
            if constexpr (Epi::HOOK) E.hook(acc, cur, t, wr, wc, fr, fq, At, B0, B1);
            const bool last = (t == nt - 2);
            const char* a1 = cA + (size_t)(t + 1) * kstep;
            const char* a2 = last ? nA : cA + (size_t)(t + 2) * kstep; const char* b2 = last ? nB : cB + (size_t)(t + 2) * kstep;
            const char* a3 = a2 + kstep; const char* b3 = b2 + kstep;
            const size_t hs2 = (AMAP && last) ? hsN : hsC; unsigned vo2[2] = {(AMAP && last) ? voN[0] : voC[0], (AMAP && last) ? voN[1] : voC[1]};
            if (last && has_next) S.a_ready(nxt);
            PG8_LDB(B0, 0, 0); PG8_LDB(B1, 0, 1); PG8_SCHED; PG8_LDA(At, 0, 0); PG8_STAGE(PG8_SA(1, 1), a1 + hsC, voC);
            PG8_WAIT_V(8); PG8_WAIT_L(0); PG8_BAR; PG8_MMA(0, 0, At, B0); PG8_MMA(0, 1, At, B1); PG8_BAR; PG8_SCHED;
            PG8_LDA(At, 0, 1); PG8_STAGE(PG8_SB(0, 0), b2, voffB); PG8_STAGE(PG8_SB(0, 1), b2 + hstepB, voffB); PG8_STAGE(PG8_SA(0, 0), a2, vo2);
            PG8_WAIT_V(8); PG8_WAIT_L(0); PG8_BAR; PG8_MMA(1, 0, At, B0); PG8_MMA(1, 1, At, B1); PG8_BAR; PG8_SCHED;
            PG8_LDB(B0, 1, 0); PG8_LDB(B1, 1, 1); PG8_SCHED; PG8_LDA(At, 1, 0); PG8_STAGE(PG8_SA(0, 1), a2 + hs2, vo2);
            PG8_WAIT_V(8); PG8_WAIT_L(0); PG8_BAR; PG8_MMA(0, 0, At, B0); PG8_MMA(0, 1, At, B1); PG8_BAR; PG8_SCHED;
            PG8_LDA(At, 1, 1); PG8_STAGE(PG8_SB(1, 0), b3, voffB); PG8_STAGE(PG8_SB(1, 1), b3 + hstepB, voffB); PG8_STAGE(PG8_SA(1, 0), a3, vo2);
            PG8_WAIT_V(8); PG8_WAIT_L(0); PG8_BAR; PG8_MMA(1, 0, At, B0); PG8_MMA(1, 1, At, B1); PG8_BAR; PG8_SCHED;
        }
        if (wr == 0) PG8_BAR;
        E(acc, cur, wr, wc, fr, fq); S.done(cur);
        if (!has_next) break;
#pragma unroll
        for (int a = 0; a < 2; ++a)
#pragma unroll
            for (int b = 0; b < 2; ++b)
#pragma unroll
                for (int m = 0; m < 4; ++m)
#pragma unroll
                    for (int n = 0; n < 2; ++n) acc[a][b][m][n] = zero4();
        cur = nxt; cA = nA; cB = nB; ++ui;
        if constexpr (AMAP) { hsC = hsN; voC[0] = voN[0]; voC[1] = voN[1]; }
        if (wr == 1) PG8_BAR;
    }
    PG8_WAIT_V(0);
    PG8_BAR;
#undef PG8_SA
#undef PG8_SB
#undef PG8_STAGE
#undef PG8_LDA
#undef PG8_LDB
#undef PG8_MMA
#undef PG8_WAIT_V
#undef PG8_WAIT_L
#undef PG8_BAR
#undef PG8_SCHED
}
}

template <class F> __device__ __forceinline__ void epi_foreach(const f32x4 (&acc)[2][2][4][2], const pg8::Unit& u, int wr, int wc, int fr, int fq, F&& f) {
    const int row0 = u.pm * 256 + wr * 64 + fr, col0 = u.pn * 256 + wc * 32 + 8 * fq;
#pragma unroll
    for (int ai = 0; ai < 2; ++ai)
#pragma unroll
        for (int m = 0; m < 4; ++m)
#pragma unroll
            for (int bj = 0; bj < 2; ++bj) f(row0 + ai * 128 + m * 16, col0 + bj * 128, acc[ai][bj][m][0], acc[ai][bj][m][1]);
}
__device__ __forceinline__ u32x4 pack8v(f32x4 v0, f32x4 v1) { u32x4 w; w.x = pk2(v0[0], v0[1]); w.y = pk2(v0[2], v0[3]); w.z = pk2(v1[0], v1[1]); w.w = pk2(v1[2], v1[3]); return w; }

struct EpiInProj {
    static constexpr bool PERM = true, HOOK = false;
    bf16_t* P; float* G; const float* bias;
    __device__ __forceinline__ void operator()(const f32x4 (&acc)[2][2][4][2], const pg8::Unit& u, int wr, int wc, int fr, int fq) const {
        if (u.pn < 48) {
            f32x4 bv[2][2];
#pragma unroll
            for (int bj = 0; bj < 2; ++bj) { const unsigned bo = (unsigned)(u.pn * 256 + wc * 32 + 8 * fq + bj * 128) * 4u; bv[bj][0] = gld<f32x4>(bias, bo); bv[bj][1] = gld<f32x4>(bias, bo + 16); }
            epi_foreach(acc, u, wr, wc, fr, fq, [&](int row, int col, f32x4 v0, f32x4 v1) {
                const int bj = (col >> 7) & 1;
                f32x4 o0 = v0 + bv[bj][0], o1 = v1 + bv[bj][1];
                if (u.pn >= PGM / 256) {
#pragma unroll
                    for (int j = 0; j < 4; ++j) { o0[j] = 1.f + __expf(-fminf(fmaxf(o0[j], -30.f), 30.f)); o1[j] = 1.f + __expf(-fminf(fmaxf(o1[j], -30.f), 30.f)); } }
                gst<u32x4>(P, (unsigned)(row * NP + col) * 2u, pack8v(o0, o1)); });
        } else if (wc == 0 && fq < 2) {
            const int row0 = u.pm * 256 + wr * 64 + fr;
            const f32x4 b0 = gld<f32x4>(bias, (unsigned)(NP + 8 * fq) * 4u), b1 = gld<f32x4>(bias, (unsigned)(NP + 8 * fq) * 4u + 16);
#pragma unroll
            for (int ai = 0; ai < 2; ++ai)
#pragma unroll
                for (int m = 0; m < 4; ++m) { const unsigned go = (unsigned)((row0 + ai * 128 + m * 16) * 16 + 8 * fq) * 4u;
                    gst<f32x4>(G, go, acc[ai][0][m][0] + b0); gst<f32x4>(G, go + 16, acc[ai][0][m][1] + b1); }
        }
    }
};
struct EpiBf16 {
    static constexpr bool PERM = true, HOOK = false;
    bf16_t* O; int ldc; int split_cols; unsigned split_stride; int pad; float* slab;
    __device__ __forceinline__ void operator()(const f32x4 (&acc)[2][2][4][2], const pg8::Unit& u, int wr, int wc, int fr, int fq) const {
        if (u.ks >= 0) { const unsigned sb = (unsigned)u.ks * (unsigned)(RC * ldc);
            epi_foreach(acc, u, wr, wc, fr, fq, [&](int row, int col, f32x4 v0, f32x4 v1) { const unsigned o = (sb + (unsigned)((row - RL) * ldc + col)) * 4u; gst<f32x4>(slab, o, v0); gst<f32x4>(slab, o + 16, v1); });
            return; }
        int colt = u.pn * 256; unsigned base = 0;
        if (split_cols) { const int t = colt / split_cols; base = (unsigned)t * split_stride; colt -= t * split_cols; }
        const int cshift = colt - u.pn * 256;
        epi_foreach(acc, u, wr, wc, fr, fq, [&](int row, int col, f32x4 v0, f32x4 v1) { gst<u32x4>(O, (base + (unsigned)(row * ldc + col + cshift)) * 2u, pack8v(v0, v1)); });
    }
};
struct EpiMerge {
    static constexpr bool PERM = true, HOOK = true;
    const bf16_t* P; bf16_t* MG;
    __device__ __forceinline__ void hook(f32x4 (&acc)[2][2][4][2], const pg8::Unit& u, int t, int wr, int wc, int fr, int fq, bf16x8 (&At)[4][2], bf16x8 (&B0)[2][2], bf16x8 (&B1)[2][2]) const {
        if (t != 16 && t != 24) return;
        const int b = t == 16 ? 0 : 1;
        const unsigned o0 = (unsigned)((u.pm * 256 + wr * 64 + fr) * NP + PGM + b * D + u.pn * 256 + wc * 32 + 8 * fq) * 2u;
#pragma unroll
        for (int ai = 0; ai < 2; ++ai) {
#pragma unroll
            for (int m = 0; m < 4; ++m) { const unsigned o = o0 + (unsigned)((ai * 128 + m * 16) * NP) * 2u;
                At[m][0] = gld<bf16x8>(P, o); At[m][1] = gld<bf16x8>(P, o + 256u);
                if (m < 2) { B0[m][0] = gld<bf16x8>(P, o + D * 2); B0[m][1] = gld<bf16x8>(P, o + D * 2 + 256u); }
                else { B1[m - 2][0] = gld<bf16x8>(P, o + D * 2); B1[m - 2][1] = gld<bf16x8>(P, o + D * 2 + 256u); } }
#pragma unroll
            for (int m = 0; m < 4; ++m)
#pragma unroll
                for (int bj = 0; bj < 2; ++bj) { float xa[8], xb[8]; unpack8(__builtin_bit_cast(u32x4, At[m][bj]), xa); unpack8(__builtin_bit_cast(u32x4, m < 2 ? B0[m][bj] : B1[m - 2][bj]), xb);
#pragma unroll
                    for (int j = 0; j < 8; ++j) acc[ai][bj][m][j >> 2][j & 3] *= xb[j] * __builtin_amdgcn_rcpf(xa[j]); }
        }
    }
    __device__ __forceinline__ void operator()(const f32x4 (&acc)[2][2][4][2], const pg8::Unit& u, int wr, int wc, int fr, int fq) const {
        const int row0 = u.pm * 256 + wr * 64 + fr, col0 = u.pn * 256 + wc * 32 + 8 * fq;
#pragma unroll
        for (int ai = 0; ai < 2; ++ai) { u32x4 gr[4][2];
#pragma unroll
            for (int m = 0; m < 4; ++m)
#pragma unroll
                for (int bj = 0; bj < 2; ++bj) gr[m][bj] = gld<u32x4>(P, (unsigned)((row0 + ai * 128 + m * 16) * NP + PGM + 2 * D + col0 + bj * 128) * 2u);
#pragma unroll
            for (int m = 0; m < 4; ++m)
#pragma unroll
                for (int bj = 0; bj < 2; ++bj) { float g[8]; unpack8(gr[m][bj], g);
                    const f32x4 g0 = {__builtin_amdgcn_rcpf(g[0]), __builtin_amdgcn_rcpf(g[1]), __builtin_amdgcn_rcpf(g[2]), __builtin_amdgcn_rcpf(g[3])},
                                g1 = {__builtin_amdgcn_rcpf(g[4]), __builtin_amdgcn_rcpf(g[5]), __builtin_amdgcn_rcpf(g[6]), __builtin_amdgcn_rcpf(g[7])};
                    gst<u32x4>(MG, (unsigned)((row0 + ai * 128 + m * 16) * D + col0 + bj * 128) * 2u, pack8v(g0 * acc[ai][bj][m][0], g1 * acc[ai][bj][m][1])); }
        }
    }
};
struct EpiUp {
    static constexpr bool PERM = true, HOOK = false;
    bf16_t* U; float* slab; bf16_t* ACT; const float* wf;
    __device__ __forceinline__ void operator()(const f32x4 (&acc)[2][2][4][2], const pg8::Unit& u, int wr, int wc, int fr, int fq) const {
        if (u.ks >= 0) { const unsigned sb = (unsigned)u.ks * (unsigned)(RC * NUP);
            epi_foreach(acc, u, wr, wc, fr, fq, [&](int row, int col, f32x4 v0, f32x4 v1) { const unsigned o = (sb + (unsigned)((row - RL) * NUP + col)) * 4u; gst<f32x4>(slab, o, v0); gst<f32x4>(slab, o + 16, v1); });
            return; }
        if (u.pm >= 32) { epi_foreach(acc, u, wr, wc, fr, fq, [&](int row, int col, f32x4 v0, f32x4 v1) { gst<u32x4>(U, (unsigned)(row * NUP + col) * 2u, pack8v(v0, v1)); }); return; }
        const int c0 = 128 * u.pn + 32 * wc + 8 * fq, lane = fq * 16 + fr;
        const int lprev = ((lane & 48) | ((fr - 1) & 15)), lnext = ((lane & 48) | ((fr + 1) & 15));
        float w0[8], w1[8], w2[8];
        { const f32x4 a0 = gld<f32x4>(wf, (unsigned)c0 * 4u), a1 = gld<f32x4>(wf, (unsigned)c0 * 4u + 16), b0 = gld<f32x4>(wf, (unsigned)(DFF + c0) * 4u), b1 = gld<f32x4>(wf, (unsigned)(DFF + c0) * 4u + 16),
                      d0 = gld<f32x4>(wf, (unsigned)(2 * DFF + c0) * 4u), d1 = gld<f32x4>(wf, (unsigned)(2 * DFF + c0) * 4u + 16);
#pragma unroll
          for (int j = 0; j < 4; ++j) { w0[j] = a0[j]; w0[4 + j] = a1[j]; w1[j] = b0[j]; w1[4 + j] = b1[j]; w2[j] = d0[j]; w2[4 + j] = d1[j]; } }
        const unsigned rowb = (unsigned)((u.pm >> 3) * 2048 + (u.pm & 7) * 8 + 2 * wr);
#pragma unroll
        for (int ai = 0; ai < 2; ++ai)
#pragma unroll
            for (int m = 0; m < 4; ++m) {
                float o[8];
#pragma unroll
                for (int n = 0; n < 2; ++n)
#pragma unroll
                    for (int e = 0; e < 4; ++e) {
                        const float a = acc[ai][0][m][n][e];
                        const float oprev = (m & 1) ? acc[ai][0][m - 1 < 0 ? 0 : m - 1][n][e] : 0.f, onext = (m & 1) ? 0.f : acc[ai][0][m + 1 > 3 ? 3 : m + 1][n][e];
                        const float pv = shl_(fr == 15 ? oprev : a, lprev), nx = shl_(fr == 0 ? onext : a, lnext);
                        o[4 * n + e] = siluf_(w0[4 * n + e] * pv + w1[4 * n + e] * a + w2[4 * n + e] * nx) * acc[ai][1][m][n][e];
                    }
                const unsigned row = rowb + (unsigned)((16 * (m & 1) + fr) * 64 + 4 * ai + (m >> 1));
                gst<u32x4>(ACT, (row * (unsigned)DFF + (unsigned)c0) * 2u, pack8(o));
            }
    }
};
struct EpiResid {
    static constexpr bool PERM = true, HOOK = false;
    int l, which, fuse; float scale;
    __device__ __forceinline__ void operator()(f32x4 (&acc)[2][2][4][2], const pg8::Unit& u, int wr, int wc, int fr, int fq) const {
        CParams& p = *okp(); unsigned char* const ws = ows(p.ws);
        float* H = (float*)(ws + OFF_H); const float* Hin = (l == 0 && which == 0) ? p.x : H;
        const float* mod = (const float*)(ws + OFF_MOD) + (size_t)l * 5 * 6 * D; const float* gate = mod + (which ? 5 : 2) * D;
        if (u.ks >= 0) { float* slab = (float*)(ws + OFF_SLAB); const unsigned sb = (unsigned)u.ks * (unsigned)(RC * D);
            epi_foreach(acc, u, wr, wc, fr, fq, [&](int row, int col, f32x4 v0, f32x4 v1) { const unsigned o = (sb + (unsigned)((row - RL) * D + col)) * 4u; gst<f32x4>(slab, o, v0); gst<f32x4>(slab, o + 16, v1); });
            return; }
        const unsigned gb = (unsigned)(u.pm < 32 ? (u.pm >> 3) : 4) * (6 * D) * 4u;
        if (!fuse || u.pm >= 32) {
            epi_foreach(acc, u, wr, wc, fr, fq, [&](int row, int col, f32x4 v0, f32x4 v1) {
                const unsigned ho = (unsigned)(row * D + col) * 4u;
                const f32x4 g0 = gld<f32x4>(gate, gb + (unsigned)col * 4u), g1 = gld<f32x4>(gate, gb + (unsigned)col * 4u + 16);
                gst<f32x4>(H, ho, gld<f32x4>(Hin, ho) + g0 * v0 * scale); gst<f32x4>(H, ho + 16, gld<f32x4>(Hin, ho + 16) + g1 * v1 * scale); });
            return; }
        bf16_t* XN = (bf16_t*)(ws + OFF_XN); const float* nw = fuse == 2 ? p.final_norm_w : which ? p.norm1_w + (size_t)(l + 1) * D : p.norm2_w + (size_t)l * D;
        const float* nmod = which ? mod + 5 * 6 * D : mod + 3 * D;
        float* xs = (float*)(ws + OFF_XS) + (size_t)(2 * l + which) * RL * 32; unsigned* cnt = (unsigned*)(ws + OFF_CTL) + CNTW + (2 * l + which) * 32 * 64;
        int lane; asm volatile("v_mbcnt_lo_u32_b32 %0, -1, 0\n\tv_mbcnt_hi_u32_b32 %0, -1, %0" : "=v"(lane));
        { const int fr2 = lane & 15, fq2 = lane >> 4, row0 = u.pm * 256 + wr * 64 + fr2, col0 = u.pn * 256 + wc * 32 + 8 * fq2;
          f32x4 gv[2][2];
#pragma unroll
          for (int bj = 0; bj < 2; ++bj) { gv[bj][0] = gld<f32x4>(gate, gb + (unsigned)(col0 + bj * 128) * 4u) * scale; gv[bj][1] = gld<f32x4>(gate, gb + (unsigned)(col0 + bj * 128) * 4u + 16) * scale; }
#pragma unroll
          for (int am = 0; am < 4; ++am) { const int ai = am >> 1; f32x4 hv[2][2][2];
#pragma unroll
            for (int mm = 0; mm < 2; ++mm)
#pragma unroll
                for (int bj = 0; bj < 2; ++bj) { const unsigned ho = (unsigned)((row0 + ai * 128 + (2 * (am & 1) + mm) * 16) * D + col0 + bj * 128) * 4u; hv[mm][bj][0] = gld<f32x4>(Hin, ho); hv[mm][bj][1] = gld<f32x4>(Hin, ho + 16); }
#pragma unroll
            for (int mm = 0; mm < 2; ++mm) { const int m = 2 * (am & 1) + mm; const int row = row0 + ai * 128 + m * 16; float ss = 0.f;
#pragma unroll
                for (int bj = 0; bj < 2; ++bj) { const unsigned ho = (unsigned)(row * D + col0 + bj * 128) * 4u;
                    const f32x4 h0 = hv[mm][bj][0] + gv[bj][0] * acc[ai][bj][m][0], h1 = hv[mm][bj][1] + gv[bj][1] * acc[ai][bj][m][1];
                    gst<f32x4>(H, ho, h0); gst<f32x4>(H, ho + 16, h1);
                    ss += (h0[0] * h0[0] + h0[1] * h0[1]) + (h0[2] * h0[2] + h0[3] * h0[3]) + (h1[0] * h1[0] + h1[1] * h1[1]) + (h1[2] * h1[2] + h1[3] * h1[3]); }
                ss += shx(ss, 16, lane); ss += shx(ss, 32, lane);
                if (fq2 == 0) __hip_atomic_store((GAS float*)xs + (row * 32 + u.pn * 4 + wc), ss, __ATOMIC_RELAXED, __HIP_MEMORY_SCOPE_AGENT);
            } } }
        asm volatile("s_waitcnt vmcnt(0)" ::: "memory");
        __builtin_amdgcn_s_barrier();
        if (lane == 0 && wr == 0 && wc == 0) {
            GAS unsigned* pc = (GAS unsigned*)cnt + 64 * u.pm;
            (void)__hip_atomic_fetch_add(pc, 1u, __ATOMIC_RELAXED, __HIP_MEMORY_SCOPE_AGENT);
            unsigned spins = 0;
            while (__hip_atomic_load(pc, __ATOMIC_RELAXED, __HIP_MEMORY_SCOPE_AGENT) < 8u && ++spins < (1u << 22)) __builtin_amdgcn_s_sleep(1);
        }
        __builtin_amdgcn_s_barrier();
        __builtin_amdgcn_fence(__ATOMIC_ACQUIRE, "agent");
        { const int hl = lane & 31, row0 = u.pm * 256 + (wr * 4 + wc) * 32 + (lane >> 5), col = u.pn * 256 + hl * 8;
          const unsigned mo = (unsigned)(u.pm >> 3) * (6 * D) * 4u, co = (unsigned)col * 4u;
          const f32x4 w0 = gld<f32x4>(nw, co), w1 = gld<f32x4>(nw, co + 16);
          if (fuse == 2) { float* out = p.out;
#pragma unroll
            for (int ib = 0; ib < 4; ++ib) { float tt[4]; f32x4 ha[4], hb[4];
#pragma unroll
              for (int i = 0; i < 4; ++i) { const int row = row0 + 2 * (4 * ib + i); const unsigned ho = (unsigned)(row * D + col) * 4u;
                  tt[i] = gld<float>(xs, (unsigned)(row * 32 + hl) * 4u); ha[i] = gld<f32x4>(H, ho); hb[i] = gld<f32x4>(H, ho + 16); }
#pragma unroll
              for (int i = 0; i < 4; ++i) { const int row = row0 + 2 * (4 * ib + i); const unsigned ho = (unsigned)(row * D + col) * 4u; float tot = tt[i];
#pragma unroll
                  for (int o = 1; o < 32; o <<= 1) tot += shx(tot, o, lane);
                  const float rstd = rsqrtf(tot * (1.f / D) + EPS);
                  gst<f32x4>(out, ho, ha[i] * rstd * w0); gst<f32x4>(out, ho + 16, hb[i] * rstd * w1); } }
            return; }
          const f32x4 sh0 = gld<f32x4>(nmod, mo + co), sh1 = gld<f32x4>(nmod, mo + co + 16);
          const f32x4 sc0 = gld<f32x4>(nmod, mo + D * 4 + co) + 1.f, sc1 = gld<f32x4>(nmod, mo + D * 4 + co + 16) + 1.f;
#pragma unroll
          for (int ib = 0; ib < 4; ++ib) { float tt[4]; f32x4 ha[4], hb[4];
#pragma unroll
            for (int i = 0; i < 4; ++i) { const int row = row0 + 2 * (4 * ib + i); const unsigned ho = (unsigned)(row * D + col) * 4u;
                tt[i] = gld<float>(xs, (unsigned)(row * 32 + hl) * 4u); ha[i] = gld<f32x4>(H, ho); hb[i] = gld<f32x4>(H, ho + 16); }
#pragma unroll
            for (int i = 0; i < 4; ++i) { const int row = row0 + 2 * (4 * ib + i); float tot = tt[i];
#pragma unroll
                for (int o = 1; o < 32; o <<= 1) tot += shx(tot, o, lane);
                const float rstd = rsqrtf(tot * (1.f / D) + EPS);
                const f32x4 y0 = (ha[i] * rstd * w0) * sc0 + sh0, y1 = (hb[i] * rstd * w1) * sc1 + sh1;
                gst<u32x4>(XN, (unsigned)(row * D + col) * 2u, pack8v(y0, y1)); } } }
    }
};

__device__ __forceinline__ bf16x8 gather8(const bf16_t* p, size_t stride) {
    bf16x8 v;
#pragma unroll
    for (int j = 0; j < 8; ++j) v[j] = (short)p[(size_t)j * stride];
    return v;
}
template <bool AV, bool BV>
__device__ __forceinline__ void wave_mm32(const bf16_t* A, size_t sam, size_t sak, const bf16_t* B, size_t sbk, size_t sbn, int K, f32x4 (&acc)[2][2], int lane) {
    const int fr = lane & 15, fq = lane >> 4;
    for (int k0 = 0; k0 < K; k0 += 32) {
        bf16x8 a[2], b[2];
#pragma unroll
        for (int mi = 0; mi < 2; ++mi) { const bf16_t* q = A + (size_t)(16 * mi + fr) * sam + (size_t)(k0 + 8 * fq) * sak; a[mi] = AV ? *(const bf16x8*)q : gather8(q, sak); }
#pragma unroll
        for (int ni = 0; ni < 2; ++ni) { const bf16_t* q = B + (size_t)(16 * ni + fr) * sbn + (size_t)(k0 + 8 * fq) * sbk; b[ni] = BV ? *(const bf16x8*)q : gather8(q, sbk); }
#pragma unroll
        for (int mi = 0; mi < 2; ++mi)
#pragma unroll
            for (int ni = 0; ni < 2; ++ni) acc[mi][ni] = __builtin_amdgcn_mfma_f32_16x16x32_bf16(a[mi], b[ni], acc[mi][ni], 0, 0, 0);
    }
}
#define ZERO_ACC22(acc) do { _Pragma("unroll") for (int _a = 0; _a < 2; ++_a) _Pragma("unroll") for (int _b = 0; _b < 2; ++_b) acc[_a][_b] = (f32x4){0.f, 0.f, 0.f, 0.f}; } while (0)

__device__ __forceinline__ void transpose_item(const float* W, int N, int pitch, int kdst0, bf16_t* WT, int dst_row0, int src_col0, int nvalid, int k0, LAS float* scr, int lane) {
    const int n4 = (lane & 15) * 4, kq = lane >> 4;
    f32x4 v[16];
#pragma unroll
    for (int i = 0; i < 16; ++i) v[i] = n4 < nvalid ? gld<f32x4>(W, (unsigned)((k0 + 4 * i + kq) * N + src_col0 + n4) * 4u) : (f32x4){0.f, 0.f, 0.f, 0.f};
#pragma unroll
    for (int i = 0; i < 16; ++i) { LAS float* d = scr + (4 * i + kq) * 65 + n4; d[0] = v[i][0]; d[1] = v[i][1]; d[2] = v[i][2]; d[3] = v[i][3]; }
    asm volatile("s_waitcnt lgkmcnt(0)" ::: "memory");
    const int c = lane & 7;
#pragma unroll
    for (int j8 = 0; j8 < 8; ++j8) { const int n = (lane >> 3) + 8 * j8; const LAS float* sp = scr + (8 * c) * 65 + n;
        u32x4 o; o.x = pk2(sp[0 * 65], sp[1 * 65]); o.y = pk2(sp[2 * 65], sp[3 * 65]); o.z = pk2(sp[4 * 65], sp[5 * 65]); o.w = pk2(sp[6 * 65], sp[7 * 65]);
        gst<u32x4>(WT, (unsigned)((dst_row0 + n) * pitch + kdst0 + k0 + 8 * c) * 2u, o); }
    asm volatile("s_waitcnt lgkmcnt(0)" ::: "memory");
}
constexpr int I_IN = (NINP / 64) * (D / 64), I_PM = (D / 64) * (DM / 64), I_PF = (D / 64) * (DF / 64), I_PC = (D / 64) * (DC / 64), I_O = (D / 64) * (D / 64),
              I_UP = (NUP / 64) * (D / 64), I_DN = (D / 64) * (DFF / 64), I_LAYER = I_IN + I_PM + I_PF + I_PC + I_O + I_UP + I_DN;
__device__ __forceinline__ void ph_convert(int wv, LAS unsigned char* lds, int l, int widx, int nwg, int it_lo, int it_hi) {
    CParams& p = *okp();
    unsigned char* const wsb = ows(p.ws);
    const int TIDX = otid(wv);
    const int lane = TIDX & 63, wave = wv;
    LAS float* scr = (LAS float*)lds + wave * 64 * 65;
    const int gw = widx * 8 + wave, NGW = nwg * 8;
    for (int it = it_lo + gw; it < it_hi; it += NGW) {
        int r = it;
        if (r < I_IN) { const int nkb = D / 64, kb = r % nkb, grp = r / nkb, j0 = 64 * grp; int src0, nv;
            if (j0 < 2048) { src0 = j0; nv = 64; } else if (j0 < NP) { src0 = j0 + 16; nv = 64; } else if (j0 == NP) { src0 = 2048; nv = 16; } else { src0 = 0; nv = 0; }
            transpose_item(p.w_in + (size_t)l * D * NIN, NIN, D, 0, WSP(bf16_t, OFF_WIN) + (size_t)l * NINP * D, j0, src0, nv, 64 * kb, scr, lane); continue; } r -= I_IN;
        if (r < I_PM) { const int nkb = DM / 64, kb = r % nkb, grp = r / nkb;
            transpose_item(p.w_pm + (size_t)l * DM * D, D, D, 0, WSP(bf16_t, OFF_WPM) + (size_t)l * D * D, 64 * grp, 64 * grp, 64, 64 * kb, scr, lane); continue; } r -= I_PM;
        if (r < I_PF) { const int nkb = DF / 64, kb = r % nkb, grp = r / nkb;
            transpose_item(p.w_pf + (size_t)l * DF * D, D, D, DM, WSP(bf16_t, OFF_WPM) + (size_t)l * D * D, 64 * grp, 64 * grp, 64, 64 * kb, scr, lane); continue; } r -= I_PF;
        if (r < I_PC) { const int nkb = DC / 64, kb = r % nkb, grp = r / nkb;
            transpose_item(p.w_pc + (size_t)l * DC * D, D, D, DM + DF, WSP(bf16_t, OFF_WPM) + (size_t)l * D * D, 64 * grp, 64 * grp, 64, 64 * kb, scr, lane); continue; } r -= I_PC;
        if (r < I_O) { const int nkb = D / 64, kb = r % nkb, grp = r / nkb;
            transpose_item(p.w_o + (size_t)l * D * D, D, D, 0, WSP(bf16_t, OFF_WO) + (size_t)l * D * D, 64 * grp, 64 * grp, 64, 64 * kb, scr, lane); continue; } r -= I_O;
        if (r < I_UP) { const int nkb = D / 64, kb = r % nkb, grp = r / nkb, j0 = 64 * grp, tile = j0 >> 8, w0 = j0 & 255;
            transpose_item(p.w_up + (size_t)l * D * NUP, NUP, D, 0, WSP(bf16_t, OFF_WUP) + (size_t)l * NUP * D, j0, w0 < 128 ? 128 * tile + w0 : DFF + 128 * tile + (w0 - 128), 64, 64 * kb, scr, lane); continue; } r -= I_UP;
        { const int nkb = DFF / 64, kb = r % nkb, grp = r / nkb;
            transpose_item(p.w_down + (size_t)l * DFF * D, D, DFF, 0, WSP(bf16_t, OFF_WDN) + (size_t)l * D * DFF, 64 * grp, 64 * grp, 64, 64 * kb, scr, lane); }
    }
}
__device__ __forceinline__ void ph_tables(int wv) {
    CParams& p = *okp();
    unsigned char* const wsb = ows(p.ws);
    const int TIDX = otid(wv), BIDX = obid(); (void)TIDX; (void)BIDX;
    const size_t gt = (size_t)BIDX * 512 + TIDX, NT = (size_t)gridDim.x * 512;
    bf16_t* ma = WSP(bf16_t, OFF_MA);
    for (size_t i = gt; i < (size_t)64 * 64; i += NT) { const int row = (int)(i >> 6), col = (int)(i & 63), ro = row >> 5, tau1 = row & 31, ri = col >> 5, t1 = col & 31;
        const float a = (float)((t1 * tau1) & 31) * (1.0f / 16.0f); const float cv = cospif(a), sv = sinpif(a);
        ma[i] = (bf16_t)f2bf(ro == ri ? cv : (ro == 0 ? sv : -sv)); }
    bf16_t* mc = WSP(bf16_t, OFF_MC);
    for (size_t i = gt; i < (size_t)32 * 64 * 128; i += NT) { const int k = (int)(i & 127), tau2 = (int)(i >> 7) & 63, tau1 = (int)(i >> 13), ri = k >> 6, t2 = k & 63, tau = tau1 + 32 * tau2;
        const float a = (float)((t2 * tau) & 2047) * (1.0f / 1024.0f); mc[i] = (bf16_t)f2bf((ri ? sinpif(a) : cospif(a)) * (1.0f / 512.0f)); }
    bf16_t* csc = WSP(bf16_t, OFF_CSC);
    for (size_t i = gt; i < (size_t)256 * 512; i += NT) { const int tau = (int)(i >> 9), k = (int)(i & 511), t = k & 255; const int idx = (tau * t) & 255;
        const float a = (float)idx * (1.0f / 128.0f); const float v = (k < 256 ? cospif(a) : -sinpif(a)) * 0.005524271728019903f  ; csc[i] = (bf16_t)f2bf(v); }
    bf16_t* ft = WSP(bf16_t, OFF_FT);
    for (size_t i = gt; i < (size_t)256 * 128; i += NT) { const int kp = (int)(i >> 7), c = (int)(i & 127), kap = kp & 127; const int idx = (c * kap) & 127;
        const float a = (float)idx * (1.0f / 64.0f); ft[i] = (bf16_t)f2bf(kp < 128 ? cospif(a) : sinpif(a)); }
    float* binr = WSP(float, OFF_BINR);
    for (size_t i = gt; i < (size_t)DEPTH * NINP; i += NT) { const int l = (int)(i / NINP), j = (int)(i % NINP);
        float v = 0.f; if (j < 2048) v = p.b_in[(size_t)l * NIN + j]; else if (j < NP) v = p.b_in[(size_t)l * NIN + j + 16]; else if (j < NP + 16) v = p.b_in[(size_t)l * NIN + 2048 + (j - NP)];
        binr[i] = v; }

}
__device__ __forceinline__ void ph_mod(int wv, LAS unsigned char* lds, int l0, int l1, int widx, int nwg) {
    CParams& p = *okp();
    unsigned char* const wsb = ows(p.ws);
    const int TIDX = otid(wv), BIDX = obid(); (void)TIDX; (void)BIDX;
    typedef float sc_row_t[D]; typedef f32x4 red_t[5][16];
    LAS sc_row_t* sc = (LAS sc_row_t*)lds; LAS red_t* red = (LAS red_t*)(lds + 5 * D * 4);
    const int tid = TIDX;
    for (int i = tid; i < 5 * D; i += 512) { const int j = i / D, k = i % D; const float v = j < 4 ? p.c[(size_t)j * D + k] : p.c_ctx[k]; sc[j][k] = siluf_(v); }
    __syncthreads();
    float* mod = WSP(float, OFF_MOD);
    const int cl = tid & 15, kg = tid >> 4;
    for (int unit = widx; unit < (l1 - l0) * (6 * D / 64); unit += nwg) {
        const int l = l0 + unit / (6 * D / 64), n0 = (unit % (6 * D / 64)) * 64;
        f32x4 a[5];
#pragma unroll
        for (int j = 0; j < 5; ++j) a[j] = (f32x4){0.f, 0.f, 0.f, 0.f};
        const float* wp = p.w_mod + (size_t)l * D * 6 * D + n0 + 4 * cl;
        for (int k = kg; k < D; k += 32) { const f32x4 w = *(const f32x4*)(wp + (size_t)k * 6 * D);
#pragma unroll
            for (int j = 0; j < 5; ++j) a[j] += sc[j][k] * w; }
#pragma unroll
        for (int j = 0; j < 5; ++j) {
#pragma unroll
            for (int e = 0; e < 4; ++e) { float v = a[j][e]; v += shx(v, 16, tid & 63); v += shx(v, 32, tid & 63); a[j][e] = v; }
            if ((tid & 63) < 16) red[tid >> 6][j][cl] = a[j]; }
        __syncthreads();
        if (tid < 5 * 64) { const int j = tid / 64, cc = tid % 64; float s = 0.f;
            for (int g = 0; g < 8; ++g) s += ((const LAS float*)&red[g][j][0])[cc];
            mod[((size_t)l * 5 + j) * 6 * D + n0 + cc] = s + p.b_mod[(size_t)l * 6 * D + n0 + cc]; }
        __syncthreads();
    }
}

__device__ __forceinline__ void ph_norm(int wv, int l, int which, const float* fixgate, int row_lo, int nrows, const float* hlat, const float* hctx) {
    CParams& p = *okp();
    unsigned char* const wsb = ows(p.ws);
    const int TIDX = otid(wv), BIDX = obid();
    const int lane = TIDX & 63, gw = BIDX * 8 + (TIDX >> 6), NGW = gridDim.x * 8;
    const float* nw = (which ? p.norm2_w : p.norm1_w) + (size_t)l * D;
    const float* mod = WSP(float, OFF_MOD) + (size_t)l * 5 * 6 * D;
    float* H = WSP(float, OFF_H); bf16_t* XN = WSP(bf16_t, OFF_XN); const float* SL = WSP(float, OFF_SLAB);
    for (int r = row_lo + gw; r < nrows; r += NGW) {
        int mj, t, T; rowinfo(r, mj, t, T);
        const unsigned so = (unsigned)(mj * 6 * D + (which ? 3 : 0) * D) * 4u;
        const unsigned ho = (unsigned)(r * D + 4 * lane) * 4u;
        const float* rd = r < RL ? hlat : hctx; const unsigned ro = (unsigned)((r < RL ? r : r - RL) * D + 4 * lane) * 4u;
        f32x4 v[8]; float ss = 0.f;
#pragma unroll
        for (int j = 0; j < 8; ++j) v[j] = gld<f32x4>(rd, ro + (unsigned)j * 1024u);
        if (fixgate != nullptr && r >= RL) {
#pragma unroll
            for (int j = 0; j < 8; ++j) { f32x4 sp[8];
#pragma unroll
                for (int sl = 0; sl < 8; ++sl) sp[sl] = gld<f32x4>(SL, (unsigned)((sl * RC + (r - RL)) * D + 4 * lane + 256 * j) * 4u);
                const f32x4 fg = gld<f32x4>(fixgate, (unsigned)(4 * lane + 256 * j) * 4u);
                f32x4 a = sp[0];
#pragma unroll
                for (int sl = 1; sl < 8; ++sl) a += sp[sl];
                v[j] += fg * a; }
#pragma unroll
            for (int j = 0; j < 8; ++j) gst<f32x4>(H, ho + (unsigned)j * 1024u, v[j]);
        }
#pragma unroll
        for (int j = 0; j < 8; ++j) ss += (v[j][0] * v[j][0] + v[j][1] * v[j][1]) + (v[j][2] * v[j][2] + v[j][3] * v[j][3]);
        const float rstd = rsqrtf(wave_sum(ss, lane) * (1.f / D) + EPS);
#pragma unroll
        for (int j = 0; j < 8; ++j) { const unsigned co = (unsigned)(4 * (lane + 64 * j)) * 4u;
            const f32x4 w = gld<f32x4>(nw, co), sc = gld<f32x4>(mod, so + D * 4 + co), sh = gld<f32x4>(mod, so + co);
            const f32x4 y = (v[j] * rstd * w) * (1.f + sc) + sh;
            u32x2 q; q.x = pk2(y[0], y[1]); q.y = pk2(y[2], y[3]); gst<u32x2>(XN, (unsigned)(r * D + 4 * (lane + 64 * j)) * 2u, q); }
    }
}
__device__ __forceinline__ void ph_final(int wv) {
    CParams& p = *okp();
    unsigned char* const wsb = ows(p.ws);
    const int TIDX = otid(wv), BIDX = obid(); (void)TIDX; (void)BIDX;
    const int lane = TIDX & 63, gw = BIDX * 8 + (TIDX >> 6), NGW = gridDim.x * 8;
    const float* H = WSP(float, OFF_H);
    for (int r = gw; r < RL; r += NGW) {
        const f32x4* xr = (const f32x4*)(H + (size_t)r * D) + lane;
        f32x4 v[8]; float ss = 0.f;
#pragma unroll
        for (int j = 0; j < 8; ++j) { v[j] = xr[64 * j]; ss += (v[j][0] * v[j][0] + v[j][1] * v[j][1]) + (v[j][2] * v[j][2] + v[j][3] * v[j][3]); }
        const float rstd = rsqrtf(wave_sum(ss, lane) * (1.f / D) + EPS);
        f32x4* o = (f32x4*)(p.out + (size_t)r * D) + lane;
#pragma unroll
        for (int j = 0; j < 8; ++j) { const f32x4 w = *(const f32x4*)(p.final_norm_w + 4 * (lane + 64 * j)); o[64 * j] = v[j] * rstd * w; }
    }
}

__device__ __forceinline__ float wave_incl_sum(float v, int lane) {
#pragma unroll
    for (int o = 1; o < 64; o <<= 1) { const float t = shl_(v, lane >= o ? lane - o : lane); if (lane >= o) v += t; }
    return v;
}
__device__ __forceinline__ float wave_incl_max(float v, int lane) {
#pragma unroll
    for (int o = 1; o < 64; o <<= 1) { const float t = shl_(v, lane >= o ? lane - o : lane); if (lane >= o) v = fmaxf(v, t); }
    return v;
}
__device__ __forceinline__ float logsigmoidf_(float x) { return fminf(x, 0.f) - log1pf(__expf(-fabsf(x))); }
struct GateV { float b0, b1, c0, c1, m0, m1, bend, cend; int s0, s1; };
__device__ __forceinline__ GateV gate_vectors(const float* G, int row0, int h, int dir, int lane) {
    GateV g; g.s0 = dir ? 127 - lane : lane; g.s1 = dir ? 63 - lane : lane + 64;
    const unsigned o0 = (unsigned)((row0 + g.s0) * 16 + dir * 8 + h) * 4u, o1 = (unsigned)((row0 + g.s1) * 16 + dir * 8 + h) * 4u;
    const float i0 = gld<float>(G, o0), f0 = gld<float>(G, o0 + 16), i1 = gld<float>(G, o1), f1 = gld<float>(G, o1 + 16);
    g.b0 = wave_incl_sum(logsigmoidf_(f0), lane); const float tot0 = shl_(g.b0, 63 + (lane & 0));
    g.b1 = wave_incl_sum(logsigmoidf_(f1), lane) + tot0;
    g.c0 = i0 - g.b0; g.c1 = i1 - g.b1;
    g.m0 = wave_incl_max(g.c0, lane); const float mx0 = shl_(g.m0, 63 + (lane & 0));
    g.m1 = fmaxf(wave_incl_max(g.c1, lane), mx0);
    g.bend = shl_(g.b1, 63 + (lane & 0)); g.cend = shl_(g.m1, 63 + (lane & 0));
    return g;
}
__device__ __forceinline__ void ph_convc(int wv, int l, int nrows, int widx, int nwg) {
    CParams& p = *okp();
    unsigned char* const wsb = ows(p.ws);
    const unsigned gt = (unsigned)widx * 512u + otid(wv), NT = (unsigned)nwg * 512u;
    const bf16_t* P = WSP(bf16_t, OFF_P); bf16_t* YC = WSP(bf16_t, OFF_HM) + (DM + DF);
    const float* wc = p.conv_c_w + (size_t)l * 3 * DC;
    for (unsigned i = gt; i < (unsigned)nrows * 64u; i += NT) {
        const int r = (int)(i >> 6), c = (int)(i & 63) * 8; int mj, t, T; rowinfo(r, mj, t, T);
        const unsigned pr = (unsigned)(r * NP) * 2u;
        const bool cp = r < RL ? (t & 63) > 0 : t > 0, cn = r < RL ? (t & 63) < 63 : t < T - 1;
        float x0[8], x1[8], y0[8], y1[8], z0[8], z1[8], cb[8], o[8];
        unpack8(gld<u32x4>(P, pr + (PCC + c) * 2), x0); unpack8(gld<u32x4>(P, pr + (PCX + c) * 2), x1); unpack8(gld<u32x4>(P, pr + (PCB + c) * 2), cb);
        const unsigned pp = cp ? pr - NP * 2 : pr, pn = cn ? pr + NP * 2 : pr;
        unpack8(gld<u32x4>(P, pp + (PCC + c) * 2), y0); unpack8(gld<u32x4>(P, pp + (PCX + c) * 2), y1);
        unpack8(gld<u32x4>(P, pn + (PCC + c) * 2), z0); unpack8(gld<u32x4>(P, pn + (PCX + c) * 2), z1);
        const f32x4 w00 = gld<f32x4>(wc, (unsigned)c * 4u), w01 = gld<f32x4>(wc, (unsigned)c * 4u + 16), w10 = gld<f32x4>(wc, (unsigned)(DC + c) * 4u), w11 = gld<f32x4>(wc, (unsigned)(DC + c) * 4u + 16),
                    w20 = gld<f32x4>(wc, (unsigned)(2 * DC + c) * 4u), w21 = gld<f32x4>(wc, (unsigned)(2 * DC + c) * 4u + 16);
#pragma unroll
        for (int j = 0; j < 8; ++j) { const float w0 = j < 4 ? w00[j & 3] : w01[j & 3], w1 = j < 4 ? w10[j & 3] : w11[j & 3], w2 = j < 4 ? w20[j & 3] : w21[j & 3];
            float v = w1 * (x0[j] * x1[j]); if (cp) v += w0 * (y0[j] * y1[j]); if (cn) v += w2 * (z0[j] * z1[j]); o[j] = cb[j] * v; }
        gst<u32x4>(YC, (unsigned)(r * D + c) * 2u, pack8(o));
    }
}
__device__ __forceinline__ void ph_fourier1(int wv, int widx, int nwg) {
    CParams& p = *okp();
    unsigned char* const wsb = ows(p.ws);
    const int TIDX = otid(wv), BIDX = obid(); (void)TIDX; (void)BIDX;
    const int lane = TIDX & 63, gw = widx * 8 + (TIDX >> 6), NGW = nwg * 8, fr = lane & 15, fq = lane >> 4;
    const bf16_t* P = WSP(bf16_t, OFF_P); const bf16_t* FT = WSP(bf16_t, OFF_FT);
    bf16_t* ZTC = WSP(bf16_t, OFF_ZTC);
    for (int task = gw; task < (RC / 32) * 4 * 8; task += NGW) {
        const int kb = task & 7, g = (task >> 3) & 3, rb = task >> 5, r0 = RL + rb * 32;
        f32x4 acc[2][2]; ZERO_ACC22(acc);
        wave_mm32<true, true>(P + (size_t)r0 * NP + PF + g * 128, NP, 1, FT + (size_t)(kb * 32) * 128, 1, 128, 128, acc, lane);
#pragma unroll
        for (int mi = 0; mi < 2; ++mi)
#pragma unroll
            for (int ni = 0; ni < 2; ++ni) {
                const int r = r0 + 16 * mi + 4 * fq, kp = kb * 32 + 16 * ni + fr, comp = kp >> 7, kap = kp & 127;
                u32x2 w; w.x = pk2(acc[mi][ni][0], acc[mi][ni][1]); w.y = pk2(acc[mi][ni][2], acc[mi][ni][3]);
                { const int q = r - RL, b = q >> 8, t = q & 255; *(u32x2*)(ZTC + (size_t)((b * 4 + g) * 128 + kap) * 512 + comp * 256 + t) = w; }
            }
    }
}
template <bool FIRST> __device__ __forceinline__ f32x4 mma16(bf16x8 a, bf16x8 b, f32x4 c) {
    if constexpr (FIRST) return __builtin_amdgcn_mfma_f32_16x16x32_bf16(a, b, (f32x4){0.f, 0.f, 0.f, 0.f}, 0, 0, 0);
    else return __builtin_amdgcn_mfma_f32_16x16x32_bf16(a, b, c, 0, 0, 0);
}
typedef short s16x4 __attribute__((ext_vector_type(4)));
constexpr int PIT_T = 544;
constexpr int PIT_R = 528;
constexpr int PIT_P = 272;
__device__ __forceinline__ bf16x8 tr_frag(LAS unsigned char* img, int pitchB, int r0, int c0, int lane) {
    const int g = lane >> 4, q = (lane & 15) >> 2, pp = lane & 3;
    LAS unsigned char* a = img + (r0 + 8 * g + q) * pitchB + (c0 + 4 * pp) * 2;
    const s16x4 lo = __builtin_amdgcn_ds_read_tr16_b64_v4i16((LAS s16x4*)a);
    const s16x4 hi = __builtin_amdgcn_ds_read_tr16_b64_v4i16((LAS s16x4*)(a + 4 * pitchB));
    return (bf16x8){lo[0], lo[1], lo[2], lo[3], hi[0], hi[1], hi[2], hi[3]};
}
template <class F> __device__ __forceinline__ void conv_silu_rows(const u32x4 (&raw)[10], const float (&w0)[8], const float (&w1)[8], const float (&w2)[8], F&& f) {
    float a[8], b[8], c[8];
    unpack8(raw[0], a); unpack8(raw[1], b);
#pragma unroll
    for (int i = 0; i < 8; ++i) {
        unpack8(raw[i + 2], c);
        float o[8];
#pragma unroll
        for (int j = 0; j < 8; ++j) o[j] = siluf_(w0[j] * a[j] + w1[j] * b[j] + w2[j] * c[j]);
        f(i, o);
#pragma unroll
        for (int j = 0; j < 8; ++j) { a[j] = b[j]; b[j] = c[j]; }
    }
}
constexpr int FPIT = 2336;
__device__ __forceinline__ void ph_fft(int wv, LAS unsigned char* lds, int u0, int ustride) {
    CParams& p = *okp();
    unsigned char* const wsb = ows(p.ws);
    const bf16_t* P = WSP(bf16_t, OFF_P); const bf16_t* FT = WSP(bf16_t, OFF_FT); const bf16_t* MA = WSP(bf16_t, OFF_MA); const bf16_t* MC = WSP(bf16_t, OFF_MC); bf16_t* HM = WSP(bf16_t, OFF_HM);
    LAS unsigned char* IMG = lds;
    const int wave = wv;
    for (int unit = u0; unit < NB * 4 * 8; unit += ustride) {
        const int kb = unit & 7, g = (unit >> 3) & 3, b = unit >> 5, kap0 = 16 * kb;
        {
            const int tid = otid(wv), lane = tid & 63, fr = lane & 15, fq = lane >> 4;
            bf16x8 fb[2][4];
#pragma unroll
            for (int ni = 0; ni < 2; ++ni)
#pragma unroll
                for (int ks = 0; ks < 4; ++ks) fb[ni][ks] = gld<bf16x8>(FT, (unsigned)((ni * 128 + kap0 + fr) * 128 + 32 * ks + 8 * fq) * 2u);
#pragma unroll 1
            for (int mi8 = 0; mi8 < 2; ++mi8) {
                bf16x8 xa[8][4];
#pragma unroll
                for (int m = 0; m < 8; ++m)
#pragma unroll
                    for (int ks = 0; ks < 4; ++ks) xa[m][ks] = gld<bf16x8>(P, (unsigned)((b * 2048 + 256 * wave + 16 * (8 * mi8 + m) + fr) * NP + PF + g * 128 + 32 * ks + 8 * fq) * 2u);
#pragma unroll
                for (int m = 0; m < 8; ++m) {
                    f32x4 zr = mma16<true>(xa[m][0], fb[0][0], zr), zi = mma16<true>(xa[m][0], fb[1][0], zi);
#pragma unroll
                    for (int ks = 1; ks < 4; ++ks) { zr = mma16<false>(xa[m][ks], fb[0][ks], zr); zi = mma16<false>(xa[m][ks], fb[1][ks], zi); }
                    const int tb = 256 * wave + 16 * (8 * mi8 + m) + 4 * fq, t1 = tb >> 6, t2 = tb & 63;
                    u32x2 wr_, wi_; wr_.x = pk2(zr[0], zr[1]); wr_.y = pk2(zr[2], zr[3]); wi_.x = pk2(-zi[0], -zi[1]); wi_.y = pk2(-zi[2], -zi[3]);
                    *(LAS u32x2*)(IMG + t1 * FPIT + fr * 144 + t2 * 2) = wr_;
                    *(LAS u32x2*)(IMG + (32 + t1) * FPIT + fr * 144 + t2 * 2) = wi_;
                }
            }
        }
        __syncthreads();
        {
            const int tid = otid(wv), lane = tid & 63, fr = lane & 15, fq = lane >> 4;
            bf16x8 ya[4][2];
#pragma unroll
            for (int mt = 0; mt < 4; ++mt)
#pragma unroll
                for (int ks = 0; ks < 2; ++ks) ya[mt][ks] = gld<bf16x8>(MA, (unsigned)((16 * mt + fr) * 64 + 32 * ks + 8 * fq) * 2u);
#pragma unroll 2
            for (int j = 0; j < 8; ++j) {
                const int grp = 8 * wave + j, c0 = (grp >> 2) * 72 + (grp & 3) * 16;
                const bf16x8 x0 = tr_frag(IMG, FPIT, 0, c0, lane), x1 = tr_frag(IMG, FPIT, 32, c0, lane);
                f32x4 d[4];
#pragma unroll
                for (int mt = 0; mt < 4; ++mt) { d[mt] = mma16<true>(x0, ya[mt][0], d[mt]); d[mt] = mma16<false>(x1, ya[mt][1], d[mt]); }
#pragma unroll
                for (int mt = 0; mt < 4; ++mt) { u32x2 w; w.x = pk2(d[mt][0], d[mt][1]); w.y = pk2(d[mt][2], d[mt][3]);
                    *(LAS u32x2*)(IMG + (16 * mt + fr) * FPIT + (c0 + 4 * fq) * 2) = w; }
            }
        }
        __syncthreads();
        {
            const int tid = otid(wv), lane = tid & 63, fr = lane & 15, fq = lane >> 4;
            bf16x8 y[4][4];
#pragma unroll
            for (int mt = 0; mt < 4; ++mt)
#pragma unroll
                for (int ks = 0; ks < 4; ++ks) y[mt][ks] = gld<bf16x8>(MC, (unsigned)((4 * wave * 64 + 16 * mt + fr) * 128 + 32 * ks + 8 * fq) * 2u);
#pragma unroll 1
            for (int q = 0; q < 4; ++q) {
                const int tau1 = 4 * wave + q, tn = q < 3 ? tau1 + 1 : tau1;
                bf16x8 yn[4][4];
#pragma unroll
                for (int mt = 0; mt < 4; ++mt)
#pragma unroll
                    for (int ks = 0; ks < 4; ++ks) yn[mt][ks] = gld<bf16x8>(MC, (unsigned)((tn * 64 + 16 * mt + fr) * 128 + 32 * ks + 8 * fq) * 2u);
                f32x4 acc[4];
#pragma unroll
                for (int ks = 0; ks < 4; ++ks) { const bf16x8 x = *(const LAS bf16x8*)(IMG + ((ks >> 1) * 32 + tau1) * FPIT + fr * 144 + (32 * (ks & 1) + 8 * fq) * 2);
#pragma unroll
                    for (int mt = 0; mt < 4; ++mt) { if (ks == 0) acc[mt] = mma16<true>(x, y[mt][ks], acc[mt]); else acc[mt] = mma16<false>(x, y[mt][ks], acc[mt]); } }
#pragma unroll
                for (int mt = 0; mt < 4; ++mt) { const int tau = tau1 + 32 * (16 * mt + fr);
                    u32x2 w; w.x = pk2(acc[mt][0], acc[mt][1]); w.y = pk2(acc[mt][2], acc[mt][3]);
                    gst<u32x2>(HM, (unsigned)((b * 2048 + tau) * D + DM + g * 128 + kap0 + 4 * fq) * 2u, w); }
#pragma unroll
                for (int mt = 0; mt < 4; ++mt)
#pragma unroll
                    for (int ks = 0; ks < 4; ++ks) y[mt][ks] = yn[mt][ks];
            }
        }
        __syncthreads();
    }
}
__device__ __forceinline__ void ph_mlstm1(int wv, int l, LAS unsigned char* lds) {
    CParams& p = *okp();
    unsigned char* const wsb = ows(p.ws);
    const int wave = wv;
    LAS unsigned char* KWs = lds; LAS unsigned char* Vs = lds + 128 * PIT_T; LAS float* vW = (LAS float*)(lds + 2 * 128 * PIT_T);
    const bf16_t* P = WSP(bf16_t, OFF_P); const float* G = WSP(float, OFF_G);
    bf16_t* UT = WSP(bf16_t, OFF_UT); float* NV = WSP(float, OFF_NV); float* CHS = WSP(float, OFF_CHS);
    const float* wk = p.conv_k_w + (size_t)l * 3 * DM;
    for (int unit = obid(); unit < NCHUNK * NH * 2; unit += gridDim.x) {
        const int tid = otid(wv), lane = tid & 63, fr = lane & 15, fq = lane >> 4, dg = tid & 31, sg = tid >> 5;
        const int dir = unit & 1, h = (unit >> 1) & 3, cidx = unit >> 3, row0 = chunk_row0(cidx);
        const bool first = cidx < 64 ? (cidx & 15) == 0 : ((cidx - 64) & 1) == 0, last = cidx < 64 ? (cidx & 15) == 15 : ((cidx - 64) & 1) == 1;
        const bf16_t* kp = P + (size_t)(row0 + 8 * sg) * NP + PK + h * DH + 8 * dg;
        u32x4 kr[10], vr[8];
#pragma unroll
        for (int i = 0; i < 10; ++i) { const int s = 8 * sg - 1 + i; const bool ok = (s >= 0 || !first) && (s < CHUNK || !last);
            kr[i] = ok ? *(const u32x4*)(kp + (ptrdiff_t)(i - 1) * NP) : (u32x4){0u, 0u, 0u, 0u}; }
#pragma unroll
        for (int i = 0; i < 8; ++i) vr[i] = *(const u32x4*)(kp + (PV - PK) + (size_t)i * NP);
        float w0[8], w1[8], w2[8];
#pragma unroll
        for (int j = 0; j < 8; ++j) { w0[j] = wk[h * DH + 8 * dg + j]; w1[j] = wk[DM + h * DH + 8 * dg + j]; w2[j] = wk[2 * DM + h * DH + 8 * dg + j]; }
        if (wave == 0)     { const GateV g = gate_vectors(G, row0, h, dir, lane); vW[g.s0] = __expf(g.c0 - g.cend); vW[g.s1] = __expf(g.c1 - g.cend);
            if (lane == 0) { CHS[(size_t)(cidx * 8 + dir * 4 + h) * 2] = g.bend; CHS[(size_t)(cidx * 8 + dir * 4 + h) * 2 + 1] = g.bend + g.cend; } }
        __syncthreads();
        conv_silu_rows(kr, w0, w1, w2, [&](int i, float (&o)[8]) { const float ws = vW[8 * sg + i];
#pragma unroll
            for (int j = 0; j < 8; ++j) o[j] *= ws;
            *(LAS u32x4*)(KWs + (8 * sg + i) * PIT_T + dg * 16) = pack8(o); });
#pragma unroll
        for (int i = 0; i < 8; ++i) *(LAS u32x4*)(Vs + (8 * sg + i) * PIT_T + dg * 16) = vr[i];
        __syncthreads();
        f32x4 acc[2][16];
        auto kstep1 = [&](int k0, auto first) {
            bf16x8 fv[2];
#pragma unroll
            for (int mi = 0; mi < 2; ++mi) fv[mi] = tr_frag(Vs, PIT_T, k0, 32 * wave + 16 * mi, lane);
#pragma unroll
            for (int ni = 0; ni < 16; ++ni) { const bf16x8 fk = tr_frag(KWs, PIT_T, k0, 16 * ni, lane);
#pragma unroll
                for (int mi = 0; mi < 2; ++mi) acc[mi][ni] = mma16<decltype(first)::value>(fk, fv[mi], acc[mi][ni]); }
        };
        kstep1(0, std::true_type{});
#pragma unroll 1
        for (int k0 = 32; k0 < CHUNK; k0 += 32) kstep1(k0, std::false_type{});
        bf16_t* out = UT + ((size_t)(cidx * NH + h) * 2 + dir) * DH * DH;
#pragma unroll
        for (int mi = 0; mi < 2; ++mi)
#pragma unroll
            for (int ni = 0; ni < 16; ++ni) { u32x2 w; w.x = pk2(acc[mi][ni][0], acc[mi][ni][1]); w.y = pk2(acc[mi][ni][2], acc[mi][ni][3]);
                *(u32x2*)(out + (size_t)(32 * wave + 16 * mi + fr) * DH + 16 * ni + 4 * fq) = w; }
        if (tid < DH) { float sum = 0.f;
#pragma unroll 8
            for (int s2 = 0; s2 < CHUNK; ++s2) sum += bf2f(*(const LAS bf16_t*)(KWs + s2 * PIT_T + tid * 2));
            NV[((size_t)(cidx * NH + h) * 2 + dir) * DH + tid] = sum; }
        __syncthreads();
    }
}
__device__ __forceinline__ void ph_mlstm2(int wv) {
    CParams& p = *okp();
    unsigned char* const wsb = ows(p.ws);
    const int tid = otid(wv);
    const bf16_t* UT = WSP(bf16_t, OFF_UT); bf16_t* CT = WSP(bf16_t, OFF_CT);
    const float *NV = WSP(float, OFF_NV), *CHS = WSP(float, OFF_CHS); float *NS = WSP(float, OFF_NS), *MST = WSP(float, OFF_MST);
    for (int task = obid(); task < NB * NH * 2 * 16; task += gridDim.x) {
        const int part = task & 15, scan = task >> 4, dir = scan & 1, h = (scan >> 1) & 3, b = scan >> 3, dh = dir * 4 + h;
        const unsigned e0 = (unsigned)(part * 4096 + olaunder(tid) * 8) * 2u;
        u32x4 u[18];
#pragma unroll
        for (int step = 0; step < 18; ++step) { const int cidx = scan_chunk(b, dir, step); u[step] = gld<u32x4>(UT, (unsigned)(((cidx * NH + h) * 2 + dir) * DH * DH) * 2u + e0); }
        float cb[18], cm[18];
#pragma unroll
        for (int step = 0; step < 18; ++step) { const int cidx = scan_chunk(b, dir, step); const f32x2 cc = gld<f32x2>(CHS, (unsigned)((cidx * 8 + dh) * 2) * 4u); cb[step] = cc[0]; cm[step] = cc[1]; }
        float C[8], m = 0.f;
        { const f32x4 z0 = zero4(), z1 = zero4();
#pragma unroll
          for (int j = 0; j < 4; ++j) { C[j] = z0[j]; C[4 + j] = z1[j]; } }
#pragma unroll
        for (int step = 0; step < 18; ++step) {
            const int cidx = scan_chunk(b, dir, step);
            gst<u32x4>(CT, (unsigned)(((cidx * NH + h) * 2 + dir) * DH * DH) * 2u + e0, pack8(C));
            const float bend = cb[step], mloc = cm[step];
            const float mn = fmaxf(bend + m, mloc), al = __expf(bend + m - mn), be = __expf(mloc - mn);
            float uu[8]; unpack8(u[step], uu);
#pragma unroll
            for (int j = 0; j < 8; ++j) C[j] = al * C[j] + be * uu[j];
            m = mn;
        }
        if (part == 0 && tid < DH) {
            float n = 0.f; m = 0.f;
            float nv[18];
#pragma unroll
            for (int step = 0; step < 18; ++step) { const int cidx = scan_chunk(b, dir, step); nv[step] = gld<float>(NV, (unsigned)(((cidx * NH + h) * 2 + dir) * DH + tid) * 4u); }
#pragma unroll
            for (int step = 0; step < 18; ++step) {
                const int cidx = scan_chunk(b, dir, step); const unsigned base = (unsigned)(((cidx * NH + h) * 2 + dir) * DH + tid) * 4u;
                gst<float>(NS, base, n); if (tid == 0) MST[cidx * 8 + dh] = m;
                const float bend = cb[step], mloc = cm[step];
                const float mn = fmaxf(bend + m, mloc), al = __expf(bend + m - mn), be = __expf(mloc - mn);
                n = al * n + be * nv[step]; m = mn;
            }
        }
    }
}
#define SECTION_LANES() const int tid = otid(wv), lane = tid & 63, fr = lane & 15, fq = lane >> 4; (void)fr; (void)fq; __builtin_amdgcn_sched_barrier(0)
__device__ __forceinline__ void ph_mlstm3(int wv, int l, LAS unsigned char* lds, int nunits) {
    CParams& p = *okp();
    unsigned char* const wsb = ows(p.ws);
    const int wave = wv;
    LAS unsigned char* Qs = lds;
    LAS unsigned char* Ks = lds + 128 * PIT_T;
    LAS unsigned char* Vs = Qs; LAS unsigned char* Ps = Ks;
    LAS float* vec = (LAS float*)(lds + 2 * 128 * PIT_T);
    LAS float *vB = vec, *vC = vec + 256, *vM = vec + 512, *nS = vec + 768, *rS = vec + 1280, *ssq = vec + 1536;
    const bf16_t* P = WSP(bf16_t, OFF_P); const float* G = WSP(float, OFF_G); const bf16_t* CT = WSP(bf16_t, OFF_CT);
    const float *NS = WSP(float, OFF_NS), *MST = WSP(float, OFF_MST); bf16_t* HM = WSP(bf16_t, OFF_HM);
    const float *wk = p.conv_k_w + (size_t)l * 3 * DM, *wq = p.conv_q_w + (size_t)l * 3 * DM, *nw = p.mlstm_norm_w + (size_t)l * DM;
    for (int unit = obid(); unit < nunits; unit += gridDim.x) {
        const int h = unit & 3, cidx = unit >> 2, row0 = chunk_row0(cidx);
        const bool first = cidx < 64 ? (cidx & 15) == 0 : ((cidx - 64) & 1) == 0, last = cidx < 64 ? (cidx & 15) == 15 : ((cidx - 64) & 1) == 1;
        {
            SECTION_LANES(); const int dg = tid & 31, sg = tid >> 5;
            nS[tid] = gld<float>(NS, (unsigned)((cidx * NH + h) * 2 * DH + tid) * 4u);
            const unsigned kp = (unsigned)((row0 + 8 * sg - 1) * NP + PK + h * DH + 8 * dg) * 2u;
            u32x4 raw[10], rawq[10]; float w0[8], w1[8], w2[8];
#pragma unroll
            for (int i = 0; i < 10; ++i) { const int s = 8 * sg - 1 + i; const bool ok = (s >= 0 || !first) && (s < CHUNK || !last);
                raw[i] = gld<u32x4>(P, ok ? kp + (unsigned)i * (NP * 2) : kp + (unsigned)(NP * 2)); if (!ok) raw[i] = (u32x4){0u, 0u, 0u, 0u}; }
#pragma unroll
            for (int i = 0; i < 10; ++i) { const int s = 8 * sg - 1 + i; const bool ok = (s >= 0 || !first) && (s < CHUNK || !last);
                rawq[i] = gld<u32x4>(P, (ok ? kp + (unsigned)i * (NP * 2) : kp + (unsigned)(NP * 2)) + (PQ - PK) * 2); if (!ok) rawq[i] = (u32x4){0u, 0u, 0u, 0u}; }
            { const unsigned wo = (unsigned)(h * DH + 8 * dg) * 4u;
              const f32x4 a0 = gld<f32x4>(wk, wo), a1 = gld<f32x4>(wk, wo + 16), b0 = gld<f32x4>(wk, wo + DM * 4), b1 = gld<f32x4>(wk, wo + DM * 4 + 16), c0 = gld<f32x4>(wk, wo + 2 * DM * 4), c1 = gld<f32x4>(wk, wo + 2 * DM * 4 + 16);
#pragma unroll
              for (int j = 0; j < 4; ++j) { w0[j] = a0[j]; w0[4 + j] = a1[j]; w1[j] = b0[j]; w1[4 + j] = b1[j]; w2[j] = c0[j]; w2[4 + j] = c1[j]; } }
            if (wave < 2) { const GateV g = gate_vectors(G, row0, h, wave, lane);
                vB[wave * 128 + g.s0] = g.b0; vB[wave * 128 + g.s1] = g.b1; vC[wave * 128 + g.s0] = g.c0; vC[wave * 128 + g.s1] = g.c1; vM[wave * 128 + g.s0] = g.m0; vM[wave * 128 + g.s1] = g.m1; }
            conv_silu_rows(raw, w0, w1, w2, [&](int i, float (&o)[8]) { *(LAS u32x4*)(Ks + (8 * sg + i) * PIT_R + dg * 16) = pack8(o); });
            { const unsigned wo = (unsigned)(h * DH + 8 * dg) * 4u;
              const f32x4 a0 = gld<f32x4>(wq, wo), a1 = gld<f32x4>(wq, wo + 16), b0 = gld<f32x4>(wq, wo + DM * 4), b1 = gld<f32x4>(wq, wo + DM * 4 + 16), c0 = gld<f32x4>(wq, wo + 2 * DM * 4), c1 = gld<f32x4>(wq, wo + 2 * DM * 4 + 16);
#pragma unroll
              for (int j = 0; j < 4; ++j) { w0[j] = a0[j]; w0[4 + j] = a1[j]; w1[j] = b0[j]; w1[4 + j] = b1[j]; w2[j] = c0[j]; w2[4 + j] = c1[j]; } }
            conv_silu_rows(rawq, w0, w1, w2, [&](int i, float (&o)[8]) {
#pragma unroll
                for (int j = 0; j < 8; ++j) o[j] *= 0.0625f;
                *(LAS u32x4*)(Qs + (8 * sg + i) * PIT_R + dg * 16) = pack8(o); });
        }
        __syncthreads();
        {
            SECTION_LANES();
            f32x4 sacc[8];
            auto kstepS = [&](int k0, auto first) {
                const bf16x8 yq = *(const LAS bf16x8*)(Qs + (16 * wave + fr) * PIT_R + (k0 + 8 * fq) * 2);
#pragma unroll
                for (int ni = 0; ni < 8; ++ni) { const bf16x8 xk = *(const LAS bf16x8*)(Ks + (16 * ni + fr) * PIT_R + (k0 + 8 * fq) * 2);
                    sacc[ni] = mma16<decltype(first)::value>(xk, yq, sacc[ni]); }
            };
            kstepS(0, std::true_type{});
#pragma unroll 1
            for (int k0 = 32; k0 < DH; k0 += 32) kstepS(k0, std::false_type{});
            const int t = 16 * wave + fr;
            const float mF = gld<float>(MST, (unsigned)(cidx * 8 + h) * 4u), mB = gld<float>(MST, (unsigned)(cidx * 8 + 4 + h) * 4u);
            const float MF = fmaxf(mF, vM[t]), MB = fmaxf(mB, vM[128 + t]);
            const float gF = __expf(mF - MF), gB = __expf(mB - MB);
            const float flF = __expf(-(vB[t] + MF)), flB = __expf(-(vB[128 + t] + MB));
            float qnF = 0.f, qnB = 0.f;
#pragma unroll
            for (int c8 = 0; c8 < 8; ++c8) { float q8[8]; unpack8(*(const LAS u32x4*)(Qs + t * PIT_R + (64 * fq + 8 * c8) * 2), q8);
                const f32x4 a0 = *(const LAS f32x4*)(nS + 64 * fq + 8 * c8), a1 = *(const LAS f32x4*)(nS + 64 * fq + 8 * c8 + 4);
                const f32x4 b0 = *(const LAS f32x4*)(nS + 256 + 64 * fq + 8 * c8), b1 = *(const LAS f32x4*)(nS + 256 + 64 * fq + 8 * c8 + 4);
#pragma unroll
                for (int j = 0; j < 4; ++j) { qnF += q8[j] * a0[j] + q8[4 + j] * a1[j]; qnB += q8[j] * b0[j] + q8[4 + j] * b1[j]; } }
            qnF += shx(qnF, 16, lane); qnF += shx(qnF, 32, lane); qnB += shx(qnB, 16, lane); qnB += shx(qnB, 32, lane);
            float sF = 0.f, sB = 0.f;
#pragma unroll
            for (int ni = 0; ni < 8; ++ni) { const f32x4 cF = *(const LAS f32x4*)(vC + 16 * ni + 4 * fq), cB = *(const LAS f32x4*)(vC + 128 + 16 * ni + 4 * fq);
#pragma unroll
                for (int rg = 0; rg < 4; ++rg) { const int s = 16 * ni + 4 * fq + rg;
                    sF += s <= t ? sacc[ni][rg] * __expf(cF[rg] - MF) : 0.f; sB += s >= t ? sacc[ni][rg] * __expf(cB[rg] - MB) : 0.f; }
                asm volatile("" : "+v"(sF), "+v"(sB)); }
            sF += shx(sF, 16, lane); sF += shx(sF, 32, lane); sB += shx(sB, 16, lane); sB += shx(sB, 32, lane);
            const float iF = 1.f / fmaxf(fabsf(gF * qnF + sF), flF), iB = 1.f / fmaxf(fabsf(gB * qnB + sB), flB);
            __syncthreads();
#pragma unroll
            for (int ni = 0; ni < 8; ++ni) { const f32x4 cF = *(const LAS f32x4*)(vC + 16 * ni + 4 * fq), cB = *(const LAS f32x4*)(vC + 128 + 16 * ni + 4 * fq);
                float pc[4];
#pragma unroll
                for (int rg = 0; rg < 4; ++rg) { const int s = 16 * ni + 4 * fq + rg;
                    pc[rg] = (s <= t ? sacc[ni][rg] * __expf(cF[rg] - MF) * iF : 0.f) + (s >= t ? sacc[ni][rg] * __expf(cB[rg] - MB) * iB : 0.f); }
                u32x2 w; w.x = pk2(pc[0], pc[1]); w.y = pk2(pc[2], pc[3]);
                *(LAS u32x2*)(Ps + t * PIT_P + (16 * ni + 4 * fq) * 2) = w; }
            if (fq == 0) { rS[t] = gF * iF; rS[128 + t] = gB * iB; }
        }
        __syncthreads();
        f32x4 tot[2][8];
        u32x4 vr[8];
        {
            SECTION_LANES();
#pragma unroll
            for (int ni = 0; ni < 2; ++ni) {
                if (ni == 1) { const int s8 = lane & 15, vq = lane >> 4; const unsigned vp = (unsigned)((row0 + 8 * s8) * NP + PV + h * DH + 32 * wave + 8 * vq) * 2u;
#pragma unroll
                    for (int i = 0; i < 8; ++i) vr[i] = gld<u32x4>(P, vp + (unsigned)i * (NP * 2)); }
                f32x4 a1[8];
                const unsigned ctf = (unsigned)((cidx * NH + h) * 2 * DH * DH + (32 * wave + 16 * ni + fr) * DH + 8 * fq) * 2u;
                bf16x8 xf = gld<bf16x8>(CT, ctf), xb = gld<bf16x8>(CT, ctf + (unsigned)(DH * DH) * 2u);
                bf16x8 xf1 = gld<bf16x8>(CT, ctf + 64u), xb1 = gld<bf16x8>(CT, ctf + (unsigned)(DH * DH) * 2u + 64u);
                auto kstepQ = [&](int k0, auto first) {
                    const unsigned kn = (unsigned)(k0 + 64 < DH ? k0 + 64 : DH - 32);
                    const bf16x8 xfn = gld<bf16x8>(CT, ctf + kn * 2u), xbn = gld<bf16x8>(CT, ctf + (unsigned)(DH * DH) * 2u + kn * 2u);
#pragma unroll
                    for (int mi = 0; mi < 8; ++mi) { const bf16x8 yq = *(const LAS bf16x8*)(Qs + (16 * mi + fr) * PIT_R + (k0 + 8 * fq) * 2);
                        tot[ni][mi] = mma16<decltype(first)::value>(xf, yq, tot[ni][mi]);
                        a1[mi] = mma16<decltype(first)::value>(xb, yq, a1[mi]); }
                    xf = xf1; xb = xb1; xf1 = xfn; xb1 = xbn;
                };
                kstepQ(0, std::true_type{});
#pragma unroll 1
                for (int k0 = 32; k0 < DH; k0 += 32) kstepQ(k0, std::false_type{});
#pragma unroll
                for (int mi = 0; mi < 8; ++mi) { const float rf = rS[16 * mi + fr], rb = rS[128 + 16 * mi + fr]; tot[ni][mi] = rf * tot[ni][mi] + rb * a1[mi]; }
            }
        }
        __syncthreads();
        u32x2 og[8][2]; f32x4 gw[2];
        {
            SECTION_LANES();
            { const int s8 = lane & 15, vq = lane >> 4;
#pragma unroll
              for (int i = 0; i < 8; ++i) *(LAS u32x4*)(Vs + (8 * s8 + i) * PIT_T + (32 * wave + 8 * vq) * 2) = vr[i]; }
            asm volatile("s_waitcnt lgkmcnt(0)" ::: "memory");
#pragma unroll
            for (int mi = 0; mi < 8; ++mi)
#pragma unroll
                for (int ni = 0; ni < 2; ++ni) og[mi][ni] = gld<u32x2>(P, (unsigned)((row0 + 16 * mi + fr) * NP + PO + h * DH + 32 * wave + 16 * ni + 4 * fq) * 2u);
#pragma unroll
            for (int ni = 0; ni < 2; ++ni) gw[ni] = gld<f32x4>(nw, (unsigned)(h * DH + 32 * wave + 16 * ni + 4 * fq) * 4u);
#pragma unroll 1
            for (int k0 = 0; k0 < CHUNK; k0 += 32) {
                bf16x8 xv[2];
#pragma unroll
                for (int ni = 0; ni < 2; ++ni) xv[ni] = tr_frag(Vs, PIT_T, k0, 32 * wave + 16 * ni, lane);
#pragma unroll
                for (int mi = 0; mi < 8; ++mi) { const bf16x8 yp = *(const LAS bf16x8*)(Ps + (16 * mi + fr) * PIT_P + (k0 + 8 * fq) * 2);
#pragma unroll
                    for (int ni = 0; ni < 2; ++ni) tot[ni][mi] = __builtin_amdgcn_mfma_f32_16x16x32_bf16(xv[ni], yp, tot[ni][mi], 0, 0, 0); }
            }
        }
        {
            SECTION_LANES();
#pragma unroll
            for (int mi = 0; mi < 8; ++mi) { float ss = 0.f;
#pragma unroll
                for (int ni = 0; ni < 2; ++ni) ss += (tot[ni][mi][0] * tot[ni][mi][0] + tot[ni][mi][1] * tot[ni][mi][1]) + (tot[ni][mi][2] * tot[ni][mi][2] + tot[ni][mi][3] * tot[ni][mi][3]);
                ss += shx(ss, 16, lane); ss += shx(ss, 32, lane);
                if (fq == 0) ssq[wave * 128 + 16 * mi + fr] = ss; }
            __syncthreads();
#pragma unroll
            for (int mi = 0; mi < 8; ++mi) { const int tt = 16 * mi + fr; float ss = 0.f;
#pragma unroll
                for (int w8 = 0; w8 < 8; ++w8) ss += ssq[w8 * 128 + tt];
                const float rstd = rsqrtf(ss * (1.f / DH) + EPS);
#pragma unroll
                for (int ni = 0; ni < 2; ++ni) { const int vd = 32 * wave + 16 * ni + 4 * fq;
                    const u32x2 ow = og[mi][ni]; const f32x4 w4 = gw[ni];
                    const float o0 = __uint_as_float(ow.x << 16), o1 = __uint_as_float(ow.x & 0xffff0000u), o2 = __uint_as_float(ow.y << 16), o3 = __uint_as_float(ow.y & 0xffff0000u);
                    u32x2 q; q.x = pk2(sigmoidf_(o0) * (tot[ni][mi][0] * rstd * w4[0]), sigmoidf_(o1) * (tot[ni][mi][1] * rstd * w4[1]));
                    q.y = pk2(sigmoidf_(o2) * (tot[ni][mi][2] * rstd * w4[2]), sigmoidf_(o3) * (tot[ni][mi][3] * rstd * w4[3]));
                    gst<u32x2>(HM, (unsigned)((row0 + tt) * D + h * DH + vd) * 2u, q); }
            }
        }
        __syncthreads();
    }
}
__device__ __forceinline__ void ph_ffnact(int wv, int l) {
    CParams& p = *okp();
    unsigned char* const wsb = ows(p.ws);
    const int TIDX = otid(wv), BIDX = obid();
    const unsigned gt = (unsigned)BIDX * 512u + TIDX, NT = gridDim.x * 512u;
    const bf16_t* U = WSP(bf16_t, OFF_P); bf16_t* ACT = WSP(bf16_t, OFF_ACT); const float* SL = WSP(float, OFF_SLAB);
    const float* wf = p.conv_ff_w + (size_t)l * 3 * DFF;
    auto ldu = [&](int r, int col, float (&o)[8]) {
        if (col >= 32 * 256) { f32x4 g0 = {0.f, 0.f, 0.f, 0.f}, g1 = {0.f, 0.f, 0.f, 0.f};
#pragma unroll
            for (int sl = 0; sl < 4; ++sl) { const unsigned o4 = (unsigned)((sl * RC + (r - RL)) * NUP + col) * 4u; g0 += gld<f32x4>(SL, o4); g1 += gld<f32x4>(SL, o4 + 16); }
#pragma unroll
            for (int j = 0; j < 4; ++j) { o[j] = g0[j]; o[4 + j] = g1[j]; } }
        else unpack8(gld<u32x4>(U, (unsigned)(r * NUP + col) * 2u), o);
    };
    for (unsigned i = gt; i < (unsigned)RC * (DFF / 8); i += NT) {
        const int r = RL + (int)(i / (DFF / 8)), c = (int)(i % (DFF / 8)) * 8, t = (r - RL) & (CTX - 1);
        const int ca = 256 * (c >> 7) + (c & 127);
        const bool hp = t > 0, hn = t < CTX - 1;
        float a0[8], a1[8], a2[8], g[8], o[8];
        ldu(r, ca, a1); ldu(r, ca + 128, g); ldu(hp ? r - 1 : r, ca, a0); ldu(hn ? r + 1 : r, ca, a2);
        const f32x4 w00 = gld<f32x4>(wf, (unsigned)c * 4u), w01 = gld<f32x4>(wf, (unsigned)c * 4u + 16), w10 = gld<f32x4>(wf, (unsigned)(DFF + c) * 4u), w11 = gld<f32x4>(wf, (unsigned)(DFF + c) * 4u + 16),
                    w20 = gld<f32x4>(wf, (unsigned)(2 * DFF + c) * 4u), w21 = gld<f32x4>(wf, (unsigned)(2 * DFF + c) * 4u + 16);
#pragma unroll
        for (int j = 0; j < 8; ++j) { const float w0 = j < 4 ? w00[j & 3] : w01[j & 3], w1 = j < 4 ? w10[j & 3] : w11[j & 3], w2 = j < 4 ? w20[j & 3] : w21[j & 3];
            float v = w1 * a1[j]; if (hp) v += w0 * a0[j]; if (hn) v += w2 * a2[j]; o[j] = siluf_(v) * g[j]; }
        gst<u32x4>(ACT, (unsigned)(r * DFF + c) * 2u, pack8(o));
    }
}

#define XB_TMO      128
#define XB_XCNT(j)  (256  + 64 * (j))
#define XB_XSUB(j)  (1280 + 64 * (j))
#define XB_XGEN(j)  (2304 + 64 * (j))
#define XB_TOP      3328
#define XB_TOPGEN   3392
#define XCD_BAR_WORDS 3456
#define XB_SPIN_CAP (1u << 18)
__device__ __forceinline__ unsigned xb_ld(unsigned* p)              { return __hip_atomic_load(p, __ATOMIC_RELAXED, __HIP_MEMORY_SCOPE_AGENT); }
__device__ __forceinline__ unsigned xb_add(unsigned* p, unsigned v) { return __hip_atomic_fetch_add(p, v, __ATOMIC_RELAXED, __HIP_MEMORY_SCOPE_AGENT); }
__device__ __forceinline__ unsigned xb_xcc_id() { return (unsigned)__builtin_amdgcn_s_getreg((3 << 11) | 20) & 0xFu; }
#define XB_SPIN(cond, bar) do { unsigned _sp = 0; while (cond) { __builtin_amdgcn_s_sleep(1); \
    if ((++_sp & 255u) == 0u) { if (xb_ld(&(bar)[XB_TMO])) break; if (_sp > XB_SPIN_CAP) { atomicAdd(&(bar)[XB_TMO], 1u); break; } } } } while (0)
struct XcdBarrier { unsigned* bar; unsigned x; volatile LAS unsigned* st; };
__device__ __forceinline__ XcdBarrier xcd_barrier_post(unsigned* bar, volatile LAS unsigned* st) {
    XcdBarrier b; b.bar = bar; b.x = xb_xcc_id(); b.st = st;
    if (threadIdx.x == 0) (void)xb_add(&bar[XB_XCNT(b.x)], 1u);
    return b;
}
__device__ __forceinline__ void xcd_barrier_complete(unsigned* bar, unsigned x, unsigned& nloc, unsigned& nx) {
    const unsigned G = gridDim.x * gridDim.y * gridDim.z;
    unsigned sum, cnt, mine, sp = 0u;
    for (;;) {
        sum = 0u; cnt = 0u; mine = 0u;
#pragma unroll
        for (unsigned j = 0; j < 16; ++j) { const unsigned c = xb_ld(&bar[XB_XCNT(j)]); sum += c; cnt += (c > 0u) ? 1u : 0u; mine = (j == x) ? c : mine; }
        if (sum == G) break;
        __builtin_amdgcn_s_sleep(1);
        if ((++sp & 255u) == 0u) { if (xb_ld(&bar[XB_TMO])) break; if (sp > XB_SPIN_CAP) { atomicAdd(&bar[XB_TMO], 1u); break; } }
    }
    nloc = mine > 0u ? mine : 1u; nx = cnt > 0u ? cnt : 1u;
}
__device__ __forceinline__ void xcd_barrier(const XcdBarrier& b, int wv) {
    asm volatile("s_waitcnt vmcnt(0)" ::: "memory");
    __syncthreads();
    if (otid(wv) == 0) {
        unsigned long long bw = (unsigned long long)b.bar; asm volatile("" : "+s"(bw));
        unsigned* bar = (unsigned*)bw;
        __builtin_amdgcn_s_waitcnt(0);
        unsigned nloc = b.st[0], nx = b.st[1];
        if (nloc == 0u) { xcd_barrier_complete(bar, b.x, nloc, nx); b.st[0] = nloc; b.st[1] = nx; }
        const unsigned old = xb_add(&bar[XB_XSUB(b.x)], 1u);
        const unsigned gen = old / nloc;
        if (old + 1u == (gen + 1u) * nloc) {
            __builtin_amdgcn_fence(__ATOMIC_RELEASE, "agent");
            asm volatile("s_waitcnt vmcnt(0)" ::: "memory");
            const unsigned og = xb_add(&bar[XB_TOP], 1u);
            const unsigned tg = og / nx;
            if (og + 1u == (tg + 1u) * nx) xb_add(&bar[XB_TOPGEN], 1u);
            else XB_SPIN(xb_ld(&bar[XB_TOPGEN]) == tg, bar);
            __builtin_amdgcn_fence(__ATOMIC_ACQUIRE, "agent");
            xb_add(&bar[XB_XGEN(b.x)], 1u);
            asm volatile("s_waitcnt vmcnt(0)" ::: "memory");
        } else {
            XB_SPIN(xb_ld(&bar[XB_XGEN(b.x)]) == gen, bar);
            __builtin_amdgcn_fence(__ATOMIC_ACQUIRE, "agent");
            asm volatile("s_waitcnt vmcnt(0)" ::: "memory");
        }
    }
    __syncthreads();
}

constexpr int I_CUT = (I_LAYER * 2 / 5 / 64) * 64;
#define REPW 3456
#define REPN(k) (1 + __builtin_amdgcn_readfirstlane(((const int*)(okp()->ws + OFF_CTL))[REPW + (k)]))
constexpr int LDS_BYTES = 163840;
constexpr int MISC_OFF = 163840 - 256;
template <class Epi, class Sched, bool AMAP = false> __device__ __forceinline__ void run_gemm(int wv, LAS unsigned char* lds, const bf16_t* A, int lda, const bf16_t* Bt, int ldb, int K, const Sched& S, const Epi& E) {
    pg8::Gemm g; g.A = A; g.Bt = Bt; g.M = 0; g.N = 0; g.K = K; g.lda = lda; g.ldb = ldb; g.pad = wv;
    pg8::gemm_phase<Epi, Sched, AMAP>((PG8_LAS unsigned char*)lds, g, S, E);
}
__global__ void __launch_bounds__(512, 2) mega_fwd(Params p_kernarg) {
    extern __shared__ __attribute__((aligned(16))) unsigned char dyn_lds[];
    LAS unsigned char* lds = (LAS unsigned char*)dyn_lds;
    const int wv = __builtin_amdgcn_readfirstlane(threadIdx.x >> 6);
    volatile LAS unsigned* MISC = (volatile LAS unsigned*)(lds + MISC_OFF);
    if (threadIdx.x < 32) MISC[threadIdx.x] = 0u;
    __syncthreads();
    (void)xcd_barrier_post((unsigned*)(okp()->ws + OFF_CTL), MISC + 8);
#define GRID_BAR() for (int rpb = 0, nrpb = REPN(10); rpb < nrpb; ++rpb) { XcdBarrier bar_; bar_.bar = (unsigned*)(okp()->ws + OFF_CTL); bar_.x = xb_xcc_id(); bar_.st = (volatile LAS unsigned*)(lds + MISC_OFF) + 8; xcd_barrier(bar_, wv); }
    for (int rp = 0, nrp = REPN(13); rp < nrp; ++rp) { ph_convert(wv, lds, 0, obid(), (int)gridDim.x, 0, I_LAYER); __syncthreads(); }
    for (int rp = 0, nrp = REPN(0); rp < nrp; ++rp) { ph_tables(wv); __syncthreads(); ph_mod(wv, lds, 0, 1, obid(), (int)gridDim.x); __syncthreads(); }
    GRID_BAR();
    for (int l = 0; l < DEPTH; ++l) {
        unsigned char* ws = ows(okp()->ws);
        const int G = (int)gridDim.x;
        const int fz = G >= 256 ? 1 : 0;
        const bool lastl = (l == DEPTH - 1);
        bf16_t* XN = (bf16_t*)(ws + OFF_XN); bf16_t* P = (bf16_t*)(ws + OFF_P); float* Gt = (float*)(ws + OFF_G); float* H = (float*)(ws + OFF_H); float* SLB = (float*)(ws + OFF_SLAB);
        const float* mod = (const float*)(ws + OFF_MOD) + (size_t)l * 5 * 6 * D;
        ph_norm(wv, l, 0, l > 0 ? mod - 5 * 6 * D + 4 * 6 * D + 5 * D : nullptr, (l > 0 && fz) ? RL : 0, R, l > 0 ? H : okp()->x, l > 0 ? H + (size_t)RL * D : okp()->ctx);
        GRID_BAR();
        for (int rp = 0, nrp = REPN(1); rp < nrp; ++rp) { EpiInProj E{P, Gt, (const float*)(ws + OFF_BINR) + (size_t)l * NINP};
          pg8::StaticOrder S; S.init(R, NINP, D, G, obid());
          run_gemm(wv, lds, XN, D, (const bf16_t*)(ws + OFF_WIN) + (size_t)l * NINP * D, D, D, S, E); }
        GRID_BAR();
        for (int rp = 0, nrp = REPN(2); rp < nrp; ++rp) ph_mlstm1(wv, l, lds);
        { const int f0 = G / 4, fn = G / 2;
          for (int rp = 0, nrp = REPN(9); rp < nrp; ++rp) if (obid() >= f0 && obid() < f0 + fn) ph_fft(wv, lds, obid() - f0, fn);
          for (int rp = 0, nrp = REPN(3); rp < nrp; ++rp) if (obid() < f0 || obid() >= f0 + fn) { const int wi = obid() < f0 ? obid() : obid() - fn;
              if (!lastl) ph_fourier1(wv, wi, G - fn); ph_convc(wv, l, lastl ? RL : R, wi, G - fn); } }
        GRID_BAR();
        for (int rp = 0, nrp = REPN(4); rp < nrp; ++rp) ph_mlstm2(wv);
        GRID_BAR();
        for (int rp = 0, nrp = REPN(5); rp < nrp; ++rp) ph_mlstm3(wv, l, lds, lastl ? 64 * NH : NCHUNK * NH);
        if (!lastl && obid() >= 32) { EpiBf16 E{(bf16_t*)(ws + OFF_HM) + (size_t)RL * D + DM, D, DF, (unsigned)(CTX * D), 0, SLB};
          pg8::StaticOrder S; S.init(256, 2048, 512, G - 32, obid() - 32);
          run_gemm(wv, lds, (const bf16_t*)(ws + OFF_CSC), 512, (const bf16_t*)(ws + OFF_ZTC), 512, 512, S, E); }
        if (!lastl && obid() >= 32) { ph_convert(wv, lds, l + 1, obid() - 32, G - 32, 0, I_CUT); }
        GRID_BAR();
        for (int rp = 0, nrp = REPN(8); rp < nrp; ++rp) { EpiMerge E{P, (bf16_t*)(ws + OFF_MG)}; pg8::StaticOrder S; S.init(lastl ? RL : R, D, D, G, obid());
          run_gemm(wv, lds, (const bf16_t*)(ws + OFF_HM), D, (const bf16_t*)(ws + OFF_WPM) + (size_t)l * D * D, D, D, S, E); }
        if (!lastl && obid() >= 32) { ph_convert(wv, lds, l + 1, obid() - 32, G - 32, I_CUT, I_LAYER); __syncthreads(); ph_mod(wv, lds, l + 1, l + 2, obid() - 32, G - 32); }
        GRID_BAR();
        for (int rp = 0, nrp = REPN(11); rp < nrp; ++rp) { EpiResid E{l, 0, fz, rp == 0 ? 1.f : 0.f};
          pg8::TailOrder S; S.init(D, D, G, obid(), lastl ? 0 : 32, 0, 8);
          run_gemm(wv, lds, (const bf16_t*)(ws + OFF_MG), D, (const bf16_t*)(ws + OFF_WO) + (size_t)l * D * D, D, D, S, E); }
        GRID_BAR();
        if (!lastl || !fz) { ph_norm(wv, l, 1, lastl ? nullptr : mod + 4 * 6 * D + 2 * D, fz ? RL : 0, lastl ? RL : R, H, l > 0 ? H + (size_t)RL * D : okp()->ctx);
          GRID_BAR(); }
        for (int rp = 0, nrp = REPN(7); rp < nrp; ++rp) { EpiUp E{P, SLB, (bf16_t*)(ws + OFF_ACT), okp()->conv_ff_w + (size_t)l * 3 * DFF};
          pg8::TailOrder S; S.init(NUP, D, G, obid(), lastl ? 0 : 176, lastl ? 0 : 128, 4);
          run_gemm<EpiUp, pg8::TailOrder, true>(wv, lds, XN, D, (const bf16_t*)(ws + OFF_WUP) + (size_t)l * NUP * D, D, D, S, E); }
        GRID_BAR();
        if (!lastl) { for (int rp = 0, nrp = REPN(6); rp < nrp; ++rp) ph_ffnact(wv, l);
          GRID_BAR(); }
        for (int rp = 0, nrp = REPN(12); rp < nrp; ++rp) { EpiResid E{l, 1, lastl ? 2 * fz : fz, rp == 0 ? 1.f : 0.f};
          pg8::TailOrder S; S.init(D, DFF, G, obid(), lastl ? 0 : 32, 0, 8);
          run_gemm(wv, lds, (const bf16_t*)(ws + OFF_ACT), DFF, (const bf16_t*)(ws + OFF_WDN) + (size_t)l * D * DFF, DFF, DFF, S, E); }
        if (!(lastl && fz)) { GRID_BAR(); }
    }
    if (gridDim.x < 256) ph_final(wv);
}

extern "C" void kernel_launch(void* const* d_in, const int* in_sizes, int n_in, void* d_out, int out_size, void* d_ws, size_t ws_size, hipStream_t stream) {
    static int grid = 0;
    if (grid == 0) {
        if (n_in != 22 || ws_size < WS_END || out_size != RL * D) { fprintf(stderr, "kernel_launch: unexpected problem (n_in %d, ws %zu < %zu, out %d)\n", n_in, ws_size, (size_t)WS_END, out_size); grid = -1; return; }
        int dev = 0, cus = 0, per_cu = 0;
        if (hipGetDevice(&dev) != hipSuccess || hipDeviceGetAttribute(&cus, hipDeviceAttributeMultiprocessorCount, dev) != hipSuccess) { grid = -1; return; }
        if (hipFuncSetAttribute((const void*)mega_fwd, hipFuncAttributeMaxDynamicSharedMemorySize, LDS_BYTES) != hipSuccess) { fprintf(stderr, "kernel_launch: hipFuncSetAttribute failed\n"); grid = -1; return; }
        if (hipOccupancyMaxActiveBlocksPerMultiprocessor(&per_cu, (const void*)mega_fwd, 512, LDS_BYTES) != hipSuccess || per_cu < 1) { fprintf(stderr, "kernel_launch: occupancy query says %d\n", per_cu); per_cu = 1; }
        (void)hipGetLastError();
        grid = cus;
    }
    if (grid < 0) return;
    Params p{};
    const float** pp = (const float**)&p;
    for (int i = 0; i < 22; ++i) pp[i] = (const float*)d_in[i];
    p.out = (float*)d_out; p.ws = (unsigned char*)d_ws;
    (void)hipMemsetAsync((char*)d_ws + OFF_CTL, 0, (size_t)CTL_ZERO_WORDS * sizeof(unsigned), stream);
    hipLaunchKernelGGL(mega_fwd, dim3(grid), dim3(512), LDS_BYTES, stream, p);
}
```

```cpp
#include <hip/hip_runtime.h>
#include <cstdio>
#include <cstdint>
#include <type_traits>

#define LAS __attribute__((address_space(3)))
typedef unsigned short bf16_t;
typedef short bf16x8 __attribute__((ext_vector_type(8)));
typedef float f32x4 __attribute__((ext_vector_type(4)));
typedef unsigned u32x4 __attribute__((ext_vector_type(4)));
typedef unsigned u32x2 __attribute__((ext_vector_type(2)));
typedef float f32x2 __attribute__((ext_vector_type(2)));

constexpr int D = 2048, NB = 4, SEQ = 2048, DEPTH = 4, CTX = 256;
constexpr int DM = 1024, NH = 4, DH = 256, DF = 512, DC = 512, DFF = 5632, CHUNK = 128;
constexpr int NIN = 12304;
constexpr int RL = NB * SEQ, RC = NB * CTX, R = RL + RC;
constexpr int NP = 12288;
constexpr int NINP = 12544;
constexpr int PK = 0, PV = 1024, PQ = 2048, PO = 3072, PF = 4096, PCB = 4608, PCC = 5120, PCX = 5632, PGM = 6144;
constexpr int NCHUNK = 72;
constexpr int NUP = 2 * DFF;
constexpr float EPS = 1e-6f;

constexpr size_t al256(size_t x) { return (x + 255) & ~(size_t)255; }
constexpr size_t OFF_CTL = 0;
constexpr size_t OFF_WIN = 1u << 20;
constexpr size_t SZ_WIN = (size_t)NINP * D * 2;            constexpr size_t OFF_WPM = OFF_WIN + DEPTH * SZ_WIN;
constexpr size_t SZ_WPM = (size_t)D * D * 2;               constexpr size_t OFF_WO = OFF_WPM + DEPTH * SZ_WPM;
constexpr size_t SZ_WO = (size_t)D * D * 2;                constexpr size_t OFF_WUP = OFF_WO + DEPTH * SZ_WO;
constexpr size_t SZ_WUP = (size_t)NUP * D * 2;             constexpr size_t OFF_WDN = OFF_WUP + DEPTH * SZ_WUP;
constexpr size_t SZ_WDN = (size_t)D * DFF * 2;             constexpr size_t OFF_BINR = OFF_WDN + DEPTH * SZ_WDN;
constexpr size_t OFF_MA = al256(OFF_BINR + (size_t)DEPTH * NINP * 4);
constexpr size_t OFF_MC = OFF_MA + (size_t)64 * 64 * 2;
constexpr size_t OFF_CSC = OFF_MC + (size_t)32 * 64 * 128 * 2;
constexpr size_t OFF_FT = OFF_CSC + (size_t)256 * 512 * 2;
constexpr size_t OFF_MOD = OFF_FT + (size_t)256 * 128 * 2;
constexpr size_t OFF_H = al256(OFF_MOD + (size_t)DEPTH * 5 * 6 * D * 4);
constexpr size_t OFF_XN = OFF_H + (size_t)R * D * 4;
constexpr size_t OFF_P = OFF_XN + (size_t)R * D * 2;
constexpr size_t OFF_G = OFF_P + (size_t)R * NP * 2;
constexpr size_t OFF_CHS = OFF_G + (size_t)R * 16 * 4;
constexpr size_t OFF_MST = al256(OFF_CHS + (size_t)NCHUNK * 8 * 2 * 4);
constexpr size_t OFF_UT = al256(OFF_MST + (size_t)NCHUNK * 8 * 4);
constexpr size_t SZ_UT = (size_t)NCHUNK * NH * 2 * DH * DH * 2;
constexpr size_t OFF_CT = OFF_UT + SZ_UT;
constexpr size_t OFF_NV = OFF_CT + SZ_UT;
constexpr size_t OFF_NS = OFF_NV + (size_t)NCHUNK * NH * 2 * DH * 4;
constexpr size_t OFF_HM = OFF_NS + (size_t)NCHUNK * NH * 2 * DH * 4;
constexpr size_t OFF_ZTC = OFF_HM + (size_t)R * D * 2;
constexpr size_t OFF_MG = OFF_ZTC + (size_t)2048 * 512 * 2;
constexpr size_t OFF_ACT = OFF_MG + (size_t)R * D * 2;
constexpr size_t OFF_SLAB = OFF_ACT + (size_t)R * DFF * 2;
constexpr size_t OFF_XS = OFF_SLAB + (size_t)4 * RC * NUP * 4;
constexpr size_t WS_END = OFF_XS + (size_t)8 * RL * 32 * 4;
constexpr int CNTW = 4096;
constexpr int CTL_ZERO_WORDS = CNTW + 8 * 32 * 64;
static_assert(WS_END <= (size_t)4 * DEPTH * D * NIN * 4, "workspace map exceeds the guaranteed d_ws size");
static_assert((size_t)R * NUP * 2 <= (size_t)R * NP * 2, "u overlays P");

struct Params {
    const float *x, *c, *ctx, *c_ctx, *w_mod, *b_mod, *norm1_w, *norm2_w, *w_in, *b_in, *conv_q_w, *conv_k_w, *mlstm_norm_w, *w_pm, *w_pf, *w_pc, *conv_c_w, *w_o, *w_up,
        *conv_ff_w, *w_down, *final_norm_w;
    float* out; unsigned char* ws;
};
#define WSP(T, off) ((T*)(wsb + (off)))
typedef const __attribute__((address_space(4))) Params CParams;
__device__ __forceinline__ CParams* okp() { CParams* k = (CParams*)__builtin_amdgcn_kernarg_segment_ptr(); asm volatile("" : "+s"(k)); return k; }

#define GAS __attribute__((address_space(1)))
template <class T> __device__ __forceinline__ T gld(const void* base, unsigned byte_off) { return *(const GAS T*)((const GAS unsigned char*)base + byte_off); }
template <class T> __device__ __forceinline__ void gst(void* base, unsigned byte_off, T v) { *(GAS T*)((GAS unsigned char*)base + byte_off) = v; }
__device__ __forceinline__ int otid(int wv) { int t; asm volatile("v_mbcnt_lo_u32_b32 %0, -1, 0\n\tv_mbcnt_hi_u32_b32 %0, -1, %0" : "=v"(t)); return (wv << 6) | t; }
__device__ __forceinline__ int olaunder(int v) { asm volatile("" : "+v"(v)); return v; }
__device__ __forceinline__ f32x4 zero4() { float a, b, c, d; asm volatile("v_mov_b32 %0, 0\n\tv_mov_b32 %1, 0\n\tv_mov_b32 %2, 0\n\tv_mov_b32 %3, 0" : "=v"(a), "=v"(b), "=v"(c), "=v"(d)); return (f32x4){a, b, c, d}; }
__device__ __forceinline__ int obid() { int b = blockIdx.x; asm volatile("" : "+s"(b)); return b; }
__device__ __forceinline__ float bf2f(bf16_t v) { return __uint_as_float(((unsigned)v) << 16); }
__device__ __forceinline__ unsigned f2bf(float f) { unsigned u = __float_as_uint(f); return (u + 0x7fffu + ((u >> 16) & 1u)) >> 16; }
__device__ __forceinline__ unsigned pk2(float lo, float hi) { return f2bf(lo) | (f2bf(hi) << 16); }
__device__ __forceinline__ float sigmoidf_(float x) { return 1.f / (1.f + __expf(-x)); }
__device__ __forceinline__ float siluf_(float x) { return x / (1.f + __expf(-x)); }
__device__ __forceinline__ float shx(float v, int k, int lane) { return __int_as_float(__builtin_amdgcn_ds_bpermute((lane ^ k) << 2, __float_as_int(v))); }
__device__ __forceinline__ float shl_(float v, int src) { return __int_as_float(__builtin_amdgcn_ds_bpermute(src << 2, __float_as_int(v))); }
__device__ __forceinline__ unsigned char* ows(unsigned char* w) { asm volatile("" : "+s"(w)); return w; }
__device__ __forceinline__ float wave_sum(float v, int lane) {
#pragma unroll
    for (int o = 1; o < 64; o <<= 1) v += shx(v, o, lane);
    return v;
}
__device__ __forceinline__ void unpack8(u32x4 w, float (&f)[8]) {
    f[0] = __uint_as_float(w.x << 16); f[1] = __uint_as_float(w.x & 0xffff0000u); f[2] = __uint_as_float(w.y << 16); f[3] = __uint_as_float(w.y & 0xffff0000u);
    f[4] = __uint_as_float(w.z << 16); f[5] = __uint_as_float(w.z & 0xffff0000u); f[6] = __uint_as_float(w.w << 16); f[7] = __uint_as_float(w.w & 0xffff0000u);
}
__device__ __forceinline__ u32x4 pack8(const float (&f)[8]) { u32x4 w; w.x = pk2(f[0], f[1]); w.y = pk2(f[2], f[3]); w.z = pk2(f[4], f[5]); w.w = pk2(f[6], f[7]); return w; }
__device__ __forceinline__ void rowinfo(int r, int& mj, int& t, int& T) { const int c = r >= RL ? 1 : 0; mj = r >> 11; T = SEQ >> (3 * c); t = r & (T - 1); }
__device__ __forceinline__ int chunk_row0(int cidx) { return cidx < 64 ? (cidx >> 4) * SEQ + (cidx & 15) * CHUNK : RL + ((cidx - 64) >> 1) * CTX + ((cidx - 64) & 1) * CHUNK; }
__device__ __forceinline__ int scan_chunk(int b, int dir, int step) {
    if (step < 2) { const int j = dir ? 1 - step : step; return 64 + b * 2 + j; }
    const int jj = step - 2, j = dir ? 15 - jj : jj; return b * 16 + j;
}

namespace pg8 {
#define PG8_LAS __attribute__((address_space(3)))
constexpr int BM = 256, BK = 64, HALF = 128, HTB = HALF * BK * 2, STAGE_BYTES = 8 * HTB, NXCD = 8, WGM = 8;
__host__ __device__ __forceinline__ int lds_byte(int r, int c) { const int st = (r >> 4) * 2 + (c >> 5), rr = r & 15, cc = c & 31, ob = rr * 64 + cc * 2; return st * 1024 + (ob ^ (((ob >> 9) & 1) << 5)); }
__host__ __device__ __forceinline__ void stage_rc(int b, int& Rr, int& C) { const int st = b / 1024, sb = b % 1024, swz = sb ^ (((sb >> 9) & 1) << 5); Rr = (st >> 1) * 16 + swz / 64; C = (st & 1) * 32 + (swz % 64) / 2; }
__host__ __device__ __forceinline__ int perm32(int rho) { const int n = rho >> 4, i = rho & 15; return 8 * (i >> 2) + 4 * n + (i & 3); }
struct Unit { int pm, pn, k0, nt, ks; };
struct Gemm { const bf16_t* A; const bf16_t* Bt; int M, N, K, lda, ldb, pad; };
__host__ __device__ __forceinline__ void tile_of(int wgid, int nM, int nN, int& pm, int& pn) {
    const int nwg = nM * nN; { const int q = nwg / NXCD, r = nwg % NXCD, xcd = wgid % NXCD, off = wgid / NXCD; wgid = (xcd < r ? xcd * (q + 1) : r * (q + 1) + (xcd - r) * q) + off; }
    const int nig = WGM * nN, gid = wgid / nig, fm = gid * WGM, gsz = (nM - fm) < WGM ? (nM - fm) : WGM;
    pm = fm + ((wgid % nig) % gsz); pn = (wgid % nig) / gsz;
}
struct StaticOrder {
    int nM, nN, nwg, G, c, K;
    __host__ __device__ void init(int M, int N, int K_, int G_, int c_) { nM = M / BM; nN = N / BM; nwg = nM * nN; G = G_; c = c_; K = K_; }
    __host__ __device__ bool next(int i, Unit& u) const {
        const long L = (long)i * G + c; if (L >= nwg) return false;
        tile_of((int)L, nM, nN, u.pm, u.pn); u.k0 = 0; u.nt = K / BK; u.ks = -1; return true;
    }
    __device__ __forceinline__ void a_ready(const Unit&) const {}
    __device__ __forceinline__ void done(const Unit&) const {}
};
struct TailOrder {
    int nN, G, c, K, nLat, nWhole, nTot, nsl;
    __host__ __device__ void init(int N, int K_, int G_, int c_, int nCtxTiles, int nCtxWhole, int nsl_) { nN = N / BM; G = G_; c = c_; K = K_; nLat = 32 * nN; nWhole = nLat + nCtxWhole; nTot = nLat + nCtxTiles; nsl = nsl_; }
    __host__ __device__ bool next(int i, Unit& u) const {
        const long L = (long)i * G + c; if (L >= (long)nWhole + (long)(nTot - nWhole) * nsl) return false;
        int tile, ks; if (L < nWhole) { tile = (int)L; ks = -1; } else { const int Lp = (int)L - nWhole; tile = nWhole + Lp / nsl; ks = Lp % nsl; }
        if (tile < nLat) tile_of(tile, 32, nN, u.pm, u.pn); else { const int tp = tile - nLat; u.pm = 32 + (tp & 3); u.pn = tp >> 2; }
        if (ks < 0) { u.k0 = 0; u.nt = K / BK; } else { const int n128 = K / 128, base = n128 / nsl, rem = n128 % nsl; u.k0 = 128 * (ks * base + (ks < rem ? ks : rem)); u.nt = 2 * (base + (ks < rem ? 1 : 0)); }
        u.ks = ks; return true;
    }
    __device__ __forceinline__ void a_ready(const Unit&) const {}
    __device__ __forceinline__ void done(const Unit&) const {}
};
template <bool AMAP> __device__ __forceinline__ void a_geom(const Gemm& g, const Unit& u, int R0, int C0, int R1, int C1, size_t& base, size_t& hstep, unsigned (&vo)[2]) {
    if (AMAP && u.pm < 32) { base = (size_t)((u.pm >> 3) * 2048 + (u.pm & 7) * 8) * g.lda * 2; hstep = (size_t)4 * g.lda * 2;
        vo[0] = (unsigned)(((R0 & 31) * 64 + (R0 >> 5)) * g.lda + C0) * 2u; vo[1] = (unsigned)(((R1 & 31) * 64 + (R1 >> 5)) * g.lda + C1) * 2u; }
    else { base = (size_t)u.pm * 256 * g.lda * 2; hstep = (size_t)HALF * g.lda * 2; vo[0] = (unsigned)(R0 * g.lda + C0) * 2u; vo[1] = (unsigned)(R1 * g.lda + C1) * 2u; }
}
template <class Epi, class Sched, bool AMAP = false>
__device__ __forceinline__ void gemm_phase(PG8_LAS unsigned char* lds, const Gemm g, const Sched& S, const Epi& E) {
    const int tid = otid(g.pad), wid = __builtin_amdgcn_readfirstlane(tid >> 6), lane = tid & 63, wr = wid >> 2, wc = wid & 3, fr = lane & 15, fq = lane >> 4;
    int R0, C0, R1, C1; stage_rc(tid * 16, R0, C0); stage_rc(tid * 16 + 8192, R1, C1);
    unsigned voffB[2];
    { const int Rb0 = Epi::PERM ? ((R0 & ~31) + perm32(R0 & 31)) : R0, Rb1 = Epi::PERM ? ((R1 & ~31) + perm32(R1 & 31)) : R1;
      voffB[0] = (unsigned)(Rb0 * g.ldb + C0) * 2u; voffB[1] = (unsigned)(Rb1 * g.ldb + C1) * 2u; }
    const size_t kstep = (size_t)(BK * 2);
    const size_t hstepB = (size_t)HALF * g.ldb * 2, tstepB = 2 * hstepB;
    const unsigned ldsw = (unsigned)wid * 1024u;
    const int aoff = lds_byte(wr * 64 + fr, fq * 8), boff = lds_byte(wc * 32 + fr, fq * 8);
#define PG8_SA(b, h) (((b) * 2 + (h)) * HTB)
#define PG8_SB(b, h) ((4 + (b) * 2 + (h)) * HTB)
#define PG8_STAGE(bufoff, gbase, voff) do { _Pragma("unroll") for (int _i = 0; _i < 2; ++_i) \
        __builtin_amdgcn_global_load_lds((const unsigned*)((const char*)(gbase) + (voff)[_i]), (PG8_LAS unsigned*)(lds + (bufoff) + ldsw + _i * 8192), 16, 0, 0); } while (0)
#define PG8_LDA(dst, b, h) do { _Pragma("unroll") for (int m = 0; m < 4; ++m) _Pragma("unroll") for (int k = 0; k < 2; ++k) dst[m][k] = *(const PG8_LAS bf16x8*)(lds + PG8_SA(b, h) + aoff + m * 2048 + k * 1024); } while (0)
#define PG8_LDB(dst, b, h) do { _Pragma("unroll") for (int n = 0; n < 2; ++n) _Pragma("unroll") for (int k = 0; k < 2; ++k) dst[n][k] = *(const PG8_LAS bf16x8*)(lds + PG8_SB(b, h) + boff + n * 2048 + k * 1024); } while (0)
#define PG8_MMA(ai, bj, At, Bt) do { __builtin_amdgcn_s_setprio(1); _Pragma("unroll") for (int m = 0; m < 4; ++m) _Pragma("unroll") for (int n = 0; n < 2; ++n) _Pragma("unroll") for (int k = 0; k < 2; ++k) \
        acc[ai][bj][m][n] = __builtin_amdgcn_mfma_f32_16x16x32_bf16(Bt[n][k], At[m][k], acc[ai][bj][m][n], 0, 0, 0); __builtin_amdgcn_s_setprio(0); } while (0)
#define PG8_WAIT_V(n) asm volatile("s_waitcnt vmcnt(" #n ")" ::: "memory")
#define PG8_WAIT_L(n) asm volatile("s_waitcnt lgkmcnt(" #n ")" ::: "memory")
#define PG8_BAR __builtin_amdgcn_s_barrier()
#define PG8_SCHED __builtin_amdgcn_sched_barrier(0)
    Unit cur, nxt; int ui = 0;
    if (!S.next(0, cur)) return;
    f32x4 acc[2][2][4][2];
#pragma unroll
    for (int a = 0; a < 2; ++a)
#pragma unroll
        for (int b = 0; b < 2; ++b)
#pragma unroll
            for (int m = 0; m < 4; ++m)
#pragma unroll
                for (int n = 0; n < 2; ++n) acc[a][b][m][n] = zero4();
    bf16x8 At[4][2], B0[2][2], B1[2][2];
    size_t baseC, hsC; unsigned voC[2]; a_geom<AMAP>(g, cur, R0, C0, R1, C1, baseC, hsC, voC);
    const char* cA = (const char*)g.A + baseC + (size_t)cur.k0 * 2; const char* cB = (const char*)g.Bt + (size_t)cur.pn * tstepB + (size_t)cur.k0 * 2;
    S.a_ready(cur);
    PG8_STAGE(PG8_SB(0, 0), cB, voffB); PG8_STAGE(PG8_SB(0, 1), cB + hstepB, voffB); PG8_STAGE(PG8_SA(0, 0), cA, voC); PG8_STAGE(PG8_SA(0, 1), cA + hsC, voC);
    if (wr == 1) PG8_BAR;
    PG8_WAIT_V(2); PG8_BAR;
    PG8_STAGE(PG8_SB(1, 0), cB + kstep, voffB); PG8_STAGE(PG8_SA(1, 0), cA + kstep, voC); PG8_STAGE(PG8_SB(1, 1), cB + hstepB + kstep, voffB);
    PG8_WAIT_V(6); PG8_BAR;
    for (;;) {
        const bool has_next = S.next(ui + 1, nxt);
        size_t baseN = baseC, hsN = hsC; unsigned voN[2] = {voC[0], voC[1]};
        if (AMAP && has_next) a_geom<AMAP>(g, nxt, R0, C0, R1, C1, baseN, hsN, voN); else if (has_next) baseN = (size_t)nxt.pm * 256 * g.lda * 2;
        const char* nA = has_next ? (const char*)g.A + baseN + (size_t)nxt.k0 * 2 : cA; const char* nB = has_next ? (const char*)g.Bt + (size_t)nxt.pn * tstepB + (size_t)nxt.k0 * 2 : cB;
        const int nt = cur.nt;
        for (int t = 0; t < nt; t += 2) {
            if constexpr (Epi::HOOK) E.hook(acc, cur, t, wr, wc, fr, fq, At, B0, B1);
            const bool last = (t == nt - 2);
            const char* a1 = cA + (size_t)(t + 1) * kstep;
            const char* a2 = last ? nA : cA + (size_t)(t + 2) * kstep; const char* b2 = last ? nB : cB + (size_t)(t + 2) * kstep;
            const char* a3 = a2 + kstep; const char* b3 = b2 + kstep;
            const size_t hs2 = (AMAP && last) ? hsN : hsC; unsigned vo2[2] = {(AMAP && last) ? voN[0] : voC[0], (AMAP && last) ? voN[1] : voC[1]};
            if (last && has_next) S.a_ready(nxt);
            PG8_LDB(B0, 0, 0); PG8_LDB(B1, 0, 1); PG8_SCHED; PG8_LDA(At, 0, 0); PG8_STAGE(PG8_SA(1, 1), a1 + hsC, voC);
            PG8_WAIT_V(8); PG8_WAIT_L(0); PG8_BAR; PG8_MMA(0, 0, At, B0); PG8_MMA(0, 1, At, B1); PG8_BAR; PG8_SCHED;
            PG8_LDA(At, 0, 1); PG8_STAGE(PG8_SB(0, 0), b2, voffB); PG8_STAGE(PG8_SB(0, 1), b2 + hstepB, voffB); PG8_STAGE(PG8_SA(0, 0), a2, vo2);
            PG8_WAIT_V(8); PG8_WAIT_L(0); PG8_BAR; PG8_MMA(1, 0, At, B0); PG8_MMA(1, 1, At, B1); PG8_BAR; PG8_SCHED;
            PG8_LDB(B0, 1, 0); PG8_LDB(B1, 1, 1); PG8_SCHED; PG8_LDA(At, 1, 0); PG8_STAGE(PG8_SA(0, 1), a2 + hs2, vo2);
            PG8_WAIT_V(8); PG8_WAIT_L(0); PG8_BAR; PG8_MMA(0, 0, At, B0); PG8_MMA(0, 1, At, B1); PG8_BAR; PG8_SCHED;
            PG8_LDA(At, 1, 1); PG8_STAGE(PG8_SB(1, 0), b3, voffB); PG8_STAGE(PG8_SB(1, 1), b3 + hstepB, voffB); PG8_STAGE(PG8_SA(1, 0), a3, vo2);
            PG8_WAIT_V(8); PG8_WAIT_L(0); PG8_BAR; PG8_MMA(1, 0, At, B0); PG8_MMA(1, 1, At, B1); PG8_BAR; PG8_SCHED;
        }
        if (wr == 0) PG8_BAR;
        E(acc, cur, wr, wc, fr, fq); S.done(cur);
        if (!has_next) break;
#pragma unroll
        for (int a = 0; a < 2; ++a)
#pragma unroll
            for (int b = 0; b < 2; ++b)
#pragma unroll
                for (int m = 0; m < 4; ++m)
#pragma unroll
                    for (int n = 0; n < 2; ++n) acc[a][b][m][n] = zero4();
        cur = nxt; cA = nA; cB = nB; ++ui;
        if constexpr (AMAP) { hsC = hsN; voC[0] = voN[0]; voC[1] = voN[1]; }
        if (wr == 1) PG8_BAR;
    }
    PG8_WAIT_V(0);
    PG8_BAR;
#undef PG8_SA
#undef PG8_SB
#undef PG8_STAGE
#undef PG8_LDA
#undef PG8_LDB
#undef PG8_MMA
#undef PG8_WAIT_V
#undef PG8_WAIT_L
#undef PG8_BAR
#undef PG8_SCHED
}
}

template <class F> __device__ __forceinline__ void epi_foreach(const f32x4 (&acc)[2][2][4][2], const pg8::Unit& u, int wr, int wc, int fr, int fq, F&& f) {
    const int row0 = u.pm * 256 + wr * 64 + fr, col0 = u.pn * 256 + wc * 32 + 8 * fq;
#pragma unroll
    for (int ai = 0; ai < 2; ++ai)
#pragma unroll
        for (int m = 0; m < 4; ++m)
#pragma unroll
            for (int bj = 0; bj < 2; ++bj) f(row0 + ai * 128 + m * 16, col0 + bj * 128, acc[ai][bj][m][0], acc[ai][bj][m][1]);
}
__device__ __forceinline__ void unpack8v(u32x4 w, f32x4& v0, f32x4& v1) {
    v0[0] = __uint_as_float(w.x << 16); v0[1] = __uint_as_float(w.x & 0xffff0000u); v0[2] = __uint_as_float(w.y << 16); v0[3] = __uint_as_float(w.y & 0xffff0000u);
    v1[0] = __uint_as_float(w.z << 16); v1[1] = __uint_as_float(w.z & 0xffff0000u); v1[2] = __uint_as_float(w.w << 16); v1[3] = __uint_as_float(w.w & 0xffff0000u);
}
__device__ __forceinline__ u32x4 pack8v(f32x4 v0, f32x4 v1) { u32x4 w; w.x = pk2(v0[0], v0[1]); w.y = pk2(v0[2], v0[3]); w.z = pk2(v1[0], v1[1]); w.w = pk2(v1[2], v1[3]); return w; }

struct EpiInProj {
    static constexpr bool PERM = true, HOOK = false;
    bf16_t* P; float* G; const float* bias;
    __device__ __forceinline__ void operator()(const f32x4 (&acc)[2][2][4][2], const pg8::Unit& u, int wr, int wc, int fr, int fq) const {
        if (u.pn < 48) {
            f32x4 bv[2][2];
#pragma unroll
            for (int bj = 0; bj < 2; ++bj) { const unsigned bo = (unsigned)(u.pn * 256 + wc * 32 + 8 * fq + bj * 128) * 4u; bv[bj][0] = gld<f32x4>(bias, bo); bv[bj][1] = gld<f32x4>(bias, bo + 16); }
            epi_foreach(acc, u, wr, wc, fr, fq, [&](int row, int col, f32x4 v0, f32x4 v1) {
                const int bj = (col >> 7) & 1;
                f32x4 o0 = v0 + bv[bj][0], o1 = v1 + bv[bj][1];
                if (u.pn >= PGM / 256) {
#pragma unroll
                    for (int j = 0; j < 4; ++j) { o0[j] = 1.f + __expf(-fminf(fmaxf(o0[j], -30.f), 30.f)); o1[j] = 1.f + __expf(-fminf(fmaxf(o1[j], -30.f), 30.f)); } }
                gst<u32x4>(P, (unsigned)(row * NP + col) * 2u, pack8v(o0, o1)); });
        } else if (wc == 0 && fq < 2) {
            const int row0 = u.pm * 256 + wr * 64 + fr;
            const f32x4 b0 = gld<f32x4>(bias, (unsigned)(NP + 8 * fq) * 4u), b1 = gld<f32x4>(bias, (unsigned)(NP + 8 * fq) * 4u + 16);
#pragma unroll
            for (int ai = 0; ai < 2; ++ai)
#pragma unroll
                for (int m = 0; m < 4; ++m) { const unsigned go = (unsigned)((row0 + ai * 128 + m * 16) * 16 + 8 * fq) * 4u;
                    gst<f32x4>(G, go, acc[ai][0][m][0] + b0); gst<f32x4>(G, go + 16, acc[ai][0][m][1] + b1); }
        }
    }
};
struct EpiBf16 {
    static constexpr bool PERM = true, HOOK = false;
    bf16_t* O; int ldc; int split_cols; unsigned split_stride; int pad; float* slab;
    __device__ __forceinline__ void operator()(const f32x4 (&acc)[2][2][4][2], const pg8::Unit& u, int wr, int wc, int fr, int fq) const {
        if (u.ks >= 0) { const unsigned sb = (unsigned)u.ks * (unsigned)(RC * ldc);
            epi_foreach(acc, u, wr, wc, fr, fq, [&](int row, int col, f32x4 v0, f32x4 v1) { const unsigned o = (sb + (unsigned)((row - RL) * ldc + col)) * 4u; gst<f32x4>(slab, o, v0); gst<f32x4>(slab, o + 16, v1); });
            return; }
        int colt = u.pn * 256; unsigned base = 0;
        if (split_cols) { const int t = colt / split_cols; base = (unsigned)t * split_stride; colt -= t * split_cols; }
        const int cshift = colt - u.pn * 256;
        epi_foreach(acc, u, wr, wc, fr, fq, [&](int row, int col, f32x4 v0, f32x4 v1) { gst<u32x4>(O, (base + (unsigned)(row * ldc + col + cshift)) * 2u, pack8v(v0, v1)); });
    }
};
struct EpiMerge {
    static constexpr bool PERM = true, HOOK = true;
    const bf16_t* P; bf16_t* MG;
    __device__ __forceinline__ void hook(f32x4 (&acc)[2][2][4][2], const pg8::Unit& u, int t, int wr, int wc, int fr, int fq, bf16x8 (&At)[4][2], bf16x8 (&B0)[2][2], bf16x8 (&B1)[2][2]) const {
        if (t != 16 && t != 24) return;
        const int b = t == 16 ? 0 : 1;
        const unsigned o0 = (unsigned)((u.pm * 256 + wr * 64 + fr) * NP + PGM + b * D + u.pn * 256 + wc * 32 + 8 * fq) * 2u;
#pragma unroll
        for (int ai = 0; ai < 2; ++ai) {
#pragma unroll
            for (int m = 0; m < 4; ++m) { const unsigned o = o0 + (unsigned)((ai * 128 + m * 16) * NP) * 2u;
                At[m][0] = gld<bf16x8>(P, o); At[m][1] = gld<bf16x8>(P, o + 256u);
                if (m < 2) { B0[m][0] = gld<bf16x8>(P, o + D * 2); B0[m][1] = gld<bf16x8>(P, o + D * 2 + 256u); }
                else { B1[m - 2][0] = gld<bf16x8>(P, o + D * 2); B1[m - 2][1] = gld<bf16x8>(P, o + D * 2 + 256u); } }
#pragma unroll
            for (int m = 0; m < 4; ++m)
#pragma unroll
                for (int bj = 0; bj < 2; ++bj) { float xa[8], xb[8]; unpack8(__builtin_bit_cast(u32x4, At[m][bj]), xa); unpack8(__builtin_bit_cast(u32x4, m < 2 ? B0[m][bj] : B1[m - 2][bj]), xb);
#pragma unroll
                    for (int j = 0; j < 8; ++j) acc[ai][bj][m][j >> 2][j & 3] *= xb[j] * __builtin_amdgcn_rcpf(xa[j]); }
        }
    }
    __device__ __forceinline__ void operator()(const f32x4 (&acc)[2][2][4][2], const pg8::Unit& u, int wr, int wc, int fr, int fq) const {
        const int row0 = u.pm * 256 + wr * 64 + fr, col0 = u.pn * 256 + wc * 32 + 8 * fq;
#pragma unroll
        for (int ai = 0; ai < 2; ++ai) { u32x4 gr[4][2];
#pragma unroll
            for (int m = 0; m < 4; ++m)
#pragma unroll
                for (int bj = 0; bj < 2; ++bj) gr[m][bj] = gld<u32x4>(P, (unsigned)((row0 + ai * 128 + m * 16) * NP + PGM + 2 * D + col0 + bj * 128) * 2u);
#pragma unroll
            for (int m = 0; m < 4; ++m)
#pragma unroll
                for (int bj = 0; bj < 2; ++bj) { float g[8]; unpack8(gr[m][bj], g);
                    const f32x4 g0 = {__builtin_amdgcn_rcpf(g[0]), __builtin_amdgcn_rcpf(g[1]), __builtin_amdgcn_rcpf(g[2]), __builtin_amdgcn_rcpf(g[3])},
                                g1 = {__builtin_amdgcn_rcpf(g[4]), __builtin_amdgcn_rcpf(g[5]), __builtin_amdgcn_rcpf(g[6]), __builtin_amdgcn_rcpf(g[7])};
                    gst<u32x4>(MG, (unsigned)((row0 + ai * 128 + m * 16) * D + col0 + bj * 128) * 2u, pack8v(g0 * acc[ai][bj][m][0], g1 * acc[ai][bj][m][1])); }
        }
    }
};
struct EpiUp {
    static constexpr bool PERM = true, HOOK = false;
    bf16_t* U; float* slab; bf16_t* ACT; const float* wf;
    __device__ __forceinline__ void operator()(const f32x4 (&acc)[2][2][4][2], const pg8::Unit& u, int wr, int wc, int fr, int fq) const {
        if (u.ks >= 0) { const unsigned sb = (unsigned)u.ks * (unsigned)(RC * NUP);
            epi_foreach(acc, u, wr, wc, fr, fq, [&](int row, int col, f32x4 v0, f32x4 v1) { const unsigned o = (sb + (unsigned)((row - RL) * NUP + col)) * 4u; gst<f32x4>(slab, o, v0); gst<f32x4>(slab, o + 16, v1); });
            return; }
        if (u.pm >= 32) { epi_foreach(acc, u, wr, wc, fr, fq, [&](int row, int col, f32x4 v0, f32x4 v1) { gst<u32x4>(U, (unsigned)(row * NUP + col) * 2u, pack8v(v0, v1)); }); return; }
        const int c0 = 128 * u.pn + 32 * wc + 8 * fq, lane = fq * 16 + fr;
        const int lprev = ((lane & 48) | ((fr - 1) & 15)), lnext = ((lane & 48) | ((fr + 1) & 15));
        float w0[8], w1[8], w2[8];
        { const f32x4 a0 = gld<f32x4>(wf, (unsigned)c0 * 4u), a1 = gld<f32x4>(wf, (unsigned)c0 * 4u + 16), b0 = gld<f32x4>(wf, (unsigned)(DFF + c0) * 4u), b1 = gld<f32x4>(wf, (unsigned)(DFF + c0) * 4u + 16),
                      d0 = gld<f32x4>(wf, (unsigned)(2 * DFF + c0) * 4u), d1 = gld<f32x4>(wf, (unsigned)(2 * DFF + c0) * 4u + 16);
#pragma unroll
          for (int j = 0; j < 4; ++j) { w0[j] = a0[j]; w0[4 + j] = a1[j]; w1[j] = b0[j]; w1[4 + j] = b1[j]; w2[j] = d0[j]; w2[4 + j] = d1[j]; } }
        const unsigned rowb = (unsigned)((u.pm >> 3) * 2048 + (u.pm & 7) * 8 + 2 * wr);
#pragma unroll
        for (int ai = 0; ai < 2; ++ai)
#pragma unroll
            for (int m = 0; m < 4; ++m) {
                float o[8];
#pragma unroll
                for (int n = 0; n < 2; ++n)
#pragma unroll
                    for (int e = 0; e < 4; ++e) {
                        const float a = acc[ai][0][m][n][e];
                        const float oprev = (m & 1) ? acc[ai][0][m - 1 < 0 ? 0 : m - 1][n][e] : 0.f, onext = (m & 1) ? 0.f : acc[ai][0][m + 1 > 3 ? 3 : m + 1][n][e];
                        const float pv = shl_(fr == 15 ? oprev : a, lprev), nx = shl_(fr == 0 ? onext : a, lnext);
                        o[4 * n + e] = siluf_(w0[4 * n + e] * pv + w1[4 * n + e] * a + w2[4 * n + e] * nx) * acc[ai][1][m][n][e];
                    }
                const unsigned row = rowb + (unsigned)((16 * (m & 1) + fr) * 64 + 4 * ai + (m >> 1));
                gst<u32x4>(ACT, (row * (unsigned)DFF + (unsigned)c0) * 2u, pack8(o));
            }
    }
};
struct EpiResid {
    static constexpr bool PERM = true, HOOK = false;
    int l, which, fuse; float scale;
    __device__ __forceinline__ void operator()(f32x4 (&acc)[2][2][4][2], const pg8::Unit& u, int wr, int wc, int fr, int fq) const {
        CParams& p = *okp(); unsigned char* const ws = ows(p.ws);
        bf16_t* H = (bf16_t*)(ws + OFF_H); const bool xin = (l == 0 && which == 0);
        const float* mod = (const float*)(ws + OFF_MOD) + (size_t)l * 5 * 6 * D; const float* gate = mod + (which ? 5 : 2) * D;
        if (u.ks >= 0) { float* slab = (float*)(ws + OFF_SLAB); const unsigned sb = (unsigned)u.ks * (unsigned)(RC * D);
            epi_foreach(acc, u, wr, wc, fr, fq, [&](int row, int col, f32x4 v0, f32x4 v1) { const unsigned o = (sb + (unsigned)((row - RL) * D + col)) * 4u; gst<f32x4>(slab, o, v0); gst<f32x4>(slab, o + 16, v1); });
            return; }
        const unsigned gb = (unsigned)(u.pm < 32 ? (u.pm >> 3) : 4) * (6 * D) * 4u;
        if (!fuse || u.pm >= 32) {
            epi_foreach(acc, u, wr, wc, fr, fq, [&](int row, int col, f32x4 v0, f32x4 v1) {
                const unsigned eo = (unsigned)(row * D + col);
                const f32x4 g0 = gld<f32x4>(gate, gb + (unsigned)col * 4u), g1 = gld<f32x4>(gate, gb + (unsigned)col * 4u + 16);
                f32x4 o0, o1; if (xin) { o0 = gld<f32x4>(p.x, eo * 4u); o1 = gld<f32x4>(p.x, eo * 4u + 16); } else unpack8v(gld<u32x4>(H, eo * 2u), o0, o1);
                gst<u32x4>(H, eo * 2u, pack8v(o0 + g0 * v0 * scale, o1 + g1 * v1 * scale)); });
            return; }
        bf16_t* XN = (bf16_t*)(ws + OFF_XN); const float* nw = fuse == 2 ? p.final_norm_w : which ? p.norm1_w + (size_t)(l + 1) * D : p.norm2_w + (size_t)l * D;
        const float* nmod = which ? mod + 5 * 6 * D : mod + 3 * D;
        float* xs = (float*)(ws + OFF_XS) + (size_t)(2 * l + which) * RL * 32; unsigned* cnt = (unsigned*)(ws + OFF_CTL) + CNTW + (2 * l + which) * 32 * 64;
        float* out = p.out;
        int lane; asm volatile("v_mbcnt_lo_u32_b32 %0, -1, 0\n\tv_mbcnt_hi_u32_b32 %0, -1, %0" : "=v"(lane));
        { const int fr2 = lane & 15, fq2 = lane >> 4, row0 = u.pm * 256 + wr * 64 + fr2, col0 = u.pn * 256 + wc * 32 + 8 * fq2;
          f32x4 gv[2][2];
#pragma unroll
          for (int bj = 0; bj < 2; ++bj) { gv[bj][0] = gld<f32x4>(gate, gb + (unsigned)(col0 + bj * 128) * 4u) * scale; gv[bj][1] = gld<f32x4>(gate, gb + (unsigned)(col0 + bj * 128) * 4u + 16) * scale; }
          float ssr[8];
          auto newh = [&](int k, int bj, f32x4 o0, f32x4 o1, float& ss) {
              const int ai = k >> 2, m = k & 3; const unsigned eo = (unsigned)((row0 + ai * 128 + m * 16) * D + col0 + bj * 128);
              const f32x4 h0 = o0 + gv[bj][0] * acc[ai][bj][m][0], h1 = o1 + gv[bj][1] * acc[ai][bj][m][1];
              if (fuse == 2) { gst<f32x4>(out, eo * 4u, h0); gst<f32x4>(out, eo * 4u + 16, h1); } else gst<u32x4>(H, eo * 2u, pack8v(h0, h1));
              ss += (h0[0] * h0[0] + h0[1] * h0[1]) + (h0[2] * h0[2] + h0[3] * h0[3]) + (h1[0] * h1[0] + h1[1] * h1[1]) + (h1[2] * h1[2] + h1[3] * h1[3]); };
          if (xin) {
#pragma unroll
            for (int am = 0; am < 4; ++am) { f32x4 hv[2][2][2];
#pragma unroll
              for (int mm = 0; mm < 2; ++mm)
#pragma unroll
                for (int bj = 0; bj < 2; ++bj) { const unsigned ho = (unsigned)((row0 + (am >> 1) * 128 + (2 * (am & 1) + mm) * 16) * D + col0 + bj * 128) * 4u; hv[mm][bj][0] = gld<f32x4>(p.x, ho); hv[mm][bj][1] = gld<f32x4>(p.x, ho + 16); }
#pragma unroll
              for (int mm = 0; mm < 2; ++mm) { const int k = 4 * (am >> 1) + 2 * (am & 1) + mm; float ss = 0.f;
#pragma unroll
                for (int bj = 0; bj < 2; ++bj) newh(k, bj, hv[mm][bj][0], hv[mm][bj][1], ss);
                ss += shx(ss, 16, lane); ss += shx(ss, 32, lane); ssr[k] = ss; } }
          } else {
#pragma unroll
            for (int kh = 0; kh < 2; ++kh) { u32x4 hr[4][2];
#pragma unroll
              for (int m = 0; m < 4; ++m)
#pragma unroll
                for (int bj = 0; bj < 2; ++bj) hr[m][bj] = gld<u32x4>(H, (unsigned)((row0 + kh * 128 + m * 16) * D + col0 + bj * 128) * 2u);
#pragma unroll
              for (int m = 0; m < 4; ++m) { const int k = 4 * kh + m; float ss = 0.f;
#pragma unroll
                for (int bj = 0; bj < 2; ++bj) { f32x4 o0, o1; unpack8v(hr[m][bj], o0, o1); newh(k, bj, o0, o1, ss); }
                ss += shx(ss, 16, lane); ss += shx(ss, 32, lane); ssr[k] = ss; } }
          }
#pragma unroll
          for (int k = 0; k < 8; ++k)
              if (fq2 == 0) __hip_atomic_store((GAS float*)xs + ((row0 + (k >> 2) * 128 + (k & 3) * 16) * 32 + u.pn * 4 + wc), ssr[k], __ATOMIC_RELAXED, __HIP_MEMORY_SCOPE_AGENT); }
        asm volatile("s_waitcnt vmcnt(0)" ::: "memory");
        __builtin_amdgcn_s_barrier();
        if (lane == 0 && wr == 0 && wc == 0) {
            GAS unsigned* pc = (GAS unsigned*)cnt + 64 * u.pm;
            (void)__hip_atomic_fetch_add(pc, 1u, __ATOMIC_RELAXED, __HIP_MEMORY_SCOPE_AGENT);
            unsigned spins = 0;
            while (__hip_atomic_load(pc, __ATOMIC_RELAXED, __HIP_MEMORY_SCOPE_AGENT) < 8u && ++spins < (1u << 22)) __builtin_amdgcn_s_sleep(1);
        }
        __builtin_amdgcn_s_barrier();
        __builtin_amdgcn_fence(__ATOMIC_ACQUIRE, "agent");
        { const int hl = lane & 31, row0 = u.pm * 256 + (wr * 4 + wc) * 32 + (lane >> 5), col = u.pn * 256 + hl * 8;
          const unsigned mo = (unsigned)(u.pm >> 3) * (6 * D) * 4u, co = (unsigned)col * 4u;
          const f32x4 w0 = gld<f32x4>(nw, co), w1 = gld<f32x4>(nw, co + 16);
          if (fuse == 2) {
#pragma unroll
            for (int ib = 0; ib < 4; ++ib) { float tt[4]; f32x4 ha[4], hb[4];
#pragma unroll
              for (int i = 0; i < 4; ++i) { const int row = row0 + 2 * (4 * ib + i); const unsigned ho = (unsigned)(row * D + col) * 4u;
                  tt[i] = gld<float>(xs, (unsigned)(row * 32 + hl) * 4u); ha[i] = gld<f32x4>(out, ho); hb[i] = gld<f32x4>(out, ho + 16); }
#pragma unroll
              for (int i = 0; i < 4; ++i) { const int row = row0 + 2 * (4 * ib + i); const unsigned ho = (unsigned)(row * D + col) * 4u; float tot = tt[i];
#pragma unroll
                  for (int o = 1; o < 32; o <<= 1) tot += shx(tot, o, lane);
                  const float rstd = rsqrtf(tot * (1.f / D) + EPS);
                  gst<f32x4>(out, ho, ha[i] * rstd * w0); gst<f32x4>(out, ho + 16, hb[i] * rstd * w1); } }
            return; }
          const f32x4 sh0 = gld<f32x4>(nmod, mo + co), sh1 = gld<f32x4>(nmod, mo + co + 16);
          const f32x4 sc0 = gld<f32x4>(nmod, mo + D * 4 + co) + 1.f, sc1 = gld<f32x4>(nmod, mo + D * 4 + co + 16) + 1.f;
#pragma unroll
          for (int ib = 0; ib < 2; ++ib) { float tt[8]; u32x4 hq[8];
#pragma unroll
            for (int i = 0; i < 8; ++i) { const int row = row0 + 2 * (8 * ib + i);
                tt[i] = gld<float>(xs, (unsigned)(row * 32 + hl) * 4u); hq[i] = gld<u32x4>(H, (unsigned)(row * D + col) * 2u); }
#pragma unroll
            for (int i = 0; i < 8; ++i) { const int row = row0 + 2 * (8 * ib + i); float tot = tt[i];
#pragma unroll
                for (int o = 1; o < 32; o <<= 1) tot += shx(tot, o, lane);
                const float rstd = rsqrtf(tot * (1.f / D) + EPS);
                f32x4 ha, hb; unpack8v(hq[i], ha, hb);
                const f32x4 y0 = (ha * rstd * w0) * sc0 + sh0, y1 = (hb * rstd * w1) * sc1 + sh1;
                gst<u32x4>(XN, (unsigned)(row * D + col) * 2u, pack8v(y0, y1)); } } }
    }
};

__device__ __forceinline__ bf16x8 gather8(const bf16_t* p, size_t stride) {
    bf16x8 v;
#pragma unroll
    for (int j = 0; j < 8; ++j) v[j] = (short)p[(size_t)j * stride];
    return v;
}
template <bool AV, bool BV>
__device__ __forceinline__ void wave_mm32(const bf16_t* A, size_t sam, size_t sak, const bf16_t* B, size_t sbk, size_t sbn, int K, f32x4 (&acc)[2][2], int lane) {
    const int fr = lane & 15, fq = lane >> 4;
    for (int k0 = 0; k0 < K; k0 += 32) {
        bf16x8 a[2], b[2];
#pragma unroll
        for (int mi = 0; mi < 2; ++mi) { const bf16_t* q = A + (size_t)(16 * mi + fr) * sam + (size_t)(k0 + 8 * fq) * sak; a[mi] = AV ? *(const bf16x8*)q : gather8(q, sak); }
#pragma unroll
        for (int ni = 0; ni < 2; ++ni) { const bf16_t* q = B + (size_t)(16 * ni + fr) * sbn + (size_t)(k0 + 8 * fq) * sbk; b[ni] = BV ? *(const bf16x8*)q : gather8(q, sbk); }
#pragma unroll
        for (int mi = 0; mi < 2; ++mi)
#pragma unroll
            for (int ni = 0; ni < 2; ++ni) acc[mi][ni] = __builtin_amdgcn_mfma_f32_16x16x32_bf16(a[mi], b[ni], acc[mi][ni], 0, 0, 0);
    }
}
#define ZERO_ACC22(acc) do { _Pragma("unroll") for (int _a = 0; _a < 2; ++_a) _Pragma("unroll") for (int _b = 0; _b < 2; ++_b) acc[_a][_b] = (f32x4){0.f, 0.f, 0.f, 0.f}; } while (0)

__device__ __forceinline__ void transpose_item(const float* W, int N, int pitch, int kdst0, bf16_t* WT, int dst_row0, int src_col0, int nvalid, int k0, LAS float* scr, int lane) {
    const int n4 = (lane & 15) * 4, kq = lane >> 4;
    f32x4 v[16];
#pragma unroll
    for (int i = 0; i < 16; ++i) v[i] = n4 < nvalid ? gld<f32x4>(W, (unsigned)((k0 + 4 * i + kq) * N + src_col0 + n4) * 4u) : (f32x4){0.f, 0.f, 0.f, 0.f};
#pragma unroll
    for (int i = 0; i < 16; ++i) { LAS float* d = scr + (4 * i + kq) * 65 + n4; d[0] = v[i][0]; d[1] = v[i][1]; d[2] = v[i][2]; d[3] = v[i][3]; }
    asm volatile("s_waitcnt lgkmcnt(0)" ::: "memory");
    const int c = lane & 7;
#pragma unroll
    for (int j8 = 0; j8 < 8; ++j8) { const int n = (lane >> 3) + 8 * j8; const LAS float* sp = scr + (8 * c) * 65 + n;
        u32x4 o; o.x = pk2(sp[0 * 65], sp[1 * 65]); o.y = pk2(sp[2 * 65], sp[3 * 65]); o.z = pk2(sp[4 * 65], sp[5 * 65]); o.w = pk2(sp[6 * 65], sp[7 * 65]);
        gst<u32x4>(WT, (unsigned)((dst_row0 + n) * pitch + kdst0 + k0 + 8 * c) * 2u, o); }
    asm volatile("s_waitcnt lgkmcnt(0)" ::: "memory");
}
constexpr int I_IN = (NINP / 64) * (D / 64), I_PM = (D / 64) * (DM / 64), I_PF = (D / 64) * (DF / 64), I_PC = (D / 64) * (DC / 64), I_O = (D / 64) * (D / 64),
              I_UP = (NUP / 64) * (D / 64), I_DN = (D / 64) * (DFF / 64), I_LAYER = I_IN + I_PM + I_PF + I_PC + I_O + I_UP + I_DN;
__device__ __forceinline__ void ph_convert(int wv, LAS unsigned char* lds, int l, int widx, int nwg, int it_lo, int it_hi) {
    CParams& p = *okp();
    unsigned char* const wsb = ows(p.ws);
    const int TIDX = otid(wv);
    const int lane = TIDX & 63, wave = wv;
    LAS float* scr = (LAS float*)lds + wave * 64 * 65;
    const int gw = widx * 8 + wave, NGW = nwg * 8;
    for (int it = it_lo + gw; it < it_hi; it += NGW) {
        int r = it;
        if (r < I_IN) { const int nkb = D / 64, kb = r % nkb, grp = r / nkb, j0 = 64 * grp; int src0, nv;
            if (j0 < 2048) { src0 = j0; nv = 64; } else if (j0 < NP) { src0 = j0 + 16; nv = 64; } else if (j0 == NP) { src0 = 2048; nv = 16; } else { src0 = 0; nv = 0; }
            transpose_item(p.w_in + (size_t)l * D * NIN, NIN, D, 0, WSP(bf16_t, OFF_WIN) + (size_t)l * NINP * D, j0, src0, nv, 64 * kb, scr, lane); continue; } r -= I_IN;
        if (r < I_PM) { const int nkb = DM / 64, kb = r % nkb, grp = r / nkb;
            transpose_item(p.w_pm + (size_t)l * DM * D, D, D, 0, WSP(bf16_t, OFF_WPM) + (size_t)l * D * D, 64 * grp, 64 * grp, 64, 64 * kb, scr, lane); continue; } r -= I_PM;
        if (r < I_PF) { const int nkb = DF / 64, kb = r % nkb, grp = r / nkb;
            transpose_item(p.w_pf + (size_t)l * DF * D, D, D, DM, WSP(bf16_t, OFF_WPM) + (size_t)l * D * D, 64 * grp, 64 * grp, 64, 64 * kb, scr, lane); continue; } r -= I_PF;
        if (r < I_PC) { const int nkb = DC / 64, kb = r % nkb, grp = r / nkb;
            transpose_item(p.w_pc + (size_t)l * DC * D, D, D, DM + DF, WSP(bf16_t, OFF_WPM) + (size_t)l * D * D, 64 * grp, 64 * grp, 64, 64 * kb, scr, lane); continue; } r -= I_PC;
        if (r < I_O) { const int nkb = D / 64, kb = r % nkb, grp = r / nkb;
            transpose_item(p.w_o + (size_t)l * D * D, D, D, 0, WSP(bf16_t, OFF_WO) + (size_t)l * D * D, 64 * grp, 64 * grp, 64, 64 * kb, scr, lane); continue; } r -= I_O;
        if (r < I_UP) { const int nkb = D / 64, kb = r % nkb, grp = r / nkb, j0 = 64 * grp, tile = j0 >> 8, w0 = j0 & 255;
            transpose_item(p.w_up + (size_t)l * D * NUP, NUP, D, 0, WSP(bf16_t, OFF_WUP) + (size_t)l * NUP * D, j0, w0 < 128 ? 128 * tile + w0 : DFF + 128 * tile + (w0 - 128), 64, 64 * kb, scr, lane); continue; } r -= I_UP;
        { const int nkb = DFF / 64, kb = r % nkb, grp = r / nkb;
            transpose_item(p.w_down + (size_t)l * DFF * D, D, DFF, 0, WSP(bf16_t, OFF_WDN) + (size_t)l * D * DFF, 64 * grp, 64 * grp, 64, 64 * kb, scr, lane); }
    }
}
__device__ __forceinline__ void ph_tables(int wv) {
    CParams& p = *okp();
    unsigned char* const wsb = ows(p.ws);
    const int TIDX = otid(wv), BIDX = obid(); (void)TIDX; (void)BIDX;
    const size_t gt = (size_t)BIDX * 512 + TIDX, NT = (size_t)gridDim.x * 512;
    bf16_t* ma = WSP(bf16_t, OFF_MA);
    for (size_t i = gt; i < (size_t)64 * 64; i += NT) { const int row = (int)(i >> 6), col = (int)(i & 63), ro = row >> 5, tau1 = row & 31, ri = col >> 5, t1 = col & 31;
        const float a = (float)((t1 * tau1) & 31) * (1.0f / 16.0f); const float cv = cospif(a), sv = sinpif(a);
        ma[i] = (bf16_t)f2bf(ro == ri ? cv : (ro == 0 ? sv : -sv)); }
    bf16_t* mc = WSP(bf16_t, OFF_MC);
    for (size_t i = gt; i < (size_t)32 * 64 * 128; i += NT) { const int k = (int)(i & 127), tau2 = (int)(i >> 7) & 63, tau1 = (int)(i >> 13), ri = k >> 6, t2 = k & 63, tau = tau1 + 32 * tau2;
        const float a = (float)((t2 * tau) & 2047) * (1.0f / 1024.0f); mc[i] = (bf16_t)f2bf((ri ? sinpif(a) : cospif(a)) * (1.0f / 512.0f)); }
    bf16_t* csc = WSP(bf16_t, OFF_CSC);
    for (size_t i = gt; i < (size_t)256 * 512; i += NT) { const int tau = (int)(i >> 9), k = (int)(i & 511), t = k & 255; const int idx = (tau * t) & 255;
        const float a = (float)idx * (1.0f / 128.0f); const float v = (k < 256 ? cospif(a) : -sinpif(a)) * 0.005524271728019903f  ; csc[i] = (bf16_t)f2bf(v); }
    bf16_t* ft = WSP(bf16_t, OFF_FT);
    for (size_t i = gt; i < (size_t)256 * 128; i += NT) { const int kp = (int)(i >> 7), c = (int)(i & 127), kap = kp & 127; const int idx = (c * kap) & 127;
        const float a = (float)idx * (1.0f / 64.0f); ft[i] = (bf16_t)f2bf(kp < 128 ? cospif(a) : sinpif(a)); }
    float* binr = WSP(float, OFF_BINR);
    for (size_t i = gt; i < (size_t)DEPTH * NINP; i += NT) { const int l = (int)(i / NINP), j = (int)(i % NINP);
        float v = 0.f; if (j < 2048) v = p.b_in[(size_t)l * NIN + j]; else if (j < NP) v = p.b_in[(size_t)l * NIN + j + 16]; else if (j < NP + 16) v = p.b_in[(size_t)l * NIN + 2048 + (j - NP)];
        binr[i] = v; }

}
__device__ __forceinline__ void ph_mod(int wv, LAS unsigned char* lds, int l0, int l1, int widx, int nwg) {
    CParams& p = *okp();
    unsigned char* const wsb = ows(p.ws);
    const int TIDX = otid(wv), BIDX = obid(); (void)TIDX; (void)BIDX;
    typedef float sc_row_t[D]; typedef f32x4 red_t[5][16];
    LAS sc_row_t* sc = (LAS sc_row_t*)lds; LAS red_t* red = (LAS red_t*)(lds + 5 * D * 4);
    const int tid = TIDX;
    for (int i = tid; i < 5 * D; i += 512) { const int j = i / D, k = i % D; const float v = j < 4 ? p.c[(size_t)j * D + k] : p.c_ctx[k]; sc[j][k] = siluf_(v); }
    __syncthreads();
    float* mod = WSP(float, OFF_MOD);
    const int cl = tid & 15, kg = tid >> 4;
    for (int unit = widx; unit < (l1 - l0) * (6 * D / 64); unit += nwg) {
        const int l = l0 + unit / (6 * D / 64), n0 = (unit % (6 * D / 64)) * 64;
        f32x4 a[5];
#pragma unroll
        for (int j = 0; j < 5; ++j) a[j] = (f32x4){0.f, 0.f, 0.f, 0.f};
        const float* wp = p.w_mod + (size_t)l * D * 6 * D + n0 + 4 * cl;
        for (int k0 = kg; k0 < D; k0 += 32 * 8) { f32x4 w8[8];
#pragma unroll
            for (int i = 0; i < 8; ++i) w8[i] = *(const f32x4*)(wp + (size_t)(k0 + 32 * i) * 6 * D);
#pragma unroll
            for (int i = 0; i < 8; ++i)
#pragma unroll
                for (int j = 0; j < 5; ++j) a[j] += sc[j][k0 + 32 * i] * w8[i]; }
#pragma unroll
        for (int j = 0; j < 5; ++j) {
#pragma unroll
            for (int e = 0; e < 4; ++e) { float v = a[j][e]; v += shx(v, 16, tid & 63); v += shx(v, 32, tid & 63); a[j][e] = v; }
            if ((tid & 63) < 16) red[tid >> 6][j][cl] = a[j]; }
        __syncthreads();
        if (tid < 5 * 64) { const int j = tid / 64, cc = tid % 64; float s = 0.f;
            for (int g = 0; g < 8; ++g) s += ((const LAS float*)&red[g][j][0])[cc];
            mod[((size_t)l * 5 + j) * 6 * D + n0 + cc] = s + p.b_mod[(size_t)l * 6 * D + n0 + cc]; }
        __syncthreads();
    }
}

template <bool F32> __device__ __forceinline__ void ph_norm(int wv, int l, int which, const float* fixgate, int row_lo, int nrows, const void* hlat, const void* hctx) {
    CParams& p = *okp();
    unsigned char* const wsb = ows(p.ws);
    const int TIDX = otid(wv), BIDX = obid();
    const int lane = TIDX & 63, gw = BIDX * 8 + (TIDX >> 6), NGW = gridDim.x * 8;
    const float* nw = (which ? p.norm2_w : p.norm1_w) + (size_t)l * D;
    const float* mod = WSP(float, OFF_MOD) + (size_t)l * 5 * 6 * D;
    bf16_t* H = WSP(bf16_t, OFF_H); bf16_t* XN = WSP(bf16_t, OFF_XN); const float* SL = WSP(float, OFF_SLAB);
    for (int r = row_lo + gw; r < nrows; r += NGW) {
        int mj, t, T; rowinfo(r, mj, t, T);
        const unsigned so = (unsigned)(mj * 6 * D + (which ? 3 : 0) * D) * 4u;
        const unsigned ho = (unsigned)(r * D + 4 * lane) * 2u;
        const void* rd = r < RL ? hlat : hctx; const unsigned re = (unsigned)((r < RL ? r : r - RL) * D + 4 * lane);
        f32x4 v[8]; float ss = 0.f;
        if constexpr (F32) {
#pragma unroll
            for (int j = 0; j < 8; ++j) v[j] = gld<f32x4>(rd, re * 4u + (unsigned)j * 1024u);
        } else { u32x2 q[8];
#pragma unroll
            for (int j = 0; j < 8; ++j) q[j] = gld<u32x2>(rd, re * 2u + (unsigned)j * 512u);
#pragma unroll
            for (int j = 0; j < 8; ++j) { v[j][0] = __uint_as_float(q[j].x << 16); v[j][1] = __uint_as_float(q[j].x & 0xffff0000u); v[j][2] = __uint_as_float(q[j].y << 16); v[j][3] = __uint_as_float(q[j].y & 0xffff0000u); } }
        if (fixgate != nullptr && r >= RL) {
            unsigned dep = 0u;
#pragma unroll
            for (int j = 0; j < 8; ++j) { f32x4 sp[8];
#pragma unroll
                for (int sl = 0; sl < 8; ++sl) sp[sl] = gld<f32x4>(SL, (unsigned)((sl * RC + (r - RL)) * D + 4 * lane + 256 * j) * 4u + dep);
                const f32x4 fg = gld<f32x4>(fixgate, (unsigned)(4 * lane + 256 * j) * 4u);
                f32x4 a = sp[0];
#pragma unroll
                for (int sl = 1; sl < 8; ++sl) a += sp[sl];
                v[j] += fg * a;
                if (j & 1) asm volatile("" : "+v"(dep), "+v"(v[j][0]), "+v"(v[j][1]), "+v"(v[j][2]), "+v"(v[j][3])); }
#pragma unroll
            for (int j = 0; j < 8; ++j) { u32x2 q; q.x = pk2(v[j][0], v[j][1]); q.y = pk2(v[j][2], v[j][3]); gst<u32x2>(H, ho + (unsigned)j * 512u, q); }
        }
#pragma unroll
        for (int j = 0; j < 8; ++j) ss += (v[j][0] * v[j][0] + v[j][1] * v[j][1]) + (v[j][2] * v[j][2] + v[j][3] * v[j][3]);
        const float rstd = rsqrtf(wave_sum(ss, lane) * (1.f / D) + EPS);
#pragma unroll
        for (int jh = 0; jh < 2; ++jh) { f32x4 wq[4], scq[4], shq[4];
#pragma unroll
          for (int jj = 0; jj < 4; ++jj) { const unsigned co = (unsigned)(4 * (lane + 64 * (4 * jh + jj))) * 4u; wq[jj] = gld<f32x4>(nw, co); scq[jj] = gld<f32x4>(mod, so + D * 4 + co); shq[jj] = gld<f32x4>(mod, so + co); }
#pragma unroll
          for (int jj = 0; jj < 4; ++jj) { const int j = 4 * jh + jj;
            const f32x4 y = (v[j] * rstd * wq[jj]) * (1.f + scq[jj]) + shq[jj];
            u32x2 q; q.x = pk2(y[0], y[1]); q.y = pk2(y[2], y[3]); gst<u32x2>(XN, (unsigned)(r * D + 4 * (lane + 64 * j)) * 2u, q); } }
    }
}
__device__ __forceinline__ void ph_final(int wv) {
    CParams& p = *okp();
    unsigned char* const wsb = ows(p.ws);
    const int TIDX = otid(wv), BIDX = obid(); (void)TIDX; (void)BIDX;
    const int lane = TIDX & 63, gw = BIDX * 8 + (TIDX >> 6), NGW = gridDim.x * 8;
    const bf16_t* H = WSP(bf16_t, OFF_H);
    for (int r = gw; r < RL; r += NGW) {
        f32x4 v[8]; float ss = 0.f;
#pragma unroll
        for (int j = 0; j < 8; ++j) { const u32x2 q = gld<u32x2>(H, (unsigned)(r * D + 4 * (lane + 64 * j)) * 2u); v[j][0] = __uint_as_float(q.x << 16); v[j][1] = __uint_as_float(q.x & 0xffff0000u); v[j][2] = __uint_as_float(q.y << 16); v[j][3] = __uint_as_float(q.y & 0xffff0000u); ss += (v[j][0] * v[j][0] + v[j][1] * v[j][1]) + (v[j][2] * v[j][2] + v[j][3] * v[j][3]); }
        const float rstd = rsqrtf(wave_sum(ss, lane) * (1.f / D) + EPS);
        f32x4* o = (f32x4*)(p.out + (size_t)r * D) + lane;
#pragma unroll
        for (int j = 0; j < 8; ++j) { const f32x4 w = *(const f32x4*)(p.final_norm_w + 4 * (lane + 64 * j)); o[64 * j] = v[j] * rstd * w; }
    }
}

__device__ __forceinline__ float wave_incl_sum(float v, int lane) {
#pragma unroll
    for (int o = 1; o < 64; o <<= 1) { const float t = shl_(v, lane >= o ? lane - o : lane); if (lane >= o) v += t; }
    return v;
}
__device__ __forceinline__ float wave_incl_max(float v, int lane) {
#pragma unroll
    for (int o = 1; o < 64; o <<= 1) { const float t = shl_(v, lane >= o ? lane - o : lane); if (lane >= o) v = fmaxf(v, t); }
    return v;
}
__device__ __forceinline__ float logsigmoidf_(float x) { return fminf(x, 0.f) - log1pf(__expf(-fabsf(x))); }
struct GateV { float b0, b1, c0, c1, m0, m1, bend, cend; int s0, s1; };
__device__ __forceinline__ GateV gate_vectors(const float* G, int row0, int h, int dir, int lane) {
    GateV g; g.s0 = dir ? 127 - lane : lane; g.s1 = dir ? 63 - lane : lane + 64;
    const unsigned o0 = (unsigned)((row0 + g.s0) * 16 + dir * 8 + h) * 4u, o1 = (unsigned)((row0 + g.s1) * 16 + dir * 8 + h) * 4u;
    const float i0 = gld<float>(G, o0), f0 = gld<float>(G, o0 + 16), i1 = gld<float>(G, o1), f1 = gld<float>(G, o1 + 16);
    g.b0 = wave_incl_sum(logsigmoidf_(f0), lane); const float tot0 = shl_(g.b0, 63 + (lane & 0));
    g.b1 = wave_incl_sum(logsigmoidf_(f1), lane) + tot0;
    g.c0 = i0 - g.b0; g.c1 = i1 - g.b1;
    g.m0 = wave_incl_max(g.c0, lane); const float mx0 = shl_(g.m0, 63 + (lane & 0));
    g.m1 = fmaxf(wave_incl_max(g.c1, lane), mx0);
    g.bend = shl_(g.b1, 63 + (lane & 0)); g.cend = shl_(g.m1, 63 + (lane & 0));
    return g;
}
__device__ __forceinline__ void ph_convc(int wv, int l, int nrows, int widx, int nwg) {
    CParams& p = *okp();
    unsigned char* const wsb = ows(p.ws);
    const unsigned gt = (unsigned)widx * 512u + otid(wv), NT = (unsigned)nwg * 512u;
    const bf16_t* P = WSP(bf16_t, OFF_P); bf16_t* YC = WSP(bf16_t, OFF_HM) + (DM + DF);
    const float* wc = p.conv_c_w + (size_t)l * 3 * DC;
    for (unsigned i = gt; i < (unsigned)nrows * 64u; i += NT) {
        const int r = (int)(i >> 6), c = (int)(i & 63) * 8; int mj, t, T; rowinfo(r, mj, t, T);
        const unsigned pr = (unsigned)(r * NP) * 2u;
        const bool cp = r < RL ? (t & 63) > 0 : t > 0, cn = r < RL ? (t & 63) < 63 : t < T - 1;
        float x0[8], x1[8], y0[8], y1[8], z0[8], z1[8], cb[8], o[8];
        unpack8(gld<u32x4>(P, pr + (PCC + c) * 2), x0); unpack8(gld<u32x4>(P, pr + (PCX + c) * 2), x1); unpack8(gld<u32x4>(P, pr + (PCB + c) * 2), cb);
        const unsigned pp = cp ? pr - NP * 2 : pr, pn = cn ? pr + NP * 2 : pr;
        unpack8(gld<u32x4>(P, pp + (PCC + c) * 2), y0); unpack8(gld<u32x4>(P, pp + (PCX + c) * 2), y1);
        unpack8(gld<u32x4>(P, pn + (PCC + c) * 2), z0); unpack8(gld<u32x4>(P, pn + (PCX + c) * 2), z1);
        const f32x4 w00 = gld<f32x4>(wc, (unsigned)c * 4u), w01 = gld<f32x4>(wc, (unsigned)c * 4u + 16), w10 = gld<f32x4>(wc, (unsigned)(DC + c) * 4u), w11 = gld<f32x4>(wc, (unsigned)(DC + c) * 4u + 16),
                    w20 = gld<f32x4>(wc, (unsigned)(2 * DC + c) * 4u), w21 = gld<f32x4>(wc, (unsigned)(2 * DC + c) * 4u + 16);
#pragma unroll
        for (int j = 0; j < 8; ++j) { const float w0 = j < 4 ? w00[j & 3] : w01[j & 3], w1 = j < 4 ? w10[j & 3] : w11[j & 3], w2 = j < 4 ? w20[j & 3] : w21[j & 3];
            float v = w1 * (x0[j] * x1[j]); if (cp) v += w0 * (y0[j] * y1[j]); if (cn) v += w2 * (z0[j] * z1[j]); o[j] = cb[j] * v; }
        gst<u32x4>(YC, (unsigned)(r * D + c) * 2u, pack8(o));
    }
}
__device__ __forceinline__ void ph_fourier1(int wv, int widx, int nwg) {
    CParams& p = *okp();
    unsigned char* const wsb = ows(p.ws);
    const int TIDX = otid(wv), BIDX = obid(); (void)TIDX; (void)BIDX;
    const int lane = TIDX & 63, gw = widx * 8 + (TIDX >> 6), NGW = nwg * 8, fr = lane & 15, fq = lane >> 4;
    const bf16_t* P = WSP(bf16_t, OFF_P); const bf16_t* FT = WSP(bf16_t, OFF_FT);
    bf16_t* ZTC = WSP(bf16_t, OFF_ZTC);
    for (int task = gw; task < (RC / 32) * 4 * 8; task += NGW) {
        const int kb = task & 7, g = (task >> 3) & 3, rb = task >> 5, r0 = RL + rb * 32;
        f32x4 acc[2][2]; ZERO_ACC22(acc);
        wave_mm32<true, true>(P + (size_t)r0 * NP + PF + g * 128, NP, 1, FT + (size_t)(kb * 32) * 128, 1, 128, 128, acc, lane);
#pragma unroll
        for (int mi = 0; mi < 2; ++mi)
#pragma unroll
            for (int ni = 0; ni < 2; ++ni) {
                const int r = r0 + 16 * mi + 4 * fq, kp = kb * 32 + 16 * ni + fr, comp = kp >> 7, kap = kp & 127;
                u32x2 w; w.x = pk2(acc[mi][ni][0], acc[mi][ni][1]); w.y = pk2(acc[mi][ni][2], acc[mi][ni][3]);
                { const int q = r - RL, b = q >> 8, t = q & 255; *(u32x2*)(ZTC + (size_t)((b * 4 + g) * 128 + kap) * 512 + comp * 256 + t) = w; }
            }
    }
}
template <bool FIRST> __device__ __forceinline__ f32x4 mma16(bf16x8 a, bf16x8 b, f32x4 c) {
    if constexpr (FIRST) return __builtin_amdgcn_mfma_f32_16x16x32_bf16(a, b, (f32x4){0.f, 0.f, 0.f, 0.f}, 0, 0, 0);
    else return __builtin_amdgcn_mfma_f32_16x16x32_bf16(a, b, c, 0, 0, 0);
}
typedef short s16x4 __attribute__((ext_vector_type(4)));
constexpr int PIT_T = 544;
constexpr int PIT_R = 528;
constexpr int PIT_P = 272;
__device__ __forceinline__ bf16x8 tr_frag(LAS unsigned char* img, int pitchB, int r0, int c0, int lane) {
    const int g = lane >> 4, q = (lane & 15) >> 2, pp = lane & 3;
    LAS unsigned char* a = img + (r0 + 8 * g + q) * pitchB + (c0 + 4 * pp) * 2;
    const s16x4 lo = __builtin_amdgcn_ds_read_tr16_b64_v4i16((LAS s16x4*)a);
    const s16x4 hi = __builtin_amdgcn_ds_read_tr16_b64_v4i16((LAS s16x4*)(a + 4 * pitchB));
    return (bf16x8){lo[0], lo[1], lo[2], lo[3], hi[0], hi[1], hi[2], hi[3]};
}
template <class F> __device__ __forceinline__ void conv_silu_rows(const u32x4 (&raw)[10], const float (&w0)[8], const float (&w1)[8], const float (&w2)[8], F&& f) {
    float a[8], b[8], c[8];
    unpack8(raw[0], a); unpack8(raw[1], b);
#pragma unroll
    for (int i = 0; i < 8; ++i) {
        unpack8(raw[i + 2], c);
        float o[8];
#pragma unroll
        for (int j = 0; j < 8; ++j) o[j] = siluf_(w0[j] * a[j] + w1[j] * b[j] + w2[j] * c[j]);
        f(i, o);
#pragma unroll
        for (int j = 0; j < 8; ++j) { a[j] = b[j]; b[j] = c[j]; }
    }
}
constexpr int FPIT = 2336;
__device__ __forceinline__ void ph_fft(int wv, LAS unsigned char* lds, int u0, int ustride) {
    CParams& p = *okp();
    unsigned char* const wsb = ows(p.ws);
    const bf16_t* P = WSP(bf16_t, OFF_P); const bf16_t* FT = WSP(bf16_t, OFF_FT); const bf16_t* MA = WSP(bf16_t, OFF_MA); const bf16_t* MC = WSP(bf16_t, OFF_MC); bf16_t* HM = WSP(bf16_t, OFF_HM);
    LAS unsigned char* IMG = lds;
    const int wave = wv;
    for (int unit = u0; unit < NB * 4 * 8; unit += ustride) {
        const int kb = unit & 7, g = (unit >> 3) & 3, b = unit >> 5, kap0 = 16 * kb;
        {
            const int tid = otid(wv), lane = tid & 63, fr = lane & 15, fq = lane >> 4;
            bf16x8 fb[2][4];
#pragma unroll
            for (int ni = 0; ni < 2; ++ni)
#pragma unroll
                for (int ks = 0; ks < 4; ++ks) fb[ni][ks] = gld<bf16x8>(FT, (unsigned)((ni * 128 + kap0 + fr) * 128 + 32 * ks + 8 * fq) * 2u);
#pragma unroll 1
            for (int mi8 = 0; mi8 < 2; ++mi8) {
                bf16x8 xa[8][4];
#pragma unroll
                for (int m = 0; m < 8; ++m)
#pragma unroll
                    for (int ks = 0; ks < 4; ++ks) xa[m][ks] = gld<bf16x8>(P, (unsigned)((b * 2048 + 256 * wave + 16 * (8 * mi8 + m) + fr) * NP + PF + g * 128 + 32 * ks + 8 * fq) * 2u);
#pragma unroll
                for (int m = 0; m < 8; ++m) {
                    f32x4 zr = mma16<true>(xa[m][0], fb[0][0], zr), zi = mma16<true>(xa[m][0], fb[1][0], zi);
#pragma unroll
                    for (int ks = 1; ks < 4; ++ks) { zr = mma16<false>(xa[m][ks], fb[0][ks], zr); zi = mma16<false>(xa[m][ks], fb[1][ks], zi); }
                    const int tb = 256 * wave + 16 * (8 * mi8 + m) + 4 * fq, t1 = tb >> 6, t2 = tb & 63;
                    u32x2 wr_, wi_; wr_.x = pk2(zr[0], zr[1]); wr_.y = pk2(zr[2], zr[3]); wi_.x = pk2(-zi[0], -zi[1]); wi_.y = pk2(-zi[2], -zi[3]);
                    *(LAS u32x2*)(IMG + t1 * FPIT + fr * 144 + t2 * 2) = wr_;
                    *(LAS u32x2*)(IMG + (32 + t1) * FPIT + fr * 144 + t2 * 2) = wi_;
                }
            }
        }
        __syncthreads();
        {
            const int tid = otid(wv), lane = tid & 63, fr = lane & 15, fq = lane >> 4;
            bf16x8 ya[4][2];
#pragma unroll
            for (int mt = 0; mt < 4; ++mt)
#pragma unroll
                for (int ks = 0; ks < 2; ++ks) ya[mt][ks] = gld<bf16x8>(MA, (unsigned)((16 * mt + fr) * 64 + 32 * ks + 8 * fq) * 2u);
#pragma unroll 2
            for (int j = 0; j < 8; ++j) {
                const int grp = 8 * wave + j, c0 = (grp >> 2) * 72 + (grp & 3) * 16;
                const bf16x8 x0 = tr_frag(IMG, FPIT, 0, c0, lane), x1 = tr_frag(IMG, FPIT, 32, c0, lane);
                f32x4 d[4];
#pragma unroll
                for (int mt = 0; mt < 4; ++mt) { d[mt] = mma16<true>(x0, ya[mt][0], d[mt]); d[mt] = mma16<false>(x1, ya[mt][1], d[mt]); }
#pragma unroll
                for (int mt = 0; mt < 4; ++mt) { u32x2 w; w.x = pk2(d[mt][0], d[mt][1]); w.y = pk2(d[mt][2], d[mt][3]);
                    *(LAS u32x2*)(IMG + (16 * mt + fr) * FPIT + (c0 + 4 * fq) * 2) = w; }
            }
        }
        __syncthreads();
        {
            const int tid = otid(wv), lane = tid & 63, fr = lane & 15, fq = lane >> 4;
            bf16x8 y[4][4];
#pragma unroll
            for (int mt = 0; mt < 4; ++mt)
#pragma unroll
                for (int ks = 0; ks < 4; ++ks) y[mt][ks] = gld<bf16x8>(MC, (unsigned)((4 * wave * 64 + 16 * mt + fr) * 128 + 32 * ks + 8 * fq) * 2u);
#pragma unroll 1
            for (int q = 0; q < 4; ++q) {
                const int tau1 = 4 * wave + q, tn = q < 3 ? tau1 + 1 : tau1;
                bf16x8 yn[4][4];
#pragma unroll
                for (int mt = 0; mt < 4; ++mt)
#pragma unroll
                    for (int ks = 0; ks < 4; ++ks) yn[mt][ks] = gld<bf16x8>(MC, (unsigned)((tn * 64 + 16 * mt + fr) * 128 + 32 * ks + 8 * fq) * 2u);
                f32x4 acc[4];
#pragma unroll
                for (int ks = 0; ks < 4; ++ks) { const bf16x8 x = *(const LAS bf16x8*)(IMG + ((ks >> 1) * 32 + tau1) * FPIT + fr * 144 + (32 * (ks & 1) + 8 * fq) * 2);
#pragma unroll
                    for (int mt = 0; mt < 4; ++mt) { if (ks == 0) acc[mt] = mma16<true>(x, y[mt][ks], acc[mt]); else acc[mt] = mma16<false>(x, y[mt][ks], acc[mt]); } }
#pragma unroll
                for (int mt = 0; mt < 4; ++mt) { const int tau = tau1 + 32 * (16 * mt + fr);
                    u32x2 w; w.x = pk2(acc[mt][0], acc[mt][1]); w.y = pk2(acc[mt][2], acc[mt][3]);
                    gst<u32x2>(HM, (unsigned)((b * 2048 + tau) * D + DM + g * 128 + kap0 + 4 * fq) * 2u, w); }
#pragma unroll
                for (int mt = 0; mt < 4; ++mt)
#pragma unroll
                    for (int ks = 0; ks < 4; ++ks) y[mt][ks] = yn[mt][ks];
            }
        }
        __syncthreads();
    }
}
__device__ __forceinline__ void ph_mlstm1(int wv, int l, LAS unsigned char* lds) {
    CParams& p = *okp();
    unsigned char* const wsb = ows(p.ws);
    const int wave = wv;
    LAS unsigned char* KWs = lds; LAS unsigned char* Vs = lds + 128 * PIT_T; LAS float* vW = (LAS float*)(lds + 2 * 128 * PIT_T);
    const bf16_t* P = WSP(bf16_t, OFF_P); const float* G = WSP(float, OFF_G);
    bf16_t* UT = WSP(bf16_t, OFF_UT); float* NV = WSP(float, OFF_NV); float* CHS = WSP(float, OFF_CHS);
    const float* wk = p.conv_k_w + (size_t)l * 3 * DM;
    for (int unit = obid(); unit < NCHUNK * NH * 2; unit += gridDim.x) {
        const int tid = otid(wv), lane = tid & 63, fr = lane & 15, fq = lane >> 4, dg = tid & 31, sg = tid >> 5;
        const int dir = unit & 1, h = (unit >> 1) & 3, cidx = unit >> 3, row0 = chunk_row0(cidx);
        const bool first = cidx < 64 ? (cidx & 15) == 0 : ((cidx - 64) & 1) == 0, last = cidx < 64 ? (cidx & 15) == 15 : ((cidx - 64) & 1) == 1;
        const bf16_t* kp = P + (size_t)(row0 + 8 * sg) * NP + PK + h * DH + 8 * dg;
        u32x4 kr[10], vr[8];
#pragma unroll
        for (int i = 0; i < 10; ++i) { const int s = 8 * sg - 1 + i; const bool ok = (s >= 0 || !first) && (s < CHUNK || !last);
            kr[i] = ok ? *(const u32x4*)(kp + (ptrdiff_t)(i - 1) * NP) : (u32x4){0u, 0u, 0u, 0u}; }
#pragma unroll
        for (int i = 0; i < 8; ++i) vr[i] = *(const u32x4*)(kp + (PV - PK) + (size_t)i * NP);
        float w0[8], w1[8], w2[8];
#pragma unroll
        for (int j = 0; j < 8; ++j) { w0[j] = wk[h * DH + 8 * dg + j]; w1[j] = wk[DM + h * DH + 8 * dg + j]; w2[j] = wk[2 * DM + h * DH + 8 * dg + j]; }
        if (wave == 0)     { const GateV g = gate_vectors(G, row0, h, dir, lane); vW[g.s0] = __expf(g.c0 - g.cend); vW[g.s1] = __expf(g.c1 - g.cend);
            if (lane == 0) { CHS[(size_t)(cidx * 8 + dir * 4 + h) * 2] = g.bend; CHS[(size_t)(cidx * 8 + dir * 4 + h) * 2 + 1] = g.bend + g.cend; } }
        __syncthreads();
        conv_silu_rows(kr, w0, w1, w2, [&](int i, float (&o)[8]) { const float ws = vW[8 * sg + i];
#pragma unroll
            for (int j = 0; j < 8; ++j) o[j] *= ws;
            *(LAS u32x4*)(KWs + (8 * sg + i) * PIT_T + dg * 16) = pack8(o); });
#pragma unroll
        for (int i = 0; i < 8; ++i) *(LAS u32x4*)(Vs + (8 * sg + i) * PIT_T + dg * 16) = vr[i];
        __syncthreads();
        f32x4 acc[2][16];
        auto kstep1 = [&](int k0, auto first) {
            bf16x8 fv[2];
#pragma unroll
            for (int mi = 0; mi < 2; ++mi) fv[mi] = tr_frag(Vs, PIT_T, k0, 32 * wave + 16 * mi, lane);
#pragma unroll
            for (int ni = 0; ni < 16; ++ni) { const bf16x8 fk = tr_frag(KWs, PIT_T, k0, 16 * ni, lane);
#pragma unroll
                for (int mi = 0; mi < 2; ++mi) acc[mi][ni] = mma16<decltype(first)::value>(fk, fv[mi], acc[mi][ni]); }
        };
        kstep1(0, std::true_type{});
#pragma unroll 1
        for (int k0 = 32; k0 < CHUNK; k0 += 32) kstep1(k0, std::false_type{});
        bf16_t* out = UT + ((size_t)(cidx * NH + h) * 2 + dir) * DH * DH;
#pragma unroll
        for (int mi = 0; mi < 2; ++mi)
#pragma unroll
            for (int ni = 0; ni < 16; ++ni) { u32x2 w; w.x = pk2(acc[mi][ni][0], acc[mi][ni][1]); w.y = pk2(acc[mi][ni][2], acc[mi][ni][3]);
                *(u32x2*)(out + (size_t)(32 * wave + 16 * mi + fr) * DH + 16 * ni + 4 * fq) = w; }
        if (tid < DH) { float sum = 0.f;
#pragma unroll 8
            for (int s2 = 0; s2 < CHUNK; ++s2) sum += bf2f(*(const LAS bf16_t*)(KWs + s2 * PIT_T + tid * 2));
            NV[((size_t)(cidx * NH + h) * 2 + dir) * DH + tid] = sum; }
        __syncthreads();
    }
}
__device__ __forceinline__ void ph_mlstm2(int wv) {
    CParams& p = *okp();
    unsigned char* const wsb = ows(p.ws);
    const int tid = otid(wv);
    const bf16_t* UT = WSP(bf16_t, OFF_UT); bf16_t* CT = WSP(bf16_t, OFF_CT);
    const float *NV = WSP(float, OFF_NV), *CHS = WSP(float, OFF_CHS); float *NS = WSP(float, OFF_NS), *MST = WSP(float, OFF_MST);
    for (int task = obid(); task < NB * NH * 2 * 16; task += gridDim.x) {
        const int part = task & 15, scan = task >> 4, dir = scan & 1, h = (scan >> 1) & 3, b = scan >> 3, dh = dir * 4 + h;
        const unsigned e0 = (unsigned)(part * 4096 + olaunder(tid) * 8) * 2u;
        u32x4 u[18];
#pragma unroll
        for (int step = 0; step < 18; ++step) { const int cidx = scan_chunk(b, dir, step); u[step] = gld<u32x4>(UT, (unsigned)(((cidx * NH + h) * 2 + dir) * DH * DH) * 2u + e0); }
        float cb[18], cm[18];
#pragma unroll
        for (int step = 0; step < 18; ++step) { const int cidx = scan_chunk(b, dir, step); const f32x2 cc = gld<f32x2>(CHS, (unsigned)((cidx * 8 + dh) * 2) * 4u); cb[step] = cc[0]; cm[step] = cc[1]; }
        float C[8], m = 0.f;
        { const f32x4 z0 = zero4(), z1 = zero4();
#pragma unroll
          for (int j = 0; j < 4; ++j) { C[j] = z0[j]; C[4 + j] = z1[j]; } }
#pragma unroll
        for (int step = 0; step < 18; ++step) {
            const int cidx = scan_chunk(b, dir, step);
            gst<u32x4>(CT, (unsigned)(((cidx * NH + h) * 2 + dir) * DH * DH) * 2u + e0, pack8(C));
            const float bend = cb[step], mloc = cm[step];
            const float mn = fmaxf(bend + m, mloc), al = __expf(bend + m - mn), be = __expf(mloc - mn);
            float uu[8]; unpack8(u[step], uu);
#pragma unroll
            for (int j = 0; j < 8; ++j) C[j] = al * C[j] + be * uu[j];
            m = mn;
        }
        if (part == 0 && tid < DH) {
            float n = 0.f; m = 0.f;
            float nv[18];
#pragma unroll
            for (int step = 0; step < 18; ++step) { const int cidx = scan_chunk(b, dir, step); nv[step] = gld<float>(NV, (unsigned)(((cidx * NH + h) * 2 + dir) * DH + tid) * 4u); }
#pragma unroll
            for (int step = 0; step < 18; ++step) {
                const int cidx = scan_chunk(b, dir, step); const unsigned base = (unsigned)(((cidx * NH + h) * 2 + dir) * DH + tid) * 4u;
                gst<float>(NS, base, n); if (tid == 0) MST[cidx * 8 + dh] = m;
                const float bend = cb[step], mloc = cm[step];
                const float mn = fmaxf(bend + m, mloc), al = __expf(bend + m - mn), be = __expf(mloc - mn);
                n = al * n + be * nv[step]; m = mn;
            }
        }
    }
}
#define SECTION_LANES() const int tid = otid(wv), lane = tid & 63, fr = lane & 15, fq = lane >> 4; (void)fr; (void)fq; __builtin_amdgcn_sched_barrier(0)
__device__ __forceinline__ void ph_mlstm3(int wv, int l, LAS unsigned char* lds, int nunits) {
    CParams& p = *okp();
    unsigned char* const wsb = ows(p.ws);
    const int wave = wv;
    LAS unsigned char* Qs = lds;
    LAS unsigned char* Ks = lds + 128 * PIT_T;
    LAS unsigned char* Vs = Qs; LAS unsigned char* Ps = Ks;
    LAS float* vec = (LAS float*)(lds + 2 * 128 * PIT_T);
    LAS float *vB = vec, *vC = vec + 256, *vM = vec + 512, *nS = vec + 768, *rS = vec + 1280, *ssq = vec + 1536;
    const bf16_t* P = WSP(bf16_t, OFF_P); const float* G = WSP(float, OFF_G); const bf16_t* CT = WSP(bf16_t, OFF_CT);
    const float *NS = WSP(float, OFF_NS), *MST = WSP(float, OFF_MST); bf16_t* HM = WSP(bf16_t, OFF_HM);
    const float *wk = p.conv_k_w + (size_t)l * 3 * DM, *wq = p.conv_q_w + (size_t)l * 3 * DM, *nw = p.mlstm_norm_w + (size_t)l * DM;
    for (int unit = obid(); unit < nunits; unit += gridDim.x) {
        const int h = unit & 3, cidx = unit >> 2, row0 = chunk_row0(cidx);
        const bool first = cidx < 64 ? (cidx & 15) == 0 : ((cidx - 64) & 1) == 0, last = cidx < 64 ? (cidx & 15) == 15 : ((cidx - 64) & 1) == 1;
        {
            SECTION_LANES(); const int dg = tid & 31, sg = tid >> 5;
            nS[tid] = gld<float>(NS, (unsigned)((cidx * NH + h) * 2 * DH + tid) * 4u);
            const unsigned kp = (unsigned)((row0 + 8 * sg - 1) * NP + PK + h * DH + 8 * dg) * 2u;
            u32x4 raw[10], rawq[10]; float w0[8], w1[8], w2[8];
#pragma unroll
            for (int i = 0; i < 10; ++i) { const int s = 8 * sg - 1 + i; const bool ok = (s >= 0 || !first) && (s < CHUNK || !last);
                raw[i] = gld<u32x4>(P, ok ? kp + (unsigned)i * (NP * 2) : kp + (unsigned)(NP * 2)); if (!ok) raw[i] = (u32x4){0u, 0u, 0u, 0u}; }
#pragma unroll
            for (int i = 0; i < 10; ++i) { const int s = 8 * sg - 1 + i; const bool ok = (s >= 0 || !first) && (s < CHUNK || !last);
                rawq[i] = gld<u32x4>(P, (ok ? kp + (unsigned)i * (NP * 2) : kp + (unsigned)(NP * 2)) + (PQ - PK) * 2); if (!ok) rawq[i] = (u32x4){0u, 0u, 0u, 0u}; }
            { const unsigned wo = (unsigned)(h * DH + 8 * dg) * 4u;
              const f32x4 a0 = gld<f32x4>(wk, wo), a1 = gld<f32x4>(wk, wo + 16), b0 = gld<f32x4>(wk, wo + DM * 4), b1 = gld<f32x4>(wk, wo + DM * 4 + 16), c0 = gld<f32x4>(wk, wo + 2 * DM * 4), c1 = gld<f32x4>(wk, wo + 2 * DM * 4 + 16);
#pragma unroll
              for (int j = 0; j < 4; ++j) { w0[j] = a0[j]; w0[4 + j] = a1[j]; w1[j] = b0[j]; w1[4 + j] = b1[j]; w2[j] = c0[j]; w2[4 + j] = c1[j]; } }
            if (wave < 2) { const GateV g = gate_vectors(G, row0, h, wave, lane);
                vB[wave * 128 + g.s0] = g.b0; vB[wave * 128 + g.s1] = g.b1; vC[wave * 128 + g.s0] = g.c0; vC[wave * 128 + g.s1] = g.c1; vM[wave * 128 + g.s0] = g.m0; vM[wave * 128 + g.s1] = g.m1; }
            conv_silu_rows(raw, w0, w1, w2, [&](int i, float (&o)[8]) { *(LAS u32x4*)(Ks + (8 * sg + i) * PIT_R + dg * 16) = pack8(o); });
            { const unsigned wo = (unsigned)(h * DH + 8 * dg) * 4u;
              const f32x4 a0 = gld<f32x4>(wq, wo), a1 = gld<f32x4>(wq, wo + 16), b0 = gld<f32x4>(wq, wo + DM * 4), b1 = gld<f32x4>(wq, wo + DM * 4 + 16), c0 = gld<f32x4>(wq, wo + 2 * DM * 4), c1 = gld<f32x4>(wq, wo + 2 * DM * 4 + 16);
#pragma unroll
              for (int j = 0; j < 4; ++j) { w0[j] = a0[j]; w0[4 + j] = a1[j]; w1[j] = b0[j]; w1[4 + j] = b1[j]; w2[j] = c0[j]; w2[4 + j] = c1[j]; } }
            conv_silu_rows(rawq, w0, w1, w2, [&](int i, float (&o)[8]) {
#pragma unroll
                for (int j = 0; j < 8; ++j) o[j] *= 0.0625f;
                *(LAS u32x4*)(Qs + (8 * sg + i) * PIT_R + dg * 16) = pack8(o); });
        }
        __syncthreads();
        {
            SECTION_LANES();
            f32x4 sacc[8];
            auto kstepS = [&](int k0, auto first) {
                const bf16x8 yq = *(const LAS bf16x8*)(Qs + (16 * wave + fr) * PIT_R + (k0 + 8 * fq) * 2);
#pragma unroll
                for (int ni = 0; ni < 8; ++ni) { const bf16x8 xk = *(const LAS bf16x8*)(Ks + (16 * ni + fr) * PIT_R + (k0 + 8 * fq) * 2);
                    sacc[ni] = mma16<decltype(first)::value>(xk, yq, sacc[ni]); }
            };
            kstepS(0, std::true_type{});
#pragma unroll 1
            for (int k0 = 32; k0 < DH; k0 += 32) kstepS(k0, std::false_type{});
            const int t = 16 * wave + fr;
            const float mF = gld<float>(MST, (unsigned)(cidx * 8 + h) * 4u), mB = gld<float>(MST, (unsigned)(cidx * 8 + 4 + h) * 4u);
            const float MF = fmaxf(mF, vM[t]), MB = fmaxf(mB, vM[128 + t]);
            const float gF = __expf(mF - MF), gB = __expf(mB - MB);
            const float flF = __expf(-(vB[t] + MF)), flB = __expf(-(vB[128 + t] + MB));
            float qnF = 0.f, qnB = 0.f;
#pragma unroll
            for (int c8 = 0; c8 < 8; ++c8) { float q8[8]; unpack8(*(const LAS u32x4*)(Qs + t * PIT_R + (64 * fq + 8 * c8) * 2), q8);
                const f32x4 a0 = *(const LAS f32x4*)(nS + 64 * fq + 8 * c8), a1 = *(const LAS f32x4*)(nS + 64 * fq + 8 * c8 + 4);
                const f32x4 b0 = *(const LAS f32x4*)(nS + 256 + 64 * fq + 8 * c8), b1 = *(const LAS f32x4*)(nS + 256 + 64 * fq + 8 * c8 + 4);
#pragma unroll
                for (int j = 0; j < 4; ++j) { qnF += q8[j] * a0[j] + q8[4 + j] * a1[j]; qnB += q8[j] * b0[j] + q8[4 + j] * b1[j]; } }
            qnF += shx(qnF, 16, lane); qnF += shx(qnF, 32, lane); qnB += shx(qnB, 16, lane); qnB += shx(qnB, 32, lane);
            float sF = 0.f, sB = 0.f;
#pragma unroll
            for (int ni = 0; ni < 8; ++ni) { const f32x4 cF = *(const LAS f32x4*)(vC + 16 * ni + 4 * fq), cB = *(const LAS f32x4*)(vC + 128 + 16 * ni + 4 * fq);
#pragma unroll
                for (int rg = 0; rg < 4; ++rg) { const int s = 16 * ni + 4 * fq + rg;
                    sF += s <= t ? sacc[ni][rg] * __expf(cF[rg] - MF) : 0.f; sB += s >= t ? sacc[ni][rg] * __expf(cB[rg] - MB) : 0.f; }
                asm volatile("" : "+v"(sF), "+v"(sB)); }
            sF += shx(sF, 16, lane); sF += shx(sF, 32, lane); sB += shx(sB, 16, lane); sB += shx(sB, 32, lane);
            const float iF = 1.f / fmaxf(fabsf(gF * qnF + sF), flF), iB = 1.f / fmaxf(fabsf(gB * qnB + sB), flB);
            __syncthreads();
#pragma unroll
            for (int ni = 0; ni < 8; ++ni) { const f32x4 cF = *(const LAS f32x4*)(vC + 16 * ni + 4 * fq), cB = *(const LAS f32x4*)(vC + 128 + 16 * ni + 4 * fq);
                float pc[4];
#pragma unroll
                for (int rg = 0; rg < 4; ++rg) { const int s = 16 * ni + 4 * fq + rg;
                    pc[rg] = (s <= t ? sacc[ni][rg] * __expf(cF[rg] - MF) * iF : 0.f) + (s >= t ? sacc[ni][rg] * __expf(cB[rg] - MB) * iB : 0.f); }
                u32x2 w; w.x = pk2(pc[0], pc[1]); w.y = pk2(pc[2], pc[3]);
                *(LAS u32x2*)(Ps + t * PIT_P + (16 * ni + 4 * fq) * 2) = w; }
            if (fq == 0) { rS[t] = gF * iF; rS[128 + t] = gB * iB; }
        }
        __syncthreads();
        f32x4 tot[2][8];
        u32x4 vr[8];
        {
            SECTION_LANES();
#pragma unroll
            for (int ni = 0; ni < 2; ++ni) {
                if (ni == 1) { const int s8 = lane & 15, vq = lane >> 4; const unsigned vp = (unsigned)((row0 + 8 * s8) * NP + PV + h * DH + 32 * wave + 8 * vq) * 2u;
#pragma unroll
                    for (int i = 0; i < 8; ++i) vr[i] = gld<u32x4>(P, vp + (unsigned)i * (NP * 2)); }
                f32x4 a1[8];
                const unsigned ctf = (unsigned)((cidx * NH + h) * 2 * DH * DH + (32 * wave + 16 * ni + fr) * DH + 8 * fq) * 2u;
                bf16x8 xf = gld<bf16x8>(CT, ctf), xb = gld<bf16x8>(CT, ctf + (unsigned)(DH * DH) * 2u);
                bf16x8 xf1 = gld<bf16x8>(CT, ctf + 64u), xb1 = gld<bf16x8>(CT, ctf + (unsigned)(DH * DH) * 2u + 64u);
                auto kstepQ = [&](int k0, auto first) {
                    const unsigned kn = (unsigned)(k0 + 64 < DH ? k0 + 64 : DH - 32);
                    const bf16x8 xfn = gld<bf16x8>(CT, ctf + kn * 2u), xbn = gld<bf16x8>(CT, ctf + (unsigned)(DH * DH) * 2u + kn * 2u);
#pragma unroll
                    for (int mi = 0; mi < 8; ++mi) { const bf16x8 yq = *(const LAS bf16x8*)(Qs + (16 * mi + fr) * PIT_R + (k0 + 8 * fq) * 2);
                        tot[ni][mi] = mma16<decltype(first)::value>(xf, yq, tot[ni][mi]);
                        a1[mi] = mma16<decltype(first)::value>(xb, yq, a1[mi]); }
                    xf = xf1; xb = xb1; xf1 = xfn; xb1 = xbn;
                };
                kstepQ(0, std::true_type{});
#pragma unroll 1
                for (int k0 = 32; k0 < DH; k0 += 32) kstepQ(k0, std::false_type{});
#pragma unroll
                for (int mi = 0; mi < 8; ++mi) { const float rf = rS[16 * mi + fr], rb = rS[128 + 16 * mi + fr]; tot[ni][mi] = rf * tot[ni][mi] + rb * a1[mi]; }
            }
        }
        __syncthreads();
        u32x2 og[8][2]; f32x4 gw[2];
        {
            SECTION_LANES();
            { const int s8 = lane & 15, vq = lane >> 4;
#pragma unroll
              for (int i = 0; i < 8; ++i) *(LAS u32x4*)(Vs + (8 * s8 + i) * PIT_T + (32 * wave + 8 * vq) * 2) = vr[i]; }
            asm volatile("s_waitcnt lgkmcnt(0)" ::: "memory");
#pragma unroll
            for (int mi = 0; mi < 8; ++mi)
#pragma unroll
                for (int ni = 0; ni < 2; ++ni) og[mi][ni] = gld<u32x2>(P, (unsigned)((row0 + 16 * mi + fr) * NP + PO + h * DH + 32 * wave + 16 * ni + 4 * fq) * 2u);
#pragma unroll
            for (int ni = 0; ni < 2; ++ni) gw[ni] = gld<f32x4>(nw, (unsigned)(h * DH + 32 * wave + 16 * ni + 4 * fq) * 4u);
#pragma unroll 1
            for (int k0 = 0; k0 < CHUNK; k0 += 32) {
                bf16x8 xv[2];
#pragma unroll
                for (int ni = 0; ni < 2; ++ni) xv[ni] = tr_frag(Vs, PIT_T, k0, 32 * wave + 16 * ni, lane);
#pragma unroll
                for (int mi = 0; mi < 8; ++mi) { const bf16x8 yp = *(const LAS bf16x8*)(Ps + (16 * mi + fr) * PIT_P + (k0 + 8 * fq) * 2);
#pragma unroll
                    for (int ni = 0; ni < 2; ++ni) tot[ni][mi] = __builtin_amdgcn_mfma_f32_16x16x32_bf16(xv[ni], yp, tot[ni][mi], 0, 0, 0); }
            }
        }
        {
            SECTION_LANES();
#pragma unroll
            for (int mi = 0; mi < 8; ++mi) { float ss = 0.f;
#pragma unroll
                for (int ni = 0; ni < 2; ++ni) ss += (tot[ni][mi][0] * tot[ni][mi][0] + tot[ni][mi][1] * tot[ni][mi][1]) + (tot[ni][mi][2] * tot[ni][mi][2] + tot[ni][mi][3] * tot[ni][mi][3]);
                ss += shx(ss, 16, lane); ss += shx(ss, 32, lane);
                if (fq == 0) ssq[wave * 128 + 16 * mi + fr] = ss; }
            __syncthreads();
#pragma unroll
            for (int mi = 0; mi < 8; ++mi) { const int tt = 16 * mi + fr; float ss = 0.f;
#pragma unroll
                for (int w8 = 0; w8 < 8; ++w8) ss += ssq[w8 * 128 + tt];
                const float rstd = rsqrtf(ss * (1.f / DH) + EPS);
#pragma unroll
                for (int ni = 0; ni < 2; ++ni) { const int vd = 32 * wave + 16 * ni + 4 * fq;
                    const u32x2 ow = og[mi][ni]; const f32x4 w4 = gw[ni];
                    const float o0 = __uint_as_float(ow.x << 16), o1 = __uint_as_float(ow.x & 0xffff0000u), o2 = __uint_as_float(ow.y << 16), o3 = __uint_as_float(ow.y & 0xffff0000u);
                    u32x2 q; q.x = pk2(sigmoidf_(o0) * (tot[ni][mi][0] * rstd * w4[0]), sigmoidf_(o1) * (tot[ni][mi][1] * rstd * w4[1]));
                    q.y = pk2(sigmoidf_(o2) * (tot[ni][mi][2] * rstd * w4[2]), sigmoidf_(o3) * (tot[ni][mi][3] * rstd * w4[3]));
                    gst<u32x2>(HM, (unsigned)((row0 + tt) * D + h * DH + vd) * 2u, q); }
            }
        }
        __syncthreads();
    }
}
__device__ __forceinline__ void ph_ffnact(int wv, int l) {
    CParams& p = *okp();
    unsigned char* const wsb = ows(p.ws);
    const int TIDX = otid(wv), BIDX = obid();
    const unsigned gt = (unsigned)BIDX * 512u + TIDX, NT = gridDim.x * 512u;
    const bf16_t* U = WSP(bf16_t, OFF_P); bf16_t* ACT = WSP(bf16_t, OFF_ACT); const float* SL = WSP(float, OFF_SLAB);
    const float* wf = p.conv_ff_w + (size_t)l * 3 * DFF;
    auto ldu = [&](int r, int col, float (&o)[8]) {
        if (col >= 32 * 256) { f32x4 g0 = {0.f, 0.f, 0.f, 0.f}, g1 = {0.f, 0.f, 0.f, 0.f};
#pragma unroll
            for (int sl = 0; sl < 4; ++sl) { const unsigned o4 = (unsigned)((sl * RC + (r - RL)) * NUP + col) * 4u; g0 += gld<f32x4>(SL, o4); g1 += gld<f32x4>(SL, o4 + 16); }
#pragma unroll
            for (int j = 0; j < 4; ++j) { o[j] = g0[j]; o[4 + j] = g1[j]; } }
        else unpack8(gld<u32x4>(U, (unsigned)(r * NUP + col) * 2u), o);
    };
    for (unsigned i = gt; i < (unsigned)RC * (DFF / 8); i += NT) {
        const int r = RL + (int)(i / (DFF / 8)), c = (int)(i % (DFF / 8)) * 8, t = (r - RL) & (CTX - 1);
        const int ca = 256 * (c >> 7) + (c & 127);
        const bool hp = t > 0, hn = t < CTX - 1;
        float a0[8], a1[8], a2[8], g[8], o[8];
        ldu(r, ca, a1); ldu(r, ca + 128, g); ldu(hp ? r - 1 : r, ca, a0); ldu(hn ? r + 1 : r, ca, a2);
        const f32x4 w00 = gld<f32x4>(wf, (unsigned)c * 4u), w01 = gld<f32x4>(wf, (unsigned)c * 4u + 16), w10 = gld<f32x4>(wf, (unsigned)(DFF + c) * 4u), w11 = gld<f32x4>(wf, (unsigned)(DFF + c) * 4u + 16),
                    w20 = gld<f32x4>(wf, (unsigned)(2 * DFF + c) * 4u), w21 = gld<f32x4>(wf, (unsigned)(2 * DFF + c) * 4u + 16);
#pragma unroll
        for (int j = 0; j < 8; ++j) { const float w0 = j < 4 ? w00[j & 3] : w01[j & 3], w1 = j < 4 ? w10[j & 3] : w11[j & 3], w2 = j < 4 ? w20[j & 3] : w21[j & 3];
            float v = w1 * a1[j]; if (hp) v += w0 * a0[j]; if (hn) v += w2 * a2[j]; o[j] = siluf_(v) * g[j]; }
        gst<u32x4>(ACT, (unsigned)(r * DFF + c) * 2u, pack8(o));
    }
}

#define XB_TMO      128
#define XB_XCNT(j)  (256  + 64 * (j))
#define XB_XSUB(j)  (1280 + 64 * (j))
#define XB_XGEN(j)  (2304 + 64 * (j))
#define XB_TOP      3328
#define XB_TOPGEN   3392
#define XCD_BAR_WORDS 3456
#define XB_SPIN_CAP (1u << 18)
__device__ __forceinline__ unsigned xb_ld(unsigned* p)              { return __hip_atomic_load(p, __ATOMIC_RELAXED, __HIP_MEMORY_SCOPE_AGENT); }
__device__ __forceinline__ unsigned xb_add(unsigned* p, unsigned v) { return __hip_atomic_fetch_add(p, v, __ATOMIC_RELAXED, __HIP_MEMORY_SCOPE_AGENT); }
__device__ __forceinline__ unsigned xb_xcc_id() { return (unsigned)__builtin_amdgcn_s_getreg((3 << 11) | 20) & 0xFu; }
#define XB_SPIN(cond, bar) do { unsigned _sp = 0; while (cond) { __builtin_amdgcn_s_sleep(1); \
    if ((++_sp & 255u) == 0u) { if (xb_ld(&(bar)[XB_TMO])) break; if (_sp > XB_SPIN_CAP) { atomicAdd(&(bar)[XB_TMO], 1u); break; } } } } while (0)
struct XcdBarrier { unsigned* bar; unsigned x; volatile LAS unsigned* st; };
__device__ __forceinline__ XcdBarrier xcd_barrier_post(unsigned* bar, volatile LAS unsigned* st) {
    XcdBarrier b; b.bar = bar; b.x = xb_xcc_id(); b.st = st;
    if (threadIdx.x == 0) (void)xb_add(&bar[XB_XCNT(b.x)], 1u);
    return b;
}
__device__ __forceinline__ void xcd_barrier_complete(unsigned* bar, unsigned x, unsigned& nloc, unsigned& nx) {
    const unsigned G = gridDim.x * gridDim.y * gridDim.z;
    unsigned sum, cnt, mine, sp = 0u;
    for (;;) {
        sum = 0u; cnt = 0u; mine = 0u;
#pragma unroll
        for (unsigned j = 0; j < 16; ++j) { const unsigned c = xb_ld(&bar[XB_XCNT(j)]); sum += c; cnt += (c > 0u) ? 1u : 0u; mine = (j == x) ? c : mine; }
        if (sum == G) break;
        __builtin_amdgcn_s_sleep(1);
        if ((++sp & 255u) == 0u) { if (xb_ld(&bar[XB_TMO])) break; if (sp > XB_SPIN_CAP) { atomicAdd(&bar[XB_TMO], 1u); break; } }
    }
    nloc = mine > 0u ? mine : 1u; nx = cnt > 0u ? cnt : 1u;
}
__device__ __forceinline__ void xcd_barrier(const XcdBarrier& b, int wv) {
    asm volatile("s_waitcnt vmcnt(0)" ::: "memory");
    __syncthreads();
    if (otid(wv) == 0) {
        unsigned long long bw = (unsigned long long)b.bar; asm volatile("" : "+s"(bw));
        unsigned* bar = (unsigned*)bw;
        __builtin_amdgcn_s_waitcnt(0);
        unsigned nloc = b.st[0], nx = b.st[1];
        if (nloc == 0u) { xcd_barrier_complete(bar, b.x, nloc, nx); b.st[0] = nloc; b.st[1] = nx; }
        const unsigned old = xb_add(&bar[XB_XSUB(b.x)], 1u);
        const unsigned gen = old / nloc;
        if (old + 1u == (gen + 1u) * nloc) {
            __builtin_amdgcn_fence(__ATOMIC_RELEASE, "agent");
            asm volatile("s_waitcnt vmcnt(0)" ::: "memory");
            const unsigned og = xb_add(&bar[XB_TOP], 1u);
            const unsigned tg = og / nx;
            if (og + 1u == (tg + 1u) * nx) xb_add(&bar[XB_TOPGEN], 1u);
            else XB_SPIN(xb_ld(&bar[XB_TOPGEN]) == tg, bar);
            __builtin_amdgcn_fence(__ATOMIC_ACQUIRE, "agent");
            xb_add(&bar[XB_XGEN(b.x)], 1u);
            asm volatile("s_waitcnt vmcnt(0)" ::: "memory");
        } else {
            XB_SPIN(xb_ld(&bar[XB_XGEN(b.x)]) == gen, bar);
            __builtin_amdgcn_fence(__ATOMIC_ACQUIRE, "agent");
            asm volatile("s_waitcnt vmcnt(0)" ::: "memory");
        }
    }
    __syncthreads();
}

constexpr int I_CUT = (I_LAYER * 2 / 5 / 64) * 64;
#define REPW 3456
#define REPN(k) (1 + __builtin_amdgcn_readfirstlane(((const int*)(okp()->ws + OFF_CTL))[REPW + (k)]))
constexpr int LDS_BYTES = 163840;
constexpr int MISC_OFF = 163840 - 256;
template <class Epi, class Sched, bool AMAP = false> __device__ __forceinline__ void run_gemm(int wv, LAS unsigned char* lds, const bf16_t* A, int lda, const bf16_t* Bt, int ldb, int K, const Sched& S, const Epi& E) {
    pg8::Gemm g; g.A = A; g.Bt = Bt; g.M = 0; g.N = 0; g.K = K; g.lda = lda; g.ldb = ldb; g.pad = wv;
    pg8::gemm_phase<Epi, Sched, AMAP>((PG8_LAS unsigned char*)lds, g, S, E);
}
__global__ void __launch_bounds__(512, 2) mega_fwd(Params p_kernarg) {
    extern __shared__ __attribute__((aligned(16))) unsigned char dyn_lds[];
    LAS unsigned char* lds = (LAS unsigned char*)dyn_lds;
    const int wv = __builtin_amdgcn_readfirstlane(threadIdx.x >> 6);
    volatile LAS unsigned* MISC = (volatile LAS unsigned*)(lds + MISC_OFF);
    if (threadIdx.x < 32) MISC[threadIdx.x] = 0u;
    __syncthreads();
    (void)xcd_barrier_post((unsigned*)(okp()->ws + OFF_CTL), MISC + 8);
#define GRID_BAR() for (int rpb = 0, nrpb = REPN(10); rpb < nrpb; ++rpb) { XcdBarrier bar_; bar_.bar = (unsigned*)(okp()->ws + OFF_CTL); bar_.x = xb_xcc_id(); bar_.st = (volatile LAS unsigned*)(lds + MISC_OFF) + 8; xcd_barrier(bar_, wv); }
    for (int rp = 0, nrp = REPN(13); rp < nrp; ++rp) { ph_convert(wv, lds, 0, obid(), (int)gridDim.x, 0, I_LAYER); __syncthreads(); }
    for (int rp = 0, nrp = REPN(0); rp < nrp; ++rp) { ph_tables(wv); __syncthreads(); ph_mod(wv, lds, 0, 1, obid(), (int)gridDim.x); __syncthreads(); }
    GRID_BAR();
    for (int l = 0; l < DEPTH; ++l) {
        unsigned char* ws = ows(okp()->ws);
        const int G = (int)gridDim.x;
        const int fz = G >= 256 ? 1 : 0;
        const bool lastl = (l == DEPTH - 1);
        bf16_t* XN = (bf16_t*)(ws + OFF_XN); bf16_t* P = (bf16_t*)(ws + OFF_P); float* Gt = (float*)(ws + OFF_G); bf16_t* H = (bf16_t*)(ws + OFF_H); float* SLB = (float*)(ws + OFF_SLAB);
        const float* mod = (const float*)(ws + OFF_MOD) + (size_t)l * 5 * 6 * D;
        if (l == 0) ph_norm<true>(wv, 0, 0, nullptr, 0, R, okp()->x, okp()->ctx);
        else ph_norm<false>(wv, l, 0, mod - 5 * 6 * D + 4 * 6 * D + 5 * D, fz ? RL : 0, R, H, H + (size_t)RL * D);
        GRID_BAR();
        for (int rp = 0, nrp = REPN(1); rp < nrp; ++rp) { EpiInProj E{P, Gt, (const float*)(ws + OFF_BINR) + (size_t)l * NINP};
          pg8::StaticOrder S; S.init(R, NINP, D, G, obid());
          run_gemm(wv, lds, XN, D, (const bf16_t*)(ws + OFF_WIN) + (size_t)l * NINP * D, D, D, S, E); }
        GRID_BAR();
        for (int rp = 0, nrp = REPN(2); rp < nrp; ++rp) ph_mlstm1(wv, l, lds);
        { const int f0 = G / 4, fn = G / 2;
          for (int rp = 0, nrp = REPN(9); rp < nrp; ++rp) if (obid() >= f0 && obid() < f0 + fn) ph_fft(wv, lds, obid() - f0, fn);
          for (int rp = 0, nrp = REPN(3); rp < nrp; ++rp) if (obid() < f0 || obid() >= f0 + fn) { const int wi = obid() < f0 ? obid() : obid() - fn;
              if (!lastl) ph_fourier1(wv, wi, G - fn); ph_convc(wv, l, lastl ? RL : R, wi, G - fn); } }
        GRID_BAR();
        for (int rp = 0, nrp = REPN(4); rp < nrp; ++rp) ph_mlstm2(wv);
        GRID_BAR();
        for (int rp = 0, nrp = REPN(5); rp < nrp; ++rp) ph_mlstm3(wv, l, lds, lastl ? 64 * NH : NCHUNK * NH);
        if (!lastl && obid() >= 32) { EpiBf16 E{(bf16_t*)(ws + OFF_HM) + (size_t)RL * D + DM, D, DF, (unsigned)(CTX * D), 0, SLB};
          pg8::StaticOrder S; S.init(256, 2048, 512, G - 32, obid() - 32);
          run_gemm(wv, lds, (const bf16_t*)(ws + OFF_CSC), 512, (const bf16_t*)(ws + OFF_ZTC), 512, 512, S, E); }
        if (!lastl && obid() >= 32) { ph_convert(wv, lds, l + 1, obid() - 32, G - 32, 0, I_CUT); }
        GRID_BAR();
        for (int rp = 0, nrp = REPN(8); rp < nrp; ++rp) { EpiMerge E{P, (bf16_t*)(ws + OFF_MG)}; pg8::StaticOrder S; S.init(lastl ? RL : R, D, D, G, obid());
          run_gemm(wv, lds, (const bf16_t*)(ws + OFF_HM), D, (const bf16_t*)(ws + OFF_WPM) + (size_t)l * D * D, D, D, S, E); }
        if (!lastl && obid() >= 32) { ph_convert(wv, lds, l + 1, obid() - 32, G - 32, I_CUT, I_LAYER); __syncthreads(); ph_mod(wv, lds, l + 1, l + 2, obid() - 32, G - 32); }
        GRID_BAR();
        for (int rp = 0, nrp = REPN(11); rp < nrp; ++rp) { EpiResid E{l, 0, fz, rp == 0 ? 1.f : 0.f};
          pg8::TailOrder S; S.init(D, D, G, obid(), lastl ? 0 : 32, 0, 8);
          run_gemm(wv, lds, (const bf16_t*)(ws + OFF_MG), D, (const bf16_t*)(ws + OFF_WO) + (size_t)l * D * D, D, D, S, E); }
        GRID_BAR();
        if (!lastl || !fz) {
          if (!fz) ph_norm<false>(wv, l, 1, nullptr, 0, RL, H, H);
          if (!lastl) { if (l == 0) ph_norm<true>(wv, 0, 1, mod + 4 * 6 * D + 2 * D, RL, R, okp()->ctx, okp()->ctx); else ph_norm<false>(wv, l, 1, mod + 4 * 6 * D + 2 * D, RL, R, H, H + (size_t)RL * D); }
          GRID_BAR(); }
        for (int rp = 0, nrp = REPN(7); rp < nrp; ++rp) { EpiUp E{P, SLB, (bf16_t*)(ws + OFF_ACT), okp()->conv_ff_w + (size_t)l * 3 * DFF};
          pg8::TailOrder S; S.init(NUP, D, G, obid(), lastl ? 0 : 176, lastl ? 0 : 128, 4);
          run_gemm<EpiUp, pg8::TailOrder, true>(wv, lds, XN, D, (const bf16_t*)(ws + OFF_WUP) + (size_t)l * NUP * D, D, D, S, E); }
        GRID_BAR();
        if (!lastl) { for (int rp = 0, nrp = REPN(6); rp < nrp; ++rp) ph_ffnact(wv, l);
          GRID_BAR(); }
        for (int rp = 0, nrp = REPN(12); rp < nrp; ++rp) { EpiResid E{l, 1, lastl ? 2 * fz : fz, rp == 0 ? 1.f : 0.f};
          pg8::TailOrder S; S.init(D, DFF, G, obid(), lastl ? 0 : 32, 0, 8);
          run_gemm(wv, lds, (const bf16_t*)(ws + OFF_ACT), DFF, (const bf16_t*)(ws + OFF_WDN) + (size_t)l * D * DFF, DFF, DFF, S, E); }
        if (!(lastl && fz)) { GRID_BAR(); }
    }
    if (gridDim.x < 256) ph_final(wv);
}

extern "C" void kernel_launch(void* const* d_in, const int* in_sizes, int n_in, void* d_out, int out_size, void* d_ws, size_t ws_size, hipStream_t stream) {
    static int grid = 0;
    if (grid == 0) {
        if (n_in != 22 || ws_size < WS_END || out_size != RL * D) { fprintf(stderr, "kernel_launch: unexpected problem (n_in %d, ws %zu < %zu, out %d)\n", n_in, ws_size, (size_t)WS_END, out_size); grid = -1; return; }
        int dev = 0, cus = 0, per_cu = 0;
        if (hipGetDevice(&dev) != hipSuccess || hipDeviceGetAttribute(&cus, hipDeviceAttributeMultiprocessorCount, dev) != hipSuccess) { grid = -1; return; }
        if (hipFuncSetAttribute((const void*)mega_fwd, hipFuncAttributeMaxDynamicSharedMemorySize, LDS_BYTES) != hipSuccess) { fprintf(stderr, "kernel_launch: hipFuncSetAttribute failed\n"); grid = -1; return; }
        if (hipOccupancyMaxActiveBlocksPerMultiprocessor(&per_cu, (const void*)mega_fwd, 512, LDS_BYTES) != hipSuccess || per_cu < 1) { fprintf(stderr, "kernel_launch: occupancy query says %d\n", per_cu); per_cu = 1; }
        (void)hipGetLastError();
        grid = cus;
    }
    if (grid < 0) return;
    Params p{};
    const float** pp = (const float**)&p;
    for (int i = 0; i < 22; ++i) pp[i] = (const float*)d_in[i];
    p.out = (float*)d_out; p.ws = (unsigned char*)d_ws;
    (void)hipMemsetAsync((char*)d_ws + OFF_CTL, 0, (size_t)CTL_ZERO_WORDS * sizeof(unsigned), stream);
    hipLaunchKernelGGL(mega_fwd, dim3(grid), dim3(512), LDS_BYTES, stream, p);
}
```

```cpp
#include <hip/hip_runtime.h>
#include <cstdio>
#include <cstdint>
#include <type_traits>

#define LAS __attribute__((address_space(3)))
typedef unsigned short bf16_t;
typedef short bf16x8 __attribute__((ext_vector_type(8)));
typedef float f32x4 __attribute__((ext_vector_type(4)));
typedef unsigned u32x4 __attribute__((ext_vector_type(4)));
typedef unsigned u32x2 __attribute__((ext_vector_type(2)));
typedef float f32x2 __attribute__((ext_vector_type(2)));

constexpr int D = 2048, NB = 4, SEQ = 2048, DEPTH = 4, CTX = 256;
constexpr int DM = 1024, NH = 4, DH = 256, DF = 512, DC = 512, DFF = 5632, CHUNK = 128;
constexpr int NIN = 12304;
constexpr int RL = NB * SEQ, RC = NB * CTX, R = RL + RC;
constexpr int NP = 12288;
constexpr int NINP = 12544;
constexpr int PK = 0, PV = 1024, PQ = 2048, PO = 3072, PF = 4096, PCB = 4608, PCC = 5120, PCX = 5632, PGM = 6144;
constexpr int NCHUNK = 72;
constexpr int NUP = 2 * DFF;
constexpr float EPS = 1e-6f;

constexpr size_t al256(size_t x) { return (x + 255) & ~(size_t)255; }
constexpr size_t OFF_CTL = 0;
constexpr size_t OFF_WIN = 1u << 20;
constexpr size_t SZ_WIN = (size_t)NINP * D * 2;            constexpr size_t OFF_WPM = OFF_WIN + DEPTH * SZ_WIN;
constexpr size_t SZ_WPM = (size_t)D * D * 2;               constexpr size_t OFF_WO = OFF_WPM + DEPTH * SZ_WPM;
constexpr size_t SZ_WO = (size_t)D * D * 2;                constexpr size_t OFF_WUP = OFF_WO + DEPTH * SZ_WO;
constexpr size_t SZ_WUP = (size_t)NUP * D * 2;             constexpr size_t OFF_WDN = OFF_WUP + DEPTH * SZ_WUP;
constexpr size_t SZ_WDN = (size_t)D * DFF * 2;             constexpr size_t OFF_BINR = OFF_WDN + DEPTH * SZ_WDN;
constexpr size_t OFF_MA = al256(OFF_BINR + (size_t)DEPTH * NINP * 4);
constexpr size_t OFF_MC = OFF_MA + (size_t)64 * 64 * 2;
constexpr size_t OFF_CSC = OFF_MC + (size_t)32 * 64 * 128 * 2;
constexpr size_t OFF_FT = OFF_CSC + (size_t)256 * 512 * 2;
constexpr size_t OFF_MOD = OFF_FT + (size_t)256 * 128 * 2;
constexpr size_t OFF_H = al256(OFF_MOD + (size_t)DEPTH * 5 * 6 * D * 4);
constexpr size_t OFF_XN = OFF_H + (size_t)R * D * 4;
constexpr size_t OFF_P = OFF_XN + (size_t)R * D * 2;
constexpr size_t OFF_G = OFF_P + (size_t)R * NP * 2;
constexpr size_t OFF_CHS = OFF_G + (size_t)R * 16 * 4;
constexpr size_t OFF_MST = al256(OFF_CHS + (size_t)NCHUNK * 8 * 2 * 4);
constexpr size_t OFF_UT = al256(OFF_MST + (size_t)NCHUNK * 8 * 4);
constexpr size_t SZ_UT = (size_t)NCHUNK * NH * 2 * DH * DH * 2;
constexpr size_t OFF_CT = OFF_UT + SZ_UT;
constexpr size_t OFF_NV = OFF_CT + SZ_UT;
constexpr size_t OFF_NS = OFF_NV + (size_t)NCHUNK * NH * 2 * DH * 4;
constexpr size_t OFF_HM = OFF_NS + (size_t)NCHUNK * NH * 2 * DH * 4;
constexpr size_t OFF_ZTC = OFF_HM + (size_t)R * D * 2;
constexpr size_t OFF_MG = OFF_ZTC + (size_t)2048 * 512 * 2;
constexpr size_t OFF_ACT = OFF_MG + (size_t)R * D * 2;
constexpr size_t OFF_SLAB = OFF_ACT + (size_t)R * DFF * 2;
constexpr size_t OFF_XS = OFF_SLAB + (size_t)4 * RC * NUP * 4;
constexpr size_t WS_END = OFF_XS + (size_t)8 * RL * 32 * 4;
constexpr int CNTW = 4096;
constexpr int CTL_ZERO_WORDS = CNTW + 8 * 32 * 64;
static_assert(WS_END <= (size_t)4 * DEPTH * D * NIN * 4, "workspace map exceeds the guaranteed d_ws size");
static_assert((size_t)R * NUP * 2 <= (size_t)R * NP * 2, "u overlays P");

struct Params {
    const float *x, *c, *ctx, *c_ctx, *w_mod, *b_mod, *norm1_w, *norm2_w, *w_in, *b_in, *conv_q_w, *conv_k_w, *mlstm_norm_w, *w_pm, *w_pf, *w_pc, *conv_c_w, *w_o, *w_up,
        *conv_ff_w, *w_down, *final_norm_w;
    float* out; unsigned char* ws;
};
#define WSP(T, off) ((T*)(wsb + (off)))
typedef const __attribute__((address_space(4))) Params CParams;
__device__ __forceinline__ CParams* okp() { CParams* k = (CParams*)__builtin_amdgcn_kernarg_segment_ptr(); asm volatile("" : "+s"(k)); return k; }

#define GAS __attribute__((address_space(1)))
template <class T> __device__ __forceinline__ T gld(const void* base, unsigned byte_off) { return *(const GAS T*)((const GAS unsigned char*)base + byte_off); }
template <class T> __device__ __forceinline__ void gst(void* base, unsigned byte_off, T v) { *(GAS T*)((GAS unsigned char*)base + byte_off) = v; }
__device__ __forceinline__ int otid(int wv) { int t; asm volatile("v_mbcnt_lo_u32_b32 %0, -1, 0\n\tv_mbcnt_hi_u32_b32 %0, -1, %0" : "=v"(t)); return (wv << 6) | t; }
__device__ __forceinline__ int olaunder(int v) { asm volatile("" : "+v"(v)); return v; }
__device__ __forceinline__ f32x4 zero4() { float a, b, c, d; asm volatile("v_mov_b32 %0, 0\n\tv_mov_b32 %1, 0\n\tv_mov_b32 %2, 0\n\tv_mov_b32 %3, 0" : "=v"(a), "=v"(b), "=v"(c), "=v"(d)); return (f32x4){a, b, c, d}; }
__device__ __forceinline__ int obid() { int b = blockIdx.x; asm volatile("" : "+s"(b)); return b; }
__device__ __forceinline__ float bf2f(bf16_t v) { return __uint_as_float(((unsigned)v) << 16); }
__device__ __forceinline__ unsigned f2bf(float f) { unsigned u = __float_as_uint(f); return (u + 0x7fffu + ((u >> 16) & 1u)) >> 16; }
__device__ __forceinline__ unsigned pk2(float lo, float hi) { return f2bf(lo) | (f2bf(hi) << 16); }
__device__ __forceinline__ float sigmoidf_(float x) { return 1.f / (1.f + __expf(-x)); }
__device__ __forceinline__ float siluf_(float x) { return x / (1.f + __expf(-x)); }
__device__ __forceinline__ float shx(float v, int k, int lane) { return __int_as_float(__builtin_amdgcn_ds_bpermute((lane ^ k) << 2, __float_as_int(v))); }
__device__ __forceinline__ float shl_(float v, int src) { return __int_as_float(__builtin_amdgcn_ds_bpermute(src << 2, __float_as_int(v))); }
__device__ __forceinline__ unsigned char* ows(unsigned char* w) { asm volatile("" : "+s"(w)); return w; }
__device__ __forceinline__ float wave_sum(float v, int lane) {
#pragma unroll
    for (int o = 1; o < 64; o <<= 1) v += shx(v, o, lane);
    return v;
}
__device__ __forceinline__ void unpack8(u32x4 w, float (&f)[8]) {
    f[0] = __uint_as_float(w.x << 16); f[1] = __uint_as_float(w.x & 0xffff0000u); f[2] = __uint_as_float(w.y << 16); f[3] = __uint_as_float(w.y & 0xffff0000u);
    f[4] = __uint_as_float(w.z << 16); f[5] = __uint_as_float(w.z & 0xffff0000u); f[6] = __uint_as_float(w.w << 16); f[7] = __uint_as_float(w.w & 0xffff0000u);
}
__device__ __forceinline__ u32x4 pack8(const float (&f)[8]) { u32x4 w; w.x = pk2(f[0], f[1]); w.y = pk2(f[2], f[3]); w.z = pk2(f[4], f[5]); w.w = pk2(f[6], f[7]); return w; }
__device__ __forceinline__ void rowinfo(int r, int& mj, int& t, int& T) { const int c = r >= RL ? 1 : 0; mj = r >> 11; T = SEQ >> (3 * c); t = r & (T - 1); }
__device__ __forceinline__ int chunk_row0(int cidx) { return cidx < 64 ? (cidx >> 4) * SEQ + (cidx & 15) * CHUNK : RL + ((cidx - 64) >> 1) * CTX + ((cidx - 64) & 1) * CHUNK; }
__device__ __forceinline__ int scan_chunk(int b, int dir, int step) {
    if (step < 2) { const int j = dir ? 1 - step : step; return 64 + b * 2 + j; }
    const int jj = step - 2, j = dir ? 15 - jj : jj; return b * 16 + j;
}

namespace pg8 {
#define PG8_LAS __attribute__((address_space(3)))
constexpr int BM = 256, BK = 64, HALF = 128, HTB = HALF * BK * 2, STAGE_BYTES = 8 * HTB, NXCD = 8, WGM = 8;
__host__ __device__ __forceinline__ int lds_byte(int r, int c) { const int st = (r >> 4) * 2 + (c >> 5), rr = r & 15, cc = c & 31, ob = rr * 64 + cc * 2; return st * 1024 + (ob ^ (((ob >> 9) & 1) << 5)); }
__host__ __device__ __forceinline__ void stage_rc(int b, int& Rr, int& C) { const int st = b / 1024, sb = b % 1024, swz = sb ^ (((sb >> 9) & 1) << 5); Rr = (st >> 1) * 16 + swz / 64; C = (st & 1) * 32 + (swz % 64) / 2; }
__host__ __device__ __forceinline__ int perm32(int rho) { const int n = rho >> 4, i = rho & 15; return 8 * (i >> 2) + 4 * n + (i & 3); }
struct Unit { int pm, pn, k0, nt, ks; };
struct Gemm { const bf16_t* A; const bf16_t* Bt; int M, N, K, lda, ldb, pad; };
__host__ __device__ __forceinline__ void tile_of(int wgid, int nM, int nN, int& pm, int& pn) {
    const int nwg = nM * nN; { const int q = nwg / NXCD, r = nwg % NXCD, xcd = wgid % NXCD, off = wgid / NXCD; wgid = (xcd < r ? xcd * (q + 1) : r * (q + 1) + (xcd - r) * q) + off; }
    const int nig = WGM * nN, gid = wgid / nig, fm = gid * WGM, gsz = (nM - fm) < WGM ? (nM - fm) : WGM;
    pm = fm + ((wgid % nig) % gsz); pn = (wgid % nig) / gsz;
}
struct StaticOrder {
    int nM, nN, nwg, G, c, K;
    __host__ __device__ void init(int M, int N, int K_, int G_, int c_) { nM = M / BM; nN = N / BM; nwg = nM * nN; G = G_; c = c_; K = K_; }
    __host__ __device__ bool next(int i, Unit& u) const {
        const long L = (long)i * G + c; if (L >= nwg) return false;
        tile_of((int)L, nM, nN, u.pm, u.pn); u.k0 = 0; u.nt = K / BK; u.ks = -1; return true;
    }
    __device__ __forceinline__ void a_ready(const Unit&) const {}
    __device__ __forceinline__ void done(const Unit&) const {}
};
struct TailOrder {
    int nN, G, c, K, nLat, nWhole, nTot, nsl;
    __host__ __device__ void init(int N, int K_, int G_, int c_, int nCtxTiles, int nCtxWhole, int nsl_) { nN = N / BM; G = G_; c = c_; K = K_; nLat = 32 * nN; nWhole = nLat + nCtxWhole; nTot = nLat + nCtxTiles; nsl = nsl_; }
    __host__ __device__ bool next(int i, Unit& u) const {
        const long L = (long)i * G + c; if (L >= (long)nWhole + (long)(nTot - nWhole) * nsl) return false;
        int tile, ks; if (L < nWhole) { tile = (int)L; ks = -1; } else { const int Lp = (int)L - nWhole; tile = nWhole + Lp / nsl; ks = Lp % nsl; }
        if (tile < nLat) tile_of(tile, 32, nN, u.pm, u.pn); else { const int tp = tile - nLat; u.pm = 32 + (tp & 3); u.pn = tp >> 2; }
        if (ks < 0) { u.k0 = 0; u.nt = K / BK; } else { const int n128 = K / 128, base = n128 / nsl, rem = n128 % nsl; u.k0 = 128 * (ks * base + (ks < rem ? ks : rem)); u.nt = 2 * (base + (ks < rem ? 1 : 0)); }
        u.ks = ks; return true;
    }
    __device__ __forceinline__ void a_ready(const Unit&) const {}
    __device__ __forceinline__ void done(const Unit&) const {}
};
template <bool AMAP> __device__ __forceinline__ void a_geom(const Gemm& g, const Unit& u, int R0, int C0, int R1, int C1, size_t& base, size_t& hstep, unsigned (&vo)[2]) {
    if (AMAP && u.pm < 32) { base = (size_t)((u.pm >> 3) * 2048 + (u.pm & 7) * 8) * g.lda * 2; hstep = (size_t)4 * g.lda * 2;
        vo[0] = (unsigned)(((R0 & 31) * 64 + (R0 >> 5)) * g.lda + C0) * 2u; vo[1] = (unsigned)(((R1 & 31) * 64 + (R1 >> 5)) * g.lda + C1) * 2u; }
    else { base = (size_t)u.pm * 256 * g.lda * 2; hstep = (size_t)HALF * g.lda * 2; vo[0] = (unsigned)(R0 * g.lda + C0) * 2u; vo[1] = (unsigned)(R1 * g.lda + C1) * 2u; }
}
template <class Epi, class Sched, bool AMAP = false>
__device__ __forceinline__ void gemm_phase(PG8_LAS unsigned char* lds, const Gemm g, const Sched& S, const Epi& E) {
    const int tid = otid(g.pad), wid = __builtin_amdgcn_readfirstlane(tid >> 6), lane = tid & 63, wr = wid >> 2, wc = wid & 3, fr = lane & 15, fq = lane >> 4;
    int R0, C0, R1, C1; stage_rc(tid * 16, R0, C0); stage_rc(tid * 16 + 8192, R1, C1);
    unsigned voffB[2];
    { const int Rb0 = Epi::PERM ? ((R0 & ~31) + perm32(R0 & 31)) : R0, Rb1 = Epi::PERM ? ((R1 & ~31) + perm32(R1 & 31)) : R1;
      voffB[0] = (unsigned)(Rb0 * g.ldb + C0) * 2u; voffB[1] = (unsigned)(Rb1 * g.ldb + C1) * 2u; }
    const size_t kstep = (size_t)(BK * 2);
    const size_t hstepB = (size_t)HALF * g.ldb * 2, tstepB = 2 * hstepB;
    const unsigned ldsw = (unsigned)wid * 1024u;
    const int aoff = lds_byte(wr * 64 + fr, fq * 8), boff = lds_byte(wc * 32 + fr, fq * 8);
#define PG8_SA(b, h) (((b) * 2 + (h)) * HTB)
#define PG8_SB(b, h) ((4 + (b) * 2 + (h)) * HTB)
#define PG8_STAGE(bufoff, gbase, voff) do { _Pragma("unroll") for (int _i = 0; _i < 2; ++_i) \
        __builtin_amdgcn_global_load_lds((const unsigned*)((const char*)(gbase) + (voff)[_i]), (PG8_LAS unsigned*)(lds + (bufoff) + ldsw + _i * 8192), 16, 0, 0); } while (0)
#define PG8_LDA(dst, b, h) do { _Pragma("unroll") for (int m = 0; m < 4; ++m) _Pragma("unroll") for (int k = 0; k < 2; ++k) dst[m][k] = *(const PG8_LAS bf16x8*)(lds + PG8_SA(b, h) + aoff + m * 2048 + k * 1024); } while (0)
#define PG8_LDB(dst, b, h) do { _Pragma("unroll") for (int n = 0; n < 2; ++n) _Pragma("unroll") for (int k = 0; k < 2; ++k) dst[n][k] = *(const PG8_LAS bf16x8*)(lds + PG8_SB(b, h) + boff + n * 2048 + k * 1024); } while (0)
#define PG8_MMA(ai, bj, At, Bt) do { __builtin_amdgcn_s_setprio(1); _Pragma("unroll") for (int m = 0; m < 4; ++m) _Pragma("unroll") for (int n = 0; n < 2; ++n) _Pragma("unroll") for (int k = 0; k < 2; ++k) \
        acc[ai][bj][m][n] = __builtin_amdgcn_mfma_f32_16x16x32_bf16(Bt[n][k], At[m][k], acc[ai][bj][m][n], 0, 0, 0); __builtin_amdgcn_s_setprio(0); } while (0)
#define PG8_WAIT_V(n) asm volatile("s_waitcnt vmcnt(" #n ")" ::: "memory")
#define PG8_WAIT_L(n) asm volatile("s_waitcnt lgkmcnt(" #n ")" ::: "memory")
#define PG8_BAR __builtin_amdgcn_s_barrier()
#define PG8_SCHED __builtin_amdgcn_sched_barrier(0)
    Unit cur, nxt; int ui = 0;
    if (!S.next(0, cur)) return;
    f32x4 acc[2][2][4][2];
#pragma unroll
    for (int a = 0; a < 2; ++a)
#pragma unroll
        for (int b = 0; b < 2; ++b)
#pragma unroll
            for (int m = 0; m < 4; ++m)
#pragma unroll
                for (int n = 0; n < 2; ++n) acc[a][b][m][n] = zero4();
    bf16x8 At[4][2], B0[2][2], B1[2][2];
    size_t baseC, hsC; unsigned voC[2]; a_geom<AMAP>(g, cur, R0, C0, R1, C1, baseC, hsC, voC);
    const char* cA = (const char*)g.A + baseC + (size_t)cur.k0 * 2; const char* cB = (const char*)g.Bt + (size_t)cur.pn * tstepB + (size_t)cur.k0 * 2;
    S.a_ready(cur);
    PG8_STAGE(PG8_SB(0, 0), cB, voffB); PG8_STAGE(PG8_SB(0, 1), cB + hstepB, voffB); PG8_STAGE(PG8_SA(0, 0), cA, voC); PG8_STAGE(PG8_SA(0, 1), cA + hsC, voC);
    if (wr == 1) PG8_BAR;
    PG8_WAIT_V(2); PG8_BAR;
    PG8_STAGE(PG8_SB(1, 0), cB + kstep, voffB); PG8_STAGE(PG8_SA(1, 0), cA + kstep, voC); PG8_STAGE(PG8_SB(1, 1), cB + hstepB + kstep, voffB);
    PG8_WAIT_V(6); PG8_BAR;
    for (;;) {
        const bool has_next = S.next(ui + 1, nxt);
        size_t baseN = baseC, hsN = hsC; unsigned voN[2] = {voC[0], voC[1]};
        if (AMAP && has_next) a_geom<AMAP>(g, nxt, R0, C0, R1, C1, baseN, hsN, voN); else if (has_next) baseN = (size_t)nxt.pm * 256 * g.lda * 2;
        const char* nA = has_next ? (const char*)g.A + baseN + (size_t)nxt.k0 * 2 : cA; const char* nB = has_next ? (const char*)g.Bt + (size_t)nxt.pn * tstepB + (size_t)nxt.k0 * 2 : cB;
        const int nt = cur.nt;
        for (int t = 0; t < nt; t += 2) {
            if constexpr (Epi::HOOK) E.hook(acc, cur, t, wr, wc, fr, fq, At, B0, B1);
            const bool last = (t == nt - 2);
            const char* a1 = cA + (size_t)(t + 1) * kstep;
            const char* a2 = last ? nA : cA + (size_t)(t + 2) * kstep; const char* b2 = last ? nB : cB + (size_t)(t + 2) * kstep;
            const char* a3 = a2 + kstep; const char* b3 = b2 + kstep;
            const size_t hs2 = (AMAP && last) ? hsN : hsC; unsigned vo2[2] = {(AMAP && last) ? voN[0] : voC[0], (AMAP && last) ? voN[1] : voC[1]};
            if (last && has_next) S.a_ready(nxt);
            PG8_LDB(B0, 0, 0); PG8_LDB(B1, 0, 1); PG8_SCHED; PG8_LDA(At, 0, 0); PG8_STAGE(PG8_SA(1, 1), a1 + hsC, voC);
            PG8_WAIT_V(8); PG8_WAIT_L(0); PG8_BAR; PG8_MMA(0, 0, At, B0); PG8_MMA(0, 1, At, B1); PG8_BAR; PG8_SCHED;
            PG8_LDA(At, 0, 1); PG8_STAGE(PG8_SB(0, 0), b2, voffB); PG8_STAGE(PG8_SB(0, 1), b2 + hstepB, voffB); PG8_STAGE(PG8_SA(0, 0), a2, vo2);
            PG8_WAIT_V(8); PG8_WAIT_L(0); PG8_BAR; PG8_MMA(1, 0, At, B0); PG8_MMA(1, 1, At, B1); PG8_BAR; PG8_SCHED;
            PG8_LDB(B0, 1, 0); PG8_LDB(B1, 1, 1); PG8_SCHED; PG8_LDA(At, 1, 0); PG8_STAGE(PG8_SA(0, 1), a2 + hs2, vo2);
            PG8_WAIT_V(8); PG8_WAIT_L(0); PG8_BAR; PG8_MMA(0, 0, At, B0); PG8_MMA(0, 1, At, B1); PG8_BAR; PG8_SCHED;
            PG8_LDA(At, 1, 1); PG8_STAGE(PG8_SB(1, 0), b3, voffB); PG8_STAGE(PG8_SB(1, 1), b3 + hstepB, voffB); PG8_STAGE(PG8_SA(1, 0), a3, vo2);
            PG8_WAIT_V(8); PG8_WAIT_L(0); PG8_BAR; PG8_MMA(1, 0, At, B0); PG8_MMA(1, 1, At, B1); PG8_BAR; PG8_SCHED;
        }
        if (wr == 0) PG8_BAR;
        E(acc, cur, wr, wc, fr, fq); S.done(cur);
        if (!has_next) break;
#pragma unroll
        for (int a = 0; a < 2; ++a)
#pragma unroll
            for (int b = 0; b < 2; ++b)
#pragma unroll
                for (int m = 0; m < 4; ++m)
#pragma unroll
                    for (int n = 0; n < 2; ++n) acc[a][b][m][n] = zero4();
        cur = nxt; cA = nA; cB = nB; ++ui;
        if constexpr (AMAP) { hsC = hsN; voC[0] = voN[0]; voC[1] = voN[1]; }
        if (wr == 1) PG8_BAR;
    }
    PG8_WAIT_V(0);
    PG8_BAR;
#undef PG8_SA
#undef PG8_SB
#undef PG8_STAGE
#undef PG8_LDA
#undef PG8_LDB
#undef PG8_MMA
#undef PG8_WAIT_V
#undef PG8_WAIT_L
#undef PG8_BAR
#undef PG8_SCHED
}
}

template <class F> __device__ __forceinline__ void epi_foreach(const f32x4 (&acc)[2][2][4][2], const pg8::Unit& u, int wr, int wc, int fr, int fq, F&& f) {
    const int row0 = u.pm * 256 + wr * 64 + fr, col0 = u.pn * 256 + wc * 32 + 8 * fq;
#pragma unroll
    for (int ai = 0; ai < 2; ++ai)
#pragma unroll
        for (int m = 0; m < 4; ++m)
#pragma unroll
            for (int bj = 0; bj < 2; ++bj) f(row0 + ai * 128 + m * 16, col0 + bj * 128, acc[ai][bj][m][0], acc[ai][bj][m][1]);
}
__device__ __forceinline__ void unpack8v(u32x4 w, f32x4& v0, f32x4& v1) {
    v0[0] = __uint_as_float(w.x << 16); v0[1] = __uint_as_float(w.x & 0xffff0000u); v0[2] = __uint_as_float(w.y << 16); v0[3] = __uint_as_float(w.y & 0xffff0000u);
    v1[0] = __uint_as_float(w.z << 16); v1[1] = __uint_as_float(w.z & 0xffff0000u); v1[2] = __uint_as_float(w.w << 16); v1[3] = __uint_as_float(w.w & 0xffff0000u);
}
__device__ __forceinline__ u32x4 pack8v(f32x4 v0, f32x4 v1) { u32x4 w; w.x = pk2(v0[0], v0[1]); w.y = pk2(v0[2], v0[3]); w.z = pk2(v1[0], v1[1]); w.w = pk2(v1[2], v1[3]); return w; }

struct EpiInProj {
    static constexpr bool PERM = true, HOOK = false;
    bf16_t* P; float* G; const float* bias;
    __device__ __forceinline__ void operator()(const f32x4 (&acc)[2][2][4][2], const pg8::Unit& u, int wr, int wc, int fr, int fq) const {
        if (u.pn < 48) {
            f32x4 bv[2][2];
#pragma unroll
            for (int bj = 0; bj < 2; ++bj) { const unsigned bo = (unsigned)(u.pn * 256 + wc * 32 + 8 * fq + bj * 128) * 4u; bv[bj][0] = gld<f32x4>(bias, bo); bv[bj][1] = gld<f32x4>(bias, bo + 16); }
            epi_foreach(acc, u, wr, wc, fr, fq, [&](int row, int col, f32x4 v0, f32x4 v1) {
                const int bj = (col >> 7) & 1;
                f32x4 o0 = v0 + bv[bj][0], o1 = v1 + bv[bj][1];
                if (u.pn >= PGM / 256) {
#pragma unroll
                    for (int j = 0; j < 4; ++j) { o0[j] = 1.f + __expf(-fminf(fmaxf(o0[j], -30.f), 30.f)); o1[j] = 1.f + __expf(-fminf(fmaxf(o1[j], -30.f), 30.f)); } }
                gst<u32x4>(P, (unsigned)(row * NP + col) * 2u, pack8v(o0, o1)); });
        } else if (wc == 0 && fq < 2) {
            const int row0 = u.pm * 256 + wr * 64 + fr;
            const f32x4 b0 = gld<f32x4>(bias, (unsigned)(NP + 8 * fq) * 4u), b1 = gld<f32x4>(bias, (unsigned)(NP + 8 * fq) * 4u + 16);
#pragma unroll
            for (int ai = 0; ai < 2; ++ai)
#pragma unroll
                for (int m = 0; m < 4; ++m) { const unsigned go = (unsigned)((row0 + ai * 128 + m * 16) * 16 + 8 * fq) * 4u;
                    gst<f32x4>(G, go, acc[ai][0][m][0] + b0); gst<f32x4>(G, go + 16, acc[ai][0][m][1] + b1); }
        }
    }
};
struct EpiBf16 {
    static constexpr bool PERM = true, HOOK = false;
    bf16_t* O; int ldc; int split_cols; unsigned split_stride; int pad; float* slab;
    __device__ __forceinline__ void operator()(const f32x4 (&acc)[2][2][4][2], const pg8::Unit& u, int wr, int wc, int fr, int fq) const {
        if (u.ks >= 0) { const unsigned sb = (unsigned)u.ks * (unsigned)(RC * ldc);
            epi_foreach(acc, u, wr, wc, fr, fq, [&](int row, int col, f32x4 v0, f32x4 v1) { const unsigned o = (sb + (unsigned)((row - RL) * ldc + col)) * 4u; gst<f32x4>(slab, o, v0); gst<f32x4>(slab, o + 16, v1); });
            return; }
        int colt = u.pn * 256; unsigned base = 0;
        if (split_cols) { const int t = colt / split_cols; base = (unsigned)t * split_stride; colt -= t * split_cols; }
        const int cshift = colt - u.pn * 256;
        epi_foreach(acc, u, wr, wc, fr, fq, [&](int row, int col, f32x4 v0, f32x4 v1) { gst<u32x4>(O, (base + (unsigned)(row * ldc + col + cshift)) * 2u, pack8v(v0, v1)); });
    }
};
struct EpiMerge {
    static constexpr bool PERM = true, HOOK = true;
    const bf16_t* P; bf16_t* MG;
    __device__ __forceinline__ void hook(f32x4 (&acc)[2][2][4][2], const pg8::Unit& u, int t, int wr, int wc, int fr, int fq, bf16x8 (&At)[4][2], bf16x8 (&B0)[2][2], bf16x8 (&B1)[2][2]) const {
        if (t != 16 && t != 24) return;
        const int b = t == 16 ? 0 : 1;
        const unsigned o0 = (unsigned)((u.pm * 256 + wr * 64 + fr) * NP + PGM + b * D + u.pn * 256 + wc * 32 + 8 * fq) * 2u;
#pragma unroll
        for (int ai = 0; ai < 2; ++ai) {
#pragma unroll
            for (int m = 0; m < 4; ++m) { const unsigned o = o0 + (unsigned)((ai * 128 + m * 16) * NP) * 2u;
                At[m][0] = gld<bf16x8>(P, o); At[m][1] = gld<bf16x8>(P, o + 256u);
                if (m < 2) { B0[m][0] = gld<bf16x8>(P, o + D * 2); B0[m][1] = gld<bf16x8>(P, o + D * 2 + 256u); }
                else { B1[m - 2][0] = gld<bf16x8>(P, o + D * 2); B1[m - 2][1] = gld<bf16x8>(P, o + D * 2 + 256u); } }
#pragma unroll
            for (int m = 0; m < 4; ++m)
#pragma unroll
                for (int bj = 0; bj < 2; ++bj) { float xa[8], xb[8]; unpack8(__builtin_bit_cast(u32x4, At[m][bj]), xa); unpack8(__builtin_bit_cast(u32x4, m < 2 ? B0[m][bj] : B1[m - 2][bj]), xb);
#pragma unroll
                    for (int j = 0; j < 8; ++j) acc[ai][bj][m][j >> 2][j & 3] *= xb[j] * __builtin_amdgcn_rcpf(xa[j]); }
        }
    }
    __device__ __forceinline__ void operator()(const f32x4 (&acc)[2][2][4][2], const pg8::Unit& u, int wr, int wc, int fr, int fq) const {
        const int row0 = u.pm * 256 + wr * 64 + fr, col0 = u.pn * 256 + wc * 32 + 8 * fq;
#pragma unroll
        for (int ai = 0; ai < 2; ++ai) { u32x4 gr[4][2];
#pragma unroll
            for (int m = 0; m < 4; ++m)
#pragma unroll
                for (int bj = 0; bj < 2; ++bj) gr[m][bj] = gld<u32x4>(P, (unsigned)((row0 + ai * 128 + m * 16) * NP + PGM + 2 * D + col0 + bj * 128) * 2u);
#pragma unroll
            for (int m = 0; m < 4; ++m)
#pragma unroll
                for (int bj = 0; bj < 2; ++bj) { float g[8]; unpack8(gr[m][bj], g);
                    const f32x4 g0 = {__builtin_amdgcn_rcpf(g[0]), __builtin_amdgcn_rcpf(g[1]), __builtin_amdgcn_rcpf(g[2]), __builtin_amdgcn_rcpf(g[3])},
                                g1 = {__builtin_amdgcn_rcpf(g[4]), __builtin_amdgcn_rcpf(g[5]), __builtin_amdgcn_rcpf(g[6]), __builtin_amdgcn_rcpf(g[7])};
                    gst<u32x4>(MG, (unsigned)((row0 + ai * 128 + m * 16) * D + col0 + bj * 128) * 2u, pack8v(g0 * acc[ai][bj][m][0], g1 * acc[ai][bj][m][1])); }
        }
    }
};
struct EpiUp {
    static constexpr bool PERM = true, HOOK = false;
    bf16_t* U; float* slab; bf16_t* ACT; const float* wf;
    __device__ __forceinline__ void operator()(const f32x4 (&acc)[2][2][4][2], const pg8::Unit& u, int wr, int wc, int fr, int fq) const {
        if (u.ks >= 0) { const unsigned sb = (unsigned)u.ks * (unsigned)(RC * NUP);
            epi_foreach(acc, u, wr, wc, fr, fq, [&](int row, int col, f32x4 v0, f32x4 v1) { const unsigned o = (sb + (unsigned)((row - RL) * NUP + col)) * 4u; gst<f32x4>(slab, o, v0); gst<f32x4>(slab, o + 16, v1); });
            return; }
        if (u.pm >= 32) { epi_foreach(acc, u, wr, wc, fr, fq, [&](int row, int col, f32x4 v0, f32x4 v1) { gst<u32x4>(U, (unsigned)(row * NUP + col) * 2u, pack8v(v0, v1)); }); return; }
        const int c0 = 128 * u.pn + 32 * wc + 8 * fq, lane = fq * 16 + fr;
        const int lprev = ((lane & 48) | ((fr - 1) & 15)), lnext = ((lane & 48) | ((fr + 1) & 15));
        float w0[8], w1[8], w2[8];
        { const f32x4 a0 = gld<f32x4>(wf, (unsigned)c0 * 4u), a1 = gld<f32x4>(wf, (unsigned)c0 * 4u + 16), b0 = gld<f32x4>(wf, (unsigned)(DFF + c0) * 4u), b1 = gld<f32x4>(wf, (unsigned)(DFF + c0) * 4u + 16),
                      d0 = gld<f32x4>(wf, (unsigned)(2 * DFF + c0) * 4u), d1 = gld<f32x4>(wf, (unsigned)(2 * DFF + c0) * 4u + 16);
#pragma unroll
          for (int j = 0; j < 4; ++j) { w0[j] = a0[j]; w0[4 + j] = a1[j]; w1[j] = b0[j]; w1[4 + j] = b1[j]; w2[j] = d0[j]; w2[4 + j] = d1[j]; } }
        const unsigned rowb = (unsigned)((u.pm >> 3) * 2048 + (u.pm & 7) * 8 + 2 * wr);
#pragma unroll
        for (int ai = 0; ai < 2; ++ai)
#pragma unroll
            for (int m = 0; m < 4; ++m) {
                float o[8];
#pragma unroll
                for (int n = 0; n < 2; ++n)
#pragma unroll
                    for (int e = 0; e < 4; ++e) {
                        const float a = acc[ai][0][m][n][e];
                        const float oprev = (m & 1) ? acc[ai][0][m - 1 < 0 ? 0 : m - 1][n][e] : 0.f, onext = (m & 1) ? 0.f : acc[ai][0][m + 1 > 3 ? 3 : m + 1][n][e];
                        const float pv = shl_(fr == 15 ? oprev : a, lprev), nx = shl_(fr == 0 ? onext : a, lnext);
                        o[4 * n + e] = siluf_(w0[4 * n + e] * pv + w1[4 * n + e] * a + w2[4 * n + e] * nx) * acc[ai][1][m][n][e];
                    }
                const unsigned row = rowb + (unsigned)((16 * (m & 1) + fr) * 64 + 4 * ai + (m >> 1));
                gst<u32x4>(ACT, (row * (unsigned)DFF + (unsigned)c0) * 2u, pack8(o));
            }
    }
};
struct EpiResid {
    static constexpr bool PERM = true, HOOK = false;
    int l, which, fuse; float scale;
    __device__ __forceinline__ void operator()(f32x4 (&acc)[2][2][4][2], const pg8::Unit& u, int wr, int wc, int fr, int fq) const {
        CParams& p = *okp(); unsigned char* const ws = ows(p.ws);
        bf16_t* H = (bf16_t*)(ws + OFF_H); const bool xin = (l == 0 && which == 0);
        const float* mod = (const float*)(ws + OFF_MOD) + (size_t)l * 5 * 6 * D; const float* gate = mod + (which ? 5 : 2) * D;
        if (u.ks >= 0) { float* slab = (float*)(ws + OFF_SLAB); const unsigned sb = (unsigned)u.ks * (unsigned)(RC * D);
            epi_foreach(acc, u, wr, wc, fr, fq, [&](int row, int col, f32x4 v0, f32x4 v1) { const unsigned o = (sb + (unsigned)((row - RL) * D + col)) * 4u; gst<f32x4>(slab, o, v0); gst<f32x4>(slab, o + 16, v1); });
            return; }
        const unsigned gb = (unsigned)(u.pm < 32 ? (u.pm >> 3) : 4) * (6 * D) * 4u;
        if (!fuse || u.pm >= 32) {
            const int row0 = u.pm * 256 + wr * 64 + fr, col0 = u.pn * 256 + wc * 32 + 8 * fq;
            f32x4 gv[2][2];
#pragma unroll
            for (int bj = 0; bj < 2; ++bj) { gv[bj][0] = gld<f32x4>(gate, gb + (unsigned)(col0 + bj * 128) * 4u) * scale; gv[bj][1] = gld<f32x4>(gate, gb + (unsigned)(col0 + bj * 128) * 4u + 16) * scale; }
            if (xin) {
#pragma unroll
              for (int am = 0; am < 4; ++am) { f32x4 hv[2][2][2];
#pragma unroll
                for (int mm = 0; mm < 2; ++mm)
#pragma unroll
                  for (int bj = 0; bj < 2; ++bj) { const unsigned ho = (unsigned)((row0 + (am >> 1) * 128 + (2 * (am & 1) + mm) * 16) * D + col0 + bj * 128) * 4u; hv[mm][bj][0] = gld<f32x4>(p.x, ho); hv[mm][bj][1] = gld<f32x4>(p.x, ho + 16); }
#pragma unroll
                for (int mm = 0; mm < 2; ++mm)
#pragma unroll
                  for (int bj = 0; bj < 2; ++bj) { const int ai = am >> 1, m = 2 * (am & 1) + mm; const unsigned eo = (unsigned)((row0 + ai * 128 + m * 16) * D + col0 + bj * 128);
                      gst<u32x4>(H, eo * 2u, pack8v(hv[mm][bj][0] + gv[bj][0] * acc[ai][bj][m][0], hv[mm][bj][1] + gv[bj][1] * acc[ai][bj][m][1])); } }
            } else {
#pragma unroll
              for (int ai = 0; ai < 2; ++ai) { u32x4 hr[4][2];
#pragma unroll
                for (int m = 0; m < 4; ++m)
#pragma unroll
                  for (int bj = 0; bj < 2; ++bj) hr[m][bj] = gld<u32x4>(H, (unsigned)((row0 + ai * 128 + m * 16) * D + col0 + bj * 128) * 2u);
#pragma unroll
                for (int m = 0; m < 4; ++m)
#pragma unroll
                  for (int bj = 0; bj < 2; ++bj) { f32x4 o0, o1; unpack8v(hr[m][bj], o0, o1);
                      gst<u32x4>(H, (unsigned)((row0 + ai * 128 + m * 16) * D + col0 + bj * 128) * 2u, pack8v(o0 + gv[bj][0] * acc[ai][bj][m][0], o1 + gv[bj][1] * acc[ai][bj][m][1])); } }
            }
            return; }
        bf16_t* XN = (bf16_t*)(ws + OFF_XN); const float* nw = fuse == 2 ? p.final_norm_w : which ? p.norm1_w + (size_t)(l + 1) * D : p.norm2_w + (size_t)l * D;
        const float* nmod = which ? mod + 5 * 6 * D : mod + 3 * D;
        float* xs = (float*)(ws + OFF_XS) + (size_t)(2 * l + which) * RL * 32; unsigned* cnt = (unsigned*)(ws + OFF_CTL) + CNTW + (2 * l + which) * 32 * 64;
        float* out = p.out;
        int lane; asm volatile("v_mbcnt_lo_u32_b32 %0, -1, 0\n\tv_mbcnt_hi_u32_b32 %0, -1, %0" : "=v"(lane));
        { const int fr2 = lane & 15, fq2 = lane >> 4, row0 = u.pm * 256 + wr * 64 + fr2, col0 = u.pn * 256 + wc * 32 + 8 * fq2;
          f32x4 gv[2][2];
#pragma unroll
          for (int bj = 0; bj < 2; ++bj) { gv[bj][0] = gld<f32x4>(gate, gb + (unsigned)(col0 + bj * 128) * 4u) * scale; gv[bj][1] = gld<f32x4>(gate, gb + (unsigned)(col0 + bj * 128) * 4u + 16) * scale; }
          float ssr[8];
          auto newh = [&](int k, int bj, f32x4 o0, f32x4 o1, float& ss) {
              const int ai = k >> 2, m = k & 3; const unsigned eo = (unsigned)((row0 + ai * 128 + m * 16) * D + col0 + bj * 128);
              const f32x4 h0 = o0 + gv[bj][0] * acc[ai][bj][m][0], h1 = o1 + gv[bj][1] * acc[ai][bj][m][1];
              if (fuse == 2) { gst<f32x4>(out, eo * 4u, h0); gst<f32x4>(out, eo * 4u + 16, h1); } else gst<u32x4>(H, eo * 2u, pack8v(h0, h1));
              ss += (h0[0] * h0[0] + h0[1] * h0[1]) + (h0[2] * h0[2] + h0[3] * h0[3]) + (h1[0] * h1[0] + h1[1] * h1[1]) + (h1[2] * h1[2] + h1[3] * h1[3]); };
          if (xin) {
#pragma unroll
            for (int am = 0; am < 4; ++am) { f32x4 hv[2][2][2];
#pragma unroll
              for (int mm = 0; mm < 2; ++mm)
#pragma unroll
                for (int bj = 0; bj < 2; ++bj) { const unsigned ho = (unsigned)((row0 + (am >> 1) * 128 + (2 * (am & 1) + mm) * 16) * D + col0 + bj * 128) * 4u; hv[mm][bj][0] = gld<f32x4>(p.x, ho); hv[mm][bj][1] = gld<f32x4>(p.x, ho + 16); }
#pragma unroll
              for (int mm = 0; mm < 2; ++mm) { const int k = 4 * (am >> 1) + 2 * (am & 1) + mm; float ss = 0.f;
#pragma unroll
                for (int bj = 0; bj < 2; ++bj) newh(k, bj, hv[mm][bj][0], hv[mm][bj][1], ss);
                ss += shx(ss, 16, lane); ss += shx(ss, 32, lane); ssr[k] = ss; } }
          } else {
#pragma unroll
            for (int kh = 0; kh < 2; ++kh) { u32x4 hr[4][2];
#pragma unroll
              for (int m = 0; m < 4; ++m)
#pragma unroll
                for (int bj = 0; bj < 2; ++bj) hr[m][bj] = gld<u32x4>(H, (unsigned)((row0 + kh * 128 + m * 16) * D + col0 + bj * 128) * 2u);
#pragma unroll
              for (int m = 0; m < 4; ++m) { const int k = 4 * kh + m; float ss = 0.f;
#pragma unroll
                for (int bj = 0; bj < 2; ++bj) { f32x4 o0, o1; unpack8v(hr[m][bj], o0, o1); newh(k, bj, o0, o1, ss); }
                ss += shx(ss, 16, lane); ss += shx(ss, 32, lane); ssr[k] = ss; } }
          }
#pragma unroll
          for (int k = 0; k < 8; ++k)
              if (fq2 == 0) __hip_atomic_store((GAS float*)xs + ((row0 + (k >> 2) * 128 + (k & 3) * 16) * 32 + u.pn * 4 + wc), ssr[k], __ATOMIC_RELAXED, __HIP_MEMORY_SCOPE_AGENT); }
        asm volatile("s_waitcnt vmcnt(0)" ::: "memory");
        __builtin_amdgcn_s_barrier();
        if (lane == 0 && wr == 0 && wc == 0) {
            GAS unsigned* pc = (GAS unsigned*)cnt + 64 * u.pm;
            (void)__hip_atomic_fetch_add(pc, 1u, __ATOMIC_RELAXED, __HIP_MEMORY_SCOPE_AGENT);
            unsigned spins = 0;
#pragma nounroll
            while (__hip_atomic_load(pc, __ATOMIC_RELAXED, __HIP_MEMORY_SCOPE_AGENT) < 8u && ++spins < (1u << 22)) __builtin_amdgcn_s_sleep(1);
        }
        __builtin_amdgcn_s_barrier();
        __builtin_amdgcn_fence(__ATOMIC_ACQUIRE, "agent");
        { const int hl = lane & 31, row0 = u.pm * 256 + (wr * 4 + wc) * 32 + (lane >> 5), col = u.pn * 256 + hl * 8;
          const unsigned mo = (unsigned)(u.pm >> 3) * (6 * D) * 4u, co = (unsigned)col * 4u;
          const f32x4 w0 = gld<f32x4>(nw, co), w1 = gld<f32x4>(nw, co + 16);
          if (fuse == 2) {
#pragma unroll
            for (int ib = 0; ib < 4; ++ib) { float tt[4]; f32x4 ha[4], hb[4];
#pragma unroll
              for (int i = 0; i < 4; ++i) { const int row = row0 + 2 * (4 * ib + i); const unsigned ho = (unsigned)(row * D + col) * 4u;
                  tt[i] = gld<float>(xs, (unsigned)(row * 32 + hl) * 4u); ha[i] = gld<f32x4>(out, ho); hb[i] = gld<f32x4>(out, ho + 16); }
#pragma unroll
              for (int i = 0; i < 4; ++i) { const int row = row0 + 2 * (4 * ib + i); const unsigned ho = (unsigned)(row * D + col) * 4u; float tot = tt[i];
#pragma unroll
                  for (int o = 1; o < 32; o <<= 1) tot += shx(tot, o, lane);
                  const float rstd = rsqrtf(tot * (1.f / D) + EPS);
                  gst<f32x4>(out, ho, ha[i] * rstd * w0); gst<f32x4>(out, ho + 16, hb[i] * rstd * w1); } }
            return; }
          const f32x4 sh0 = gld<f32x4>(nmod, mo + co), sh1 = gld<f32x4>(nmod, mo + co + 16);
          const f32x4 sc0 = gld<f32x4>(nmod, mo + D * 4 + co) + 1.f, sc1 = gld<f32x4>(nmod, mo + D * 4 + co + 16) + 1.f;
#pragma unroll
          for (int ib = 0; ib < 2; ++ib) { float tt[8]; u32x4 hq[8];
#pragma unroll
            for (int i = 0; i < 8; ++i) { const int row = row0 + 2 * (8 * ib + i);
                tt[i] = gld<float>(xs, (unsigned)(row * 32 + hl) * 4u); hq[i] = gld<u32x4>(H, (unsigned)(row * D + col) * 2u); }
#pragma unroll
            for (int i = 0; i < 8; ++i) { const int row = row0 + 2 * (8 * ib + i); float tot = tt[i];
#pragma unroll
                for (int o = 1; o < 32; o <<= 1) tot += shx(tot, o, lane);
                const float rstd = rsqrtf(tot * (1.f / D) + EPS);
                f32x4 ha, hb; unpack8v(hq[i], ha, hb);
                const f32x4 y0 = (ha * rstd * w0) * sc0 + sh0, y1 = (hb * rstd * w1) * sc1 + sh1;
                gst<u32x4>(XN, (unsigned)(row * D + col) * 2u, pack8v(y0, y1)); } } }
    }
};

__device__ __forceinline__ bf16x8 gather8(const bf16_t* p, size_t stride) {
    bf16x8 v;
#pragma unroll
    for (int j = 0; j < 8; ++j) v[j] = (short)p[(size_t)j * stride];
    return v;
}
template <bool AV, bool BV>
__device__ __forceinline__ void wave_mm32(const bf16_t* A, size_t sam, size_t sak, const bf16_t* B, size_t sbk, size_t sbn, int K, f32x4 (&acc)[2][2], int lane) {
    const int fr = lane & 15, fq = lane >> 4;
    for (int k0 = 0; k0 < K; k0 += 32) {
        bf16x8 a[2], b[2];
#pragma unroll
        for (int mi = 0; mi < 2; ++mi) { const bf16_t* q = A + (size_t)(16 * mi + fr) * sam + (size_t)(k0 + 8 * fq) * sak; a[mi] = AV ? *(const bf16x8*)q : gather8(q, sak); }
#pragma unroll
        for (int ni = 0; ni < 2; ++ni) { const bf16_t* q = B + (size_t)(16 * ni + fr) * sbn + (size_t)(k0 + 8 * fq) * sbk; b[ni] = BV ? *(const bf16x8*)q : gather8(q, sbk); }
#pragma unroll
        for (int mi = 0; mi < 2; ++mi)
#pragma unroll
            for (int ni = 0; ni < 2; ++ni) acc[mi][ni] = __builtin_amdgcn_mfma_f32_16x16x32_bf16(a[mi], b[ni], acc[mi][ni], 0, 0, 0);
    }
}
#define ZERO_ACC22(acc) do { _Pragma("unroll") for (int _a = 0; _a < 2; ++_a) _Pragma("unroll") for (int _b = 0; _b < 2; ++_b) acc[_a][_b] = (f32x4){0.f, 0.f, 0.f, 0.f}; } while (0)

__device__ __forceinline__ void transpose_item(const float* W, int N, int pitch, int kdst0, bf16_t* WT, int dst_row0, int src_col0, int nvalid, int k0, LAS float* scr, int lane) {
    const int n4 = (lane & 15) * 4, kq = lane >> 4;
    f32x4 v[16];
#pragma unroll
    for (int i = 0; i < 16; ++i) v[i] = n4 < nvalid ? gld<f32x4>(W, (unsigned)((k0 + 4 * i + kq) * N + src_col0 + n4) * 4u) : (f32x4){0.f, 0.f, 0.f, 0.f};
#pragma unroll
    for (int i = 0; i < 16; ++i) { LAS float* d = scr + (4 * i + kq) * 65 + n4; d[0] = v[i][0]; d[1] = v[i][1]; d[2] = v[i][2]; d[3] = v[i][3]; }
    asm volatile("s_waitcnt lgkmcnt(0)" ::: "memory");
    const int c = lane & 7;
#pragma unroll
    for (int j8 = 0; j8 < 8; ++j8) { const int n = (lane >> 3) + 8 * j8; const LAS float* sp = scr + (8 * c) * 65 + n;
        u32x4 o; o.x = pk2(sp[0 * 65], sp[1 * 65]); o.y = pk2(sp[2 * 65], sp[3 * 65]); o.z = pk2(sp[4 * 65], sp[5 * 65]); o.w = pk2(sp[6 * 65], sp[7 * 65]);
        gst<u32x4>(WT, (unsigned)((dst_row0 + n) * pitch + kdst0 + k0 + 8 * c) * 2u, o); }
    asm volatile("s_waitcnt lgkmcnt(0)" ::: "memory");
}
constexpr int I_IN = (NINP / 64) * (D / 64), I_PM = (D / 64) * (DM / 64), I_PF = (D / 64) * (DF / 64), I_PC = (D / 64) * (DC / 64), I_O = (D / 64) * (D / 64),
              I_UP = (NUP / 64) * (D / 64), I_DN = (D / 64) * (DFF / 64), I_LAYER = I_IN + I_PM + I_PF + I_PC + I_O + I_UP + I_DN;
__device__ __forceinline__ void ph_convert(int wv, LAS unsigned char* lds, int l, int widx, int nwg, int it_lo, int it_hi) {
    CParams& p = *okp();
    unsigned char* const wsb = ows(p.ws);
    const int TIDX = otid(wv);
    const int lane = TIDX & 63, wave = wv;
    LAS float* scr = (LAS float*)lds + wave * 64 * 65;
    const int gw = widx * 8 + wave, NGW = nwg * 8;
    for (int it = it_lo + gw; it < it_hi; it += NGW) {
        int r = it;
        if (r < I_IN) { const int nkb = D / 64, kb = r % nkb, grp = r / nkb, j0 = 64 * grp; int src0, nv;
            if (j0 < 2048) { src0 = j0; nv = 64; } else if (j0 < NP) { src0 = j0 + 16; nv = 64; } else if (j0 == NP) { src0 = 2048; nv = 16; } else { src0 = 0; nv = 0; }
            transpose_item(p.w_in + (size_t)l * D * NIN, NIN, D, 0, WSP(bf16_t, OFF_WIN) + (size_t)l * NINP * D, j0, src0, nv, 64 * kb, scr, lane); continue; } r -= I_IN;
        if (r < I_PM) { const int nkb = DM / 64, kb = r % nkb, grp = r / nkb;
            transpose_item(p.w_pm + (size_t)l * DM * D, D, D, 0, WSP(bf16_t, OFF_WPM) + (size_t)l * D * D, 64 * grp, 64 * grp, 64, 64 * kb, scr, lane); continue; } r -= I_PM;
        if (r < I_PF) { const int nkb = DF / 64, kb = r % nkb, grp = r / nkb;
            transpose_item(p.w_pf + (size_t)l * DF * D, D, D, DM, WSP(bf16_t, OFF_WPM) + (size_t)l * D * D, 64 * grp, 64 * grp, 64, 64 * kb, scr, lane); continue; } r -= I_PF;
        if (r < I_PC) { const int nkb = DC / 64, kb = r % nkb, grp = r / nkb;
            transpose_item(p.w_pc + (size_t)l * DC * D, D, D, DM + DF, WSP(bf16_t, OFF_WPM) + (size_t)l * D * D, 64 * grp, 64 * grp, 64, 64 * kb, scr, lane); continue; } r -= I_PC;
        if (r < I_O) { const int nkb = D / 64, kb = r % nkb, grp = r / nkb;
            transpose_item(p.w_o + (size_t)l * D * D, D, D, 0, WSP(bf16_t, OFF_WO) + (size_t)l * D * D, 64 * grp, 64 * grp, 64, 64 * kb, scr, lane); continue; } r -= I_O;
        if (r < I_UP) { const int nkb = D / 64, kb = r % nkb, grp = r / nkb, j0 = 64 * grp, tile = j0 >> 8, w0 = j0 & 255;
            transpose_item(p.w_up + (size_t)l * D * NUP, NUP, D, 0, WSP(bf16_t, OFF_WUP) + (size_t)l * NUP * D, j0, w0 < 128 ? 128 * tile + w0 : DFF + 128 * tile + (w0 - 128), 64, 64 * kb, scr, lane); continue; } r -= I_UP;
        { const int nkb = DFF / 64, kb = r % nkb, grp = r / nkb;
            transpose_item(p.w_down + (size_t)l * DFF * D, D, DFF, 0, WSP(bf16_t, OFF_WDN) + (size_t)l * D * DFF, 64 * grp, 64 * grp, 64, 64 * kb, scr, lane); }
    }
}
__device__ __forceinline__ void ph_tables(int wv) {
    CParams& p = *okp();
    unsigned char* const wsb = ows(p.ws);
    const int TIDX = otid(wv), BIDX = obid(); (void)TIDX; (void)BIDX;
    const size_t gt = (size_t)BIDX * 512 + TIDX, NT = (size_t)gridDim.x * 512;
    bf16_t* ma = WSP(bf16_t, OFF_MA);
    for (size_t i = gt; i < (size_t)64 * 64; i += NT) { const int row = (int)(i >> 6), col = (int)(i & 63), ro = row >> 5, tau1 = row & 31, ri = col >> 5, t1 = col & 31;
        const float a = (float)((t1 * tau1) & 31) * (1.0f / 16.0f); const float cv = cospif(a), sv = sinpif(a);
        ma[i] = (bf16_t)f2bf(ro == ri ? cv : (ro == 0 ? sv : -sv)); }
    bf16_t* mc = WSP(bf16_t, OFF_MC);
    for (size_t i = gt; i < (size_t)32 * 64 * 128; i += NT) { const int k = (int)(i & 127), tau2 = (int)(i >> 7) & 63, tau1 = (int)(i >> 13), ri = k >> 6, t2 = k & 63, tau = tau1 + 32 * tau2;
        const float a = (float)((t2 * tau) & 2047) * (1.0f / 1024.0f); mc[i] = (bf16_t)f2bf((ri ? sinpif(a) : cospif(a)) * (1.0f / 512.0f)); }
    bf16_t* csc = WSP(bf16_t, OFF_CSC);
    for (size_t i = gt; i < (size_t)256 * 512; i += NT) { const int tau = (int)(i >> 9), k = (int)(i & 511), t = k & 255; const int idx = (tau * t) & 255;
        const float a = (float)idx * (1.0f / 128.0f); const float v = (k < 256 ? cospif(a) : -sinpif(a)) * 0.005524271728019903f  ; csc[i] = (bf16_t)f2bf(v); }
    bf16_t* ft = WSP(bf16_t, OFF_FT);
    for (size_t i = gt; i < (size_t)256 * 128; i += NT) { const int kp = (int)(i >> 7), c = (int)(i & 127), kap = kp & 127; const int idx = (c * kap) & 127;
        const float a = (float)idx * (1.0f / 64.0f); ft[i] = (bf16_t)f2bf(kp < 128 ? cospif(a) : sinpif(a)); }
    float* binr = WSP(float, OFF_BINR);
    for (size_t i = gt; i < (size_t)DEPTH * NINP; i += NT) { const int l = (int)(i / NINP), j = (int)(i % NINP);
        float v = 0.f; if (j < 2048) v = p.b_in[(size_t)l * NIN + j]; else if (j < NP) v = p.b_in[(size_t)l * NIN + j + 16]; else if (j < NP + 16) v = p.b_in[(size_t)l * NIN + 2048 + (j - NP)];
        binr[i] = v; }

}
__device__ __forceinline__ void ph_mod(int wv, LAS unsigned char* lds, int l0, int l1, int widx, int nwg) {
    CParams& p = *okp();
    unsigned char* const wsb = ows(p.ws);
    const int TIDX = otid(wv), BIDX = obid(); (void)TIDX; (void)BIDX;
    typedef float sc_row_t[D]; typedef f32x4 red_t[5][16];
    LAS sc_row_t* sc = (LAS sc_row_t*)lds; LAS red_t* red = (LAS red_t*)(lds + 5 * D * 4);
    const int tid = TIDX;
    for (int i = tid; i < 5 * D; i += 512) { const int j = i / D, k = i % D; const float v = j < 4 ? p.c[(size_t)j * D + k] : p.c_ctx[k]; sc[j][k] = siluf_(v); }
    __syncthreads();
    float* mod = WSP(float, OFF_MOD);
    const int cl = tid & 15, kg = tid >> 4;
    for (int unit = widx; unit < (l1 - l0) * (6 * D / 64); unit += nwg) {
        const int l = l0 + unit / (6 * D / 64), n0 = (unit % (6 * D / 64)) * 64;
        f32x4 a[5];
#pragma unroll
        for (int j = 0; j < 5; ++j) a[j] = (f32x4){0.f, 0.f, 0.f, 0.f};
        const float* wp = p.w_mod + (size_t)l * D * 6 * D + n0 + 4 * cl;
        for (int k0 = kg; k0 < D; k0 += 32 * 8) { f32x4 w8[8];
#pragma unroll
            for (int i = 0; i < 8; ++i) w8[i] = *(const f32x4*)(wp + (size_t)(k0 + 32 * i) * 6 * D);
#pragma unroll
            for (int i = 0; i < 8; ++i)
#pragma unroll
                for (int j = 0; j < 5; ++j) a[j] += sc[j][k0 + 32 * i] * w8[i]; }
#pragma unroll
        for (int j = 0; j < 5; ++j) {
#pragma unroll
            for (int e = 0; e < 4; ++e) { float v = a[j][e]; v += shx(v, 16, tid & 63); v += shx(v, 32, tid & 63); a[j][e] = v; }
            if ((tid & 63) < 16) red[tid >> 6][j][cl] = a[j]; }
        __syncthreads();
        if (tid < 5 * 64) { const int j = tid / 64, cc = tid % 64; float s = 0.f;
            for (int g = 0; g < 8; ++g) s += ((const LAS float*)&red[g][j][0])[cc];
            mod[((size_t)l * 5 + j) * 6 * D + n0 + cc] = s + p.b_mod[(size_t)l * 6 * D + n0 + cc]; }
        __syncthreads();
    }
}

template <bool F32> __device__ __forceinline__ void ph_norm(int wv, int l, int which, const float* fixgate, int row_lo, int nrows, const void* hlat, const void* hctx) {
    CParams& p = *okp();
    unsigned char* const wsb = ows(p.ws);
    const int TIDX = otid(wv), BIDX = obid();
    const int lane = TIDX & 63, gw = BIDX * 8 + (TIDX >> 6), NGW = gridDim.x * 8;
    const float* nw = (which ? p.norm2_w : p.norm1_w) + (size_t)l * D;
    const float* mod = WSP(float, OFF_MOD) + (size_t)l * 5 * 6 * D;
    bf16_t* H = WSP(bf16_t, OFF_H); bf16_t* XN = WSP(bf16_t, OFF_XN); const float* SL = WSP(float, OFF_SLAB);
    for (int r = row_lo + gw; r < nrows; r += NGW) {
        int mj, t, T; rowinfo(r, mj, t, T);
        const unsigned so = (unsigned)(mj * 6 * D + (which ? 3 : 0) * D) * 4u;
        const unsigned ho = (unsigned)(r * D + 4 * lane) * 2u;
        const void* rd = r < RL ? hlat : hctx; const unsigned re = (unsigned)((r < RL ? r : r - RL) * D + 4 * lane);
        f32x4 v[8]; float ss = 0.f;
        if constexpr (F32) {
#pragma unroll
            for (int j = 0; j < 8; ++j) v[j] = gld<f32x4>(rd, re * 4u + (unsigned)j * 1024u);
        } else { u32x2 q[8];
#pragma unroll
            for (int j = 0; j < 8; ++j) q[j] = gld<u32x2>(rd, re * 2u + (unsigned)j * 512u);
#pragma unroll
            for (int j = 0; j < 8; ++j) { v[j][0] = __uint_as_float(q[j].x << 16); v[j][1] = __uint_as_float(q[j].x & 0xffff0000u); v[j][2] = __uint_as_float(q[j].y << 16); v[j][3] = __uint_as_float(q[j].y & 0xffff0000u); } }
#pragma unroll
        for (int j = 0; j < 8; ++j) ss += (v[j][0] * v[j][0] + v[j][1] * v[j][1]) + (v[j][2] * v[j][2] + v[j][3] * v[j][3]);
        const float rstd = rsqrtf(wave_sum(ss, lane) * (1.f / D) + EPS);
#pragma unroll
        for (int jh = 0; jh < 2; ++jh) { f32x4 wq[4], scq[4], shq[4];
#pragma unroll
          for (int jj = 0; jj < 4; ++jj) { const unsigned co = (unsigned)(4 * (lane + 64 * (4 * jh + jj))) * 4u; wq[jj] = gld<f32x4>(nw, co); scq[jj] = gld<f32x4>(mod, so + D * 4 + co); shq[jj] = gld<f32x4>(mod, so + co); }
#pragma unroll
          for (int jj = 0; jj < 4; ++jj) { const int j = 4 * jh + jj;
            const f32x4 y = (v[j] * rstd * wq[jj]) * (1.f + scq[jj]) + shq[jj];
            u32x2 q; q.x = pk2(y[0], y[1]); q.y = pk2(y[2], y[3]); gst<u32x2>(XN, (unsigned)(r * D + 4 * (lane + 64 * j)) * 2u, q); } }
    }
}
template <bool F32> __device__ __forceinline__ void ph_norm_ctx(int wv, LAS unsigned char* lds, int l, int which) {
    CParams& p = *okp();
    unsigned char* const wsb = ows(p.ws);
    const int TIDX = otid(wv), lane = TIDX & 63, wave = wv, half = wave & 1;
    const float* nw = (which ? p.norm2_w : p.norm1_w) + (size_t)l * D;
    const float* mod = WSP(float, OFF_MOD) + (size_t)l * 5 * 6 * D;
    bf16_t* H = WSP(bf16_t, OFF_H); bf16_t* XN = WSP(bf16_t, OFF_XN); const float* SL = WSP(float, OFF_SLAB);
    const void* hctx = F32 ? (const void*)p.ctx : (const void*)(H + (size_t)RL * D);
    const float* fixgate = which ? mod + 4 * 6 * D + 2 * D : mod - 5 * 6 * D + 4 * 6 * D + 5 * D;
    LAS float* red = (LAS float*)lds;
    const unsigned so = (unsigned)(4 * 6 * D + (which ? 3 : 0) * D) * 4u;
    for (int rb = obid(); rb < RC / 4; rb += gridDim.x) {
        const int rc = 4 * rb + (wave >> 1), r = RL + rc;
        f32x4 v[4]; float ss = 0.f;
#pragma unroll
        for (int jp = 0; jp < 2; ++jp) { f32x4 sp[2][8], fg[2]; u32x2 q[2];
#pragma unroll
            for (int jj = 0; jj < 2; ++jj) { const int j = 4 * half + 2 * jp + jj; const unsigned e = (unsigned)(rc * D + 4 * lane + 256 * j);
                if constexpr (F32) v[2 * jp + jj] = gld<f32x4>(hctx, e * 4u); else q[jj] = gld<u32x2>(hctx, e * 2u);
#pragma unroll
                for (int sl = 0; sl < 8; ++sl) sp[jj][sl] = gld<f32x4>(SL, ((unsigned)(sl * RC) * D + e) * 4u);
                fg[jj] = gld<f32x4>(fixgate, (unsigned)(4 * lane + 256 * j) * 4u); }
#pragma unroll
            for (int jj = 0; jj < 2; ++jj) { const int j = 4 * half + 2 * jp + jj; f32x4& vv = v[2 * jp + jj];
                if constexpr (!F32) { vv[0] = __uint_as_float(q[jj].x << 16); vv[1] = __uint_as_float(q[jj].x & 0xffff0000u); vv[2] = __uint_as_float(q[jj].y << 16); vv[3] = __uint_as_float(q[jj].y & 0xffff0000u); }
                f32x4 a = sp[jj][0];
#pragma unroll
                for (int sl = 1; sl < 8; ++sl) a += sp[jj][sl];
                vv += fg[jj] * a;
                u32x2 hq; hq.x = pk2(vv[0], vv[1]); hq.y = pk2(vv[2], vv[3]); gst<u32x2>(H, (unsigned)(r * D + 4 * lane + 256 * j) * 2u, hq);
                ss += (vv[0] * vv[0] + vv[1] * vv[1]) + (vv[2] * vv[2] + vv[3] * vv[3]); } }
        f32x4 wq[4], scq[4], shq[4];
#pragma unroll
        for (int jj = 0; jj < 4; ++jj) { const unsigned co = (unsigned)(4 * lane + 256 * (4 * half + jj)) * 4u; wq[jj] = gld<f32x4>(nw, co); scq[jj] = gld<f32x4>(mod, so + D * 4 + co); shq[jj] = gld<f32x4>(mod, so + co); }
        ss = wave_sum(ss, lane);
        if (lane == 0) red[wave] = ss;
        __syncthreads();
        const float rstd = rsqrtf((red[wave & ~1] + red[wave | 1]) * (1.f / D) + EPS);
#pragma unroll
        for (int jj = 0; jj < 4; ++jj) { const int j = 4 * half + jj;
            const f32x4 y = (v[jj] * rstd * wq[jj]) * (1.f + scq[jj]) + shq[jj];
            u32x2 qq; qq.x = pk2(y[0], y[1]); qq.y = pk2(y[2], y[3]); gst<u32x2>(XN, (unsigned)(r * D + 4 * lane + 256 * j) * 2u, qq); }
        __syncthreads();
    }
}
__device__ __forceinline__ void ph_final(int wv) {
    CParams& p = *okp();
    unsigned char* const wsb = ows(p.ws);
    const int TIDX = otid(wv), BIDX = obid(); (void)TIDX; (void)BIDX;
    const int lane = TIDX & 63, gw = BIDX * 8 + (TIDX >> 6), NGW = gridDim.x * 8;
    const bf16_t* H = WSP(bf16_t, OFF_H);
    for (int r = gw; r < RL; r += NGW) {
        f32x4 v[8]; float ss = 0.f;
#pragma unroll
        for (int j = 0; j < 8; ++j) { const u32x2 q = gld<u32x2>(H, (unsigned)(r * D + 4 * (lane + 64 * j)) * 2u); v[j][0] = __uint_as_float(q.x << 16); v[j][1] = __uint_as_float(q.x & 0xffff0000u); v[j][2] = __uint_as_float(q.y << 16); v[j][3] = __uint_as_float(q.y & 0xffff0000u); ss += (v[j][0] * v[j][0] + v[j][1] * v[j][1]) + (v[j][2] * v[j][2] + v[j][3] * v[j][3]); }
        const float rstd = rsqrtf(wave_sum(ss, lane) * (1.f / D) + EPS);
        f32x4* o = (f32x4*)(p.out + (size_t)r * D) + lane;
#pragma unroll
        for (int j = 0; j < 8; ++j) { const f32x4 w = *(const f32x4*)(p.final_norm_w + 4 * (lane + 64 * j)); o[64 * j] = v[j] * rstd * w; }
    }
}

__device__ __forceinline__ float wave_incl_sum(float v, int lane) {
#pragma unroll
    for (int o = 1; o < 64; o <<= 1) { const float t = shl_(v, lane >= o ? lane - o : lane); if (lane >= o) v += t; }
    return v;
}
__device__ __forceinline__ float wave_incl_max(float v, int lane) {
#pragma unroll
    for (int o = 1; o < 64; o <<= 1) { const float t = shl_(v, lane >= o ? lane - o : lane); if (lane >= o) v = fmaxf(v, t); }
    return v;
}
__device__ __forceinline__ float logsigmoidf_(float x) { return fminf(x, 0.f) - log1pf(__expf(-fabsf(x))); }
struct GateV { float b0, b1, c0, c1, m0, m1, bend, cend; int s0, s1; };
__device__ __forceinline__ GateV gate_vectors(const float* G, int row0, int h, int dir, int lane) {
    GateV g; g.s0 = dir ? 127 - lane : lane; g.s1 = dir ? 63 - lane : lane + 64;
    const unsigned o0 = (unsigned)((row0 + g.s0) * 16 + dir * 8 + h) * 4u, o1 = (unsigned)((row0 + g.s1) * 16 + dir * 8 + h) * 4u;
    const float i0 = gld<float>(G, o0), f0 = gld<float>(G, o0 + 16), i1 = gld<float>(G, o1), f1 = gld<float>(G, o1 + 16);
    g.b0 = wave_incl_sum(logsigmoidf_(f0), lane); const float tot0 = shl_(g.b0, 63 + (lane & 0));
    g.b1 = wave_incl_sum(logsigmoidf_(f1), lane) + tot0;
    g.c0 = i0 - g.b0; g.c1 = i1 - g.b1;
    g.m0 = wave_incl_max(g.c0, lane); const float mx0 = shl_(g.m0, 63 + (lane & 0));
    g.m1 = fmaxf(wave_incl_max(g.c1, lane), mx0);
    g.bend = shl_(g.b1, 63 + (lane & 0)); g.cend = shl_(g.m1, 63 + (lane & 0));
    return g;
}
__device__ __forceinline__ void ph_convc(int wv, int l, int nrows, int widx, int nwg) {
    CParams& p = *okp();
    unsigned char* const wsb = ows(p.ws);
    const unsigned gt = (unsigned)widx * 512u + otid(wv), NT = (unsigned)nwg * 512u;
    const bf16_t* P = WSP(bf16_t, OFF_P); bf16_t* YC = WSP(bf16_t, OFF_HM) + (DM + DF);
    const float* wc = p.conv_c_w + (size_t)l * 3 * DC;
    for (unsigned i = gt; i < (unsigned)nrows * 64u; i += NT) {
        const int r = (int)(i >> 6), c = (int)(i & 63) * 8; int mj, t, T; rowinfo(r, mj, t, T);
        const unsigned pr = (unsigned)(r * NP) * 2u;
        const bool cp = r < RL ? (t & 63) > 0 : t > 0, cn = r < RL ? (t & 63) < 63 : t < T - 1;
        float x0[8], x1[8], y0[8], y1[8], z0[8], z1[8], cb[8], o[8];
        unpack8(gld<u32x4>(P, pr + (PCC + c) * 2), x0); unpack8(gld<u32x4>(P, pr + (PCX + c) * 2), x1); unpack8(gld<u32x4>(P, pr + (PCB + c) * 2), cb);
        const unsigned pp = cp ? pr - NP * 2 : pr, pn = cn ? pr + NP * 2 : pr;
        unpack8(gld<u32x4>(P, pp + (PCC + c) * 2), y0); unpack8(gld<u32x4>(P, pp + (PCX + c) * 2), y1);
        unpack8(gld<u32x4>(P, pn + (PCC + c) * 2), z0); unpack8(gld<u32x4>(P, pn + (PCX + c) * 2), z1);
        const f32x4 w00 = gld<f32x4>(wc, (unsigned)c * 4u), w01 = gld<f32x4>(wc, (unsigned)c * 4u + 16), w10 = gld<f32x4>(wc, (unsigned)(DC + c) * 4u), w11 = gld<f32x4>(wc, (unsigned)(DC + c) * 4u + 16),
                    w20 = gld<f32x4>(wc, (unsigned)(2 * DC + c) * 4u), w21 = gld<f32x4>(wc, (unsigned)(2 * DC + c) * 4u + 16);
#pragma unroll
        for (int j = 0; j < 8; ++j) { const float w0 = j < 4 ? w00[j & 3] : w01[j & 3], w1 = j < 4 ? w10[j & 3] : w11[j & 3], w2 = j < 4 ? w20[j & 3] : w21[j & 3];
            float v = w1 * (x0[j] * x1[j]); if (cp) v += w0 * (y0[j] * y1[j]); if (cn) v += w2 * (z0[j] * z1[j]); o[j] = cb[j] * v; }
        gst<u32x4>(YC, (unsigned)(r * D + c) * 2u, pack8(o));
    }
}
__device__ __forceinline__ void ph_fourier1(int wv, int widx, int nwg) {
    CParams& p = *okp();
    unsigned char* const wsb = ows(p.ws);
    const int TIDX = otid(wv), BIDX = obid(); (void)TIDX; (void)BIDX;
    const int lane = TIDX & 63, gw = widx * 8 + (TIDX >> 6), NGW = nwg * 8, fr = lane & 15, fq = lane >> 4;
    const bf16_t* P = WSP(bf16_t, OFF_P); const bf16_t* FT = WSP(bf16_t, OFF_FT);
    bf16_t* ZTC = WSP(bf16_t, OFF_ZTC);
    for (int task = gw; task < (RC / 32) * 4 * 8; task += NGW) {
        const int kb = task & 7, g = (task >> 3) & 3, rb = task >> 5, r0 = RL + rb * 32;
        f32x4 acc[2][2]; ZERO_ACC22(acc);
        wave_mm32<true, true>(P + (size_t)r0 * NP + PF + g * 128, NP, 1, FT + (size_t)(kb * 32) * 128, 1, 128, 128, acc, lane);
#pragma unroll
        for (int mi = 0; mi < 2; ++mi)
#pragma unroll
            for (int ni = 0; ni < 2; ++ni) {
                const int r = r0 + 16 * mi + 4 * fq, kp = kb * 32 + 16 * ni + fr, comp = kp >> 7, kap = kp & 127;
                u32x2 w; w.x = pk2(acc[mi][ni][0], acc[mi][ni][1]); w.y = pk2(acc[mi][ni][2], acc[mi][ni][3]);
                { const int q = r - RL, b = q >> 8, t = q & 255; *(u32x2*)(ZTC + (size_t)((b * 4 + g) * 128 + kap) * 512 + comp * 256 + t) = w; }
            }
    }
}
template <bool FIRST> __device__ __forceinline__ f32x4 mma16(bf16x8 a, bf16x8 b, f32x4 c) {
    if constexpr (FIRST) return __builtin_amdgcn_mfma_f32_16x16x32_bf16(a, b, (f32x4){0.f, 0.f, 0.f, 0.f}, 0, 0, 0);
    else return __builtin_amdgcn_mfma_f32_16x16x32_bf16(a, b, c, 0, 0, 0);
}
typedef short s16x4 __attribute__((ext_vector_type(4)));
constexpr int PIT_T = 544;
constexpr int PIT_R = 528;
constexpr int PIT_P = 272;
__device__ __forceinline__ bf16x8 tr_frag(LAS unsigned char* img, int pitchB, int r0, int c0, int lane) {
    const int g = lane >> 4, q = (lane & 15) >> 2, pp = lane & 3;
    LAS unsigned char* a = img + (r0 + 8 * g + q) * pitchB + (c0 + 4 * pp) * 2;
    const s16x4 lo = __builtin_amdgcn_ds_read_tr16_b64_v4i16((LAS s16x4*)a);
    const s16x4 hi = __builtin_amdgcn_ds_read_tr16_b64_v4i16((LAS s16x4*)(a + 4 * pitchB));
    return (bf16x8){lo[0], lo[1], lo[2], lo[3], hi[0], hi[1], hi[2], hi[3]};
}
template <class F> __device__ __forceinline__ void conv_silu_rows(const u32x4 (&raw)[10], const float (&w0)[8], const float (&w1)[8], const float (&w2)[8], F&& f) {
    float a[8], b[8], c[8];
    unpack8(raw[0], a); unpack8(raw[1], b);
#pragma unroll
    for (int i = 0; i < 8; ++i) {
        unpack8(raw[i + 2], c);
        float o[8];
#pragma unroll
        for (int j = 0; j < 8; ++j) o[j] = siluf_(w0[j] * a[j] + w1[j] * b[j] + w2[j] * c[j]);
        f(i, o);
#pragma unroll
        for (int j = 0; j < 8; ++j) { a[j] = b[j]; b[j] = c[j]; }
    }
}
constexpr int FPIT = 2336;
__device__ __forceinline__ void ph_fft(int wv, LAS unsigned char* lds, int u0, int ustride) {
    CParams& p = *okp();
    unsigned char* const wsb = ows(p.ws);
    const bf16_t* P = WSP(bf16_t, OFF_P); const bf16_t* FT = WSP(bf16_t, OFF_FT); const bf16_t* MA = WSP(bf16_t, OFF_MA); const bf16_t* MC = WSP(bf16_t, OFF_MC); bf16_t* HM = WSP(bf16_t, OFF_HM);
    LAS unsigned char* IMG = lds;
    const int wave = wv;
    for (int unit = u0; unit < NB * 4 * 8; unit += ustride) {
        const int kb = unit & 7, g = (unit >> 3) & 3, b = unit >> 5, kap0 = 16 * kb;
        {
            const int tid = otid(wv), lane = tid & 63, fr = lane & 15, fq = lane >> 4;
            bf16x8 fb[2][4];
#pragma unroll
            for (int ni = 0; ni < 2; ++ni)
#pragma unroll
                for (int ks = 0; ks < 4; ++ks) fb[ni][ks] = gld<bf16x8>(FT, (unsigned)((ni * 128 + kap0 + fr) * 128 + 32 * ks + 8 * fq) * 2u);
#pragma unroll 1
            for (int mi8 = 0; mi8 < 2; ++mi8) {
                bf16x8 xa[8][4];
#pragma unroll
                for (int m = 0; m < 8; ++m)
#pragma unroll
                    for (int ks = 0; ks < 4; ++ks) xa[m][ks] = gld<bf16x8>(P, (unsigned)((b * 2048 + 256 * wave + 16 * (8 * mi8 + m) + fr) * NP + PF + g * 128 + 32 * ks + 8 * fq) * 2u);
#pragma unroll
                for (int m = 0; m < 8; ++m) {
                    f32x4 zr = mma16<true>(xa[m][0], fb[0][0], zr), zi = mma16<true>(xa[m][0], fb[1][0], zi);
#pragma unroll
                    for (int ks = 1; ks < 4; ++ks) { zr = mma16<false>(xa[m][ks], fb[0][ks], zr); zi = mma16<false>(xa[m][ks], fb[1][ks], zi); }
                    const int tb = 256 * wave + 16 * (8 * mi8 + m) + 4 * fq, t1 = tb >> 6, t2 = tb & 63;
                    u32x2 wr_, wi_; wr_.x = pk2(zr[0], zr[1]); wr_.y = pk2(zr[2], zr[3]); wi_.x = pk2(-zi[0], -zi[1]); wi_.y = pk2(-zi[2], -zi[3]);
                    *(LAS u32x2*)(IMG + t1 * FPIT + fr * 144 + t2 * 2) = wr_;
                    *(LAS u32x2*)(IMG + (32 + t1) * FPIT + fr * 144 + t2 * 2) = wi_;
                }
            }
        }
        __syncthreads();
        {
            const int tid = otid(wv), lane = tid & 63, fr = lane & 15, fq = lane >> 4;
            bf16x8 ya[4][2];
#pragma unroll
            for (int mt = 0; mt < 4; ++mt)
#pragma unroll
                for (int ks = 0; ks < 2; ++ks) ya[mt][ks] = gld<bf16x8>(MA, (unsigned)((16 * mt + fr) * 64 + 32 * ks + 8 * fq) * 2u);
#pragma unroll 2
            for (int j = 0; j < 8; ++j) {
                const int grp = 8 * wave + j, c0 = (grp >> 2) * 72 + (grp & 3) * 16;
                const bf16x8 x0 = tr_frag(IMG, FPIT, 0, c0, lane), x1 = tr_frag(IMG, FPIT, 32, c0, lane);
                f32x4 d[4];
#pragma unroll
                for (int mt = 0; mt < 4; ++mt) { d[mt] = mma16<true>(x0, ya[mt][0], d[mt]); d[mt] = mma16<false>(x1, ya[mt][1], d[mt]); }
#pragma unroll
                for (int mt = 0; mt < 4; ++mt) { u32x2 w; w.x = pk2(d[mt][0], d[mt][1]); w.y = pk2(d[mt][2], d[mt][3]);
                    *(LAS u32x2*)(IMG + (16 * mt + fr) * FPIT + (c0 + 4 * fq) * 2) = w; }
            }
        }
        __syncthreads();
        {
            const int tid = otid(wv), lane = tid & 63, fr = lane & 15, fq = lane >> 4;
            bf16x8 y[4][4];
#pragma unroll
            for (int mt = 0; mt < 4; ++mt)
#pragma unroll
                for (int ks = 0; ks < 4; ++ks) y[mt][ks] = gld<bf16x8>(MC, (unsigned)((4 * wave * 64 + 16 * mt + fr) * 128 + 32 * ks + 8 * fq) * 2u);
#pragma unroll 1
            for (int q = 0; q < 4; ++q) {
                const int tau1 = 4 * wave + q, tn = q < 3 ? tau1 + 1 : tau1;
                bf16x8 yn[4][4];
#pragma unroll
                for (int mt = 0; mt < 4; ++mt)
#pragma unroll
                    for (int ks = 0; ks < 4; ++ks) yn[mt][ks] = gld<bf16x8>(MC, (unsigned)((tn * 64 + 16 * mt + fr) * 128 + 32 * ks + 8 * fq) * 2u);
                f32x4 acc[4];
#pragma unroll
                for (int ks = 0; ks < 4; ++ks) { const bf16x8 x = *(const LAS bf16x8*)(IMG + ((ks >> 1) * 32 + tau1) * FPIT + fr * 144 + (32 * (ks & 1) + 8 * fq) * 2);
#pragma unroll
                    for (int mt = 0; mt < 4; ++mt) { if (ks == 0) acc[mt] = mma16<true>(x, y[mt][ks], acc[mt]); else acc[mt] = mma16<false>(x, y[mt][ks], acc[mt]); } }
#pragma unroll
                for (int mt = 0; mt < 4; ++mt) { const int tau = tau1 + 32 * (16 * mt + fr);
                    u32x2 w; w.x = pk2(acc[mt][0], acc[mt][1]); w.y = pk2(acc[mt][2], acc[mt][3]);
                    gst<u32x2>(HM, (unsigned)((b * 2048 + tau) * D + DM + g * 128 + kap0 + 4 * fq) * 2u, w); }
#pragma unroll
                for (int mt = 0; mt < 4; ++mt)
#pragma unroll
                    for (int ks = 0; ks < 4; ++ks) y[mt][ks] = yn[mt][ks];
            }
        }
        __syncthreads();
    }
}
__device__ __forceinline__ void ph_mlstm1(int wv, int l, LAS unsigned char* lds) {
    CParams& p = *okp();
    unsigned char* const wsb = ows(p.ws);
    const int wave = wv;
    LAS unsigned char* KWs = lds; LAS unsigned char* Vs = lds + 128 * PIT_T; LAS float* vW = (LAS float*)(lds + 2 * 128 * PIT_T);
    const bf16_t* P = WSP(bf16_t, OFF_P); const float* G = WSP(float, OFF_G);
    bf16_t* UT = WSP(bf16_t, OFF_UT); float* NV = WSP(float, OFF_NV); float* CHS = WSP(float, OFF_CHS);
    const float* wk = p.conv_k_w + (size_t)l * 3 * DM;
    for (int unit = obid(); unit < NCHUNK * NH * 2; unit += gridDim.x) {
        const int tid = otid(wv), lane = tid & 63, fr = lane & 15, fq = lane >> 4, dg = tid & 31, sg = tid >> 5;
        const int dir = unit & 1, h = (unit >> 1) & 3, cidx = unit >> 3, row0 = chunk_row0(cidx);
        const bool first = cidx < 64 ? (cidx & 15) == 0 : ((cidx - 64) & 1) == 0, last = cidx < 64 ? (cidx & 15) == 15 : ((cidx - 64) & 1) == 1;
        const bf16_t* kp = P + (size_t)(row0 + 8 * sg) * NP + PK + h * DH + 8 * dg;
        u32x4 kr[10], vr[8];
#pragma unroll
        for (int i = 0; i < 10; ++i) { const int s = 8 * sg - 1 + i; const bool ok = (s >= 0 || !first) && (s < CHUNK || !last);
            kr[i] = ok ? *(const u32x4*)(kp + (ptrdiff_t)(i - 1) * NP) : (u32x4){0u, 0u, 0u, 0u}; }
#pragma unroll
        for (int i = 0; i < 8; ++i) vr[i] = *(const u32x4*)(kp + (PV - PK) + (size_t)i * NP);
        float w0[8], w1[8], w2[8];
#pragma unroll
        for (int j = 0; j < 8; ++j) { w0[j] = wk[h * DH + 8 * dg + j]; w1[j] = wk[DM + h * DH + 8 * dg + j]; w2[j] = wk[2 * DM + h * DH + 8 * dg + j]; }
        if (wave == 0)     { const GateV g = gate_vectors(G, row0, h, dir, lane); vW[g.s0] = __expf(g.c0 - g.cend); vW[g.s1] = __expf(g.c1 - g.cend);
            if (lane == 0) { CHS[(size_t)(cidx * 8 + dir * 4 + h) * 2] = g.bend; CHS[(size_t)(cidx * 8 + dir * 4 + h) * 2 + 1] = g.bend + g.cend; } }
        __syncthreads();
        conv_silu_rows(kr, w0, w1, w2, [&](int i, float (&o)[8]) { const float ws = vW[8 * sg + i];
#pragma unroll
            for (int j = 0; j < 8; ++j) o[j] *= ws;
            *(LAS u32x4*)(KWs + (8 * sg + i) * PIT_T + dg * 16) = pack8(o); });
#pragma unroll
        for (int i = 0; i < 8; ++i) *(LAS u32x4*)(Vs + (8 * sg + i) * PIT_T + dg * 16) = vr[i];
        __syncthreads();
        f32x4 acc[2][16];
        auto kstep1 = [&](int k0, auto first) {
            bf16x8 fv[2];
#pragma unroll
            for (int mi = 0; mi < 2; ++mi) fv[mi] = tr_frag(Vs, PIT_T, k0, 32 * wave + 16 * mi, lane);
#pragma unroll
            for (int ni = 0; ni < 16; ++ni) { const bf16x8 fk = tr_frag(KWs, PIT_T, k0, 16 * ni, lane);
#pragma unroll
                for (int mi = 0; mi < 2; ++mi) acc[mi][ni] = mma16<decltype(first)::value>(fk, fv[mi], acc[mi][ni]); }
        };
        kstep1(0, std::true_type{});
#pragma unroll 1
        for (int k0 = 32; k0 < CHUNK; k0 += 32) kstep1(k0, std::false_type{});
        bf16_t* out = UT + ((size_t)(cidx * NH + h) * 2 + dir) * DH * DH;
#pragma unroll
        for (int mi = 0; mi < 2; ++mi)
#pragma unroll
            for (int ni = 0; ni < 16; ++ni) { u32x2 w; w.x = pk2(acc[mi][ni][0], acc[mi][ni][1]); w.y = pk2(acc[mi][ni][2], acc[mi][ni][3]);
                *(u32x2*)(out + (size_t)(32 * wave + 16 * mi + fr) * DH + 16 * ni + 4 * fq) = w; }
        if (tid < DH) { float sum = 0.f;
#pragma unroll 8
            for (int s2 = 0; s2 < CHUNK; ++s2) sum += bf2f(*(const LAS bf16_t*)(KWs + s2 * PIT_T + tid * 2));
            NV[((size_t)(cidx * NH + h) * 2 + dir) * DH + tid] = sum; }
        __syncthreads();
    }
}
__device__ __forceinline__ void ph_mlstm2(int wv) {
    CParams& p = *okp();
    unsigned char* const wsb = ows(p.ws);
    const int tid = otid(wv);
    const bf16_t* UT = WSP(bf16_t, OFF_UT); bf16_t* CT = WSP(bf16_t, OFF_CT);
    const float *NV = WSP(float, OFF_NV), *CHS = WSP(float, OFF_CHS); float *NS = WSP(float, OFF_NS), *MST = WSP(float, OFF_MST);
    for (int task = obid(); task < NB * NH * 2 * 16; task += gridDim.x) {
        const int part = task & 15, scan = task >> 4, dir = scan & 1, h = (scan >> 1) & 3, b = scan >> 3, dh = dir * 4 + h;
        const unsigned e0 = (unsigned)(part * 4096 + olaunder(tid) * 8) * 2u;
        u32x4 u[18];
#pragma unroll
        for (int step = 0; step < 18; ++step) { const int cidx = scan_chunk(b, dir, step); u[step] = gld<u32x4>(UT, (unsigned)(((cidx * NH + h) * 2 + dir) * DH * DH) * 2u + e0); }
        float cb[18], cm[18];
#pragma unroll
        for (int step = 0; step < 18; ++step) { const int cidx = scan_chunk(b, dir, step); const f32x2 cc = gld<f32x2>(CHS, (unsigned)((cidx * 8 + dh) * 2) * 4u); cb[step] = cc[0]; cm[step] = cc[1]; }
        float C[8], m = 0.f;
        { const f32x4 z0 = zero4(), z1 = zero4();
#pragma unroll
          for (int j = 0; j < 4; ++j) { C[j] = z0[j]; C[4 + j] = z1[j]; } }
#pragma unroll
        for (int step = 0; step < 18; ++step) {
            const int cidx = scan_chunk(b, dir, step);
            gst<u32x4>(CT, (unsigned)(((cidx * NH + h) * 2 + dir) * DH * DH) * 2u + e0, pack8(C));
            const float bend = cb[step], mloc = cm[step];
            const float mn = fmaxf(bend + m, mloc), al = __expf(bend + m - mn), be = __expf(mloc - mn);
            float uu[8]; unpack8(u[step], uu);
#pragma unroll
            for (int j = 0; j < 8; ++j) C[j] = al * C[j] + be * uu[j];
            m = mn;
        }
        if (part == 0 && tid < DH) {
            float n = 0.f; m = 0.f;
            float nv[18];
#pragma unroll
            for (int step = 0; step < 18; ++step) { const int cidx = scan_chunk(b, dir, step); nv[step] = gld<float>(NV, (unsigned)(((cidx * NH + h) * 2 + dir) * DH + tid) * 4u); }
#pragma unroll
            for (int step = 0; step < 18; ++step) {
                const int cidx = scan_chunk(b, dir, step); const unsigned base = (unsigned)(((cidx * NH + h) * 2 + dir) * DH + tid) * 4u;
                gst<float>(NS, base, n); if (tid == 0) MST[cidx * 8 + dh] = m;
                const float bend = cb[step], mloc = cm[step];
                const float mn = fmaxf(bend + m, mloc), al = __expf(bend + m - mn), be = __expf(mloc - mn);
                n = al * n + be * nv[step]; m = mn;
            }
        }
    }
}
#define SECTION_LANES() const int tid = otid(wv), lane = tid & 63, fr = lane & 15, fq = lane >> 4; (void)fr; (void)fq; __builtin_amdgcn_sched_barrier(0)
__device__ __forceinline__ void ph_mlstm3(int wv, int l, LAS unsigned char* lds, int nunits) {
    CParams& p = *okp();
    unsigned char* const wsb = ows(p.ws);
    const int wave = wv;
    LAS unsigned char* Qs = lds;
    LAS unsigned char* Ks = lds + 128 * PIT_T;
    LAS unsigned char* Vs = Qs; LAS unsigned char* Ps = Ks;
    LAS float* vec = (LAS float*)(lds + 2 * 128 * PIT_T);
    LAS float *vB = vec, *vC = vec + 256, *vM = vec + 512, *nS = vec + 768, *rS = vec + 1280, *ssq = vec + 1536;
    const bf16_t* P = WSP(bf16_t, OFF_P); const float* G = WSP(float, OFF_G); const bf16_t* CT = WSP(bf16_t, OFF_CT);
    const float *NS = WSP(float, OFF_NS), *MST = WSP(float, OFF_MST); bf16_t* HM = WSP(bf16_t, OFF_HM);
    const float *wk = p.conv_k_w + (size_t)l * 3 * DM, *wq = p.conv_q_w + (size_t)l * 3 * DM, *nw = p.mlstm_norm_w + (size_t)l * DM;
    for (int unit = obid(); unit < nunits; unit += gridDim.x) {
        const int h = unit & 3, cidx = unit >> 2, row0 = chunk_row0(cidx);
        const bool first = cidx < 64 ? (cidx & 15) == 0 : ((cidx - 64) & 1) == 0, last = cidx < 64 ? (cidx & 15) == 15 : ((cidx - 64) & 1) == 1;
        {
            SECTION_LANES(); const int dg = tid & 31, sg = tid >> 5;
            nS[tid] = gld<float>(NS, (unsigned)((cidx * NH + h) * 2 * DH + tid) * 4u);
            const unsigned kp = (unsigned)((row0 + 8 * sg - 1) * NP + PK + h * DH + 8 * dg) * 2u;
            u32x4 raw[10], rawq[10]; float w0[8], w1[8], w2[8];
#pragma unroll
            for (int i = 0; i < 10; ++i) { const int s = 8 * sg - 1 + i; const bool ok = (s >= 0 || !first) && (s < CHUNK || !last);
                raw[i] = gld<u32x4>(P, ok ? kp + (unsigned)i * (NP * 2) : kp + (unsigned)(NP * 2)); if (!ok) raw[i] = (u32x4){0u, 0u, 0u, 0u}; }
#pragma unroll
            for (int i = 0; i < 10; ++i) { const int s = 8 * sg - 1 + i; const bool ok = (s >= 0 || !first) && (s < CHUNK || !last);
                rawq[i] = gld<u32x4>(P, (ok ? kp + (unsigned)i * (NP * 2) : kp + (unsigned)(NP * 2)) + (PQ - PK) * 2); if (!ok) rawq[i] = (u32x4){0u, 0u, 0u, 0u}; }
            { const unsigned wo = (unsigned)(h * DH + 8 * dg) * 4u;
              const f32x4 a0 = gld<f32x4>(wk, wo), a1 = gld<f32x4>(wk, wo + 16), b0 = gld<f32x4>(wk, wo + DM * 4), b1 = gld<f32x4>(wk, wo + DM * 4 + 16), c0 = gld<f32x4>(wk, wo + 2 * DM * 4), c1 = gld<f32x4>(wk, wo + 2 * DM * 4 + 16);
#pragma unroll
              for (int j = 0; j < 4; ++j) { w0[j] = a0[j]; w0[4 + j] = a1[j]; w1[j] = b0[j]; w1[4 + j] = b1[j]; w2[j] = c0[j]; w2[4 + j] = c1[j]; } }
            if (wave < 2) { const GateV g = gate_vectors(G, row0, h, wave, lane);
                vB[wave * 128 + g.s0] = g.b0; vB[wave * 128 + g.s1] = g.b1; vC[wave * 128 + g.s0] = g.c0; vC[wave * 128 + g.s1] = g.c1; vM[wave * 128 + g.s0] = g.m0; vM[wave * 128 + g.s1] = g.m1; }
            conv_silu_rows(raw, w0, w1, w2, [&](int i, float (&o)[8]) { *(LAS u32x4*)(Ks + (8 * sg + i) * PIT_R + dg * 16) = pack8(o); });
            { const unsigned wo = (unsigned)(h * DH + 8 * dg) * 4u;
              const f32x4 a0 = gld<f32x4>(wq, wo), a1 = gld<f32x4>(wq, wo + 16), b0 = gld<f32x4>(wq, wo + DM * 4), b1 = gld<f32x4>(wq, wo + DM * 4 + 16), c0 = gld<f32x4>(wq, wo + 2 * DM * 4), c1 = gld<f32x4>(wq, wo + 2 * DM * 4 + 16);
#pragma unroll
              for (int j = 0; j < 4; ++j) { w0[j] = a0[j]; w0[4 + j] = a1[j]; w1[j] = b0[j]; w1[4 + j] = b1[j]; w2[j] = c0[j]; w2[4 + j] = c1[j]; } }
            conv_silu_rows(rawq, w0, w1, w2, [&](int i, float (&o)[8]) {
#pragma unroll
                for (int j = 0; j < 8; ++j) o[j] *= 0.0625f;
                *(LAS u32x4*)(Qs + (8 * sg + i) * PIT_R + dg * 16) = pack8(o); });
        }
        __syncthreads();
        {
            SECTION_LANES();
            f32x4 sacc[8];
            auto kstepS = [&](int k0, auto first) {
                const bf16x8 yq = *(const LAS bf16x8*)(Qs + (16 * wave + fr) * PIT_R + (k0 + 8 * fq) * 2);
#pragma unroll
                for (int ni = 0; ni < 8; ++ni) { const bf16x8 xk = *(const LAS bf16x8*)(Ks + (16 * ni + fr) * PIT_R + (k0 + 8 * fq) * 2);
                    sacc[ni] = mma16<decltype(first)::value>(xk, yq, sacc[ni]); }
            };
            kstepS(0, std::true_type{});
#pragma unroll 1
            for (int k0 = 32; k0 < DH; k0 += 32) kstepS(k0, std::false_type{});
            const int t = 16 * wave + fr;
            const float mF = gld<float>(MST, (unsigned)(cidx * 8 + h) * 4u), mB = gld<float>(MST, (unsigned)(cidx * 8 + 4 + h) * 4u);
            const float MF = fmaxf(mF, vM[t]), MB = fmaxf(mB, vM[128 + t]);
            const float gF = __expf(mF - MF), gB = __expf(mB - MB);
            const float flF = __expf(-(vB[t] + MF)), flB = __expf(-(vB[128 + t] + MB));
            float qnF = 0.f, qnB = 0.f;
#pragma unroll
            for (int c8 = 0; c8 < 8; ++c8) { float q8[8]; unpack8(*(const LAS u32x4*)(Qs + t * PIT_R + (64 * fq + 8 * c8) * 2), q8);
                const f32x4 a0 = *(const LAS f32x4*)(nS + 64 * fq + 8 * c8), a1 = *(const LAS f32x4*)(nS + 64 * fq + 8 * c8 + 4);
                const f32x4 b0 = *(const LAS f32x4*)(nS + 256 + 64 * fq + 8 * c8), b1 = *(const LAS f32x4*)(nS + 256 + 64 * fq + 8 * c8 + 4);
#pragma unroll
                for (int j = 0; j < 4; ++j) { qnF += q8[j] * a0[j] + q8[4 + j] * a1[j]; qnB += q8[j] * b0[j] + q8[4 + j] * b1[j]; } }
            qnF += shx(qnF, 16, lane); qnF += shx(qnF, 32, lane); qnB += shx(qnB, 16, lane); qnB += shx(qnB, 32, lane);
            float sF = 0.f, sB = 0.f;
#pragma unroll
            for (int ni = 0; ni < 8; ++ni) { const f32x4 cF = *(const LAS f32x4*)(vC + 16 * ni + 4 * fq), cB = *(const LAS f32x4*)(vC + 128 + 16 * ni + 4 * fq);
#pragma unroll
                for (int rg = 0; rg < 4; ++rg) { const int s = 16 * ni + 4 * fq + rg;
                    sF += s <= t ? sacc[ni][rg] * __expf(cF[rg] - MF) : 0.f; sB += s >= t ? sacc[ni][rg] * __expf(cB[rg] - MB) : 0.f; }
                asm volatile("" : "+v"(sF), "+v"(sB)); }
            sF += shx(sF, 16, lane); sF += shx(sF, 32, lane); sB += shx(sB, 16, lane); sB += shx(sB, 32, lane);
            const float iF = 1.f / fmaxf(fabsf(gF * qnF + sF), flF), iB = 1.f / fmaxf(fabsf(gB * qnB + sB), flB);
            __syncthreads();
#pragma unroll
            for (int ni = 0; ni < 8; ++ni) { const f32x4 cF = *(const LAS f32x4*)(vC + 16 * ni + 4 * fq), cB = *(const LAS f32x4*)(vC + 128 + 16 * ni + 4 * fq);
                float pc[4];
#pragma unroll
                for (int rg = 0; rg < 4; ++rg) { const int s = 16 * ni + 4 * fq + rg;
                    pc[rg] = (s <= t ? sacc[ni][rg] * __expf(cF[rg] - MF) * iF : 0.f) + (s >= t ? sacc[ni][rg] * __expf(cB[rg] - MB) * iB : 0.f); }
                u32x2 w; w.x = pk2(pc[0], pc[1]); w.y = pk2(pc[2], pc[3]);
                *(LAS u32x2*)(Ps + t * PIT_P + (16 * ni + 4 * fq) * 2) = w; }
            if (fq == 0) { rS[t] = gF * iF; rS[128 + t] = gB * iB; }
        }
        __syncthreads();
        f32x4 tot[2][8];
        u32x4 vr[8];
        {
            SECTION_LANES();
#pragma unroll
            for (int ni = 0; ni < 2; ++ni) {
                if (ni == 1) { const int s8 = lane & 15, vq = lane >> 4; const unsigned vp = (unsigned)((row0 + 8 * s8) * NP + PV + h * DH + 32 * wave + 8 * vq) * 2u;
#pragma unroll
                    for (int i = 0; i < 8; ++i) vr[i] = gld<u32x4>(P, vp + (unsigned)i * (NP * 2)); }
                f32x4 a1[8];
                const unsigned ctf = (unsigned)((cidx * NH + h) * 2 * DH * DH + (32 * wave + 16 * ni + fr) * DH + 8 * fq) * 2u;
                bf16x8 xf = gld<bf16x8>(CT, ctf), xb = gld<bf16x8>(CT, ctf + (unsigned)(DH * DH) * 2u);
                bf16x8 xf1 = gld<bf16x8>(CT, ctf + 64u), xb1 = gld<bf16x8>(CT, ctf + (unsigned)(DH * DH) * 2u + 64u);
                auto kstepQ = [&](int k0, auto first) {
                    const unsigned kn = (unsigned)(k0 + 64 < DH ? k0 + 64 : DH - 32);
                    const bf16x8 xfn = gld<bf16x8>(CT, ctf + kn * 2u), xbn = gld<bf16x8>(CT, ctf + (unsigned)(DH * DH) * 2u + kn * 2u);
#pragma unroll
                    for (int mi = 0; mi < 8; ++mi) { const bf16x8 yq = *(const LAS bf16x8*)(Qs + (16 * mi + fr) * PIT_R + (k0 + 8 * fq) * 2);
                        tot[ni][mi] = mma16<decltype(first)::value>(xf, yq, tot[ni][mi]);
                        a1[mi] = mma16<decltype(first)::value>(xb, yq, a1[mi]); }
                    xf = xf1; xb = xb1; xf1 = xfn; xb1 = xbn;
                };
                kstepQ(0, std::true_type{});
#pragma unroll 1
                for (int k0 = 32; k0 < DH; k0 += 32) kstepQ(k0, std::false_type{});
#pragma unroll
                for (int mi = 0; mi < 8; ++mi) { const float rf = rS[16 * mi + fr], rb = rS[128 + 16 * mi + fr]; tot[ni][mi] = rf * tot[ni][mi] + rb * a1[mi]; }
            }
        }
        __syncthreads();
        u32x2 og[8][2]; f32x4 gw[2];
        {
            SECTION_LANES();
            { const int s8 = lane & 15, vq = lane >> 4;
#pragma unroll
              for (int i = 0; i < 8; ++i) *(LAS u32x4*)(Vs + (8 * s8 + i) * PIT_T + (32 * wave + 8 * vq) * 2) = vr[i]; }
            asm volatile("s_waitcnt lgkmcnt(0)" ::: "memory");
#pragma unroll
            for (int mi = 0; mi < 8; ++mi)
#pragma unroll
                for (int ni = 0; ni < 2; ++ni) og[mi][ni] = gld<u32x2>(P, (unsigned)((row0 + 16 * mi + fr) * NP + PO + h * DH + 32 * wave + 16 * ni + 4 * fq) * 2u);
#pragma unroll
            for (int ni = 0; ni < 2; ++ni) gw[ni] = gld<f32x4>(nw, (unsigned)(h * DH + 32 * wave + 16 * ni + 4 * fq) * 4u);
#pragma unroll 1
            for (int k0 = 0; k0 < CHUNK; k0 += 32) {
                bf16x8 xv[2];
#pragma unroll
                for (int ni = 0; ni < 2; ++ni) xv[ni] = tr_frag(Vs, PIT_T, k0, 32 * wave + 16 * ni, lane);
#pragma unroll
                for (int mi = 0; mi < 8; ++mi) { const bf16x8 yp = *(const LAS bf16x8*)(Ps + (16 * mi + fr) * PIT_P + (k0 + 8 * fq) * 2);
#pragma unroll
                    for (int ni = 0; ni < 2; ++ni) tot[ni][mi] = __builtin_amdgcn_mfma_f32_16x16x32_bf16(xv[ni], yp, tot[ni][mi], 0, 0, 0); }
            }
        }
        {
            SECTION_LANES();
#pragma unroll
            for (int mi = 0; mi < 8; ++mi) { float ss = 0.f;
#pragma unroll
                for (int ni = 0; ni < 2; ++ni) ss += (tot[ni][mi][0] * tot[ni][mi][0] + tot[ni][mi][1] * tot[ni][mi][1]) + (tot[ni][mi][2] * tot[ni][mi][2] + tot[ni][mi][3] * tot[ni][mi][3]);
                ss += shx(ss, 16, lane); ss += shx(ss, 32, lane);
                if (fq == 0) ssq[wave * 128 + 16 * mi + fr] = ss; }
            __syncthreads();
#pragma unroll
            for (int mi = 0; mi < 8; ++mi) { const int tt = 16 * mi + fr; float ss = 0.f;
#pragma unroll
                for (int w8 = 0; w8 < 8; ++w8) ss += ssq[w8 * 128 + tt];
                const float rstd = rsqrtf(ss * (1.f / DH) + EPS);
#pragma unroll
                for (int ni = 0; ni < 2; ++ni) { const int vd = 32 * wave + 16 * ni + 4 * fq;
                    const u32x2 ow = og[mi][ni]; const f32x4 w4 = gw[ni];
                    const float o0 = __uint_as_float(ow.x << 16), o1 = __uint_as_float(ow.x & 0xffff0000u), o2 = __uint_as_float(ow.y << 16), o3 = __uint_as_float(ow.y & 0xffff0000u);
                    u32x2 q; q.x = pk2(sigmoidf_(o0) * (tot[ni][mi][0] * rstd * w4[0]), sigmoidf_(o1) * (tot[ni][mi][1] * rstd * w4[1]));
                    q.y = pk2(sigmoidf_(o2) * (tot[ni][mi][2] * rstd * w4[2]), sigmoidf_(o3) * (tot[ni][mi][3] * rstd * w4[3]));
                    gst<u32x2>(HM, (unsigned)((row0 + tt) * D + h * DH + vd) * 2u, q); }
            }
        }
        __syncthreads();
    }
}
__device__ __forceinline__ void ph_ffnact(int wv, int l) {
    CParams& p = *okp();
    unsigned char* const wsb = ows(p.ws);
    const int TIDX = otid(wv), BIDX = obid();
    const unsigned gt = (unsigned)BIDX * 512u + TIDX, NT = gridDim.x * 512u;
    const bf16_t* U = WSP(bf16_t, OFF_P); bf16_t* ACT = WSP(bf16_t, OFF_ACT); const float* SL = WSP(float, OFF_SLAB);
    const float* wf = p.conv_ff_w + (size_t)l * 3 * DFF;
    auto ldu = [&](int r, int col, float (&o)[8]) {
        if (col >= 32 * 256) { f32x4 g0 = {0.f, 0.f, 0.f, 0.f}, g1 = {0.f, 0.f, 0.f, 0.f};
#pragma unroll
            for (int sl = 0; sl < 4; ++sl) { const unsigned o4 = (unsigned)((sl * RC + (r - RL)) * NUP + col) * 4u; g0 += gld<f32x4>(SL, o4); g1 += gld<f32x4>(SL, o4 + 16); }
#pragma unroll
            for (int j = 0; j < 4; ++j) { o[j] = g0[j]; o[4 + j] = g1[j]; } }
        else unpack8(gld<u32x4>(U, (unsigned)(r * NUP + col) * 2u), o);
    };
    for (unsigned i = gt; i < (unsigned)RC * (DFF / 8); i += NT) {
        const int r = RL + (int)(i / (DFF / 8)), c = (int)(i % (DFF / 8)) * 8, t = (r - RL) & (CTX - 1);
        const int ca = 256 * (c >> 7) + (c & 127);
        const bool hp = t > 0, hn = t < CTX - 1;
        float a0[8], a1[8], a2[8], g[8], o[8];
        ldu(r, ca, a1); ldu(r, ca + 128, g); ldu(hp ? r - 1 : r, ca, a0); ldu(hn ? r + 1 : r, ca, a2);
        const f32x4 w00 = gld<f32x4>(wf, (unsigned)c * 4u), w01 = gld<f32x4>(wf, (unsigned)c * 4u + 16), w10 = gld<f32x4>(wf, (unsigned)(DFF + c) * 4u), w11 = gld<f32x4>(wf, (unsigned)(DFF + c) * 4u + 16),
                    w20 = gld<f32x4>(wf, (unsigned)(2 * DFF + c) * 4u), w21 = gld<f32x4>(wf, (unsigned)(2 * DFF + c) * 4u + 16);
#pragma unroll
        for (int j = 0; j < 8; ++j) { const float w0 = j < 4 ? w00[j & 3] : w01[j & 3], w1 = j < 4 ? w10[j & 3] : w11[j & 3], w2 = j < 4 ? w20[j & 3] : w21[j & 3];
            float v = w1 * a1[j]; if (hp) v += w0 * a0[j]; if (hn) v += w2 * a2[j]; o[j] = siluf_(v) * g[j]; }
        gst<u32x4>(ACT, (unsigned)(r * DFF + c) * 2u, pack8(o));
    }
}

#define XB_TMO      128
#define XB_XCNT(j)  (256  + 64 * (j))
#define XB_XSUB(j)  (1280 + 64 * (j))
#define XB_XGEN(j)  (2304 + 64 * (j))
#define XB_TOP      3328
#define XB_TOPGEN   3392
#define XCD_BAR_WORDS 3456
#define XB_SPIN_CAP (1u << 18)
__device__ __forceinline__ unsigned xb_ld(unsigned* p)              { return __hip_atomic_load(p, __ATOMIC_RELAXED, __HIP_MEMORY_SCOPE_AGENT); }
__device__ __forceinline__ unsigned xb_add(unsigned* p, unsigned v) { return __hip_atomic_fetch_add(p, v, __ATOMIC_RELAXED, __HIP_MEMORY_SCOPE_AGENT); }
__device__ __forceinline__ unsigned xb_xcc_id() { return (unsigned)__builtin_amdgcn_s_getreg((3 << 11) | 20) & 0xFu; }
#define XB_SPIN(cond, bar) do { unsigned _sp = 0; while (cond) { __builtin_amdgcn_s_sleep(1); \
    if ((++_sp & 255u) == 0u) { if (xb_ld(&(bar)[XB_TMO])) break; if (_sp > XB_SPIN_CAP) { atomicAdd(&(bar)[XB_TMO], 1u); break; } } } } while (0)
struct XcdBarrier { unsigned* bar; unsigned x; volatile LAS unsigned* st; };
__device__ __forceinline__ XcdBarrier xcd_barrier_post(unsigned* bar, volatile LAS unsigned* st) {
    XcdBarrier b; b.bar = bar; b.x = xb_xcc_id(); b.st = st;
    if (threadIdx.x == 0) (void)xb_add(&bar[XB_XCNT(b.x)], 1u);
    return b;
}
__device__ __forceinline__ void xcd_barrier_complete(unsigned* bar, unsigned x, unsigned& nloc, unsigned& nx) {
    const unsigned G = gridDim.x * gridDim.y * gridDim.z;
    unsigned sum, cnt, mine, sp = 0u;
    for (;;) {
        sum = 0u; cnt = 0u; mine = 0u;
#pragma unroll
        for (unsigned j = 0; j < 16; ++j) { const unsigned c = xb_ld(&bar[XB_XCNT(j)]); sum += c; cnt += (c > 0u) ? 1u : 0u; mine = (j == x) ? c : mine; }
        if (sum == G) break;
        __builtin_amdgcn_s_sleep(1);
        if ((++sp & 255u) == 0u) { if (xb_ld(&bar[XB_TMO])) break; if (sp > XB_SPIN_CAP) { atomicAdd(&bar[XB_TMO], 1u); break; } }
    }
    nloc = mine > 0u ? mine : 1u; nx = cnt > 0u ? cnt : 1u;
}
__device__ __forceinline__ void xcd_barrier(const XcdBarrier& b, int wv) {
    asm volatile("s_waitcnt vmcnt(0)" ::: "memory");
    __syncthreads();
    if (otid(wv) == 0) {
        unsigned long long bw = (unsigned long long)b.bar; asm volatile("" : "+s"(bw));
        unsigned* bar = (unsigned*)bw;
        __builtin_amdgcn_s_waitcnt(0);
        unsigned nloc = b.st[0], nx = b.st[1];
        if (nloc == 0u) { xcd_barrier_complete(bar, b.x, nloc, nx); b.st[0] = nloc; b.st[1] = nx; }
        const unsigned old = xb_add(&bar[XB_XSUB(b.x)], 1u);
        const unsigned gen = old / nloc;
        if (old + 1u == (gen + 1u) * nloc) {
            __builtin_amdgcn_fence(__ATOMIC_RELEASE, "agent");
            asm volatile("s_waitcnt vmcnt(0)" ::: "memory");
            const unsigned og = xb_add(&bar[XB_TOP], 1u);
            const unsigned tg = og / nx;
            if (og + 1u == (tg + 1u) * nx) xb_add(&bar[XB_TOPGEN], 1u);
            else XB_SPIN(xb_ld(&bar[XB_TOPGEN]) == tg, bar);
            __builtin_amdgcn_fence(__ATOMIC_ACQUIRE, "agent");
            xb_add(&bar[XB_XGEN(b.x)], 1u);
            asm volatile("s_waitcnt vmcnt(0)" ::: "memory");
        } else {
            XB_SPIN(xb_ld(&bar[XB_XGEN(b.x)]) == gen, bar);
            __builtin_amdgcn_fence(__ATOMIC_ACQUIRE, "agent");
            asm volatile("s_waitcnt vmcnt(0)" ::: "memory");
        }
    }
    __syncthreads();
}

constexpr int I_CUT = (I_LAYER * 2 / 5 / 64) * 64;
#define REPW 3456
#define REPN(k) (1 + __builtin_amdgcn_readfirstlane(((const int*)(okp()->ws + OFF_CTL))[REPW + (k)]))
constexpr int LDS_BYTES = 163840;
constexpr int MISC_OFF = 163840 - 256;
template <class Epi, class Sched, bool AMAP = false> __device__ __forceinline__ void run_gemm(int wv, LAS unsigned char* lds, const bf16_t* A, int lda, const bf16_t* Bt, int ldb, int K, const Sched& S, const Epi& E) {
    pg8::Gemm g; g.A = A; g.Bt = Bt; g.M = 0; g.N = 0; g.K = K; g.lda = lda; g.ldb = ldb; g.pad = wv;
    pg8::gemm_phase<Epi, Sched, AMAP>((PG8_LAS unsigned char*)lds, g, S, E);
}
__global__ void __launch_bounds__(512, 2) mega_fwd(Params p_kernarg) {
    extern __shared__ __attribute__((aligned(16))) unsigned char dyn_lds[];
    LAS unsigned char* lds = (LAS unsigned char*)dyn_lds;
    const int wv = __builtin_amdgcn_readfirstlane(threadIdx.x >> 6);
    volatile LAS unsigned* MISC = (volatile LAS unsigned*)(lds + MISC_OFF);
    if (threadIdx.x < 32) MISC[threadIdx.x] = 0u;
    __syncthreads();
    (void)xcd_barrier_post((unsigned*)(okp()->ws + OFF_CTL), MISC + 8);
#define GRID_BAR() for (int rpb = 0, nrpb = REPN(10); rpb < nrpb; ++rpb) { XcdBarrier bar_; bar_.bar = (unsigned*)(okp()->ws + OFF_CTL); bar_.x = xb_xcc_id(); bar_.st = (volatile LAS unsigned*)(lds + MISC_OFF) + 8; xcd_barrier(bar_, wv); }
    for (int rp = 0, nrp = REPN(13); rp < nrp; ++rp) { ph_convert(wv, lds, 0, obid(), (int)gridDim.x, 0, I_LAYER); __syncthreads(); }
    for (int rp = 0, nrp = REPN(0); rp < nrp; ++rp) { ph_tables(wv); __syncthreads(); ph_mod(wv, lds, 0, 1, obid(), (int)gridDim.x); __syncthreads(); }
    GRID_BAR();
    for (int l = 0; l < DEPTH; ++l) {
        unsigned char* ws = ows(okp()->ws);
        const int G = (int)gridDim.x;
        const int fz = 0;
        const bool lastl = (l == DEPTH - 1);
        if (l == 0) ph_norm<true>(wv, 0, 0, nullptr, 0, R, okp()->x, okp()->ctx);
        else { if (!fz) { const bf16_t* H = (const bf16_t*)(ows(okp()->ws) + OFF_H); ph_norm<false>(wv, l, 0, nullptr, 0, RL, H, H); } ph_norm_ctx<false>(wv, lds, l, 0); }
        GRID_BAR();
        for (int rp = 0, nrp = REPN(1); rp < nrp; ++rp) { EpiInProj E{(bf16_t*)(ws + OFF_P), (float*)(ws + OFF_G), (const float*)(ws + OFF_BINR) + (size_t)l * NINP};
          pg8::StaticOrder S; S.init(R, NINP, D, G, obid());
          run_gemm(wv, lds, (const bf16_t*)(ws + OFF_XN), D, (const bf16_t*)(ws + OFF_WIN) + (size_t)l * NINP * D, D, D, S, E); }
        GRID_BAR();
        for (int rp = 0, nrp = REPN(2); rp < nrp; ++rp) ph_mlstm1(wv, l, lds);
        { const int f0 = G / 4, fn = G / 2;
          for (int rp = 0, nrp = REPN(9); rp < nrp; ++rp) if (obid() >= f0 && obid() < f0 + fn) ph_fft(wv, lds, obid() - f0, fn);
          for (int rp = 0, nrp = REPN(3); rp < nrp; ++rp) if (obid() < f0 || obid() >= f0 + fn) { const int wi = obid() < f0 ? obid() : obid() - fn;
              if (!lastl) ph_fourier1(wv, wi, G - fn); ph_convc(wv, l, lastl ? RL : R, wi, G - fn); } }
        GRID_BAR();
        for (int rp = 0, nrp = REPN(4); rp < nrp; ++rp) ph_mlstm2(wv);
        GRID_BAR();
        for (int rp = 0, nrp = REPN(5); rp < nrp; ++rp) ph_mlstm3(wv, l, lds, lastl ? 64 * NH : NCHUNK * NH);
        if (!lastl && obid() >= 32) { EpiBf16 E{(bf16_t*)(ws + OFF_HM) + (size_t)RL * D + DM, D, DF, (unsigned)(CTX * D), 0, (float*)(ows(okp()->ws) + OFF_SLAB)};
          pg8::StaticOrder S; S.init(256, 2048, 512, G - 32, obid() - 32);
          run_gemm(wv, lds, (const bf16_t*)(ws + OFF_CSC), 512, (const bf16_t*)(ws + OFF_ZTC), 512, 512, S, E); }
        if (!lastl && obid() >= 32) { ph_convert(wv, lds, l + 1, obid() - 32, G - 32, 0, I_CUT); }
        GRID_BAR();
        for (int rp = 0, nrp = REPN(8); rp < nrp; ++rp) { EpiMerge E{(const bf16_t*)(ows(okp()->ws) + OFF_P), (bf16_t*)(ows(okp()->ws) + OFF_MG)}; pg8::StaticOrder S; S.init(lastl ? RL : R, D, D, G, obid());
          run_gemm(wv, lds, (const bf16_t*)(ws + OFF_HM), D, (const bf16_t*)(ws + OFF_WPM) + (size_t)l * D * D, D, D, S, E); }
        if (!lastl && obid() >= 32) { ph_convert(wv, lds, l + 1, obid() - 32, G - 32, I_CUT, I_LAYER); __syncthreads(); ph_mod(wv, lds, l + 1, l + 2, obid() - 32, G - 32); }
        GRID_BAR();
        for (int rp = 0, nrp = REPN(11); rp < nrp; ++rp) { EpiResid E{l, 0, fz, rp == 0 ? 1.f : 0.f};
          pg8::TailOrder S; S.init(D, D, G, obid(), lastl ? 0 : 32, 0, 8);
          run_gemm(wv, lds, (const bf16_t*)(ws + OFF_MG), D, (const bf16_t*)(ws + OFF_WO) + (size_t)l * D * D, D, D, S, E); }
        GRID_BAR();
        if (!lastl || !fz) {
          if (!fz) { const bf16_t* H = (const bf16_t*)(ows(okp()->ws) + OFF_H); ph_norm<false>(wv, l, 1, nullptr, 0, RL, H, H); }
          if (!lastl) { if (l == 0) ph_norm_ctx<true>(wv, lds, 0, 1); else ph_norm_ctx<false>(wv, lds, l, 1); }
          GRID_BAR(); }
        for (int rp = 0, nrp = REPN(7); rp < nrp; ++rp) { EpiUp E{(bf16_t*)(ows(okp()->ws) + OFF_P), (float*)(ows(okp()->ws) + OFF_SLAB), (bf16_t*)(ows(okp()->ws) + OFF_ACT), okp()->conv_ff_w + (size_t)l * 3 * DFF};
          pg8::TailOrder S; S.init(NUP, D, G, obid(), lastl ? 0 : 176, lastl ? 0 : 128, 4);
          run_gemm<EpiUp, pg8::TailOrder, true>(wv, lds, (const bf16_t*)(ows(okp()->ws) + OFF_XN), D, (const bf16_t*)(ws + OFF_WUP) + (size_t)l * NUP * D, D, D, S, E); }
        GRID_BAR();
        if (!lastl) { for (int rp = 0, nrp = REPN(6); rp < nrp; ++rp) ph_ffnact(wv, l);
          GRID_BAR(); }
        for (int rp = 0, nrp = REPN(12); rp < nrp; ++rp) { EpiResid E{l, 1, lastl ? 2 * fz : fz, rp == 0 ? 1.f : 0.f};
          pg8::TailOrder S; S.init(D, DFF, G, obid(), lastl ? 0 : 32, 0, 8);
          run_gemm(wv, lds, (const bf16_t*)(ws + OFF_ACT), DFF, (const bf16_t*)(ws + OFF_WDN) + (size_t)l * D * DFF, DFF, DFF, S, E); }
        if (!(lastl && fz)) { GRID_BAR(); }
    }
    ph_final(wv);
}

extern "C" void kernel_launch(void* const* d_in, const int* in_sizes, int n_in, void* d_out, int out_size, void* d_ws, size_t ws_size, hipStream_t stream) {
    static int grid = 0;
    if (grid == 0) {
        if (n_in != 22 || ws_size < WS_END || out_size != RL * D) { fprintf(stderr, "kernel_launch: unexpected problem (n_in %d, ws %zu < %zu, out %d)\n", n_in, ws_size, (size_t)WS_END, out_size); grid = -1; return; }
        int dev = 0, cus = 0, per_cu = 0;
        if (hipGetDevice(&dev) != hipSuccess || hipDeviceGetAttribute(&cus, hipDeviceAttributeMultiprocessorCount, dev) != hipSuccess) { grid = -1; return; }
        if (hipFuncSetAttribute((const void*)mega_fwd, hipFuncAttributeMaxDynamicSharedMemorySize, LDS_BYTES) != hipSuccess) { fprintf(stderr, "kernel_launch: hipFuncSetAttribute failed\n"); grid = -1; return; }
        if (hipOccupancyMaxActiveBlocksPerMultiprocessor(&per_cu, (const void*)mega_fwd, 512, LDS_BYTES) != hipSuccess || per_cu < 1) { fprintf(stderr, "kernel_launch: occupancy query says %d\n", per_cu); per_cu = 1; }
        (void)hipGetLastError();
        grid = cus;
    }
    if (grid < 0) return;
    Params p{};
    const float** pp = (const float**)&p;
    for (int i = 0; i < 22; ++i) pp[i] = (const float*)d_in[i];
    p.out = (float*)d_out; p.ws = (unsigned char*)d_ws;
    (void)hipMemsetAsync((char*)d_ws + OFF_CTL, 0, (size_t)CTL_ZERO_WORDS * sizeof(unsigned), stream);
    hipLaunchKernelGGL(mega_fwd, dim3(grid), dim3(512), LDS_BYTES, stream, p);
}
```

```cpp
#include <hip/hip_runtime.h>
#include <cstdio>
#include <cstdint>
#include <type_traits>

#define LAS __attribute__((address_space(3)))
typedef unsigned short bf16_t;
typedef short bf16x8 __attribute__((ext_vector_type(8)));
typedef float f32x4 __attribute__((ext_vector_type(4)));
typedef unsigned u32x4 __attribute__((ext_vector_type(4)));
typedef unsigned u32x2 __attribute__((ext_vector_type(2)));
typedef float f32x2 __attribute__((ext_vector_type(2)));

constexpr int D = 2048, NB = 4, SEQ = 2048, DEPTH = 4, CTX = 256;
constexpr int DM = 1024, NH = 4, DH = 256, DF = 512, DC = 512, DFF = 5632, CHUNK = 128;
constexpr int NIN = 12304;
constexpr int RL = NB * SEQ, RC = NB * CTX, R = RL + RC;
constexpr int NP = 12288;
constexpr int NINP = 12544;
constexpr int PK = 0, PV = 1024, PQ = 2048, PO = 3072, PF = 4096, PCB = 4608, PCC = 5120, PCX = 5632, PGM = 6144;
constexpr int NCHUNK = 72;
constexpr int NUP = 2 * DFF;
constexpr float EPS = 1e-6f;

constexpr size_t al256(size_t x) { return (x + 255) & ~(size_t)255; }
constexpr size_t OFF_CTL = 0;
constexpr size_t OFF_WIN = 1u << 20;
constexpr size_t SZ_WIN = (size_t)NINP * D * 2;            constexpr size_t OFF_WPM = OFF_WIN + DEPTH * SZ_WIN;
constexpr size_t SZ_WPM = (size_t)D * D * 2;               constexpr size_t OFF_WO = OFF_WPM + DEPTH * SZ_WPM;
constexpr size_t SZ_WO = (size_t)D * D * 2;                constexpr size_t OFF_WUP = OFF_WO + DEPTH * SZ_WO;
constexpr size_t SZ_WUP = (size_t)NUP * D * 2;             constexpr size_t OFF_WDN = OFF_WUP + DEPTH * SZ_WUP;
constexpr size_t SZ_WDN = (size_t)D * DFF * 2;             constexpr size_t OFF_BINR = OFF_WDN + DEPTH * SZ_WDN;
constexpr size_t OFF_MA = al256(OFF_BINR + (size_t)DEPTH * NINP * 4);
constexpr size_t OFF_MC = OFF_MA + (size_t)64 * 64 * 2;
constexpr size_t OFF_CSC = OFF_MC + (size_t)32 * 64 * 128 * 2;
constexpr size_t OFF_FT = OFF_CSC + (size_t)256 * 512 * 2;
constexpr size_t OFF_MOD = OFF_FT + (size_t)256 * 128 * 2;
constexpr size_t OFF_H = al256(OFF_MOD + (size_t)DEPTH * 5 * 6 * D * 4);
constexpr size_t OFF_XN = OFF_H + (size_t)R * D * 4;
constexpr size_t OFF_P = OFF_XN + (size_t)R * D * 2;
constexpr size_t OFF_G = OFF_P + (size_t)R * NP * 2;
constexpr size_t OFF_CHS = OFF_G + (size_t)R * 16 * 4;
constexpr size_t OFF_MST = al256(OFF_CHS + (size_t)NCHUNK * 8 * 2 * 4);
constexpr size_t OFF_UT = al256(OFF_MST + (size_t)NCHUNK * 8 * 4);
constexpr size_t SZ_UT = (size_t)NCHUNK * NH * 2 * DH * DH * 2;
constexpr size_t OFF_CT = OFF_UT + SZ_UT;
constexpr size_t OFF_NV = OFF_CT + SZ_UT;
constexpr size_t OFF_NS = OFF_NV + (size_t)NCHUNK * NH * 2 * DH * 4;
constexpr size_t OFF_HM = OFF_NS + (size_t)NCHUNK * NH * 2 * DH * 4;
constexpr size_t OFF_ZTC = OFF_HM + (size_t)R * D * 2;
constexpr size_t OFF_MG = OFF_ZTC + (size_t)2048 * 512 * 2;
constexpr size_t OFF_ACT = OFF_MG + (size_t)R * D * 2;
constexpr size_t OFF_SLAB = OFF_ACT + (size_t)R * DFF * 2;
constexpr size_t OFF_XS = OFF_SLAB + (size_t)4 * RC * NUP * 4;
constexpr size_t WS_END = OFF_XS + (size_t)8 * RL * 32 * 4;
constexpr int CNTW = 4096;
constexpr int CTL_ZERO_WORDS = CNTW + 8 * 32 * 64;
static_assert(WS_END <= (size_t)4 * DEPTH * D * NIN * 4, "workspace map exceeds the guaranteed d_ws size");
static_assert((size_t)R * NUP * 2 <= (size_t)R * NP * 2, "u overlays P");

struct Params {
    const float *x, *c, *ctx, *c_ctx, *w_mod, *b_mod, *norm1_w, *norm2_w, *w_in, *b_in, *conv_q_w, *conv_k_w, *mlstm_norm_w, *w_pm, *w_pf, *w_pc, *conv_c_w, *w_o, *w_up,
        *conv_ff_w, *w_down, *final_norm_w;
    float* out; unsigned char* ws;
};
#define WSP(T, off) ((T*)(wsb + (off)))
typedef const __attribute__((address_space(4))) Params CParams;
__device__ __forceinline__ CParams* okp() { CParams* k = (CParams*)__builtin_amdgcn_kernarg_segment_ptr(); asm volatile("" : "+s"(k)); return k; }

#define GAS __attribute__((address_space(1)))
template <class T> __device__ __forceinline__ T gld(const void* base, unsigned byte_off) { return *(const GAS T*)((const GAS unsigned char*)base + byte_off); }
template <class T> __device__ __forceinline__ void gst(void* base, unsigned byte_off, T v) { *(GAS T*)((GAS unsigned char*)base + byte_off) = v; }
__device__ __forceinline__ int otid(int wv) { int t; asm volatile("v_mbcnt_lo_u32_b32 %0, -1, 0\n\tv_mbcnt_hi_u32_b32 %0, -1, %0" : "=v"(t)); return (wv << 6) | t; }
__device__ __forceinline__ int olaunder(int v) { asm volatile("" : "+v"(v)); return v; }
__device__ __forceinline__ f32x4 zero4() { float a, b, c, d; asm volatile("v_mov_b32 %0, 0\n\tv_mov_b32 %1, 0\n\tv_mov_b32 %2, 0\n\tv_mov_b32 %3, 0" : "=v"(a), "=v"(b), "=v"(c), "=v"(d)); return (f32x4){a, b, c, d}; }
__device__ __forceinline__ int obid() { int b = blockIdx.x; asm volatile("" : "+s"(b)); return b; }
__device__ __forceinline__ float bf2f(bf16_t v) { return __uint_as_float(((unsigned)v) << 16); }
__device__ __forceinline__ unsigned f2bf(float f) { unsigned u = __float_as_uint(f); return (u + 0x7fffu + ((u >> 16) & 1u)) >> 16; }
__device__ __forceinline__ unsigned pk2(float lo, float hi) { return f2bf(lo) | (f2bf(hi) << 16); }
__device__ __forceinline__ float sigmoidf_(float x) { return 1.f / (1.f + __expf(-x)); }
__device__ __forceinline__ float siluf_(float x) { return x / (1.f + __expf(-x)); }
__device__ __forceinline__ float shx(float v, int k, int lane) { return __int_as_float(__builtin_amdgcn_ds_bpermute((lane ^ k) << 2, __float_as_int(v))); }
__device__ __forceinline__ float shl_(float v, int src) { return __int_as_float(__builtin_amdgcn_ds_bpermute(src << 2, __float_as_int(v))); }
__device__ __forceinline__ unsigned char* ows(unsigned char* w) { asm volatile("" : "+s"(w)); return w; }
__device__ __forceinline__ float wave_sum(float v, int lane) {
#pragma unroll
    for (int o = 1; o < 64; o <<= 1) v += shx(v, o, lane);
    return v;
}
__device__ __forceinline__ void unpack8(u32x4 w, float (&f)[8]) {
    f[0] = __uint_as_float(w.x << 16); f[1] = __uint_as_float(w.x & 0xffff0000u); f[2] = __uint_as_float(w.y << 16); f[3] = __uint_as_float(w.y & 0xffff0000u);
    f[4] = __uint_as_float(w.z << 16); f[5] = __uint_as_float(w.z & 0xffff0000u); f[6] = __uint_as_float(w.w << 16); f[7] = __uint_as_float(w.w & 0xffff0000u);
}
__device__ __forceinline__ u32x4 pack8(const float (&f)[8]) { u32x4 w; w.x = pk2(f[0], f[1]); w.y = pk2(f[2], f[3]); w.z = pk2(f[4], f[5]); w.w = pk2(f[6], f[7]); return w; }
__device__ __forceinline__ void rowinfo(int r, int& mj, int& t, int& T) { const int c = r >= RL ? 1 : 0; mj = r >> 11; T = SEQ >> (3 * c); t = r & (T - 1); }
__device__ __forceinline__ int chunk_row0(int cidx) { return cidx < 64 ? (cidx >> 4) * SEQ + (cidx & 15) * CHUNK : RL + ((cidx - 64) >> 1) * CTX + ((cidx - 64) & 1) * CHUNK; }
__device__ __forceinline__ int scan_chunk(int b, int dir, int step) {
    if (step < 2) { const int j = dir ? 1 - step : step; return 64 + b * 2 + j; }
    const int jj = step - 2, j = dir ? 15 - jj : jj; return b * 16 + j;
}

namespace pg8 {
#define PG8_LAS __attribute__((address_space(3)))
constexpr int BM = 256, BK = 64, HALF = 128, HTB = HALF * BK * 2, STAGE_BYTES = 8 * HTB, NXCD = 8, WGM = 8;
__host__ __device__ __forceinline__ int lds_byte(int r, int c) { const int st = (r >> 4) * 2 + (c >> 5), rr = r & 15, cc = c & 31, ob = rr * 64 + cc * 2; return st * 1024 + (ob ^ (((ob >> 9) & 1) << 5)); }
__host__ __device__ __forceinline__ void stage_rc(int b, int& Rr, int& C) { const int st = b / 1024, sb = b % 1024, swz = sb ^ (((sb >> 9) & 1) << 5); Rr = (st >> 1) * 16 + swz / 64; C = (st & 1) * 32 + (swz % 64) / 2; }
__host__ __device__ __forceinline__ int perm32(int rho) { const int n = rho >> 4, i = rho & 15; return 8 * (i >> 2) + 4 * n + (i & 3); }
struct Unit { int pm, pn, k0, nt, ks; };
struct Gemm { const bf16_t* A; const bf16_t* Bt; int M, N, K, lda, ldb, pad; };
__host__ __device__ __forceinline__ void tile_of(int wgid, int nM, int nN, int& pm, int& pn) {
    const int nwg = nM * nN; { const int q = nwg / NXCD, r = nwg % NXCD, xcd = wgid % NXCD, off = wgid / NXCD; wgid = (xcd < r ? xcd * (q + 1) : r * (q + 1) + (xcd - r) * q) + off; }
    const int nig = WGM * nN, gid = wgid / nig, fm = gid * WGM, gsz = (nM - fm) < WGM ? (nM - fm) : WGM;
    pm = fm + ((wgid % nig) % gsz); pn = (wgid % nig) / gsz;
}
struct StaticOrder {
    int nM, nN, nwg, G, c, K;
    __host__ __device__ void init(int M, int N, int K_, int G_, int c_) { nM = M / BM; nN = N / BM; nwg = nM * nN; G = G_; c = c_; K = K_; }
    __host__ __device__ bool next(int i, Unit& u) const {
        const long L = (long)i * G + c; if (L >= nwg) return false;
        tile_of((int)L, nM, nN, u.pm, u.pn); u.k0 = 0; u.nt = K / BK; u.ks = -1; return true;
    }
    __device__ __forceinline__ void a_ready(const Unit&) const {}
    __device__ __forceinline__ void done(const Unit&) const {}
};
struct TailOrder {
    int nN, G, c, K, nLat, nWhole, nTot, nsl;
    __host__ __device__ void init(int N, int K_, int G_, int c_, int nCtxTiles, int nCtxWhole, int nsl_) { nN = N / BM; G = G_; c = c_; K = K_; nLat = 32 * nN; nWhole = nLat + nCtxWhole; nTot = nLat + nCtxTiles; nsl = nsl_; }
    __host__ __device__ bool next(int i, Unit& u) const {
        const long L = (long)i * G + c; if (L >= (long)nWhole + (long)(nTot - nWhole) * nsl) return false;
        int tile, ks; if (L < nWhole) { tile = (int)L; ks = -1; } else { const int Lp = (int)L - nWhole; tile = nWhole + Lp / nsl; ks = Lp % nsl; }
        if (tile < nLat) tile_of(tile, 32, nN, u.pm, u.pn); else { const int tp = tile - nLat; u.pm = 32 + (tp & 3); u.pn = tp >> 2; }
        if (ks < 0) { u.k0 = 0; u.nt = K / BK; } else { const int n128 = K / 128, base = n128 / nsl, rem = n128 % nsl; u.k0 = 128 * (ks * base + (ks < rem ? ks : rem)); u.nt = 2 * (base + (ks < rem ? 1 : 0)); }
        u.ks = ks; return true;
    }
    __device__ __forceinline__ void a_ready(const Unit&) const {}
    __device__ __forceinline__ void done(const Unit&) const {}
};
template <bool AMAP> __device__ __forceinline__ void a_geom(const Gemm& g, const Unit& u, int R0, int C0, int R1, int C1, size_t& base, size_t& hstep, unsigned (&vo)[2]) {
    if (AMAP && u.pm < 32) { base = (size_t)((u.pm >> 3) * 2048 + (u.pm & 7) * 8) * g.lda * 2; hstep = (size_t)4 * g.lda * 2;
        vo[0] = (unsigned)(((R0 & 31) * 64 + (R0 >> 5)) * g.lda + C0) * 2u; vo[1] = (unsigned)(((R1 & 31) * 64 + (R1 >> 5)) * g.lda + C1) * 2u; }
    else { base = (size_t)u.pm * 256 * g.lda * 2; hstep = (size_t)HALF * g.lda * 2; vo[0] = (unsigned)(R0 * g.lda + C0) * 2u; vo[1] = (unsigned)(R1 * g.lda + C1) * 2u; }
}
template <class Epi, class Sched, bool AMAP = false>
__device__ __forceinline__ void gemm_phase(PG8_LAS unsigned char* lds, const Gemm g, const Sched& S, const Epi& E) {
    const int tid = otid(g.pad), wid = __builtin_amdgcn_readfirstlane(tid >> 6), lane = tid & 63, wr = wid >> 2, wc = wid & 3, fr = lane & 15, fq = lane >> 4;
    int R0, C0, R1, C1; stage_rc(tid * 16, R0, C0); stage_rc(tid * 16 + 8192, R1, C1);
    unsigned voffB[2];
    { const int Rb0 = Epi::PERM ? ((R0 & ~31) + perm32(R0 & 31)) : R0, Rb1 = Epi::PERM ? ((R1 & ~31) + perm32(R1 & 31)) : R1;
      voffB[0] = (unsigned)(Rb0 * g.ldb + C0) * 2u; voffB[1] = (unsigned)(Rb1 * g.ldb + C1) * 2u; }
    const size_t kstep = (size_t)(BK * 2);
    const size_t hstepB = (size_t)HALF * g.ldb * 2, tstepB = 2 * hstepB;
    const unsigned ldsw = (unsigned)wid * 1024u;
    const int aoff = lds_byte(wr * 64 + fr, fq * 8), boff = lds_byte(wc * 32 + fr, fq * 8);
#define PG8_SA(b, h) (((b) * 2 + (h)) * HTB)
#define PG8_SB(b, h) ((4 + (b) * 2 + (h)) * HTB)
#define PG8_STAGE(bufoff, gbase, voff) do { _Pragma("unroll") for (int _i = 0; _i < 2; ++_i) \
        __builtin_amdgcn_global_load_lds((const unsigned*)((const char*)(gbase) + (voff)[_i]), (PG8_LAS unsigned*)(lds + (bufoff) + ldsw + _i * 8192), 16, 0, 0); } while (0)
#define PG8_LDA(dst, b, h) do { _Pragma("unroll") for (int m = 0; m < 4; ++m) _Pragma("unroll") for (int k = 0; k < 2; ++k) dst[m][k] = *(const PG8_LAS bf16x8*)(lds + PG8_SA(b, h) + aoff + m * 2048 + k * 1024); } while (0)
#define PG8_LDB(dst, b, h) do { _Pragma("unroll") for (int n = 0; n < 2; ++n) _Pragma("unroll") for (int k = 0; k < 2; ++k) dst[n][k] = *(const PG8_LAS bf16x8*)(lds + PG8_SB(b, h) + boff + n * 2048 + k * 1024); } while (0)
#define PG8_MMA(ai, bj, At, Bt) do { __builtin_amdgcn_s_setprio(1); _Pragma("unroll") for (int m = 0; m < 4; ++m) _Pragma("unroll") for (int n = 0; n < 2; ++n) _Pragma("unroll") for (int k = 0; k < 2; ++k) \
        acc[ai][bj][m][n] = __builtin_amdgcn_mfma_f32_16x16x32_bf16(Bt[n][k], At[m][k], acc[ai][bj][m][n], 0, 0, 0); __builtin_amdgcn_s_setprio(0); } while (0)
#define PG8_WAIT_V(n) asm volatile("s_waitcnt vmcnt(" #n ")" ::: "memory")
#define PG8_WAIT_L(n) asm volatile("s_waitcnt lgkmcnt(" #n ")" ::: "memory")
#define PG8_BAR __builtin_amdgcn_s_barrier()
#define PG8_SCHED __builtin_amdgcn_sched_barrier(0)
    Unit cur, nxt; int ui = 0;
    if (!S.next(0, cur)) return;
    f32x4 acc[2][2][4][2];
#pragma unroll
    for (int a = 0; a < 2; ++a)
#pragma unroll
        for (int b = 0; b < 2; ++b)
#pragma unroll
            for (int m = 0; m < 4; ++m)
#pragma unroll
                for (int n = 0; n < 2; ++n) acc[a][b][m][n] = zero4();
    bf16x8 At[4][2], B0[2][2], B1[2][2];
    size_t baseC, hsC; unsigned voC[2]; a_geom<AMAP>(g, cur, R0, C0, R1, C1, baseC, hsC, voC);
    const char* cA = (const char*)g.A + baseC + (size_t)cur.k0 * 2; const char* cB = (const char*)g.Bt + (size_t)cur.pn * tstepB + (size_t)cur.k0 * 2;
    S.a_ready(cur);
    PG8_STAGE(PG8_SB(0, 0), cB, voffB); PG8_STAGE(PG8_SB(0, 1), cB + hstepB, voffB); PG8_STAGE(PG8_SA(0, 0), cA, voC); PG8_STAGE(PG8_SA(0, 1), cA + hsC, voC);
    if (wr == 1) PG8_BAR;
    PG8_WAIT_V(2); PG8_BAR;
    PG8_STAGE(PG8_SB(1, 0), cB + kstep, voffB); PG8_STAGE(PG8_SA(1, 0), cA + kstep, voC); PG8_STAGE(PG8_SB(1, 1), cB + hstepB + kstep, voffB);
    PG8_WAIT_V(6); PG8_BAR;
    for (;;) {
        const bool has_next = S.next(ui + 1, nxt);
        size_t baseN = baseC, hsN = hsC; unsigned voN[2] = {voC[0], voC[1]};
        if (AMAP && has_next) a_geom<AMAP>(g, nxt, R0, C0, R1, C1, baseN, hsN, voN); else if (has_next) baseN = (size_t)nxt.pm * 256 * g.lda * 2;
        const char* nA = has_next ? (const char*)g.A + baseN + (size_t)nxt.k0 * 2 : cA; const char* nB = has_next ? (const char*)g.Bt + (size_t)nxt.pn * tstepB + (size_t)nxt.k0 * 2 : cB;
        const int nt = cur.nt;
        for (int t = 0; t < nt; t += 2) {
            if constexpr (Epi::HOOK) E.hook(acc, cur, t, wr, wc, fr, fq, At, B0, B1);
            const bool last = (t == nt - 2);
            const char* a1 = cA + (size_t)(t + 1) * kstep;
            const char* a2 = last ? nA : cA + (size_t)(t + 2) * kstep; const char* b2 = last ? nB : cB + (size_t)(t + 2) * kstep;
            const char* a3 = a2 + kstep; const char* b3 = b2 + kstep;
            const size_t hs2 = (AMAP && last) ? hsN : hsC; unsigned vo2[2] = {(AMAP && last) ? voN[0] : voC[0], (AMAP && last) ? voN[1] : voC[1]};
            if (last && has_next) S.a_ready(nxt);
            PG8_LDB(B0, 0, 0); PG8_LDB(B1, 0, 1); PG8_SCHED; PG8_LDA(At, 0, 0); PG8_STAGE(PG8_SA(1, 1), a1 + hsC, voC);
            PG8_WAIT_V(8); PG8_WAIT_L(0); PG8_BAR; PG8_MMA(0, 0, At, B0); PG8_MMA(0, 1, At, B1); PG8_BAR; PG8_SCHED;
            PG8_LDA(At, 0, 1); PG8_STAGE(PG8_SB(0, 0), b2, voffB); PG8_STAGE(PG8_SB(0, 1), b2 + hstepB, voffB); PG8_STAGE(PG8_SA(0, 0), a2, vo2);
            PG8_WAIT_V(8); PG8_WAIT_L(0); PG8_BAR; PG8_MMA(1, 0, At, B0); PG8_MMA(1, 1, At, B1); PG8_BAR; PG8_SCHED;
            PG8_LDB(B0, 1, 0); PG8_LDB(B1, 1, 1); PG8_SCHED; PG8_LDA(At, 1, 0); PG8_STAGE(PG8_SA(0, 1), a2 + hs2, vo2);
            PG8_WAIT_V(8); PG8_WAIT_L(0); PG8_BAR; PG8_MMA(0, 0, At, B0); PG8_MMA(0, 1, At, B1); PG8_BAR; PG8_SCHED;
            PG8_LDA(At, 1, 1); PG8_STAGE(PG8_SB(1, 0), b3, voffB); PG8_STAGE(PG8_SB(1, 1), b3 + hstepB, voffB); PG8_STAGE(PG8_SA(1, 0), a3, vo2);
            PG8_WAIT_V(8); PG8_WAIT_L(0); PG8_BAR; PG8_MMA(1, 0, At, B0); PG8_MMA(1, 1, At, B1); PG8_BAR; PG8_SCHED;
        }
        if (wr == 0) PG8_BAR;
        E(acc, cur, wr, wc, fr, fq); S.done(cur);
        if (!has_next) break;
#pragma unroll
        for (int a = 0; a < 2; ++a)
#pragma unroll
            for (int b = 0; b < 2; ++b)
#pragma unroll
                for (int m = 0; m < 4; ++m)
#pragma unroll
                    for (int n = 0; n < 2; ++n) acc[a][b][m][n] = zero4();
        cur = nxt; cA = nA; cB = nB; ++ui;
        if constexpr (AMAP) { hsC = hsN; voC[0] = voN[0]; voC[1] = voN[1]; }
        if (wr == 1) PG8_BAR;
    }
    PG8_WAIT_V(0);
    PG8_BAR;
#undef PG8_SA
#undef PG8_SB
#undef PG8_STAGE
#undef PG8_LDA
#undef PG8_LDB
#undef PG8_MMA
#undef PG8_WAIT_V
#undef PG8_WAIT_L
#undef PG8_BAR
#undef PG8_SCHED
}
}

template <class F> __device__ __forceinline__ void epi_foreach(const f32x4 (&acc)[2][2][4][2], const pg8::Unit& u, int wr, int wc, int fr, int fq, F&& f) {
    const int row0 = u.pm * 256 + wr * 64 + fr, col0 = u.pn * 256 + wc * 32 + 8 * fq;
#pragma unroll
    for (int ai = 0; ai < 2; ++ai)
#pragma unroll
        for (int m = 0; m < 4; ++m)
#pragma unroll
            for (int bj = 0; bj < 2; ++bj) f(row0 + ai * 128 + m * 16, col0 + bj * 128, acc[ai][bj][m][0], acc[ai][bj][m][1]);
}
__device__ __forceinline__ void unpack8v(u32x4 w, f32x4& v0, f32x4& v1) {
    v0[0] = __uint_as_float(w.x << 16); v0[1] = __uint_as_float(w.x & 0xffff0000u); v0[2] = __uint_as_float(w.y << 16); v0[3] = __uint_as_float(w.y & 0xffff0000u);
    v1[0] = __uint_as_float(w.z << 16); v1[1] = __uint_as_float(w.z & 0xffff0000u); v1[2] = __uint_as_float(w.w << 16); v1[3] = __uint_as_float(w.w & 0xffff0000u);
}
__device__ __forceinline__ u32x4 pack8v(f32x4 v0, f32x4 v1) { u32x4 w; w.x = pk2(v0[0], v0[1]); w.y = pk2(v0[2], v0[3]); w.z = pk2(v1[0], v1[1]); w.w = pk2(v1[2], v1[3]); return w; }

struct EpiInProj {
    static constexpr bool PERM = true, HOOK = false;
    bf16_t* P; float* G; const float* bias;
    __device__ __forceinline__ void operator()(const f32x4 (&acc)[2][2][4][2], const pg8::Unit& u, int wr, int wc, int fr, int fq) const {
        if (u.pn < 48) {
            f32x4 bv[2][2];
#pragma unroll
            for (int bj = 0; bj < 2; ++bj) { const unsigned bo = (unsigned)(u.pn * 256 + wc * 32 + 8 * fq + bj * 128) * 4u; bv[bj][0] = gld<f32x4>(bias, bo); bv[bj][1] = gld<f32x4>(bias, bo + 16); }
            epi_foreach(acc, u, wr, wc, fr, fq, [&](int row, int col, f32x4 v0, f32x4 v1) {
                const int bj = (col >> 7) & 1;
                f32x4 o0 = v0 + bv[bj][0], o1 = v1 + bv[bj][1];
                if (u.pn >= PGM / 256) {
#pragma unroll
                    for (int j = 0; j < 4; ++j) { o0[j] = 1.f + __expf(-fminf(fmaxf(o0[j], -30.f), 30.f)); o1[j] = 1.f + __expf(-fminf(fmaxf(o1[j], -30.f), 30.f)); } }
                gst<u32x4>(P, (unsigned)(row * NP + col) * 2u, pack8v(o0, o1)); });
        } else if (wc == 0 && fq < 2) {
            const int row0 = u.pm * 256 + wr * 64 + fr;
            const f32x4 b0 = gld<f32x4>(bias, (unsigned)(NP + 8 * fq) * 4u), b1 = gld<f32x4>(bias, (unsigned)(NP + 8 * fq) * 4u + 16);
#pragma unroll
            for (int ai = 0; ai < 2; ++ai)
#pragma unroll
                for (int m = 0; m < 4; ++m) { const unsigned go = (unsigned)((row0 + ai * 128 + m * 16) * 16 + 8 * fq) * 4u;
                    gst<f32x4>(G, go, acc[ai][0][m][0] + b0); gst<f32x4>(G, go + 16, acc[ai][0][m][1] + b1); }
        }
    }
};
struct EpiBf16 {
    static constexpr bool PERM = true, HOOK = false;
    bf16_t* O; int ldc; int split_cols; unsigned split_stride; int pad; float* slab;
    __device__ __forceinline__ void operator()(const f32x4 (&acc)[2][2][4][2], const pg8::Unit& u, int wr, int wc, int fr, int fq) const {
        if (u.ks >= 0) { const unsigned sb = (unsigned)u.ks * (unsigned)(RC * ldc);
            epi_foreach(acc, u, wr, wc, fr, fq, [&](int row, int col, f32x4 v0, f32x4 v1) { const unsigned o = (sb + (unsigned)((row - RL) * ldc + col)) * 4u; gst<f32x4>(slab, o, v0); gst<f32x4>(slab, o + 16, v1); });
            return; }
        int colt = u.pn * 256; unsigned base = 0;
        if (split_cols) { const int t = colt / split_cols; base = (unsigned)t * split_stride; colt -= t * split_cols; }
        const int cshift = colt - u.pn * 256;
        epi_foreach(acc, u, wr, wc, fr, fq, [&](int row, int col, f32x4 v0, f32x4 v1) { gst<u32x4>(O, (base + (unsigned)(row * ldc + col + cshift)) * 2u, pack8v(v0, v1)); });
    }
};
struct EpiMerge {
    static constexpr bool PERM = true, HOOK = true;
    const bf16_t* P; bf16_t* MG;
    __device__ __forceinline__ void hook(f32x4 (&acc)[2][2][4][2], const pg8::Unit& u, int t, int wr, int wc, int fr, int fq, bf16x8 (&At)[4][2], bf16x8 (&B0)[2][2], bf16x8 (&B1)[2][2]) const {
        if (t != 16 && t != 24) return;
        const int b = t == 16 ? 0 : 1;
        const unsigned o0 = (unsigned)((u.pm * 256 + wr * 64 + fr) * NP + PGM + b * D + u.pn * 256 + wc * 32 + 8 * fq) * 2u;
#pragma unroll
        for (int ai = 0; ai < 2; ++ai) {
#pragma unroll
            for (int m = 0; m < 4; ++m) { const unsigned o = o0 + (unsigned)((ai * 128 + m * 16) * NP) * 2u;
                At[m][0] = gld<bf16x8>(P, o); At[m][1] = gld<bf16x8>(P, o + 256u);
                if (m < 2) { B0[m][0] = gld<bf16x8>(P, o + D * 2); B0[m][1] = gld<bf16x8>(P, o + D * 2 + 256u); }
                else { B1[m - 2][0] = gld<bf16x8>(P, o + D * 2); B1[m - 2][1] = gld<bf16x8>(P, o + D * 2 + 256u); } }
#pragma unroll
            for (int m = 0; m < 4; ++m)
#pragma unroll
                for (int bj = 0; bj < 2; ++bj) { float xa[8], xb[8]; unpack8(__builtin_bit_cast(u32x4, At[m][bj]), xa); unpack8(__builtin_bit_cast(u32x4, m < 2 ? B0[m][bj] : B1[m - 2][bj]), xb);
#pragma unroll
                    for (int j = 0; j < 8; ++j) acc[ai][bj][m][j >> 2][j & 3] *= xb[j] * __builtin_amdgcn_rcpf(xa[j]); }
        }
    }
    __device__ __forceinline__ void operator()(const f32x4 (&acc)[2][2][4][2], const pg8::Unit& u, int wr, int wc, int fr, int fq) const {
        const int row0 = u.pm * 256 + wr * 64 + fr, col0 = u.pn * 256 + wc * 32 + 8 * fq;
#pragma unroll
        for (int ai = 0; ai < 2; ++ai) { u32x4 gr[4][2];
#pragma unroll
            for (int m = 0; m < 4; ++m)
#pragma unroll
                for (int bj = 0; bj < 2; ++bj) gr[m][bj] = gld<u32x4>(P, (unsigned)((row0 + ai * 128 + m * 16) * NP + PGM + 2 * D + col0 + bj * 128) * 2u);
#pragma unroll
            for (int m = 0; m < 4; ++m)
#pragma unroll
                for (int bj = 0; bj < 2; ++bj) { float g[8]; unpack8(gr[m][bj], g);
                    const f32x4 g0 = {__builtin_amdgcn_rcpf(g[0]), __builtin_amdgcn_rcpf(g[1]), __builtin_amdgcn_rcpf(g[2]), __builtin_amdgcn_rcpf(g[3])},
                                g1 = {__builtin_amdgcn_rcpf(g[4]), __builtin_amdgcn_rcpf(g[5]), __builtin_amdgcn_rcpf(g[6]), __builtin_amdgcn_rcpf(g[7])};
                    gst<u32x4>(MG, (unsigned)((row0 + ai * 128 + m * 16) * D + col0 + bj * 128) * 2u, pack8v(g0 * acc[ai][bj][m][0], g1 * acc[ai][bj][m][1])); }
        }
    }
};
struct EpiUp {
    static constexpr bool PERM = true, HOOK = false;
    bf16_t* U; float* slab; bf16_t* ACT; const float* wf;
    __device__ __forceinline__ void operator()(const f32x4 (&acc)[2][2][4][2], const pg8::Unit& u, int wr, int wc, int fr, int fq) const {
        if (u.ks >= 0) { const unsigned sb = (unsigned)u.ks * (unsigned)(RC * NUP);
            epi_foreach(acc, u, wr, wc, fr, fq, [&](int row, int col, f32x4 v0, f32x4 v1) { const unsigned o = (sb + (unsigned)((row - RL) * NUP + col)) * 4u; gst<f32x4>(slab, o, v0); gst<f32x4>(slab, o + 16, v1); });
            return; }
        if (u.pm >= 32) { epi_foreach(acc, u, wr, wc, fr, fq, [&](int row, int col, f32x4 v0, f32x4 v1) { gst<u32x4>(U, (unsigned)(row * NUP + col) * 2u, pack8v(v0, v1)); }); return; }
        const int c0 = 128 * u.pn + 32 * wc + 8 * fq, lane = fq * 16 + fr;
        const int lprev = ((lane & 48) | ((fr - 1) & 15)), lnext = ((lane & 48) | ((fr + 1) & 15));
        float w0[8], w1[8], w2[8];
        { const f32x4 a0 = gld<f32x4>(wf, (unsigned)c0 * 4u), a1 = gld<f32x4>(wf, (unsigned)c0 * 4u + 16), b0 = gld<f32x4>(wf, (unsigned)(DFF + c0) * 4u), b1 = gld<f32x4>(wf, (unsigned)(DFF + c0) * 4u + 16),
                      d0 = gld<f32x4>(wf, (unsigned)(2 * DFF + c0) * 4u), d1 = gld<f32x4>(wf, (unsigned)(2 * DFF + c0) * 4u + 16);
#pragma unroll
          for (int j = 0; j < 4; ++j) { w0[j] = a0[j]; w0[4 + j] = a1[j]; w1[j] = b0[j]; w1[4 + j] = b1[j]; w2[j] = d0[j]; w2[4 + j] = d1[j]; } }
        const unsigned rowb = (unsigned)((u.pm >> 3) * 2048 + (u.pm & 7) * 8 + 2 * wr);
#pragma unroll
        for (int ai = 0; ai < 2; ++ai)
#pragma unroll
            for (int m = 0; m < 4; ++m) {
                float o[8];
#pragma unroll
                for (int n = 0; n < 2; ++n)
#pragma unroll
                    for (int e = 0; e < 4; ++e) {
                        const float a = acc[ai][0][m][n][e];
                        const float oprev = (m & 1) ? acc[ai][0][m - 1 < 0 ? 0 : m - 1][n][e] : 0.f, onext = (m & 1) ? 0.f : acc[ai][0][m + 1 > 3 ? 3 : m + 1][n][e];
                        const float pv = shl_(fr == 15 ? oprev : a, lprev), nx = shl_(fr == 0 ? onext : a, lnext);
                        o[4 * n + e] = siluf_(w0[4 * n + e] * pv + w1[4 * n + e] * a + w2[4 * n + e] * nx) * acc[ai][1][m][n][e];
                    }
                const unsigned row = rowb + (unsigned)((16 * (m & 1) + fr) * 64 + 4 * ai + (m >> 1));
                gst<u32x4>(ACT, (row * (unsigned)DFF + (unsigned)c0) * 2u, pack8(o));
            }
    }
};
struct EpiResid {
    static constexpr bool PERM = true, HOOK = false;
    int l, which, fuse; float scale;
    __device__ __forceinline__ void operator()(f32x4 (&acc)[2][2][4][2], const pg8::Unit& u, int wr, int wc, int fr, int fq) const {
        CParams& p = *okp(); unsigned char* const ws = ows(p.ws);
        bf16_t* H = (bf16_t*)(ws + OFF_H); const bool xin = (l == 0 && which == 0);
        const float* mod = (const float*)(ws + OFF_MOD) + (size_t)l * 5 * 6 * D; const float* gate = mod + (which ? 5 : 2) * D;
        if (u.ks >= 0) { float* slab = (float*)(ws + OFF_SLAB); const unsigned sb = (unsigned)u.ks * (unsigned)(RC * D);
            epi_foreach(acc, u, wr, wc, fr, fq, [&](int row, int col, f32x4 v0, f32x4 v1) { const unsigned o = (sb + (unsigned)((row - RL) * D + col)) * 4u; gst<f32x4>(slab, o, v0); gst<f32x4>(slab, o + 16, v1); });
            return; }
        const unsigned gb = (unsigned)(u.pm < 32 ? (u.pm >> 3) : 4) * (6 * D) * 4u;
        if (!fuse || u.pm >= 32) {
            const int row0 = u.pm * 256 + wr * 64 + fr, col0 = u.pn * 256 + wc * 32 + 8 * fq;
            f32x4 gv[2][2];
#pragma unroll
            for (int bj = 0; bj < 2; ++bj) { gv[bj][0] = gld<f32x4>(gate, gb + (unsigned)(col0 + bj * 128) * 4u) * scale; gv[bj][1] = gld<f32x4>(gate, gb + (unsigned)(col0 + bj * 128) * 4u + 16) * scale; }
            if (xin) {
#pragma unroll
              for (int am = 0; am < 4; ++am) { f32x4 hv[2][2][2];
#pragma unroll
                for (int mm = 0; mm < 2; ++mm)
#pragma unroll
                  for (int bj = 0; bj < 2; ++bj) { const unsigned ho = (unsigned)((row0 + (am >> 1) * 128 + (2 * (am & 1) + mm) * 16) * D + col0 + bj * 128) * 4u; hv[mm][bj][0] = gld<f32x4>(p.x, ho); hv[mm][bj][1] = gld<f32x4>(p.x, ho + 16); }
#pragma unroll
                for (int mm = 0; mm < 2; ++mm)
#pragma unroll
                  for (int bj = 0; bj < 2; ++bj) { const int ai = am >> 1, m = 2 * (am & 1) + mm; const unsigned eo = (unsigned)((row0 + ai * 128 + m * 16) * D + col0 + bj * 128);
                      gst<u32x4>(H, eo * 2u, pack8v(hv[mm][bj][0] + gv[bj][0] * acc[ai][bj][m][0], hv[mm][bj][1] + gv[bj][1] * acc[ai][bj][m][1])); } }
            } else {
#pragma unroll
              for (int ai = 0; ai < 2; ++ai) { u32x4 hr[4][2];
#pragma unroll
                for (int m = 0; m < 4; ++m)
#pragma unroll
                  for (int bj = 0; bj < 2; ++bj) hr[m][bj] = gld<u32x4>(H, (unsigned)((row0 + ai * 128 + m * 16) * D + col0 + bj * 128) * 2u);
#pragma unroll
                for (int m = 0; m < 4; ++m)
#pragma unroll
                  for (int bj = 0; bj < 2; ++bj) { f32x4 o0, o1; unpack8v(hr[m][bj], o0, o1);
                      gst<u32x4>(H, (unsigned)((row0 + ai * 128 + m * 16) * D + col0 + bj * 128) * 2u, pack8v(o0 + gv[bj][0] * acc[ai][bj][m][0], o1 + gv[bj][1] * acc[ai][bj][m][1])); } }
            }
            return; }
        bf16_t* XN = (bf16_t*)(ws + OFF_XN); const float* nw = fuse == 2 ? p.final_norm_w : which ? p.norm1_w + (size_t)(l + 1) * D : p.norm2_w + (size_t)l * D;
        const float* nmod = which ? mod + 5 * 6 * D : mod + 3 * D;
        float* xs = (float*)(ws + OFF_XS) + (size_t)(2 * l + which) * RL * 32; unsigned* cnt = (unsigned*)(ws + OFF_CTL) + CNTW + (2 * l + which) * 32 * 64;
        float* out = p.out;
        int lane; asm volatile("v_mbcnt_lo_u32_b32 %0, -1, 0\n\tv_mbcnt_hi_u32_b32 %0, -1, %0" : "=v"(lane));
        { const int fr2 = lane & 15, fq2 = lane >> 4, row0 = u.pm * 256 + wr * 64 + fr2, col0 = u.pn * 256 + wc * 32 + 8 * fq2;
          f32x4 gv[2][2];
#pragma unroll
          for (int bj = 0; bj < 2; ++bj) { gv[bj][0] = gld<f32x4>(gate, gb + (unsigned)(col0 + bj * 128) * 4u) * scale; gv[bj][1] = gld<f32x4>(gate, gb + (unsigned)(col0 + bj * 128) * 4u + 16) * scale; }
          float ssr[8];
          auto newh = [&](int k, int bj, f32x4 o0, f32x4 o1, float& ss) {
              const int ai = k >> 2, m = k & 3; const unsigned eo = (unsigned)((row0 + ai * 128 + m * 16) * D + col0 + bj * 128);
              const f32x4 h0 = o0 + gv[bj][0] * acc[ai][bj][m][0], h1 = o1 + gv[bj][1] * acc[ai][bj][m][1];
              if (fuse == 2) { gst<f32x4>(out, eo * 4u, h0); gst<f32x4>(out, eo * 4u + 16, h1); } else gst<u32x4>(H, eo * 2u, pack8v(h0, h1));
              ss += (h0[0] * h0[0] + h0[1] * h0[1]) + (h0[2] * h0[2] + h0[3] * h0[3]) + (h1[0] * h1[0] + h1[1] * h1[1]) + (h1[2] * h1[2] + h1[3] * h1[3]); };
          if (xin) {
#pragma unroll
            for (int am = 0; am < 4; ++am) { f32x4 hv[2][2][2];
#pragma unroll
              for (int mm = 0; mm < 2; ++mm)
#pragma unroll
                for (int bj = 0; bj < 2; ++bj) { const unsigned ho = (unsigned)((row0 + (am >> 1) * 128 + (2 * (am & 1) + mm) * 16) * D + col0 + bj * 128) * 4u; hv[mm][bj][0] = gld<f32x4>(p.x, ho); hv[mm][bj][1] = gld<f32x4>(p.x, ho + 16); }
#pragma unroll
              for (int mm = 0; mm < 2; ++mm) { const int k = 4 * (am >> 1) + 2 * (am & 1) + mm; float ss = 0.f;
#pragma unroll
                for (int bj = 0; bj < 2; ++bj) newh(k, bj, hv[mm][bj][0], hv[mm][bj][1], ss);
                ss += shx(ss, 16, lane); ss += shx(ss, 32, lane); ssr[k] = ss; } }
          } else {
#pragma unroll
            for (int kh = 0; kh < 2; ++kh) { u32x4 hr[4][2];
#pragma unroll
              for (int m = 0; m < 4; ++m)
#pragma unroll
                for (int bj = 0; bj < 2; ++bj) hr[m][bj] = gld<u32x4>(H, (unsigned)((row0 + kh * 128 + m * 16) * D + col0 + bj * 128) * 2u);
#pragma unroll
              for (int m = 0; m < 4; ++m) { const int k = 4 * kh + m; float ss = 0.f;
#pragma unroll
                for (int bj = 0; bj < 2; ++bj) { f32x4 o0, o1; unpack8v(hr[m][bj], o0, o1); newh(k, bj, o0, o1, ss); }
                ss += shx(ss, 16, lane); ss += shx(ss, 32, lane); ssr[k] = ss; } }
          }
#pragma unroll
          for (int k = 0; k < 8; ++k)
              if (fq2 == 0) __hip_atomic_store((GAS float*)xs + ((row0 + (k >> 2) * 128 + (k & 3) * 16) * 32 + u.pn * 4 + wc), ssr[k], __ATOMIC_RELAXED, __HIP_MEMORY_SCOPE_AGENT); }
        asm volatile("s_waitcnt vmcnt(0)" ::: "memory");
        __builtin_amdgcn_s_barrier();
        if (lane == 0 && wr == 0 && wc == 0) {
            GAS unsigned* pc = (GAS unsigned*)cnt + 64 * u.pm;
            (void)__hip_atomic_fetch_add(pc, 1u, __ATOMIC_RELAXED, __HIP_MEMORY_SCOPE_AGENT);
            unsigned spins = 0;
#pragma nounroll
            while (__hip_atomic_load(pc, __ATOMIC_RELAXED, __HIP_MEMORY_SCOPE_AGENT) < 8u && ++spins < (1u << 22)) __builtin_amdgcn_s_sleep(1);
        }
        __builtin_amdgcn_s_barrier();
        __builtin_amdgcn_fence(__ATOMIC_ACQUIRE, "agent");
        { const int hl = lane & 31, row0 = u.pm * 256 + (wr * 4 + wc) * 32 + (lane >> 5), col = u.pn * 256 + hl * 8;
          const unsigned mo = (unsigned)(u.pm >> 3) * (6 * D) * 4u, co = (unsigned)col * 4u;
          const f32x4 w0 = gld<f32x4>(nw, co), w1 = gld<f32x4>(nw, co + 16);
          if (fuse == 2) {
#pragma unroll
            for (int ib = 0; ib < 4; ++ib) { float tt[4]; f32x4 ha[4], hb[4];
#pragma unroll
              for (int i = 0; i < 4; ++i) { const int row = row0 + 2 * (4 * ib + i); const unsigned ho = (unsigned)(row * D + col) * 4u;
                  tt[i] = gld<float>(xs, (unsigned)(row * 32 + hl) * 4u); ha[i] = gld<f32x4>(out, ho); hb[i] = gld<f32x4>(out, ho + 16); }
#pragma unroll
              for (int i = 0; i < 4; ++i) { const int row = row0 + 2 * (4 * ib + i); const unsigned ho = (unsigned)(row * D + col) * 4u; float tot = tt[i];
#pragma unroll
                  for (int o = 1; o < 32; o <<= 1) tot += shx(tot, o, lane);
                  const float rstd = rsqrtf(tot * (1.f / D) + EPS);
                  gst<f32x4>(out, ho, ha[i] * rstd * w0); gst<f32x4>(out, ho + 16, hb[i] * rstd * w1); } }
            return; }
          const f32x4 sh0 = gld<f32x4>(nmod, mo + co), sh1 = gld<f32x4>(nmod, mo + co + 16);
          const f32x4 sc0 = gld<f32x4>(nmod, mo + D * 4 + co) + 1.f, sc1 = gld<f32x4>(nmod, mo + D * 4 + co + 16) + 1.f;
#pragma unroll
          for (int ib = 0; ib < 2; ++ib) { float tt[8]; u32x4 hq[8];
#pragma unroll
            for (int i = 0; i < 8; ++i) { const int row = row0 + 2 * (8 * ib + i);
                tt[i] = gld<float>(xs, (unsigned)(row * 32 + hl) * 4u); hq[i] = gld<u32x4>(H, (unsigned)(row * D + col) * 2u); }
#pragma unroll
            for (int i = 0; i < 8; ++i) { const int row = row0 + 2 * (8 * ib + i); float tot = tt[i];
#pragma unroll
                for (int o = 1; o < 32; o <<= 1) tot += shx(tot, o, lane);
                const float rstd = rsqrtf(tot * (1.f / D) + EPS);
                f32x4 ha, hb; unpack8v(hq[i], ha, hb);
                const f32x4 y0 = (ha * rstd * w0) * sc0 + sh0, y1 = (hb * rstd * w1) * sc1 + sh1;
                gst<u32x4>(XN, (unsigned)(row * D + col) * 2u, pack8v(y0, y1)); } } }
    }
};

__device__ __forceinline__ bf16x8 gather8(const bf16_t* p, size_t stride) {
    bf16x8 v;
#pragma unroll
    for (int j = 0; j < 8; ++j) v[j] = (short)p[(size_t)j * stride];
    return v;
}
template <bool AV, bool BV>
__device__ __forceinline__ void wave_mm32(const bf16_t* A, size_t sam, size_t sak, const bf16_t* B, size_t sbk, size_t sbn, int K, f32x4 (&acc)[2][2], int lane) {
    const int fr = lane & 15, fq = lane >> 4;
    for (int k0 = 0; k0 < K; k0 += 32) {
        bf16x8 a[2], b[2];
#pragma unroll
        for (int mi = 0; mi < 2; ++mi) { const bf16_t* q = A + (size_t)(16 * mi + fr) * sam + (size_t)(k0 + 8 * fq) * sak; a[mi] = AV ? *(const bf16x8*)q : gather8(q, sak); }
#pragma unroll
        for (int ni = 0; ni < 2; ++ni) { const bf16_t* q = B + (size_t)(16 * ni + fr) * sbn + (size_t)(k0 + 8 * fq) * sbk; b[ni] = BV ? *(const bf16x8*)q : gather8(q, sbk); }
#pragma unroll
        for (int mi = 0; mi < 2; ++mi)
#pragma unroll
            for (int ni = 0; ni < 2; ++ni) acc[mi][ni] = __builtin_amdgcn_mfma_f32_16x16x32_bf16(a[mi], b[ni], acc[mi][ni], 0, 0, 0);
    }
}
#define ZERO_ACC22(acc) do { _Pragma("unroll") for (int _a = 0; _a < 2; ++_a) _Pragma("unroll") for (int _b = 0; _b < 2; ++_b) acc[_a][_b] = (f32x4){0.f, 0.f, 0.f, 0.f}; } while (0)

__device__ __forceinline__ void transpose_item(const float* W, int N, int pitch, int kdst0, bf16_t* WT, int dst_row0, int src_col0, int nvalid, int k0, LAS float* scr, int lane) {
    const int n4 = (lane & 15) * 4, kq = lane >> 4;
    f32x4 v[16];
#pragma unroll
    for (int i = 0; i < 16; ++i) v[i] = n4 < nvalid ? gld<f32x4>(W, (unsigned)((k0 + 4 * i + kq) * N + src_col0 + n4) * 4u) : (f32x4){0.f, 0.f, 0.f, 0.f};
#pragma unroll
    for (int i = 0; i < 16; ++i) { LAS float* d = scr + (4 * i + kq) * 65 + n4; d[0] = v[i][0]; d[1] = v[i][1]; d[2] = v[i][2]; d[3] = v[i][3]; }
    asm volatile("s_waitcnt lgkmcnt(0)" ::: "memory");
    const int c = lane & 7;
#pragma unroll
    for (int j8 = 0; j8 < 8; ++j8) { const int n = (lane >> 3) + 8 * j8; const LAS float* sp = scr + (8 * c) * 65 + n;
        u32x4 o; o.x = pk2(sp[0 * 65], sp[1 * 65]); o.y = pk2(sp[2 * 65], sp[3 * 65]); o.z = pk2(sp[4 * 65], sp[5 * 65]); o.w = pk2(sp[6 * 65], sp[7 * 65]);
        gst<u32x4>(WT, (unsigned)((dst_row0 + n) * pitch + kdst0 + k0 + 8 * c) * 2u, o); }
    asm volatile("s_waitcnt lgkmcnt(0)" ::: "memory");
}
constexpr int I_IN = (NINP / 64) * (D / 64), I_PM = (D / 64) * (DM / 64), I_PF = (D / 64) * (DF / 64), I_PC = (D / 64) * (DC / 64), I_O = (D / 64) * (D / 64),
              I_UP = (NUP / 64) * (D / 64), I_DN = (D / 64) * (DFF / 64), I_LAYER = I_IN + I_PM + I_PF + I_PC + I_O + I_UP + I_DN;
__device__ __forceinline__ void ph_convert(int wv, LAS unsigned char* lds, int l, int widx, int nwg, int it_lo, int it_hi) {
    CParams& p = *okp();
    unsigned char* const wsb = ows(p.ws);
    const int TIDX = otid(wv);
    const int lane = TIDX & 63, wave = wv;
    LAS float* scr = (LAS float*)lds + wave * 64 * 65;
    const int gw = widx * 8 + wave, NGW = nwg * 8;
    for (int it = it_lo + gw; it < it_hi; it += NGW) {
        int r = it;
        if (r < I_IN) { const int nkb = D / 64, kb = r % nkb, grp = r / nkb, j0 = 64 * grp; int src0, nv;
            if (j0 < 2048) { src0 = j0; nv = 64; } else if (j0 < NP) { src0 = j0 + 16; nv = 64; } else if (j0 == NP) { src0 = 2048; nv = 16; } else { src0 = 0; nv = 0; }
            transpose_item(p.w_in + (size_t)l * D * NIN, NIN, D, 0, WSP(bf16_t, OFF_WIN) + (size_t)l * NINP * D, j0, src0, nv, 64 * kb, scr, lane); continue; } r -= I_IN;
        if (r < I_PM) { const int nkb = DM / 64, kb = r % nkb, grp = r / nkb;
            transpose_item(p.w_pm + (size_t)l * DM * D, D, D, 0, WSP(bf16_t, OFF_WPM) + (size_t)l * D * D, 64 * grp, 64 * grp, 64, 64 * kb, scr, lane); continue; } r -= I_PM;
        if (r < I_PF) { const int nkb = DF / 64, kb = r % nkb, grp = r / nkb;
            transpose_item(p.w_pf + (size_t)l * DF * D, D, D, DM, WSP(bf16_t, OFF_WPM) + (size_t)l * D * D, 64 * grp, 64 * grp, 64, 64 * kb, scr, lane); continue; } r -= I_PF;
        if (r < I_PC) { const int nkb = DC / 64, kb = r % nkb, grp = r / nkb;
            transpose_item(p.w_pc + (size_t)l * DC * D, D, D, DM + DF, WSP(bf16_t, OFF_WPM) + (size_t)l * D * D, 64 * grp, 64 * grp, 64, 64 * kb, scr, lane); continue; } r -= I_PC;
        if (r < I_O) { const int nkb = D / 64, kb = r % nkb, grp = r / nkb;
            transpose_item(p.w_o + (size_t)l * D * D, D, D, 0, WSP(bf16_t, OFF_WO) + (size_t)l * D * D, 64 * grp, 64 * grp, 64, 64 * kb, scr, lane); continue; } r -= I_O;
        if (r < I_UP) { const int nkb = D / 64, kb = r % nkb, grp = r / nkb, j0 = 64 * grp, tile = j0 >> 8, w0 = j0 & 255;
            transpose_item(p.w_up + (size_t)l * D * NUP, NUP, D, 0, WSP(bf16_t, OFF_WUP) + (size_t)l * NUP * D, j0, w0 < 128 ? 128 * tile + w0 : DFF + 128 * tile + (w0 - 128), 64, 64 * kb, scr, lane); continue; } r -= I_UP;
        { const int nkb = DFF / 64, kb = r % nkb, grp = r / nkb;
            transpose_item(p.w_down + (size_t)l * DFF * D, D, DFF, 0, WSP(bf16_t, OFF_WDN) + (size_t)l * D * DFF, 64 * grp, 64 * grp, 64, 64 * kb, scr, lane); }
    }
}
__device__ __forceinline__ void ph_tables(int wv) {
    CParams& p = *okp();
    unsigned char* const wsb = ows(p.ws);
    const int TIDX = otid(wv), BIDX = obid(); (void)TIDX; (void)BIDX;
    const size_t gt = (size_t)BIDX * 512 + TIDX, NT = (size_t)gridDim.x * 512;
    bf16_t* ma = WSP(bf16_t, OFF_MA);
    for (size_t i = gt; i < (size_t)64 * 64; i += NT) { const int row = (int)(i >> 6), col = (int)(i & 63), ro = row >> 5, tau1 = row & 31, ri = col >> 5, t1 = col & 31;
        const float a = (float)((t1 * tau1) & 31) * (1.0f / 16.0f); const float cv = cospif(a), sv = sinpif(a);
        ma[i] = (bf16_t)f2bf(ro == ri ? cv : (ro == 0 ? sv : -sv)); }
    bf16_t* mc = WSP(bf16_t, OFF_MC);
    for (size_t i = gt; i < (size_t)32 * 64 * 128; i += NT) { const int k = (int)(i & 127), tau2 = (int)(i >> 7) & 63, tau1 = (int)(i >> 13), ri = k >> 6, t2 = k & 63, tau = tau1 + 32 * tau2;
        const float a = (float)((t2 * tau) & 2047) * (1.0f / 1024.0f); mc[i] = (bf16_t)f2bf((ri ? sinpif(a) : cospif(a)) * (1.0f / 512.0f)); }
    bf16_t* csc = WSP(bf16_t, OFF_CSC);
    for (size_t i = gt; i < (size_t)256 * 512; i += NT) { const int tau = (int)(i >> 9), k = (int)(i & 511), t = k & 255; const int idx = (tau * t) & 255;
        const float a = (float)idx * (1.0f / 128.0f); const float v = (k < 256 ? cospif(a) : -sinpif(a)) * 0.005524271728019903f  ; csc[i] = (bf16_t)f2bf(v); }
    bf16_t* ft = WSP(bf16_t, OFF_FT);
    for (size_t i = gt; i < (size_t)256 * 128; i += NT) { const int kp = (int)(i >> 7), c = (int)(i & 127), kap = kp & 127; const int idx = (c * kap) & 127;
        const float a = (float)idx * (1.0f / 64.0f); ft[i] = (bf16_t)f2bf(kp < 128 ? cospif(a) : sinpif(a)); }
    float* binr = WSP(float, OFF_BINR);
    for (size_t i = gt; i < (size_t)DEPTH * NINP; i += NT) { const int l = (int)(i / NINP), j = (int)(i % NINP);
        float v = 0.f; if (j < 2048) v = p.b_in[(size_t)l * NIN + j]; else if (j < NP) v = p.b_in[(size_t)l * NIN + j + 16]; else if (j < NP + 16) v = p.b_in[(size_t)l * NIN + 2048 + (j - NP)];
        binr[i] = v; }

}
__device__ __forceinline__ void ph_mod(int wv, LAS unsigned char* lds, int l0, int l1, int widx, int nwg) {
    CParams& p = *okp();
    unsigned char* const wsb = ows(p.ws);
    const int TIDX = otid(wv), BIDX = obid(); (void)TIDX; (void)BIDX;
    typedef float sc_row_t[D]; typedef f32x4 red_t[5][16];
    LAS sc_row_t* sc = (LAS sc_row_t*)lds; LAS red_t* red = (LAS red_t*)(lds + 5 * D * 4);
    const int tid = TIDX;
    for (int i = tid; i < 5 * D; i += 512) { const int j = i / D, k = i % D; const float v = j < 4 ? p.c[(size_t)j * D + k] : p.c_ctx[k]; sc[j][k] = siluf_(v); }
    __syncthreads();
    float* mod = WSP(float, OFF_MOD);
    const int cl = tid & 15, kg = tid >> 4;
    for (int unit = widx; unit < (l1 - l0) * (6 * D / 64); unit += nwg) {
        const int l = l0 + unit / (6 * D / 64), n0 = (unit % (6 * D / 64)) * 64;
        f32x4 a[5];
#pragma unroll
        for (int j = 0; j < 5; ++j) a[j] = (f32x4){0.f, 0.f, 0.f, 0.f};
        const float* wp = p.w_mod + (size_t)l * D * 6 * D + n0 + 4 * cl;
        for (int k0 = kg; k0 < D; k0 += 32 * 8) { f32x4 w8[8];
#pragma unroll
            for (int i = 0; i < 8; ++i) w8[i] = *(const f32x4*)(wp + (size_t)(k0 + 32 * i) * 6 * D);
#pragma unroll
            for (int i = 0; i < 8; ++i)
#pragma unroll
                for (int j = 0; j < 5; ++j) a[j] += sc[j][k0 + 32 * i] * w8[i]; }
#pragma unroll
        for (int j = 0; j < 5; ++j) {
#pragma unroll
            for (int e = 0; e < 4; ++e) { float v = a[j][e]; v += shx(v, 16, tid & 63); v += shx(v, 32, tid & 63); a[j][e] = v; }
            if ((tid & 63) < 16) red[tid >> 6][j][cl] = a[j]; }
        __syncthreads();
        if (tid < 5 * 64) { const int j = tid / 64, cc = tid % 64; float s = 0.f;
            for (int g = 0; g < 8; ++g) s += ((const LAS float*)&red[g][j][0])[cc];
            mod[((size_t)l * 5 + j) * 6 * D + n0 + cc] = s + p.b_mod[(size_t)l * 6 * D + n0 + cc]; }
        __syncthreads();
    }
}

template <bool F32> __device__ __forceinline__ void ph_norm(int wv, int l, int which, const float* fixgate, int row_lo, int nrows, const void* hlat, const void* hctx) {
    CParams& p = *okp();
    unsigned char* const wsb = ows(p.ws);
    const int TIDX = otid(wv), BIDX = obid();
    const int lane = TIDX & 63, gw = BIDX * 8 + (TIDX >> 6), NGW = gridDim.x * 8;
    const float* nw = (which ? p.norm2_w : p.norm1_w) + (size_t)l * D;
    const float* mod = WSP(float, OFF_MOD) + (size_t)l * 5 * 6 * D;
    bf16_t* H = WSP(bf16_t, OFF_H); bf16_t* XN = WSP(bf16_t, OFF_XN); const float* SL = WSP(float, OFF_SLAB);
    for (int r = row_lo + gw; r < nrows; r += NGW) {
        int mj, t, T; rowinfo(r, mj, t, T);
        const unsigned so = (unsigned)(mj * 6 * D + (which ? 3 : 0) * D) * 4u;
        const unsigned ho = (unsigned)(r * D + 4 * lane) * 2u;
        const void* rd = r < RL ? hlat : hctx; const unsigned re = (unsigned)((r < RL ? r : r - RL) * D + 4 * lane);
        f32x4 v[8]; float ss = 0.f;
        if constexpr (F32) {
#pragma unroll
            for (int j = 0; j < 8; ++j) v[j] = gld<f32x4>(rd, re * 4u + (unsigned)j * 1024u);
        } else { u32x2 q[8];
#pragma unroll
            for (int j = 0; j < 8; ++j) q[j] = gld<u32x2>(rd, re * 2u + (unsigned)j * 512u);
#pragma unroll
            for (int j = 0; j < 8; ++j) { v[j][0] = __uint_as_float(q[j].x << 16); v[j][1] = __uint_as_float(q[j].x & 0xffff0000u); v[j][2] = __uint_as_float(q[j].y << 16); v[j][3] = __uint_as_float(q[j].y & 0xffff0000u); } }
#pragma unroll
        for (int j = 0; j < 8; ++j) ss += (v[j][0] * v[j][0] + v[j][1] * v[j][1]) + (v[j][2] * v[j][2] + v[j][3] * v[j][3]);
        const float rstd = rsqrtf(wave_sum(ss, lane) * (1.f / D) + EPS);
#pragma unroll
        for (int jh = 0; jh < 2; ++jh) { f32x4 wq[4], scq[4], shq[4];
#pragma unroll
          for (int jj = 0; jj < 4; ++jj) { const unsigned co = (unsigned)(4 * (lane + 64 * (4 * jh + jj))) * 4u; wq[jj] = gld<f32x4>(nw, co); scq[jj] = gld<f32x4>(mod, so + D * 4 + co); shq[jj] = gld<f32x4>(mod, so + co); }
#pragma unroll
          for (int jj = 0; jj < 4; ++jj) { const int j = 4 * jh + jj;
            const f32x4 y = (v[j] * rstd * wq[jj]) * (1.f + scq[jj]) + shq[jj];
            u32x2 q; q.x = pk2(y[0], y[1]); q.y = pk2(y[2], y[3]); gst<u32x2>(XN, (unsigned)(r * D + 4 * (lane + 64 * j)) * 2u, q); } }
    }
}
__device__ __forceinline__ void ph_norm_lat(int wv, int l, int which) {
    CParams& p = *okp();
    unsigned char* const wsb = ows(p.ws);
    const int TIDX = otid(wv), lane = TIDX & 63, gw = obid() * 8 + (TIDX >> 6), NGW = gridDim.x * 8;
    const float* nw = (which ? p.norm2_w : p.norm1_w) + (size_t)l * D;
    const float* mod = WSP(float, OFF_MOD) + (size_t)l * 5 * 6 * D;
    const bf16_t* H = WSP(bf16_t, OFF_H); bf16_t* XN = WSP(bf16_t, OFF_XN);
    for (int g = gw; g < RL / 4; g += NGW) {
        const int r0 = 4 * g; const unsigned so = (unsigned)((r0 >> 11) * 6 * D + (which ? 3 : 0) * D) * 4u;
        u32x2 q[4][8]; f32x4 wq[8], scq[8], shq[8];
#pragma unroll
        for (int k = 0; k < 4; ++k)
#pragma unroll
            for (int j = 0; j < 8; ++j) q[k][j] = gld<u32x2>(H, (unsigned)((r0 + k) * D + 4 * lane + 256 * j) * 2u);
#pragma unroll
        for (int j = 0; j < 8; ++j) { const unsigned co = (unsigned)(4 * lane + 256 * j) * 4u; wq[j] = gld<f32x4>(nw, co); scq[j] = gld<f32x4>(mod, so + D * 4 + co) + 1.f; shq[j] = gld<f32x4>(mod, so + co); }
#pragma unroll
        for (int j = 0; j < 8; ++j) wq[j] = wq[j] * scq[j];
#pragma unroll
        for (int k = 0; k < 4; ++k) { f32x4 v[8]; float ss = 0.f;
#pragma unroll
            for (int j = 0; j < 8; ++j) { v[j][0] = __uint_as_float(q[k][j].x << 16); v[j][1] = __uint_as_float(q[k][j].x & 0xffff0000u); v[j][2] = __uint_as_float(q[k][j].y << 16); v[j][3] = __uint_as_float(q[k][j].y & 0xffff0000u);
                ss += (v[j][0] * v[j][0] + v[j][1] * v[j][1]) + (v[j][2] * v[j][2] + v[j][3] * v[j][3]); }
            const float rstd = rsqrtf(wave_sum(ss, lane) * (1.f / D) + EPS);
#pragma unroll
            for (int j = 0; j < 8; ++j) { const f32x4 y = (v[j] * rstd) * wq[j] + shq[j];
                u32x2 o; o.x = pk2(y[0], y[1]); o.y = pk2(y[2], y[3]); gst<u32x2>(XN, (unsigned)((r0 + k) * D + 4 * lane + 256 * j) * 2u, o); } }
    }
}
template <bool F32> __device__ __forceinline__ void ph_norm_ctx(int wv, LAS unsigned char* lds, int l, int which) {
    CParams& p = *okp();
    unsigned char* const wsb = ows(p.ws);
    const int TIDX = otid(wv), lane = TIDX & 63, wave = wv, half = wave & 1;
    const float* nw = (which ? p.norm2_w : p.norm1_w) + (size_t)l * D;
    const float* mod = WSP(float, OFF_MOD) + (size_t)l * 5 * 6 * D;
    bf16_t* H = WSP(bf16_t, OFF_H); bf16_t* XN = WSP(bf16_t, OFF_XN); const float* SL = WSP(float, OFF_SLAB);
    const void* hctx = F32 ? (const void*)p.ctx : (const void*)(H + (size_t)RL * D);
    const float* fixgate = which ? mod + 4 * 6 * D + 2 * D : mod - 5 * 6 * D + 4 * 6 * D + 5 * D;
    LAS float* red = (LAS float*)lds;
    const unsigned so = (unsigned)(4 * 6 * D + (which ? 3 : 0) * D) * 4u;
    for (int rb = obid(); rb < RC / 4; rb += gridDim.x) {
        const int rc = 4 * rb + (wave >> 1), r = RL + rc;
        f32x4 v[4]; float ss = 0.f;
#pragma unroll
        for (int jp = 0; jp < 2; ++jp) { f32x4 sp[2][8], fg[2]; u32x2 q[2];
#pragma unroll
            for (int jj = 0; jj < 2; ++jj) { const int j = 4 * half + 2 * jp + jj; const unsigned e = (unsigned)(rc * D + 4 * lane + 256 * j);
                if constexpr (F32) v[2 * jp + jj] = gld<f32x4>(hctx, e * 4u); else q[jj] = gld<u32x2>(hctx, e * 2u);
#pragma unroll
                for (int sl = 0; sl < 8; ++sl) sp[jj][sl] = gld<f32x4>(SL, ((unsigned)(sl * RC) * D + e) * 4u);
                fg[jj] = gld<f32x4>(fixgate, (unsigned)(4 * lane + 256 * j) * 4u); }
#pragma unroll
            for (int jj = 0; jj < 2; ++jj) { const int j = 4 * half + 2 * jp + jj; f32x4& vv = v[2 * jp + jj];
                if constexpr (!F32) { vv[0] = __uint_as_float(q[jj].x << 16); vv[1] = __uint_as_float(q[jj].x & 0xffff0000u); vv[2] = __uint_as_float(q[jj].y << 16); vv[3] = __uint_as_float(q[jj].y & 0xffff0000u); }
                f32x4 a = sp[jj][0];
#pragma unroll
                for (int sl = 1; sl < 8; ++sl) a += sp[jj][sl];
                vv += fg[jj] * a;
                u32x2 hq; hq.x = pk2(vv[0], vv[1]); hq.y = pk2(vv[2], vv[3]); gst<u32x2>(H, (unsigned)(r * D + 4 * lane + 256 * j) * 2u, hq);
                ss += (vv[0] * vv[0] + vv[1] * vv[1]) + (vv[2] * vv[2] + vv[3] * vv[3]); } }
        f32x4 wq[4], scq[4], shq[4];
#pragma unroll
        for (int jj = 0; jj < 4; ++jj) { const unsigned co = (unsigned)(4 * lane + 256 * (4 * half + jj)) * 4u; wq[jj] = gld<f32x4>(nw, co); scq[jj] = gld<f32x4>(mod, so + D * 4 + co); shq[jj] = gld<f32x4>(mod, so + co); }
        ss = wave_sum(ss, lane);
        if (lane == 0) red[wave] = ss;
        __syncthreads();
        const float rstd = rsqrtf((red[wave & ~1] + red[wave | 1]) * (1.f / D) + EPS);
#pragma unroll
        for (int jj = 0; jj < 4; ++jj) { const int j = 4 * half + jj;
            const f32x4 y = (v[jj] * rstd * wq[jj]) * (1.f + scq[jj]) + shq[jj];
            u32x2 qq; qq.x = pk2(y[0], y[1]); qq.y = pk2(y[2], y[3]); gst<u32x2>(XN, (unsigned)(r * D + 4 * lane + 256 * j) * 2u, qq); }
        __syncthreads();
    }
}
__device__ __forceinline__ void ph_final(int wv) {
    CParams& p = *okp();
    unsigned char* const wsb = ows(p.ws);
    const int TIDX = otid(wv), BIDX = obid(); (void)TIDX; (void)BIDX;
    const int lane = TIDX & 63, gw = BIDX * 8 + (TIDX >> 6), NGW = gridDim.x * 8;
    const bf16_t* H = WSP(bf16_t, OFF_H);
    for (int r = gw; r < RL; r += NGW) {
        f32x4 v[8]; float ss = 0.f;
#pragma unroll
        for (int j = 0; j < 8; ++j) { const u32x2 q = gld<u32x2>(H, (unsigned)(r * D + 4 * (lane + 64 * j)) * 2u); v[j][0] = __uint_as_float(q.x << 16); v[j][1] = __uint_as_float(q.x & 0xffff0000u); v[j][2] = __uint_as_float(q.y << 16); v[j][3] = __uint_as_float(q.y & 0xffff0000u); ss += (v[j][0] * v[j][0] + v[j][1] * v[j][1]) + (v[j][2] * v[j][2] + v[j][3] * v[j][3]); }
        const float rstd = rsqrtf(wave_sum(ss, lane) * (1.f / D) + EPS);
        f32x4* o = (f32x4*)(p.out + (size_t)r * D) + lane;
#pragma unroll
        for (int j = 0; j < 8; ++j) { const f32x4 w = *(const f32x4*)(p.final_norm_w + 4 * (lane + 64 * j)); o[64 * j] = v[j] * rstd * w; }
    }
}

__device__ __forceinline__ float wave_incl_sum(float v, int lane) {
#pragma unroll
    for (int o = 1; o < 64; o <<= 1) { const float t = shl_(v, lane >= o ? lane - o : lane); if (lane >= o) v += t; }
    return v;
}
__device__ __forceinline__ float wave_incl_max(float v, int lane) {
#pragma unroll
    for (int o = 1; o < 64; o <<= 1) { const float t = shl_(v, lane >= o ? lane - o : lane); if (lane >= o) v = fmaxf(v, t); }
    return v;
}
__device__ __forceinline__ float logsigmoidf_(float x) { return fminf(x, 0.f) - log1pf(__expf(-fabsf(x))); }
struct GateV { float b0, b1, c0, c1, m0, m1, bend, cend; int s0, s1; };
__device__ __forceinline__ GateV gate_vectors(const float* G, int row0, int h, int dir, int lane) {
    GateV g; g.s0 = dir ? 127 - lane : lane; g.s1 = dir ? 63 - lane : lane + 64;
    const unsigned o0 = (unsigned)((row0 + g.s0) * 16 + dir * 8 + h) * 4u, o1 = (unsigned)((row0 + g.s1) * 16 + dir * 8 + h) * 4u;
    const float i0 = gld<float>(G, o0), f0 = gld<float>(G, o0 + 16), i1 = gld<float>(G, o1), f1 = gld<float>(G, o1 + 16);
    g.b0 = wave_incl_sum(logsigmoidf_(f0), lane); const float tot0 = shl_(g.b0, 63 + (lane & 0));
    g.b1 = wave_incl_sum(logsigmoidf_(f1), lane) + tot0;
    g.c0 = i0 - g.b0; g.c1 = i1 - g.b1;
    g.m0 = wave_incl_max(g.c0, lane); const float mx0 = shl_(g.m0, 63 + (lane & 0));
    g.m1 = fmaxf(wave_incl_max(g.c1, lane), mx0);
    g.bend = shl_(g.b1, 63 + (lane & 0)); g.cend = shl_(g.m1, 63 + (lane & 0));
    return g;
}
__device__ __forceinline__ void ph_convc(int wv, int l, int nrows, int widx, int nwg) {
    CParams& p = *okp();
    unsigned char* const wsb = ows(p.ws);
    const unsigned gt = (unsigned)widx * 512u + otid(wv), NT = (unsigned)nwg * 512u;
    const bf16_t* P = WSP(bf16_t, OFF_P); bf16_t* YC = WSP(bf16_t, OFF_HM) + (DM + DF);
    const float* wc = p.conv_c_w + (size_t)l * 3 * DC;
    for (unsigned i = gt; i < (unsigned)nrows * 64u; i += NT) {
        const int r = (int)(i >> 6), c = (int)(i & 63) * 8; int mj, t, T; rowinfo(r, mj, t, T);
        const unsigned pr = (unsigned)(r * NP) * 2u;
        const bool cp = r < RL ? (t & 63) > 0 : t > 0, cn = r < RL ? (t & 63) < 63 : t < T - 1;
        float x0[8], x1[8], y0[8], y1[8], z0[8], z1[8], cb[8], o[8];
        unpack8(gld<u32x4>(P, pr + (PCC + c) * 2), x0); unpack8(gld<u32x4>(P, pr + (PCX + c) * 2), x1); unpack8(gld<u32x4>(P, pr + (PCB + c) * 2), cb);
        const unsigned pp = cp ? pr - NP * 2 : pr, pn = cn ? pr + NP * 2 : pr;
        unpack8(gld<u32x4>(P, pp + (PCC + c) * 2), y0); unpack8(gld<u32x4>(P, pp + (PCX + c) * 2), y1);
        unpack8(gld<u32x4>(P, pn + (PCC + c) * 2), z0); unpack8(gld<u32x4>(P, pn + (PCX + c) * 2), z1);
        const f32x4 w00 = gld<f32x4>(wc, (unsigned)c * 4u), w01 = gld<f32x4>(wc, (unsigned)c * 4u + 16), w10 = gld<f32x4>(wc, (unsigned)(DC + c) * 4u), w11 = gld<f32x4>(wc, (unsigned)(DC + c) * 4u + 16),
                    w20 = gld<f32x4>(wc, (unsigned)(2 * DC + c) * 4u), w21 = gld<f32x4>(wc, (unsigned)(2 * DC + c) * 4u + 16);
#pragma unroll
        for (int j = 0; j < 8; ++j) { const float w0 = j < 4 ? w00[j & 3] : w01[j & 3], w1 = j < 4 ? w10[j & 3] : w11[j & 3], w2 = j < 4 ? w20[j & 3] : w21[j & 3];
            float v = w1 * (x0[j] * x1[j]); if (cp) v += w0 * (y0[j] * y1[j]); if (cn) v += w2 * (z0[j] * z1[j]); o[j] = cb[j] * v; }
        gst<u32x4>(YC, (unsigned)(r * D + c) * 2u, pack8(o));
    }
}
__device__ __forceinline__ void ph_fourier1(int wv, int widx, int nwg) {
    CParams& p = *okp();
    unsigned char* const wsb = ows(p.ws);
    const int TIDX = otid(wv), BIDX = obid(); (void)TIDX; (void)BIDX;
    const int lane = TIDX & 63, gw = widx * 8 + (TIDX >> 6), NGW = nwg * 8, fr = lane & 15, fq = lane >> 4;
    const bf16_t* P = WSP(bf16_t, OFF_P); const bf16_t* FT = WSP(bf16_t, OFF_FT);
    bf16_t* ZTC = WSP(bf16_t, OFF_ZTC);
    for (int task = gw; task < (RC / 32) * 4 * 8; task += NGW) {
        const int kb = task & 7, g = (task >> 3) & 3, rb = task >> 5, r0 = RL + rb * 32;
        f32x4 acc[2][2]; ZERO_ACC22(acc);
        wave_mm32<true, true>(P + (size_t)r0 * NP + PF + g * 128, NP, 1, FT + (size_t)(kb * 32) * 128, 1, 128, 128, acc, lane);
#pragma unroll
        for (int mi = 0; mi < 2; ++mi)
#pragma unroll
            for (int ni = 0; ni < 2; ++ni) {
                const int r = r0 + 16 * mi + 4 * fq, kp = kb * 32 + 16 * ni + fr, comp = kp >> 7, kap = kp & 127;
                u32x2 w; w.x = pk2(acc[mi][ni][0], acc[mi][ni][1]); w.y = pk2(acc[mi][ni][2], acc[mi][ni][3]);
                { const int q = r - RL, b = q >> 8, t = q & 255; *(u32x2*)(ZTC + (size_t)((b * 4 + g) * 128 + kap) * 512 + comp * 256 + t) = w; }
            }
    }
}
template <bool FIRST> __device__ __forceinline__ f32x4 mma16(bf16x8 a, bf16x8 b, f32x4 c) {
    if constexpr (FIRST) return __builtin_amdgcn_mfma_f32_16x16x32_bf16(a, b, (f32x4){0.f, 0.f, 0.f, 0.f}, 0, 0, 0);
    else return __builtin_amdgcn_mfma_f32_16x16x32_bf16(a, b, c, 0, 0, 0);
}
typedef short s16x4 __attribute__((ext_vector_type(4)));
constexpr int PIT_T = 544;
constexpr int PIT_R = 528;
constexpr int PIT_P = 272;
__device__ __forceinline__ bf16x8 tr_frag(LAS unsigned char* img, int pitchB, int r0, int c0, int lane) {
    const int g = lane >> 4, q = (lane & 15) >> 2, pp = lane & 3;
    LAS unsigned char* a = img + (r0 + 8 * g + q) * pitchB + (c0 + 4 * pp) * 2;
    const s16x4 lo = __builtin_amdgcn_ds_read_tr16_b64_v4i16((LAS s16x4*)a);
    const s16x4 hi = __builtin_amdgcn_ds_read_tr16_b64_v4i16((LAS s16x4*)(a + 4 * pitchB));
    return (bf16x8){lo[0], lo[1], lo[2], lo[3], hi[0], hi[1], hi[2], hi[3]};
}
template <class F> __device__ __forceinline__ void conv_silu_rows(const u32x4 (&raw)[10], const float (&w0)[8], const float (&w1)[8], const float (&w2)[8], F&& f) {
    float a[8], b[8], c[8];
    unpack8(raw[0], a); unpack8(raw[1], b);
#pragma unroll
    for (int i = 0; i < 8; ++i) {
        unpack8(raw[i + 2], c);
        float o[8];
#pragma unroll
        for (int j = 0; j < 8; ++j) o[j] = siluf_(w0[j] * a[j] + w1[j] * b[j] + w2[j] * c[j]);
        f(i, o);
#pragma unroll
        for (int j = 0; j < 8; ++j) { a[j] = b[j]; b[j] = c[j]; }
    }
}
constexpr int FPIT = 2336;
__device__ __forceinline__ void ph_fft(int wv, LAS unsigned char* lds, int u0, int ustride) {
    CParams& p = *okp();
    unsigned char* const wsb = ows(p.ws);
    const bf16_t* P = WSP(bf16_t, OFF_P); const bf16_t* FT = WSP(bf16_t, OFF_FT); const bf16_t* MA = WSP(bf16_t, OFF_MA); const bf16_t* MC = WSP(bf16_t, OFF_MC); bf16_t* HM = WSP(bf16_t, OFF_HM);
    LAS unsigned char* IMG = lds;
    const int wave = wv;
    for (int unit = u0; unit < NB * 4 * 8; unit += ustride) {
        const int kb = unit & 7, g = (unit >> 3) & 3, b = unit >> 5, kap0 = 16 * kb;
        {
            const int tid = otid(wv), lane = tid & 63, fr = lane & 15, fq = lane >> 4;
            bf16x8 fb[2][4];
#pragma unroll
            for (int ni = 0; ni < 2; ++ni)
#pragma unroll
                for (int ks = 0; ks < 4; ++ks) fb[ni][ks] = gld<bf16x8>(FT, (unsigned)((ni * 128 + kap0 + fr) * 128 + 32 * ks + 8 * fq) * 2u);
#pragma unroll 1
            for (int mi8 = 0; mi8 < 2; ++mi8) {
                bf16x8 xa[8][4];
#pragma unroll
                for (int m = 0; m < 8; ++m)
#pragma unroll
                    for (int ks = 0; ks < 4; ++ks) xa[m][ks] = gld<bf16x8>(P, (unsigned)((b * 2048 + 256 * wave + 16 * (8 * mi8 + m) + fr) * NP + PF + g * 128 + 32 * ks + 8 * fq) * 2u);
#pragma unroll
                for (int m = 0; m < 8; ++m) {
                    f32x4 zr = mma16<true>(xa[m][0], fb[0][0], zr), zi = mma16<true>(xa[m][0], fb[1][0], zi);
#pragma unroll
                    for (int ks = 1; ks < 4; ++ks) { zr = mma16<false>(xa[m][ks], fb[0][ks], zr); zi = mma16<false>(xa[m][ks], fb[1][ks], zi); }
                    const int tb = 256 * wave + 16 * (8 * mi8 + m) + 4 * fq, t1 = tb >> 6, t2 = tb & 63;
                    u32x2 wr_, wi_; wr_.x = pk2(zr[0], zr[1]); wr_.y = pk2(zr[2], zr[3]); wi_.x = pk2(-zi[0], -zi[1]); wi_.y = pk2(-zi[2], -zi[3]);
                    *(LAS u32x2*)(IMG + t1 * FPIT + fr * 144 + t2 * 2) = wr_;
                    *(LAS u32x2*)(IMG + (32 + t1) * FPIT + fr * 144 + t2 * 2) = wi_;
                }
            }
        }
        __syncthreads();
        {
            const int tid = otid(wv), lane = tid & 63, fr = lane & 15, fq = lane >> 4;
            bf16x8 ya[4][2];
#pragma unroll
            for (int mt = 0; mt < 4; ++mt)
#pragma unroll
                for (int ks = 0; ks < 2; ++ks) ya[mt][ks] = gld<bf16x8>(MA, (unsigned)((16 * mt + fr) * 64 + 32 * ks + 8 * fq) * 2u);
#pragma unroll 2
            for (int j = 0; j < 8; ++j) {
                const int grp = 8 * wave + j, c0 = (grp >> 2) * 72 + (grp & 3) * 16;
                const bf16x8 x0 = tr_frag(IMG, FPIT, 0, c0, lane), x1 = tr_frag(IMG, FPIT, 32, c0, lane);
                f32x4 d[4];
#pragma unroll
                for (int mt = 0; mt < 4; ++mt) { d[mt] = mma16<true>(x0, ya[mt][0], d[mt]); d[mt] = mma16<false>(x1, ya[mt][1], d[mt]); }
#pragma unroll
                for (int mt = 0; mt < 4; ++mt) { u32x2 w; w.x = pk2(d[mt][0], d[mt][1]); w.y = pk2(d[mt][2], d[mt][3]);
                    *(LAS u32x2*)(IMG + (16 * mt + fr) * FPIT + (c0 + 4 * fq) * 2) = w; }
            }
        }
        __syncthreads();
        {
            const int tid = otid(wv), lane = tid & 63, fr = lane & 15, fq = lane >> 4;
            bf16x8 y[4][4];
#pragma unroll
            for (int mt = 0; mt < 4; ++mt)
#pragma unroll
                for (int ks = 0; ks < 4; ++ks) y[mt][ks] = gld<bf16x8>(MC, (unsigned)((4 * wave * 64 + 16 * mt + fr) * 128 + 32 * ks + 8 * fq) * 2u);
#pragma unroll 1
            for (int q = 0; q < 4; ++q) {
                const int tau1 = 4 * wave + q, tn = q < 3 ? tau1 + 1 : tau1;
                bf16x8 yn[4][4];
#pragma unroll
                for (int mt = 0; mt < 4; ++mt)
#pragma unroll
                    for (int ks = 0; ks < 4; ++ks) yn[mt][ks] = gld<bf16x8>(MC, (unsigned)((tn * 64 + 16 * mt + fr) * 128 + 32 * ks + 8 * fq) * 2u);
                f32x4 acc[4];
#pragma unroll
                for (int ks = 0; ks < 4; ++ks) { const bf16x8 x = *(const LAS bf16x8*)(IMG + ((ks >> 1) * 32 + tau1) * FPIT + fr * 144 + (32 * (ks & 1) + 8 * fq) * 2);
#pragma unroll
                    for (int mt = 0; mt < 4; ++mt) { if (ks == 0) acc[mt] = mma16<true>(x, y[mt][ks], acc[mt]); else acc[mt] = mma16<false>(x, y[mt][ks], acc[mt]); } }
#pragma unroll
                for (int mt = 0; mt < 4; ++mt) { const int tau = tau1 + 32 * (16 * mt + fr);
                    u32x2 w; w.x = pk2(acc[mt][0], acc[mt][1]); w.y = pk2(acc[mt][2], acc[mt][3]);
                    gst<u32x2>(HM, (unsigned)((b * 2048 + tau) * D + DM + g * 128 + kap0 + 4 * fq) * 2u, w); }
#pragma unroll
                for (int mt = 0; mt < 4; ++mt)
#pragma unroll
                    for (int ks = 0; ks < 4; ++ks) y[mt][ks] = yn[mt][ks];
            }
        }
        __syncthreads();
    }
}
__device__ __forceinline__ void ph_mlstm1(int wv, int l, LAS unsigned char* lds) {
    CParams& p = *okp();
    unsigned char* const wsb = ows(p.ws);
    const int wave = wv;
    LAS unsigned char* KWs = lds; LAS unsigned char* Vs = lds + 128 * PIT_T; LAS float* vW = (LAS float*)(lds + 2 * 128 * PIT_T);
    const bf16_t* P = WSP(bf16_t, OFF_P); const float* G = WSP(float, OFF_G);
    bf16_t* UT = WSP(bf16_t, OFF_UT); float* NV = WSP(float, OFF_NV); float* CHS = WSP(float, OFF_CHS);
    const float* wk = p.conv_k_w + (size_t)l * 3 * DM;
    for (int unit = obid(); unit < NCHUNK * NH * 2; unit += gridDim.x) {
        const int tid = otid(wv), lane = tid & 63, fr = lane & 15, fq = lane >> 4, dg = tid & 31, sg = tid >> 5;
        const int dir = unit & 1, h = (unit >> 1) & 3, cidx = unit >> 3, row0 = chunk_row0(cidx);
        const bool first = cidx < 64 ? (cidx & 15) == 0 : ((cidx - 64) & 1) == 0, last = cidx < 64 ? (cidx & 15) == 15 : ((cidx - 64) & 1) == 1;
        const bf16_t* kp = P + (size_t)(row0 + 8 * sg) * NP + PK + h * DH + 8 * dg;
        u32x4 kr[10], vr[8];
#pragma unroll
        for (int i = 0; i < 10; ++i) { const int s = 8 * sg - 1 + i; const bool ok = (s >= 0 || !first) && (s < CHUNK || !last);
            kr[i] = ok ? *(const u32x4*)(kp + (ptrdiff_t)(i - 1) * NP) : (u32x4){0u, 0u, 0u, 0u}; }
#pragma unroll
        for (int i = 0; i < 8; ++i) vr[i] = *(const u32x4*)(kp + (PV - PK) + (size_t)i * NP);
        float w0[8], w1[8], w2[8];
#pragma unroll
        for (int j = 0; j < 8; ++j) { w0[j] = wk[h * DH + 8 * dg + j]; w1[j] = wk[DM + h * DH + 8 * dg + j]; w2[j] = wk[2 * DM + h * DH + 8 * dg + j]; }
        if (wave == 0)     { const GateV g = gate_vectors(G, row0, h, dir, lane); vW[g.s0] = __expf(g.c0 - g.cend); vW[g.s1] = __expf(g.c1 - g.cend);
            if (lane == 0) { CHS[(size_t)(cidx * 8 + dir * 4 + h) * 2] = g.bend; CHS[(size_t)(cidx * 8 + dir * 4 + h) * 2 + 1] = g.bend + g.cend; } }
        __syncthreads();
        conv_silu_rows(kr, w0, w1, w2, [&](int i, float (&o)[8]) { const float ws = vW[8 * sg + i];
#pragma unroll
            for (int j = 0; j < 8; ++j) o[j] *= ws;
            *(LAS u32x4*)(KWs + (8 * sg + i) * PIT_T + dg * 16) = pack8(o); });
#pragma unroll
        for (int i = 0; i < 8; ++i) *(LAS u32x4*)(Vs + (8 * sg + i) * PIT_T + dg * 16) = vr[i];
        __syncthreads();
        f32x4 acc[2][16];
        auto kstep1 = [&](int k0, auto first) {
            bf16x8 fv[2];
#pragma unroll
            for (int mi = 0; mi < 2; ++mi) fv[mi] = tr_frag(Vs, PIT_T, k0, 32 * wave + 16 * mi, lane);
#pragma unroll
            for (int ni = 0; ni < 16; ++ni) { const bf16x8 fk = tr_frag(KWs, PIT_T, k0, 16 * ni, lane);
#pragma unroll
                for (int mi = 0; mi < 2; ++mi) acc[mi][ni] = mma16<decltype(first)::value>(fk, fv[mi], acc[mi][ni]); }
        };
        kstep1(0, std::true_type{});
#pragma unroll 1
        for (int k0 = 32; k0 < CHUNK; k0 += 32) kstep1(k0, std::false_type{});
        bf16_t* out = UT + ((size_t)(cidx * NH + h) * 2 + dir) * DH * DH;
#pragma unroll
        for (int mi = 0; mi < 2; ++mi)
#pragma unroll
            for (int ni = 0; ni < 16; ++ni) { u32x2 w; w.x = pk2(acc[mi][ni][0], acc[mi][ni][1]); w.y = pk2(acc[mi][ni][2], acc[mi][ni][3]);
                *(u32x2*)(out + (size_t)(32 * wave + 16 * mi + fr) * DH + 16 * ni + 4 * fq) = w; }
        if (tid < DH) { float sum = 0.f;
#pragma unroll 8
            for (int s2 = 0; s2 < CHUNK; ++s2) sum += bf2f(*(const LAS bf16_t*)(KWs + s2 * PIT_T + tid * 2));
            NV[((size_t)(cidx * NH + h) * 2 + dir) * DH + tid] = sum; }
        __syncthreads();
    }
}
__device__ __forceinline__ void ph_mlstm2(int wv) {
    CParams& p = *okp();
    unsigned char* const wsb = ows(p.ws);
    const int tid = otid(wv);
    const bf16_t* UT = WSP(bf16_t, OFF_UT); bf16_t* CT = WSP(bf16_t, OFF_CT);
    const float *NV = WSP(float, OFF_NV), *CHS = WSP(float, OFF_CHS); float *NS = WSP(float, OFF_NS), *MST = WSP(float, OFF_MST);
    for (int task = obid(); task < NB * NH * 2 * 16; task += gridDim.x) {
        const int part = task & 15, scan = task >> 4, dir = scan & 1, h = (scan >> 1) & 3, b = scan >> 3, dh = dir * 4 + h;
        const unsigned e0 = (unsigned)(part * 4096 + olaunder(tid) * 8) * 2u;
        u32x4 u[18];
#pragma unroll
        for (int step = 0; step < 18; ++step) { const int cidx = scan_chunk(b, dir, step); u[step] = gld<u32x4>(UT, (unsigned)(((cidx * NH + h) * 2 + dir) * DH * DH) * 2u + e0); }
        float cb[18], cm[18];
#pragma unroll
        for (int step = 0; step < 18; ++step) { const int cidx = scan_chunk(b, dir, step); const f32x2 cc = gld<f32x2>(CHS, (unsigned)((cidx * 8 + dh) * 2) * 4u); cb[step] = cc[0]; cm[step] = cc[1]; }
        float C[8], m = 0.f;
        { const f32x4 z0 = zero4(), z1 = zero4();
#pragma unroll
          for (int j = 0; j < 4; ++j) { C[j] = z0[j]; C[4 + j] = z1[j]; } }
#pragma unroll
        for (int step = 0; step < 18; ++step) {
            const int cidx = scan_chunk(b, dir, step);
            gst<u32x4>(CT, (unsigned)(((cidx * NH + h) * 2 + dir) * DH * DH) * 2u + e0, pack8(C));
            const float bend = cb[step], mloc = cm[step];
            const float mn = fmaxf(bend + m, mloc), al = __expf(bend + m - mn), be = __expf(mloc - mn);
            float uu[8]; unpack8(u[step], uu);
#pragma unroll
            for (int j = 0; j < 8; ++j) C[j] = al * C[j] + be * uu[j];
            m = mn;
        }
        if (part == 0 && tid < DH) {
            float n = 0.f; m = 0.f;
            float nv[18];
#pragma unroll
            for (int step = 0; step < 18; ++step) { const int cidx = scan_chunk(b, dir, step); nv[step] = gld<float>(NV, (unsigned)(((cidx * NH + h) * 2 + dir) * DH + tid) * 4u); }
#pragma unroll
            for (int step = 0; step < 18; ++step) {
                const int cidx = scan_chunk(b, dir, step); const unsigned base = (unsigned)(((cidx * NH + h) * 2 + dir) * DH + tid) * 4u;
                gst<float>(NS, base, n); if (tid == 0) MST[cidx * 8 + dh] = m;
                const float bend = cb[step], mloc = cm[step];
                const float mn = fmaxf(bend + m, mloc), al = __expf(bend + m - mn), be = __expf(mloc - mn);
                n = al * n + be * nv[step]; m = mn;
            }
        }
    }
}
#define SECTION_LANES() const int tid = otid(wv), lane = tid & 63, fr = lane & 15, fq = lane >> 4; (void)fr; (void)fq; __builtin_amdgcn_sched_barrier(0)
__device__ __forceinline__ void ph_mlstm3(int wv, int l, LAS unsigned char* lds, int nunits) {
    CParams& p = *okp();
    unsigned char* const wsb = ows(p.ws);
    const int wave = wv;
    LAS unsigned char* Qs = lds;
    LAS unsigned char* Ks = lds + 128 * PIT_T;
    LAS unsigned char* Vs = Qs; LAS unsigned char* Ps = Ks;
    LAS float* vec = (LAS float*)(lds + 2 * 128 * PIT_T);
    LAS float *vB = vec, *vC = vec + 256, *vM = vec + 512, *nS = vec + 768, *rS = vec + 1280, *ssq = vec + 1536;
    const bf16_t* P = WSP(bf16_t, OFF_P); const float* G = WSP(float, OFF_G); const bf16_t* CT = WSP(bf16_t, OFF_CT);
    const float *NS = WSP(float, OFF_NS), *MST = WSP(float, OFF_MST); bf16_t* HM = WSP(bf16_t, OFF_HM);
    const float *wk = p.conv_k_w + (size_t)l * 3 * DM, *wq = p.conv_q_w + (size_t)l * 3 * DM, *nw = p.mlstm_norm_w + (size_t)l * DM;
    for (int unit = obid(); unit < nunits; unit += gridDim.x) {
        const int h = unit & 3, cidx = unit >> 2, row0 = chunk_row0(cidx);
        const bool first = cidx < 64 ? (cidx & 15) == 0 : ((cidx - 64) & 1) == 0, last = cidx < 64 ? (cidx & 15) == 15 : ((cidx - 64) & 1) == 1;
        {
            SECTION_LANES(); const int dg = tid & 31, sg = tid >> 5;
            nS[tid] = gld<float>(NS, (unsigned)((cidx * NH + h) * 2 * DH + tid) * 4u);
            const unsigned kp = (unsigned)((row0 + 8 * sg - 1) * NP + PK + h * DH + 8 * dg) * 2u;
            u32x4 raw[10], rawq[10]; float w0[8], w1[8], w2[8];
#pragma unroll
            for (int i = 0; i < 10; ++i) { const int s = 8 * sg - 1 + i; const bool ok = (s >= 0 || !first) && (s < CHUNK || !last);
                raw[i] = gld<u32x4>(P, ok ? kp + (unsigned)i * (NP * 2) : kp + (unsigned)(NP * 2)); if (!ok) raw[i] = (u32x4){0u, 0u, 0u, 0u}; }
#pragma unroll
            for (int i = 0; i < 10; ++i) { const int s = 8 * sg - 1 + i; const bool ok = (s >= 0 || !first) && (s < CHUNK || !last);
                rawq[i] = gld<u32x4>(P, (ok ? kp + (unsigned)i * (NP * 2) : kp + (unsigned)(NP * 2)) + (PQ - PK) * 2); if (!ok) rawq[i] = (u32x4){0u, 0u, 0u, 0u}; }
            { const unsigned wo = (unsigned)(h * DH + 8 * dg) * 4u;
              const f32x4 a0 = gld<f32x4>(wk, wo), a1 = gld<f32x4>(wk, wo + 16), b0 = gld<f32x4>(wk, wo + DM * 4), b1 = gld<f32x4>(wk, wo + DM * 4 + 16), c0 = gld<f32x4>(wk, wo + 2 * DM * 4), c1 = gld<f32x4>(wk, wo + 2 * DM * 4 + 16);
#pragma unroll
              for (int j = 0; j < 4; ++j) { w0[j] = a0[j]; w0[4 + j] = a1[j]; w1[j] = b0[j]; w1[4 + j] = b1[j]; w2[j] = c0[j]; w2[4 + j] = c1[j]; } }
            if (wave < 2) { const GateV g = gate_vectors(G, row0, h, wave, lane);
                vB[wave * 128 + g.s0] = g.b0; vB[wave * 128 + g.s1] = g.b1; vC[wave * 128 + g.s0] = g.c0; vC[wave * 128 + g.s1] = g.c1; vM[wave * 128 + g.s0] = g.m0; vM[wave * 128 + g.s1] = g.m1; }
            conv_silu_rows(raw, w0, w1, w2, [&](int i, float (&o)[8]) { *(LAS u32x4*)(Ks + (8 * sg + i) * PIT_R + dg * 16) = pack8(o); });
            { const unsigned wo = (unsigned)(h * DH + 8 * dg) * 4u;
              const f32x4 a0 = gld<f32x4>(wq, wo), a1 = gld<f32x4>(wq, wo + 16), b0 = gld<f32x4>(wq, wo + DM * 4), b1 = gld<f32x4>(wq, wo + DM * 4 + 16), c0 = gld<f32x4>(wq, wo + 2 * DM * 4), c1 = gld<f32x4>(wq, wo + 2 * DM * 4 + 16);
#pragma unroll
              for (int j = 0; j < 4; ++j) { w0[j] = a0[j]; w0[4 + j] = a1[j]; w1[j] = b0[j]; w1[4 + j] = b1[j]; w2[j] = c0[j]; w2[4 + j] = c1[j]; } }
            conv_silu_rows(rawq, w0, w1, w2, [&](int i, float (&o)[8]) {
#pragma unroll
                for (int j = 0; j < 8; ++j) o[j] *= 0.0625f;
                *(LAS u32x4*)(Qs + (8 * sg + i) * PIT_R + dg * 16) = pack8(o); });
        }
        __syncthreads();
        {
            SECTION_LANES();
            f32x4 sacc[8];
            auto kstepS = [&](int k0, auto first) {
                const bf16x8 yq = *(const LAS bf16x8*)(Qs + (16 * wave + fr) * PIT_R + (k0 + 8 * fq) * 2);
#pragma unroll
                for (int ni = 0; ni < 8; ++ni) { const bf16x8 xk = *(const LAS bf16x8*)(Ks + (16 * ni + fr) * PIT_R + (k0 + 8 * fq) * 2);
                    sacc[ni] = mma16<decltype(first)::value>(xk, yq, sacc[ni]); }
            };
            kstepS(0, std::true_type{});
#pragma unroll 1
            for (int k0 = 32; k0 < DH; k0 += 32) kstepS(k0, std::false_type{});
            const int t = 16 * wave + fr;
            const float mF = gld<float>(MST, (unsigned)(cidx * 8 + h) * 4u), mB = gld<float>(MST, (unsigned)(cidx * 8 + 4 + h) * 4u);
            const float MF = fmaxf(mF, vM[t]), MB = fmaxf(mB, vM[128 + t]);
            const float gF = __expf(mF - MF), gB = __expf(mB - MB);
            const float flF = __expf(-(vB[t] + MF)), flB = __expf(-(vB[128 + t] + MB));
            float qnF = 0.f, qnB = 0.f;
#pragma unroll
            for (int c8 = 0; c8 < 8; ++c8) { float q8[8]; unpack8(*(const LAS u32x4*)(Qs + t * PIT_R + (64 * fq + 8 * c8) * 2), q8);
                const f32x4 a0 = *(const LAS f32x4*)(nS + 64 * fq + 8 * c8), a1 = *(const LAS f32x4*)(nS + 64 * fq + 8 * c8 + 4);
                const f32x4 b0 = *(const LAS f32x4*)(nS + 256 + 64 * fq + 8 * c8), b1 = *(const LAS f32x4*)(nS + 256 + 64 * fq + 8 * c8 + 4);
#pragma unroll
                for (int j = 0; j < 4; ++j) { qnF += q8[j] * a0[j] + q8[4 + j] * a1[j]; qnB += q8[j] * b0[j] + q8[4 + j] * b1[j]; } }
            qnF += shx(qnF, 16, lane); qnF += shx(qnF, 32, lane); qnB += shx(qnB, 16, lane); qnB += shx(qnB, 32, lane);
            float sF = 0.f, sB = 0.f;
#pragma unroll
            for (int ni = 0; ni < 8; ++ni) { const f32x4 cF = *(const LAS f32x4*)(vC + 16 * ni + 4 * fq), cB = *(const LAS f32x4*)(vC + 128 + 16 * ni + 4 * fq);
#pragma unroll
                for (int rg = 0; rg < 4; ++rg) { const int s = 16 * ni + 4 * fq + rg;
                    sF += s <= t ? sacc[ni][rg] * __expf(cF[rg] - MF) : 0.f; sB += s >= t ? sacc[ni][rg] * __expf(cB[rg] - MB) : 0.f; }
                asm volatile("" : "+v"(sF), "+v"(sB)); }
            sF += shx(sF, 16, lane); sF += shx(sF, 32, lane); sB += shx(sB, 16, lane); sB += shx(sB, 32, lane);
            const float iF = 1.f / fmaxf(fabsf(gF * qnF + sF), flF), iB = 1.f / fmaxf(fabsf(gB * qnB + sB), flB);
            __syncthreads();
#pragma unroll
            for (int ni = 0; ni < 8; ++ni) { const f32x4 cF = *(const LAS f32x4*)(vC + 16 * ni + 4 * fq), cB = *(const LAS f32x4*)(vC + 128 + 16 * ni + 4 * fq);
                float pc[4];
#pragma unroll
                for (int rg = 0; rg < 4; ++rg) { const int s = 16 * ni + 4 * fq + rg;
                    pc[rg] = (s <= t ? sacc[ni][rg] * __expf(cF[rg] - MF) * iF : 0.f) + (s >= t ? sacc[ni][rg] * __expf(cB[rg] - MB) * iB : 0.f); }
                u32x2 w; w.x = pk2(pc[0], pc[1]); w.y = pk2(pc[2], pc[3]);
                *(LAS u32x2*)(Ps + t * PIT_P + (16 * ni + 4 * fq) * 2) = w; }
            if (fq == 0) { rS[t] = gF * iF; rS[128 + t] = gB * iB; }
        }
        __syncthreads();
        f32x4 tot[2][8];
        u32x4 vr[8];
        {
            SECTION_LANES();
#pragma unroll
            for (int ni = 0; ni < 2; ++ni) {
                if (ni == 1) { const int s8 = lane & 15, vq = lane >> 4; const unsigned vp = (unsigned)((row0 + 8 * s8) * NP + PV + h * DH + 32 * wave + 8 * vq) * 2u;
#pragma unroll
                    for (int i = 0; i < 8; ++i) vr[i] = gld<u32x4>(P, vp + (unsigned)i * (NP * 2)); }
                f32x4 a1[8];
                const unsigned ctf = (unsigned)((cidx * NH + h) * 2 * DH * DH + (32 * wave + 16 * ni + fr) * DH + 8 * fq) * 2u;
                bf16x8 xf = gld<bf16x8>(CT, ctf), xb = gld<bf16x8>(CT, ctf + (unsigned)(DH * DH) * 2u);
                bf16x8 xf1 = gld<bf16x8>(CT, ctf + 64u), xb1 = gld<bf16x8>(CT, ctf + (unsigned)(DH * DH) * 2u + 64u);
                auto kstepQ = [&](int k0, auto first) {
                    const unsigned kn = (unsigned)(k0 + 64 < DH ? k0 + 64 : DH - 32);
                    const bf16x8 xfn = gld<bf16x8>(CT, ctf + kn * 2u), xbn = gld<bf16x8>(CT, ctf + (unsigned)(DH * DH) * 2u + kn * 2u);
#pragma unroll
                    for (int mi = 0; mi < 8; ++mi) { const bf16x8 yq = *(const LAS bf16x8*)(Qs + (16 * mi + fr) * PIT_R + (k0 + 8 * fq) * 2);
                        tot[ni][mi] = mma16<decltype(first)::value>(xf, yq, tot[ni][mi]);
                        a1[mi] = mma16<decltype(first)::value>(xb, yq, a1[mi]); }
                    xf = xf1; xb = xb1; xf1 = xfn; xb1 = xbn;
                };
                kstepQ(0, std::true_type{});
#pragma unroll 1
                for (int k0 = 32; k0 < DH; k0 += 32) kstepQ(k0, std::false_type{});
#pragma unroll
                for (int mi = 0; mi < 8; ++mi) { const float rf = rS[16 * mi + fr], rb = rS[128 + 16 * mi + fr]; tot[ni][mi] = rf * tot[ni][mi] + rb * a1[mi]; }
            }
        }
        __syncthreads();
        u32x2 og[8][2]; f32x4 gw[2];
        {
            SECTION_LANES();
            { const int s8 = lane & 15, vq = lane >> 4;
#pragma unroll
              for (int i = 0; i < 8; ++i) *(LAS u32x4*)(Vs + (8 * s8 + i) * PIT_T + (32 * wave + 8 * vq) * 2) = vr[i]; }
            asm volatile("s_waitcnt lgkmcnt(0)" ::: "memory");
#pragma unroll
            for (int mi = 0; mi < 8; ++mi)
#pragma unroll
                for (int ni = 0; ni < 2; ++ni) og[mi][ni] = gld<u32x2>(P, (unsigned)((row0 + 16 * mi + fr) * NP + PO + h * DH + 32 * wave + 16 * ni + 4 * fq) * 2u);
#pragma unroll
            for (int ni = 0; ni < 2; ++ni) gw[ni] = gld<f32x4>(nw, (unsigned)(h * DH + 32 * wave + 16 * ni + 4 * fq) * 4u);
#pragma unroll 1
            for (int k0 = 0; k0 < CHUNK; k0 += 32) {
                bf16x8 xv[2];
#pragma unroll
                for (int ni = 0; ni < 2; ++ni) xv[ni] = tr_frag(Vs, PIT_T, k0, 32 * wave + 16 * ni, lane);
#pragma unroll
                for (int mi = 0; mi < 8; ++mi) { const bf16x8 yp = *(const LAS bf16x8*)(Ps + (16 * mi + fr) * PIT_P + (k0 + 8 * fq) * 2);
#pragma unroll
                    for (int ni = 0; ni < 2; ++ni) tot[ni][mi] = __builtin_amdgcn_mfma_f32_16x16x32_bf16(xv[ni], yp, tot[ni][mi], 0, 0, 0); }
            }
        }
        {
            SECTION_LANES();
#pragma unroll
            for (int mi = 0; mi < 8; ++mi) { float ss = 0.f;
#pragma unroll
                for (int ni = 0; ni < 2; ++ni) ss += (tot[ni][mi][0] * tot[ni][mi][0] + tot[ni][mi][1] * tot[ni][mi][1]) + (tot[ni][mi][2] * tot[ni][mi][2] + tot[ni][mi][3] * tot[ni][mi][3]);
                ss += shx(ss, 16, lane); ss += shx(ss, 32, lane);
                if (fq == 0) ssq[wave * 128 + 16 * mi + fr] = ss; }
            __syncthreads();
#pragma unroll
            for (int mi = 0; mi < 8; ++mi) { const int tt = 16 * mi + fr; float ss = 0.f;
#pragma unroll
                for (int w8 = 0; w8 < 8; ++w8) ss += ssq[w8 * 128 + tt];
                const float rstd = rsqrtf(ss * (1.f / DH) + EPS);
#pragma unroll
                for (int ni = 0; ni < 2; ++ni) { const int vd = 32 * wave + 16 * ni + 4 * fq;
                    const u32x2 ow = og[mi][ni]; const f32x4 w4 = gw[ni];
                    const float o0 = __uint_as_float(ow.x << 16), o1 = __uint_as_float(ow.x & 0xffff0000u), o2 = __uint_as_float(ow.y << 16), o3 = __uint_as_float(ow.y & 0xffff0000u);
                    u32x2 q; q.x = pk2(sigmoidf_(o0) * (tot[ni][mi][0] * rstd * w4[0]), sigmoidf_(o1) * (tot[ni][mi][1] * rstd * w4[1]));
                    q.y = pk2(sigmoidf_(o2) * (tot[ni][mi][2] * rstd * w4[2]), sigmoidf_(o3) * (tot[ni][mi][3] * rstd * w4[3]));
                    gst<u32x2>(HM, (unsigned)((row0 + tt) * D + h * DH + vd) * 2u, q); }
            }
        }
        __syncthreads();
    }
}
__device__ __forceinline__ void ph_ffnact(int wv, int l) {
    CParams& p = *okp();
    unsigned char* const wsb = ows(p.ws);
    const int TIDX = otid(wv), BIDX = obid();
    const unsigned gt = (unsigned)BIDX * 512u + TIDX, NT = gridDim.x * 512u;
    const bf16_t* U = WSP(bf16_t, OFF_P); bf16_t* ACT = WSP(bf16_t, OFF_ACT); const float* SL = WSP(float, OFF_SLAB);
    const float* wf = p.conv_ff_w + (size_t)l * 3 * DFF;
    auto ldu = [&](int r, int col, float (&o)[8]) {
        if (col >= 32 * 256) { f32x4 g0 = {0.f, 0.f, 0.f, 0.f}, g1 = {0.f, 0.f, 0.f, 0.f};
#pragma unroll
            for (int sl = 0; sl < 4; ++sl) { const unsigned o4 = (unsigned)((sl * RC + (r - RL)) * NUP + col) * 4u; g0 += gld<f32x4>(SL, o4); g1 += gld<f32x4>(SL, o4 + 16); }
#pragma unroll
            for (int j = 0; j < 4; ++j) { o[j] = g0[j]; o[4 + j] = g1[j]; } }
        else unpack8(gld<u32x4>(U, (unsigned)(r * NUP + col) * 2u), o);
    };
    struct Item { float a0[8], a1[8], a2[8], g[8]; f32x4 w[6]; int r, c; bool hp, hn; };
    auto load_item = [&](unsigned i, Item& it) {
        it.r = RL + (int)(i / (DFF / 8)); it.c = (int)(i % (DFF / 8)) * 8; const int t = (it.r - RL) & (CTX - 1), ca = 256 * (it.c >> 7) + (it.c & 127);
        it.hp = t > 0; it.hn = t < CTX - 1;
        ldu(it.r, ca, it.a1); ldu(it.r, ca + 128, it.g); ldu(it.hp ? it.r - 1 : it.r, ca, it.a0); ldu(it.hn ? it.r + 1 : it.r, ca, it.a2);
#pragma unroll
        for (int k = 0; k < 3; ++k) { it.w[2 * k] = gld<f32x4>(wf, (unsigned)(k * DFF + it.c) * 4u); it.w[2 * k + 1] = gld<f32x4>(wf, (unsigned)(k * DFF + it.c) * 4u + 16); } };
    auto finish_item = [&](const Item& it) { float o[8];
#pragma unroll
        for (int j = 0; j < 8; ++j) { const float w0 = it.w[j >> 2][j & 3], w1 = it.w[2 + (j >> 2)][j & 3], w2 = it.w[4 + (j >> 2)][j & 3];
            float v = w1 * it.a1[j]; if (it.hp) v += w0 * it.a0[j]; if (it.hn) v += w2 * it.a2[j]; o[j] = siluf_(v) * it.g[j]; }
        gst<u32x4>(ACT, (unsigned)(it.r * DFF + it.c) * 2u, pack8(o)); };
    for (unsigned i = gt; i < (unsigned)RC * (DFF / 8); i += 2 * NT) {
        const bool two = i + NT < (unsigned)RC * (DFF / 8);
        Item A, B; load_item(i, A); if (two) load_item(i + NT, B);
        finish_item(A); if (two) finish_item(B);
    }
}

#define XB_TMO      128
#define XB_XCNT(j)  (256  + 64 * (j))
#define XB_XSUB(j)  (1280 + 64 * (j))
#define XB_XGEN(j)  (2304 + 64 * (j))
#define XB_TOP      3328
#define XB_TOPGEN   3392
#define XCD_BAR_WORDS 3456
#define XB_SPIN_CAP (1u << 18)
__device__ __forceinline__ unsigned xb_ld(unsigned* p)              { return __hip_atomic_load(p, __ATOMIC_RELAXED, __HIP_MEMORY_SCOPE_AGENT); }
__device__ __forceinline__ unsigned xb_add(unsigned* p, unsigned v) { return __hip_atomic_fetch_add(p, v, __ATOMIC_RELAXED, __HIP_MEMORY_SCOPE_AGENT); }
__device__ __forceinline__ unsigned xb_xcc_id() { return (unsigned)__builtin_amdgcn_s_getreg((3 << 11) | 20) & 0xFu; }
#define XB_SPIN(cond, bar) do { unsigned _sp = 0; while (cond) { __builtin_amdgcn_s_sleep(1); \
    if ((++_sp & 255u) == 0u) { if (xb_ld(&(bar)[XB_TMO])) break; if (_sp > XB_SPIN_CAP) { atomicAdd(&(bar)[XB_TMO], 1u); break; } } } } while (0)
struct XcdBarrier { unsigned* bar; unsigned x; volatile LAS unsigned* st; };
__device__ __forceinline__ XcdBarrier xcd_barrier_post(unsigned* bar, volatile LAS unsigned* st) {
    XcdBarrier b; b.bar = bar; b.x = xb_xcc_id(); b.st = st;
    if (threadIdx.x == 0) (void)xb_add(&bar[XB_XCNT(b.x)], 1u);
    return b;
}
__device__ __forceinline__ void xcd_barrier_complete(unsigned* bar, unsigned x, unsigned& nloc, unsigned& nx) {
    const unsigned G = gridDim.x * gridDim.y * gridDim.z;
    unsigned sum, cnt, mine, sp = 0u;
    for (;;) {
        sum = 0u; cnt = 0u; mine = 0u;
#pragma unroll
        for (unsigned j = 0; j < 16; ++j) { const unsigned c = xb_ld(&bar[XB_XCNT(j)]); sum += c; cnt += (c > 0u) ? 1u : 0u; mine = (j == x) ? c : mine; }
        if (sum == G) break;
        __builtin_amdgcn_s_sleep(1);
        if ((++sp & 255u) == 0u) { if (xb_ld(&bar[XB_TMO])) break; if (sp > XB_SPIN_CAP) { atomicAdd(&bar[XB_TMO], 1u); break; } }
    }
    nloc = mine > 0u ? mine : 1u; nx = cnt > 0u ? cnt : 1u;
}
__device__ __forceinline__ void xcd_barrier(const XcdBarrier& b, int wv) {
    asm volatile("s_waitcnt vmcnt(0)" ::: "memory");
    __syncthreads();
    if (otid(wv) == 0) {
        unsigned long long bw = (unsigned long long)b.bar; asm volatile("" : "+s"(bw));
        unsigned* bar = (unsigned*)bw;
        __builtin_amdgcn_s_waitcnt(0);
        unsigned nloc = b.st[0], nx = b.st[1];
        if (nloc == 0u) { xcd_barrier_complete(bar, b.x, nloc, nx); b.st[0] = nloc; b.st[1] = nx; }
        const unsigned old = xb_add(&bar[XB_XSUB(b.x)], 1u);
        const unsigned gen = old / nloc;
        if (old + 1u == (gen + 1u) * nloc) {
            __builtin_amdgcn_fence(__ATOMIC_RELEASE, "agent");
            asm volatile("s_waitcnt vmcnt(0)" ::: "memory");
            const unsigned og = xb_add(&bar[XB_TOP], 1u);
            const unsigned tg = og / nx;
            if (og + 1u == (tg + 1u) * nx) xb_add(&bar[XB_TOPGEN], 1u);
            else XB_SPIN(xb_ld(&bar[XB_TOPGEN]) == tg, bar);
            __builtin_amdgcn_fence(__ATOMIC_ACQUIRE, "agent");
            xb_add(&bar[XB_XGEN(b.x)], 1u);
            asm volatile("s_waitcnt vmcnt(0)" ::: "memory");
        } else {
            XB_SPIN(xb_ld(&bar[XB_XGEN(b.x)]) == gen, bar);
            __builtin_amdgcn_fence(__ATOMIC_ACQUIRE, "agent");
            asm volatile("s_waitcnt vmcnt(0)" ::: "memory");
        }
    }
    __syncthreads();
}

constexpr int I_CUT = (I_LAYER * 2 / 5 / 64) * 64;
#define REPW 3456
#define REPN(k) (1 + __builtin_amdgcn_readfirstlane(((const int*)(okp()->ws + OFF_CTL))[REPW + (k)]))
constexpr int LDS_BYTES = 163840;
constexpr int MISC_OFF = 163840 - 256;
template <class Epi, class Sched, bool AMAP = false> __device__ __forceinline__ void run_gemm(int wv, LAS unsigned char* lds, const bf16_t* A, int lda, const bf16_t* Bt, int ldb, int K, const Sched& S, const Epi& E) {
    pg8::Gemm g; g.A = A; g.Bt = Bt; g.M = 0; g.N = 0; g.K = K; g.lda = lda; g.ldb = ldb; g.pad = wv;
    pg8::gemm_phase<Epi, Sched, AMAP>((PG8_LAS unsigned char*)lds, g, S, E);
}
__global__ void __launch_bounds__(512, 2) mega_fwd(Params p_kernarg) {
    extern __shared__ __attribute__((aligned(16))) unsigned char dyn_lds[];
    LAS unsigned char* lds = (LAS unsigned char*)dyn_lds;
    const int wv = __builtin_amdgcn_readfirstlane(threadIdx.x >> 6);
    volatile LAS unsigned* MISC = (volatile LAS unsigned*)(lds + MISC_OFF);
    if (threadIdx.x < 32) MISC[threadIdx.x] = 0u;
    __syncthreads();
    (void)xcd_barrier_post((unsigned*)(okp()->ws + OFF_CTL), MISC + 8);
#define GRID_BAR() for (int rpb = 0, nrpb = REPN(10); rpb < nrpb; ++rpb) { XcdBarrier bar_; bar_.bar = (unsigned*)(okp()->ws + OFF_CTL); bar_.x = xb_xcc_id(); bar_.st = (volatile LAS unsigned*)(lds + MISC_OFF) + 8; xcd_barrier(bar_, wv); }
    for (int rp = 0, nrp = REPN(13); rp < nrp; ++rp) { ph_convert(wv, lds, 0, obid(), (int)gridDim.x, 0, I_LAYER); __syncthreads(); }
    for (int rp = 0, nrp = REPN(0); rp < nrp; ++rp) { ph_tables(wv); __syncthreads(); ph_mod(wv, lds, 0, 1, obid(), (int)gridDim.x); __syncthreads(); }
    GRID_BAR();
    for (int l = 0; l < DEPTH; ++l) {
        unsigned char* ws = ows(okp()->ws);
        const int G = (int)gridDim.x;
        const int fz = 0;
        const bool lastl = (l == DEPTH - 1);
        if (l == 0) ph_norm<true>(wv, 0, 0, nullptr, 0, R, okp()->x, okp()->ctx);
        else { if (!fz) ph_norm_lat(wv, l, 0); ph_norm_ctx<false>(wv, lds, l, 0); }
        GRID_BAR();
        for (int rp = 0, nrp = REPN(1); rp < nrp; ++rp) { EpiInProj E{(bf16_t*)(ws + OFF_P), (float*)(ws + OFF_G), (const float*)(ws + OFF_BINR) + (size_t)l * NINP};
          pg8::StaticOrder S; S.init(R, NINP, D, G, obid());
          run_gemm(wv, lds, (const bf16_t*)(ws + OFF_XN), D, (const bf16_t*)(ws + OFF_WIN) + (size_t)l * NINP * D, D, D, S, E); }
        GRID_BAR();
        for (int rp = 0, nrp = REPN(2); rp < nrp; ++rp) ph_mlstm1(wv, l, lds);
        { const int f0 = G / 4, fn = G / 2;
          for (int rp = 0, nrp = REPN(9); rp < nrp; ++rp) if (obid() >= f0 && obid() < f0 + fn) ph_fft(wv, lds, obid() - f0, fn);
          for (int rp = 0, nrp = REPN(3); rp < nrp; ++rp) if (obid() < f0 || obid() >= f0 + fn) { const int wi = obid() < f0 ? obid() : obid() - fn;
              if (!lastl) ph_fourier1(wv, wi, G - fn); ph_convc(wv, l, lastl ? RL : R, wi, G - fn); } }
        GRID_BAR();
        for (int rp = 0, nrp = REPN(4); rp < nrp; ++rp) ph_mlstm2(wv);
        GRID_BAR();
        for (int rp = 0, nrp = REPN(5); rp < nrp; ++rp) ph_mlstm3(wv, l, lds, lastl ? 64 * NH : NCHUNK * NH);
        if (!lastl && obid() >= 32) { EpiBf16 E{(bf16_t*)(ws + OFF_HM) + (size_t)RL * D + DM, D, DF, (unsigned)(CTX * D), 0, (float*)(ows(okp()->ws) + OFF_SLAB)};
          pg8::StaticOrder S; S.init(256, 2048, 512, G - 32, obid() - 32);
          run_gemm(wv, lds, (const bf16_t*)(ws + OFF_CSC), 512, (const bf16_t*)(ws + OFF_ZTC), 512, 512, S, E); }
        if (!lastl && obid() >= 32) { ph_convert(wv, lds, l + 1, obid() - 32, G - 32, 0, I_CUT); }
        GRID_BAR();
        for (int rp = 0, nrp = REPN(8); rp < nrp; ++rp) { EpiMerge E{(const bf16_t*)(ows(okp()->ws) + OFF_P), (bf16_t*)(ows(okp()->ws) + OFF_MG)}; pg8::StaticOrder S; S.init(lastl ? RL : R, D, D, G, obid());
          run_gemm(wv, lds, (const bf16_t*)(ws + OFF_HM), D, (const bf16_t*)(ws + OFF_WPM) + (size_t)l * D * D, D, D, S, E); }
        if (!lastl && obid() >= 32) { ph_convert(wv, lds, l + 1, obid() - 32, G - 32, I_CUT, I_LAYER); __syncthreads(); ph_mod(wv, lds, l + 1, l + 2, obid() - 32, G - 32); }
        GRID_BAR();
        for (int rp = 0, nrp = REPN(11); rp < nrp; ++rp) { EpiResid E{l, 0, fz, rp == 0 ? 1.f : 0.f};
          pg8::TailOrder S; S.init(D, D, G, obid(), lastl ? 0 : 32, 0, 8);
          run_gemm(wv, lds, (const bf16_t*)(ws + OFF_MG), D, (const bf16_t*)(ws + OFF_WO) + (size_t)l * D * D, D, D, S, E); }
        GRID_BAR();
        if (!lastl || !fz) {
          if (!fz) ph_norm_lat(wv, l, 1);
          if (!lastl) { if (l == 0) ph_norm_ctx<true>(wv, lds, 0, 1); else ph_norm_ctx<false>(wv, lds, l, 1); }
          GRID_BAR(); }
        for (int rp = 0, nrp = REPN(7); rp < nrp; ++rp) { EpiUp E{(bf16_t*)(ows(okp()->ws) + OFF_P), (float*)(ows(okp()->ws) + OFF_SLAB), (bf16_t*)(ows(okp()->ws) + OFF_ACT), okp()->conv_ff_w + (size_t)l * 3 * DFF};
          pg8::TailOrder S; S.init(NUP, D, G, obid(), lastl ? 0 : 176, lastl ? 0 : 128, 4);
          run_gemm<EpiUp, pg8::TailOrder, true>(wv, lds, (const bf16_t*)(ows(okp()->ws) + OFF_XN), D, (const bf16_t*)(ws + OFF_WUP) + (size_t)l * NUP * D, D, D, S, E); }
        GRID_BAR();
        if (!lastl) { for (int rp = 0, nrp = REPN(6); rp < nrp; ++rp) ph_ffnact(wv, l);
          GRID_BAR(); }
        for (int rp = 0, nrp = REPN(12); rp < nrp; ++rp) { EpiResid E{l, 1, lastl ? 2 * fz : fz, rp == 0 ? 1.f : 0.f};
          pg8::TailOrder S; S.init(D, DFF, G, obid(), lastl ? 0 : 32, 0, 8);
          run_gemm(wv, lds, (const bf16_t*)(ws + OFF_ACT), DFF, (const bf16_t*)(ws + OFF_WDN) + (size_t)l * D * DFF, DFF, DFF, S, E); }
        if (!(lastl && fz)) { GRID_BAR(); }
    }
    ph_final(wv);
}

extern "C" void kernel_launch(void* const* d_in, const int* in_sizes, int n_in, void* d_out, int out_size, void* d_ws, size_t ws_size, hipStream_t stream) {
    static int grid = 0;
    if (grid == 0) {
        if (n_in != 22 || ws_size < WS_END || out_size != RL * D) { fprintf(stderr, "kernel_launch: unexpected problem (n_in %d, ws %zu < %zu, out %d)\n", n_in, ws_size, (size_t)WS_END, out_size); grid = -1; return; }
        int dev = 0, cus = 0, per_cu = 0;
        if (hipGetDevice(&dev) != hipSuccess || hipDeviceGetAttribute(&cus, hipDeviceAttributeMultiprocessorCount, dev) != hipSuccess) { grid = -1; return; }
        if (hipFuncSetAttribute((const void*)mega_fwd, hipFuncAttributeMaxDynamicSharedMemorySize, LDS_BYTES) != hipSuccess) { fprintf(stderr, "kernel_launch: hipFuncSetAttribute failed\n"); grid = -1; return; }
        if (hipOccupancyMaxActiveBlocksPerMultiprocessor(&per_cu, (const void*)mega_fwd, 512, LDS_BYTES) != hipSuccess || per_cu < 1) { fprintf(stderr, "kernel_launch: occupancy query says %d\n", per_cu); per_cu = 1; }
        (void)hipGetLastError();
        grid = cus;
    }
    if (grid < 0) return;
    Params p{};
    const float** pp = (const float**)&p;
    for (int i = 0; i < 22; ++i) pp[i] = (const float*)d_in[i];
    p.out = (float*)d_out; p.ws = (unsigned char*)d_ws;
    (void)hipMemsetAsync((char*)d_ws + OFF_CTL, 0, (size_t)(XCD_BAR_WORDS + 16) * sizeof(unsigned), stream);
    hipLaunchKernelGGL(mega_fwd, dim3(grid), dim3(512), LDS_BYTES, stream, p);
}
```

```cpp
#include <hip/hip_runtime.h>
#include <cstdio>
#include <cstdint>
#include <type_traits>

#define LAS __attribute__((address_space(3)))
typedef unsigned short bf16_t;
typedef short bf16x8 __attribute__((ext_vector_type(8)));
typedef float f32x4 __attribute__((ext_vector_type(4)));
typedef unsigned u32x4 __attribute__((ext_vector_type(4)));
typedef unsigned u32x2 __attribute__((ext_vector_type(2)));
typedef float f32x2 __attribute__((ext_vector_type(2)));

constexpr int D = 2048, NB = 4, SEQ = 2048, DEPTH = 4, CTX = 256;
constexpr int DM = 1024, NH = 4, DH = 256, DF = 512, DC = 512, DFF = 5632, CHUNK = 128;
constexpr int NIN = 12304;
constexpr int RL = NB * SEQ, RC = NB * CTX, R = RL + RC;
constexpr int NP = 12288;
constexpr int NINP = 12544;
constexpr int PK = 0, PV = 1024, PQ = 2048, PO = 3072, PF = 4096, PCB = 4608, PCC = 5120, PCX = 5632, PGM = 6144;
constexpr int NCHUNK = 72;
constexpr int NUP = 2 * DFF;
constexpr float EPS = 1e-6f;

constexpr size_t al256(size_t x) { return (x + 255) & ~(size_t)255; }
constexpr size_t OFF_CTL = 0;
constexpr size_t OFF_WIN = 1u << 20;
constexpr size_t SZ_WIN = (size_t)NINP * D * 2;            constexpr size_t OFF_WPM = OFF_WIN + DEPTH * SZ_WIN;
constexpr size_t SZ_WPM = (size_t)D * D * 2;               constexpr size_t OFF_WO = OFF_WPM + DEPTH * SZ_WPM;
constexpr size_t SZ_WO = (size_t)D * D * 2;                constexpr size_t OFF_WUP = OFF_WO + DEPTH * SZ_WO;
constexpr size_t SZ_WUP = (size_t)NUP * D * 2;             constexpr size_t OFF_WDN = OFF_WUP + DEPTH * SZ_WUP;
constexpr size_t SZ_WDN = (size_t)D * DFF * 2;             constexpr size_t OFF_BINR = OFF_WDN + DEPTH * SZ_WDN;
constexpr size_t OFF_MA = al256(OFF_BINR + (size_t)DEPTH * NINP * 4);
constexpr size_t OFF_MC = OFF_MA + (size_t)64 * 64 * 2;
constexpr size_t OFF_CSC = OFF_MC + (size_t)32 * 64 * 128 * 2;
constexpr size_t OFF_FT = OFF_CSC + (size_t)256 * 512 * 2;
constexpr size_t OFF_MOD = OFF_FT + (size_t)256 * 128 * 2;
constexpr size_t OFF_H = al256(OFF_MOD + (size_t)DEPTH * 5 * 6 * D * 4);
constexpr size_t OFF_XN = OFF_H + (size_t)R * D * 4;
constexpr size_t OFF_P = OFF_XN + (size_t)R * D * 2;
constexpr size_t OFF_G = OFF_P + (size_t)R * NP * 2;
constexpr size_t OFF_CHS = OFF_G + (size_t)R * 16 * 4;
constexpr size_t OFF_MST = al256(OFF_CHS + (size_t)NCHUNK * 8 * 2 * 4);
constexpr size_t OFF_UT = al256(OFF_MST + (size_t)NCHUNK * 8 * 4);
constexpr size_t SZ_UT = (size_t)NCHUNK * NH * 2 * DH * DH * 2;
constexpr size_t OFF_CT = OFF_UT + SZ_UT;
constexpr size_t OFF_NV = OFF_CT + SZ_UT;
constexpr size_t OFF_NS = OFF_NV + (size_t)NCHUNK * NH * 2 * DH * 4;
constexpr size_t OFF_HM = OFF_NS + (size_t)NCHUNK * NH * 2 * DH * 4;
constexpr size_t OFF_ZTC = OFF_HM + (size_t)R * D * 2;
constexpr size_t OFF_MG = OFF_ZTC + (size_t)2048 * 512 * 2;
constexpr size_t OFF_ACT = OFF_MG + (size_t)R * D * 2;
constexpr size_t OFF_SLAB = OFF_ACT + (size_t)R * DFF * 2;
constexpr size_t OFF_XS = OFF_SLAB + (size_t)4 * RC * NUP * 4;
constexpr size_t WS_END = OFF_XS + (size_t)8 * RL * 32 * 4;
constexpr int CNTW = 4096;
constexpr int CTL_ZERO_WORDS = CNTW + 8 * 32 * 64;
static_assert(WS_END <= (size_t)4 * DEPTH * D * NIN * 4, "workspace map exceeds the guaranteed d_ws size");
static_assert((size_t)R * NUP * 2 <= (size_t)R * NP * 2, "u overlays P");

struct Params {
    const float *x, *c, *ctx, *c_ctx, *w_mod, *b_mod, *norm1_w, *norm2_w, *w_in, *b_in, *conv_q_w, *conv_k_w, *mlstm_norm_w, *w_pm, *w_pf, *w_pc, *conv_c_w, *w_o, *w_up,
        *conv_ff_w, *w_down, *final_norm_w;
    float* out; unsigned char* ws;
};
#define WSP(T, off) ((T*)(wsb + (off)))
typedef const __attribute__((address_space(4))) Params CParams;
__device__ __forceinline__ CParams* okp() { CParams* k = (CParams*)__builtin_amdgcn_kernarg_segment_ptr(); asm volatile("" : "+s"(k)); return k; }

#define GAS __attribute__((address_space(1)))
template <class T> __device__ __forceinline__ T gld(const void* base, unsigned byte_off) { return *(const GAS T*)((const GAS unsigned char*)base + byte_off); }
template <class T> __device__ __forceinline__ void gst(void* base, unsigned byte_off, T v) { *(GAS T*)((GAS unsigned char*)base + byte_off) = v; }
__device__ __forceinline__ int otid(int wv) { int t; asm volatile("v_mbcnt_lo_u32_b32 %0, -1, 0\n\tv_mbcnt_hi_u32_b32 %0, -1, %0" : "=v"(t)); return (wv << 6) | t; }
__device__ __forceinline__ int olaunder(int v) { asm volatile("" : "+v"(v)); return v; }
__device__ __forceinline__ f32x4 zero4() { float a, b, c, d; asm volatile("v_mov_b32 %0, 0\n\tv_mov_b32 %1, 0\n\tv_mov_b32 %2, 0\n\tv_mov_b32 %3, 0" : "=v"(a), "=v"(b), "=v"(c), "=v"(d)); return (f32x4){a, b, c, d}; }
__device__ __forceinline__ int obid() { int b = blockIdx.x; asm volatile("" : "+s"(b)); return b; }
__device__ __forceinline__ float bf2f(bf16_t v) { return __uint_as_float(((unsigned)v) << 16); }
__device__ __forceinline__ unsigned f2bf(float f) { unsigned u = __float_as_uint(f); return (u + 0x7fffu + ((u >> 16) & 1u)) >> 16; }
__device__ __forceinline__ unsigned pk2(float lo, float hi) { return f2bf(lo) | (f2bf(hi) << 16); }
__device__ __forceinline__ float sigmoidf_(float x) { return 1.f / (1.f + __expf(-x)); }
__device__ __forceinline__ float siluf_(float x) { return x / (1.f + __expf(-x)); }
__device__ __forceinline__ float shx(float v, int k, int lane) { return __int_as_float(__builtin_amdgcn_ds_bpermute((lane ^ k) << 2, __float_as_int(v))); }
__device__ __forceinline__ float shl_(float v, int src) { return __int_as_float(__builtin_amdgcn_ds_bpermute(src << 2, __float_as_int(v))); }
__device__ __forceinline__ unsigned char* ows(unsigned char* w) { asm volatile("" : "+s"(w)); return w; }
__device__ __forceinline__ float wave_sum(float v, int lane) {
#pragma unroll
    for (int o = 1; o < 64; o <<= 1) v += shx(v, o, lane);
    return v;
}
__device__ __forceinline__ void unpack8(u32x4 w, float (&f)[8]) {
    f[0] = __uint_as_float(w.x << 16); f[1] = __uint_as_float(w.x & 0xffff0000u); f[2] = __uint_as_float(w.y << 16); f[3] = __uint_as_float(w.y & 0xffff0000u);
    f[4] = __uint_as_float(w.z << 16); f[5] = __uint_as_float(w.z & 0xffff0000u); f[6] = __uint_as_float(w.w << 16); f[7] = __uint_as_float(w.w & 0xffff0000u);
}
__device__ __forceinline__ u32x4 pack8(const float (&f)[8]) { u32x4 w; w.x = pk2(f[0], f[1]); w.y = pk2(f[2], f[3]); w.z = pk2(f[4], f[5]); w.w = pk2(f[6], f[7]); return w; }
__device__ __forceinline__ void rowinfo(int r, int& mj, int& t, int& T) { const int c = r >= RL ? 1 : 0; mj = r >> 11; T = SEQ >> (3 * c); t = r & (T - 1); }
__device__ __forceinline__ int chunk_row0(int cidx) { return cidx < 64 ? (cidx >> 4) * SEQ + (cidx & 15) * CHUNK : RL + ((cidx - 64) >> 1) * CTX + ((cidx - 64) & 1) * CHUNK; }
__device__ __forceinline__ int scan_chunk(int b, int dir, int step) {
    if (step < 2) { const int j = dir ? 1 - step : step; return 64 + b * 2 + j; }
    const int jj = step - 2, j = dir ? 15 - jj : jj; return b * 16 + j;
}

namespace pg8 {
#define PG8_LAS __attribute__((address_space(3)))
constexpr int BM = 256, BK = 64, HALF = 128, HTB = HALF * BK * 2, STAGE_BYTES = 8 * HTB, NXCD = 8, WGM = 8;
__host__ __device__ __forceinline__ int lds_byte(int r, int c) { const int st = (r >> 4) * 2 + (c >> 5), rr = r & 15, cc = c & 31, ob = rr * 64 + cc * 2; return st * 1024 + (ob ^ (((ob >> 9) & 1) << 5)); }
__host__ __device__ __forceinline__ void stage_rc(int b, int& Rr, int& C) { const int st = b / 1024, sb = b % 1024, swz = sb ^ (((sb >> 9) & 1) << 5); Rr = (st >> 1) * 16 + swz / 64; C = (st & 1) * 32 + (swz % 64) / 2; }
__host__ __device__ __forceinline__ int perm32(int rho) { const int n = rho >> 4, i = rho & 15; return 8 * (i >> 2) + 4 * n + (i & 3); }
struct Unit { int pm, pn, k0, nt, ks; };
struct Gemm { const bf16_t* A; const bf16_t* Bt; int M, N, K, lda, ldb, pad; };
__host__ __device__ __forceinline__ void tile_of(int wgid, int nM, int nN, int& pm, int& pn) {
    const int nwg = nM * nN; { const int q = nwg / NXCD, r = nwg % NXCD, xcd = wgid % NXCD, off = wgid / NXCD; wgid = (xcd < r ? xcd * (q + 1) : r * (q + 1) + (xcd - r) * q) + off; }
    const int nig = WGM * nN, gid = wgid / nig, fm = gid * WGM, gsz = (nM - fm) < WGM ? (nM - fm) : WGM;
    pm = fm + ((wgid % nig) % gsz); pn = (wgid % nig) / gsz;
}
struct StaticOrder {
    int nM, nN, nwg, G, c, K;
    __host__ __device__ void init(int M, int N, int K_, int G_, int c_) { nM = M / BM; nN = N / BM; nwg = nM * nN; G = G_; c = c_; K = K_; }
    __host__ __device__ bool next(int i, Unit& u) const {
        const long L = (long)i * G + c; if (L >= nwg) return false;
        tile_of((int)L, nM, nN, u.pm, u.pn); u.k0 = 0; u.nt = K / BK; u.ks = -1; return true;
    }
    __device__ __forceinline__ void a_ready(const Unit&) const {}
    __device__ __forceinline__ void done(const Unit&) const {}
};
struct TailOrder {
    int nN, G, c, K, nLat, nWhole, nTot, nsl;
    __host__ __device__ void init(int N, int K_, int G_, int c_, int nCtxTiles, int nCtxWhole, int nsl_) { nN = N / BM; G = G_; c = c_; K = K_; nLat = 32 * nN; nWhole = nLat + nCtxWhole; nTot = nLat + nCtxTiles; nsl = nsl_; }
    __host__ __device__ bool next(int i, Unit& u) const {
        const long L = (long)i * G + c; if (L >= (long)nWhole + (long)(nTot - nWhole) * nsl) return false;
        int tile, ks; if (L < nWhole) { tile = (int)L; ks = -1; } else { const int Lp = (int)L - nWhole; tile = nWhole + Lp / nsl; ks = Lp % nsl; }
        if (tile < nLat) tile_of(tile, 32, nN, u.pm, u.pn); else { const int tp = tile - nLat; u.pm = 32 + (tp & 3); u.pn = tp >> 2; }
        if (ks < 0) { u.k0 = 0; u.nt = K / BK; } else { const int n128 = K / 128, base = n128 / nsl, rem = n128 % nsl; u.k0 = 128 * (ks * base + (ks < rem ? ks : rem)); u.nt = 2 * (base + (ks < rem ? 1 : 0)); }
        u.ks = ks; return true;
    }
    __device__ __forceinline__ void a_ready(const Unit&) const {}
    __device__ __forceinline__ void done(const Unit&) const {}
};
template <bool AMAP> __device__ __forceinline__ void a_geom(const Gemm& g, const Unit& u, int R0, int C0, int R1, int C1, size_t& base, size_t& hstep, unsigned (&vo)[2]) {
    if (AMAP && u.pm < 32) { base = (size_t)((u.pm >> 3) * 2048 + (u.pm & 7) * 8) * g.lda * 2; hstep = (size_t)4 * g.lda * 2;
        vo[0] = (unsigned)(((R0 & 31) * 64 + (R0 >> 5)) * g.lda + C0) * 2u; vo[1] = (unsigned)(((R1 & 31) * 64 + (R1 >> 5)) * g.lda + C1) * 2u; }
    else { base = (size_t)u.pm * 256 * g.lda * 2; hstep = (size_t)HALF * g.lda * 2; vo[0] = (unsigned)(R0 * g.lda + C0) * 2u; vo[1] = (unsigned)(R1 * g.lda + C1) * 2u; }
}
template <class Epi, class Sched, bool AMAP = false>
__device__ __forceinline__ void gemm_phase(PG8_LAS unsigned char* lds, const Gemm g, const Sched& S, const Epi& E) {
    const int tid = otid(g.pad), wid = __builtin_amdgcn_readfirstlane(tid >> 6), lane = tid & 63, wr = wid >> 2, wc = wid & 3, fr = lane & 15, fq = lane >> 4;
    int R0, C0, R1, C1; stage_rc(tid * 16, R0, C0); stage_rc(tid * 16 + 8192, R1, C1);
    unsigned voffB[2];
    { const int Rb0 = Epi::PERM ? ((R0 & ~31) + perm32(R0 & 31)) : R0, Rb1 = Epi::PERM ? ((R1 & ~31) + perm32(R1 & 31)) : R1;
      voffB[0] = (unsigned)(Rb0 * g.ldb + C0) * 2u; voffB[1] = (unsigned)(Rb1 * g.ldb + C1) * 2u; }
    const size_t kstep = (size_t)(BK * 2);
    const size_t hstepB = (size_t)HALF * g.ldb * 2, tstepB = 2 * hstepB;
    const unsigned ldsw = (unsigned)wid * 1024u;
    const int aoff = lds_byte(wr * 64 + fr, fq * 8), boff = lds_byte(wc * 32 + fr, fq * 8);
#define PG8_SA(b, h) (((b) * 2 + (h)) * HTB)
#define PG8_SB(b, h) ((4 + (b) * 2 + (h)) * HTB)
#define PG8_STAGE(bufoff, gbase, voff) do { _Pragma("unroll") for (int _i = 0; _i < 2; ++_i) \
        __builtin_amdgcn_global_load_lds((const unsigned*)((const char*)(gbase) + (voff)[_i]), (PG8_LAS unsigned*)(lds + (bufoff) + ldsw + _i * 8192), 16, 0, 0); } while (0)
#define PG8_LDA(dst, b, h) do { _Pragma("unroll") for (int m = 0; m < 4; ++m) _Pragma("unroll") for (int k = 0; k < 2; ++k) dst[m][k] = *(const PG8_LAS bf16x8*)(lds + PG8_SA(b, h) + aoff + m * 2048 + k * 1024); } while (0)
#define PG8_LDB(dst, b, h) do { _Pragma("unroll") for (int n = 0; n < 2; ++n) _Pragma("unroll") for (int k = 0; k < 2; ++k) dst[n][k] = *(const PG8_LAS bf16x8*)(lds + PG8_SB(b, h) + boff + n * 2048 + k * 1024); } while (0)
#define PG8_MMA(ai, bj, At, Bt) do { __builtin_amdgcn_s_setprio(1); _Pragma("unroll") for (int m = 0; m < 4; ++m) _Pragma("unroll") for (int n = 0; n < 2; ++n) _Pragma("unroll") for (int k = 0; k < 2; ++k) \
        acc[ai][bj][m][n] = __builtin_amdgcn_mfma_f32_16x16x32_bf16(Bt[n][k], At[m][k], acc[ai][bj][m][n], 0, 0, 0); __builtin_amdgcn_s_setprio(0); } while (0)
#define PG8_WAIT_V(n) asm volatile("s_waitcnt vmcnt(" #n ")" ::: "memory")
#define PG8_WAIT_L(n) asm volatile("s_waitcnt lgkmcnt(" #n ")" ::: "memory")
#define PG8_BAR __builtin_amdgcn_s_barrier()
#define PG8_SCHED __builtin_amdgcn_sched_barrier(0)
    Unit cur, nxt; int ui = 0;
    if (!S.next(0, cur)) return;
    f32x4 acc[2][2][4][2];
#pragma unroll
    for (int a = 0; a < 2; ++a)
#pragma unroll
        for (int b = 0; b < 2; ++b)
#pragma unroll
            for (int m = 0; m < 4; ++m)
#pragma unroll
                for (int n = 0; n < 2; ++n) acc[a][b][m][n] = zero4();
    bf16x8 At[4][2], B0[2][2], B1[2][2];
    size_t baseC, hsC; unsigned voC[2]; a_geom<AMAP>(g, cur, R0, C0, R1, C1, baseC, hsC, voC);
    const char* cA = (const char*)g.A + baseC + (size_t)cur.k0 * 2; const char* cB = (const char*)g.Bt + (size_t)cur.pn * tstepB + (size_t)cur.k0 * 2;
    S.a_ready(cur);
    PG8_STAGE(PG8_SB(0, 0), cB, voffB); PG8_STAGE(PG8_SB(0, 1), cB + hstepB, voffB); PG8_STAGE(PG8_SA(0, 0), cA, voC); PG8_STAGE(PG8_SA(0, 1), cA + hsC, voC);
    if (wr == 1) PG8_BAR;
    PG8_WAIT_V(2); PG8_BAR;
    PG8_STAGE(PG8_SB(1, 0), cB + kstep, voffB); PG8_STAGE(PG8_SA(1, 0), cA + kstep, voC); PG8_STAGE(PG8_SB(1, 1), cB + hstepB + kstep, voffB);
    PG8_WAIT_V(6); PG8_BAR;
    for (;;) {
        const bool has_next = S.next(ui + 1, nxt);
        size_t baseN = baseC, hsN = hsC; unsigned voN[2] = {voC[0], voC[1]};
        if (AMAP && has_next) a_geom<AMAP>(g, nxt, R0, C0, R1, C1, baseN, hsN, voN); else if (has_next) baseN = (size_t)nxt.pm * 256 * g.lda * 2;
        const char* nA = has_next ? (const char*)g.A + baseN + (size_t)nxt.k0 * 2 : cA; const char* nB = has_next ? (const char*)g.Bt + (size_t)nxt.pn * tstepB + (size_t)nxt.k0 * 2 : cB;
        const int nt = cur.nt;
        for (int t = 0; t < nt; t += 2) {
            if constexpr (Epi::HOOK) E.hook(acc, cur, t, wr, wc, fr, fq, At, B0, B1);
            const bool last = (t == nt - 2);
            const char* a1 = cA + (size_t)(t + 1) * kstep;
            const char* a2 = last ? nA : cA + (size_t)(t + 2) * kstep; const char* b2 = last ? nB : cB + (size_t)(t + 2) * kstep;
            const char* a3 = a2 + kstep; const char* b3 = b2 + kstep;
            const size_t hs2 = (AMAP && last) ? hsN : hsC; unsigned vo2[2] = {(AMAP && last) ? voN[0] : voC[0], (AMAP && last) ? voN[1] : voC[1]};
            if (last && has_next) S.a_ready(nxt);
            PG8_LDB(B0, 0, 0); PG8_LDB(B1, 0, 1); PG8_SCHED; PG8_LDA(At, 0, 0); PG8_STAGE(PG8_SA(1, 1), a1 + hsC, voC);
            PG8_WAIT_V(8); PG8_WAIT_L(0); PG8_BAR; PG8_MMA(0, 0, At, B0); PG8_MMA(0, 1, At, B1); PG8_BAR; PG8_SCHED;
            PG8_LDA(At, 0, 1); PG8_STAGE(PG8_SB(0, 0), b2, voffB); PG8_STAGE(PG8_SB(0, 1), b2 + hstepB, voffB); PG8_STAGE(PG8_SA(0, 0), a2, vo2);
            PG8_WAIT_V(8); PG8_WAIT_L(0); PG8_BAR; PG8_MMA(1, 0, At, B0); PG8_MMA(1, 1, At, B1); PG8_BAR; PG8_SCHED;
            PG8_LDB(B0, 1, 0); PG8_LDB(B1, 1, 1); PG8_SCHED; PG8_LDA(At, 1, 0); PG8_STAGE(PG8_SA(0, 1), a2 + hs2, vo2);
            PG8_WAIT_V(8); PG8_WAIT_L(0); PG8_BAR; PG8_MMA(0, 0, At, B0); PG8_MMA(0, 1, At, B1); PG8_BAR; PG8_SCHED;
            PG8_LDA(At, 1, 1); PG8_STAGE(PG8_SB(1, 0), b3, voffB); PG8_STAGE(PG8_SB(1, 1), b3 + hstepB, voffB); PG8_STAGE(PG8_SA(1, 0), a3, vo2);
            PG8_WAIT_V(8); PG8_WAIT_L(0); PG8_BAR; PG8_MMA(1, 0, At, B0); PG8_MMA(1, 1, At, B1); PG8_BAR; PG8_SCHED;
        }
        if (wr == 0) PG8_BAR;
        E(acc, cur, wr, wc, fr, fq); S.done(cur);
        if (!has_next) break;
#pragma unroll
        for (int a = 0; a < 2; ++a)
#pragma unroll
            for (int b = 0; b < 2; ++b)
#pragma unroll
                for (int m = 0; m < 4; ++m)
#pragma unroll
                    for (int n = 0; n < 2; ++n) acc[a][b][m][n] = zero4();
        cur = nxt; cA = nA; cB = nB; ++ui;
        if constexpr (AMAP) { hsC = hsN; voC[0] = voN[0]; voC[1] = voN[1]; }
        if (wr == 1) PG8_BAR;
    }
    PG8_WAIT_V(0);
    PG8_BAR;
#undef PG8_SA
#undef PG8_SB
#undef PG8_STAGE
#undef PG8_LDA
#undef PG8_LDB
#undef PG8_MMA
#undef PG8_WAIT_V
#undef PG8_WAIT_L
#undef PG8_BAR
#undef PG8_SCHED
}
}

template <class F> __device__ __forceinline__ void epi_foreach(const f32x4 (&acc)[2][2][4][2], const pg8::Unit& u, int wr, int wc, int fr, int fq, F&& f) {
    const int row0 = u.pm * 256 + wr * 64 + fr, col0 = u.pn * 256 + wc * 32 + 8 * fq;
#pragma unroll
    for (int ai = 0; ai < 2; ++ai)
#pragma unroll
        for (int m = 0; m < 4; ++m)
#pragma unroll
            for (int bj = 0; bj < 2; ++bj) f(row0 + ai * 128 + m * 16, col0 + bj * 128, acc[ai][bj][m][0], acc[ai][bj][m][1]);
}
__device__ __forceinline__ void unpack8v(u32x4 w, f32x4& v0, f32x4& v1) {
    v0[0] = __uint_as_float(w.x << 16); v0[1] = __uint_as_float(w.x & 0xffff0000u); v0[2] = __uint_as_float(w.y << 16); v0[3] = __uint_as_float(w.y & 0xffff0000u);
    v1[0] = __uint_as_float(w.z << 16); v1[1] = __uint_as_float(w.z & 0xffff0000u); v1[2] = __uint_as_float(w.w << 16); v1[3] = __uint_as_float(w.w & 0xffff0000u);
}
__device__ __forceinline__ u32x4 pack8v(f32x4 v0, f32x4 v1) { u32x4 w; w.x = pk2(v0[0], v0[1]); w.y = pk2(v0[2], v0[3]); w.z = pk2(v1[0], v1[1]); w.w = pk2(v1[2], v1[3]); return w; }

struct EpiInProj {
    static constexpr bool PERM = true, HOOK = false;
    bf16_t* P; float* G; const float* bias;
    __device__ __forceinline__ void operator()(const f32x4 (&acc)[2][2][4][2], const pg8::Unit& u, int wr, int wc, int fr, int fq) const {
        if (u.pn < 48) {
            f32x4 bv[2][2];
#pragma unroll
            for (int bj = 0; bj < 2; ++bj) { const unsigned bo = (unsigned)(u.pn * 256 + wc * 32 + 8 * fq + bj * 128) * 4u; bv[bj][0] = gld<f32x4>(bias, bo); bv[bj][1] = gld<f32x4>(bias, bo + 16); }
            epi_foreach(acc, u, wr, wc, fr, fq, [&](int row, int col, f32x4 v0, f32x4 v1) {
                const int bj = (col >> 7) & 1;
                f32x4 o0 = v0 + bv[bj][0], o1 = v1 + bv[bj][1];
                if (u.pn >= PGM / 256) {
#pragma unroll
                    for (int j = 0; j < 4; ++j) { o0[j] = 1.f + __expf(-fminf(fmaxf(o0[j], -30.f), 30.f)); o1[j] = 1.f + __expf(-fminf(fmaxf(o1[j], -30.f), 30.f)); } }
                gst<u32x4>(P, (unsigned)(row * NP + col) * 2u, pack8v(o0, o1)); });
        } else if (wc == 0 && fq < 2) {
            const int row0 = u.pm * 256 + wr * 64 + fr;
            const f32x4 b0 = gld<f32x4>(bias, (unsigned)(NP + 8 * fq) * 4u), b1 = gld<f32x4>(bias, (unsigned)(NP + 8 * fq) * 4u + 16);
#pragma unroll
            for (int ai = 0; ai < 2; ++ai)
#pragma unroll
                for (int m = 0; m < 4; ++m) { const unsigned go = (unsigned)((row0 + ai * 128 + m * 16) * 16 + 8 * fq) * 4u;
                    gst<f32x4>(G, go, acc[ai][0][m][0] + b0); gst<f32x4>(G, go + 16, acc[ai][0][m][1] + b1); }
        }
    }
};
struct EpiBf16 {
    static constexpr bool PERM = true, HOOK = false;
    bf16_t* O; int ldc; int split_cols; unsigned split_stride; int pad; float* slab;
    __device__ __forceinline__ void operator()(const f32x4 (&acc)[2][2][4][2], const pg8::Unit& u, int wr, int wc, int fr, int fq) const {
        if (u.ks >= 0) { const unsigned sb = (unsigned)u.ks * (unsigned)(RC * ldc);
            epi_foreach(acc, u, wr, wc, fr, fq, [&](int row, int col, f32x4 v0, f32x4 v1) { const unsigned o = (sb + (unsigned)((row - RL) * ldc + col)) * 4u; gst<f32x4>(slab, o, v0); gst<f32x4>(slab, o + 16, v1); });
            return; }
        int colt = u.pn * 256; unsigned base = 0;
        if (split_cols) { const int t = colt / split_cols; base = (unsigned)t * split_stride; colt -= t * split_cols; }
        const int cshift = colt - u.pn * 256;
        epi_foreach(acc, u, wr, wc, fr, fq, [&](int row, int col, f32x4 v0, f32x4 v1) { gst<u32x4>(O, (base + (unsigned)(row * ldc + col + cshift)) * 2u, pack8v(v0, v1)); });
    }
};
struct EpiMerge {
    static constexpr bool PERM = true, HOOK = true;
    const bf16_t* P; bf16_t* MG; float* slab;
    __device__ __forceinline__ void hook(f32x4 (&acc)[2][2][4][2], const pg8::Unit& u, int t, int wr, int wc, int fr, int fq, bf16x8 (&At)[4][2], bf16x8 (&B0)[2][2], bf16x8 (&B1)[2][2]) const {
        const int tg = t + (u.k0 >> 6);
        if ((tg != 16 && tg != 24) || t == 0) return;
        const int b = tg == 16 ? 0 : 1;
        const unsigned o0 = (unsigned)((u.pm * 256 + wr * 64 + fr) * NP + PGM + b * D + u.pn * 256 + wc * 32 + 8 * fq) * 2u;
#pragma unroll
        for (int ai = 0; ai < 2; ++ai) {
#pragma unroll
            for (int m = 0; m < 4; ++m) { const unsigned o = o0 + (unsigned)((ai * 128 + m * 16) * NP) * 2u;
                At[m][0] = gld<bf16x8>(P, o); At[m][1] = gld<bf16x8>(P, o + 256u);
                if (m < 2) { B0[m][0] = gld<bf16x8>(P, o + D * 2); B0[m][1] = gld<bf16x8>(P, o + D * 2 + 256u); }
                else { B1[m - 2][0] = gld<bf16x8>(P, o + D * 2); B1[m - 2][1] = gld<bf16x8>(P, o + D * 2 + 256u); } }
#pragma unroll
            for (int m = 0; m < 4; ++m)
#pragma unroll
                for (int bj = 0; bj < 2; ++bj) { float xa[8], xb[8]; unpack8(__builtin_bit_cast(u32x4, At[m][bj]), xa); unpack8(__builtin_bit_cast(u32x4, m < 2 ? B0[m][bj] : B1[m - 2][bj]), xb);
#pragma unroll
                    for (int j = 0; j < 8; ++j) acc[ai][bj][m][j >> 2][j & 3] *= xb[j] * __builtin_amdgcn_rcpf(xa[j]); }
        }
    }
    __device__ __forceinline__ void operator()(const f32x4 (&acc)[2][2][4][2], const pg8::Unit& u, int wr, int wc, int fr, int fq) const {
        const int row0 = u.pm * 256 + wr * 64 + fr, col0 = u.pn * 256 + wc * 32 + 8 * fq;
        const int gsec = u.ks == 0 ? 0 : 2;
#pragma unroll
        for (int ai = 0; ai < 2; ++ai) { u32x4 gr[4][2];
#pragma unroll
            for (int m = 0; m < 4; ++m)
#pragma unroll
                for (int bj = 0; bj < 2; ++bj) gr[m][bj] = gld<u32x4>(P, (unsigned)((row0 + ai * 128 + m * 16) * NP + PGM + gsec * D + col0 + bj * 128) * 2u);
#pragma unroll
            for (int m = 0; m < 4; ++m)
#pragma unroll
                for (int bj = 0; bj < 2; ++bj) { float g[8]; unpack8(gr[m][bj], g);
                    const f32x4 g0 = {__builtin_amdgcn_rcpf(g[0]), __builtin_amdgcn_rcpf(g[1]), __builtin_amdgcn_rcpf(g[2]), __builtin_amdgcn_rcpf(g[3])},
                                g1 = {__builtin_amdgcn_rcpf(g[4]), __builtin_amdgcn_rcpf(g[5]), __builtin_amdgcn_rcpf(g[6]), __builtin_amdgcn_rcpf(g[7])};
                    if (u.ks < 0) gst<u32x4>(MG, (unsigned)((row0 + ai * 128 + m * 16) * D + col0 + bj * 128) * 2u, pack8v(g0 * acc[ai][bj][m][0], g1 * acc[ai][bj][m][1]));
                    else { const unsigned so = (unsigned)((u.ks * RC + (row0 + ai * 128 + m * 16 - RL)) * D + col0 + bj * 128) * 4u; gst<f32x4>(slab, so, g0 * acc[ai][bj][m][0]); gst<f32x4>(slab, so + 16, g1 * acc[ai][bj][m][1]); } }
        }
    }
};
struct EpiUp {
    static constexpr bool PERM = true, HOOK = false;
    bf16_t* U; float* slab; bf16_t* ACT; const float* wf;
    __device__ __forceinline__ void operator()(const f32x4 (&acc)[2][2][4][2], const pg8::Unit& u, int wr, int wc, int fr, int fq) const {
        if (u.ks >= 0) { const unsigned sb = (unsigned)u.ks * (unsigned)(RC * NUP);
            epi_foreach(acc, u, wr, wc, fr, fq, [&](int row, int col, f32x4 v0, f32x4 v1) { const unsigned o = (sb + (unsigned)((row - RL) * NUP + col)) * 4u; gst<f32x4>(slab, o, v0); gst<f32x4>(slab, o + 16, v1); });
            return; }
        if (u.pm >= 32) { epi_foreach(acc, u, wr, wc, fr, fq, [&](int row, int col, f32x4 v0, f32x4 v1) { gst<u32x4>(U, (unsigned)(row * NUP + col) * 2u, pack8v(v0, v1)); }); return; }
        const int c0 = 128 * u.pn + 32 * wc + 8 * fq, lane = fq * 16 + fr;
        const int lprev = ((lane & 48) | ((fr - 1) & 15)), lnext = ((lane & 48) | ((fr + 1) & 15));
        float w0[8], w1[8], w2[8];
        { const f32x4 a0 = gld<f32x4>(wf, (unsigned)c0 * 4u), a1 = gld<f32x4>(wf, (unsigned)c0 * 4u + 16), b0 = gld<f32x4>(wf, (unsigned)(DFF + c0) * 4u), b1 = gld<f32x4>(wf, (unsigned)(DFF + c0) * 4u + 16),
                      d0 = gld<f32x4>(wf, (unsigned)(2 * DFF + c0) * 4u), d1 = gld<f32x4>(wf, (unsigned)(2 * DFF + c0) * 4u + 16);
#pragma unroll
          for (int j = 0; j < 4; ++j) { w0[j] = a0[j]; w0[4 + j] = a1[j]; w1[j] = b0[j]; w1[4 + j] = b1[j]; w2[j] = d0[j]; w2[4 + j] = d1[j]; } }
        const unsigned rowb = (unsigned)((u.pm >> 3) * 2048 + (u.pm & 7) * 8 + 2 * wr);
#pragma unroll
        for (int ai = 0; ai < 2; ++ai)
#pragma unroll
            for (int m = 0; m < 4; ++m) {
                float o[8];
#pragma unroll
                for (int n = 0; n < 2; ++n)
#pragma unroll
                    for (int e = 0; e < 4; ++e) {
                        const float a = acc[ai][0][m][n][e];
                        const float oprev = (m & 1) ? acc[ai][0][m - 1 < 0 ? 0 : m - 1][n][e] : 0.f, onext = (m & 1) ? 0.f : acc[ai][0][m + 1 > 3 ? 3 : m + 1][n][e];
                        const float pv = shl_(fr == 15 ? oprev : a, lprev), nx = shl_(fr == 0 ? onext : a, lnext);
                        o[4 * n + e] = siluf_(w0[4 * n + e] * pv + w1[4 * n + e] * a + w2[4 * n + e] * nx) * acc[ai][1][m][n][e];
                    }
                const unsigned row = rowb + (unsigned)((16 * (m & 1) + fr) * 64 + 4 * ai + (m >> 1));
                gst<u32x4>(ACT, (row * (unsigned)DFF + (unsigned)c0) * 2u, pack8(o));
            }
    }
};
struct EpiResid {
    static constexpr bool PERM = true, HOOK = false;
    int l, which, fuse; float scale;
    __device__ __forceinline__ void operator()(f32x4 (&acc)[2][2][4][2], const pg8::Unit& u, int wr, int wc, int fr, int fq) const {
        CParams& p = *okp(); unsigned char* const ws = ows(p.ws);
        bf16_t* H = (bf16_t*)(ws + OFF_H); const bool xin = (l == 0 && which == 0);
        const float* mod = (const float*)(ws + OFF_MOD) + (size_t)l * 5 * 6 * D; const float* gate = mod + (which ? 5 : 2) * D;
        if (u.ks >= 0) { float* slab = (float*)(ws + OFF_SLAB); const unsigned sb = (unsigned)u.ks * (unsigned)(RC * D);
            epi_foreach(acc, u, wr, wc, fr, fq, [&](int row, int col, f32x4 v0, f32x4 v1) { const unsigned o = (sb + (unsigned)((row - RL) * D + col)) * 4u; gst<f32x4>(slab, o, v0); gst<f32x4>(slab, o + 16, v1); });
            return; }
        const unsigned gb = (unsigned)(u.pm < 32 ? (u.pm >> 3) : 4) * (6 * D) * 4u;
        if (!fuse || u.pm >= 32) {
            const int row0 = u.pm * 256 + wr * 64 + fr, col0 = u.pn * 256 + wc * 32 + 8 * fq;
            f32x4 gv[2][2];
#pragma unroll
            for (int bj = 0; bj < 2; ++bj) { gv[bj][0] = gld<f32x4>(gate, gb + (unsigned)(col0 + bj * 128) * 4u) * scale; gv[bj][1] = gld<f32x4>(gate, gb + (unsigned)(col0 + bj * 128) * 4u + 16) * scale; }
            if (xin) {
#pragma unroll
              for (int am = 0; am < 4; ++am) { f32x4 hv[2][2][2];
#pragma unroll
                for (int mm = 0; mm < 2; ++mm)
#pragma unroll
                  for (int bj = 0; bj < 2; ++bj) { const unsigned ho = (unsigned)((row0 + (am >> 1) * 128 + (2 * (am & 1) + mm) * 16) * D + col0 + bj * 128) * 4u; hv[mm][bj][0] = gld<f32x4>(p.x, ho); hv[mm][bj][1] = gld<f32x4>(p.x, ho + 16); }
#pragma unroll
                for (int mm = 0; mm < 2; ++mm)
#pragma unroll
                  for (int bj = 0; bj < 2; ++bj) { const int ai = am >> 1, m = 2 * (am & 1) + mm; const unsigned eo = (unsigned)((row0 + ai * 128 + m * 16) * D + col0 + bj * 128);
                      gst<u32x4>(H, eo * 2u, pack8v(hv[mm][bj][0] + gv[bj][0] * acc[ai][bj][m][0], hv[mm][bj][1] + gv[bj][1] * acc[ai][bj][m][1])); } }
            } else {
#pragma unroll
              for (int ai = 0; ai < 2; ++ai) { u32x4 hr[4][2];
#pragma unroll
                for (int m = 0; m < 4; ++m)
#pragma unroll
                  for (int bj = 0; bj < 2; ++bj) hr[m][bj] = gld<u32x4>(H, (unsigned)((row0 + ai * 128 + m * 16) * D + col0 + bj * 128) * 2u);
#pragma unroll
                for (int m = 0; m < 4; ++m)
#pragma unroll
                  for (int bj = 0; bj < 2; ++bj) { f32x4 o0, o1; unpack8v(hr[m][bj], o0, o1);
                      gst<u32x4>(H, (unsigned)((row0 + ai * 128 + m * 16) * D + col0 + bj * 128) * 2u, pack8v(o0 + gv[bj][0] * acc[ai][bj][m][0], o1 + gv[bj][1] * acc[ai][bj][m][1])); } }
            }
            return; }
        bf16_t* XN = (bf16_t*)(ws + OFF_XN); const float* nw = fuse == 2 ? p.final_norm_w : which ? p.norm1_w + (size_t)(l + 1) * D : p.norm2_w + (size_t)l * D;
        const float* nmod = which ? mod + 5 * 6 * D : mod + 3 * D;
        float* xs = (float*)(ws + OFF_XS) + (size_t)(2 * l + which) * RL * 32; unsigned* cnt = (unsigned*)(ws + OFF_CTL) + CNTW + (2 * l + which) * 32 * 64;
        float* out = p.out;
        int lane; asm volatile("v_mbcnt_lo_u32_b32 %0, -1, 0\n\tv_mbcnt_hi_u32_b32 %0, -1, %0" : "=v"(lane));
        { const int fr2 = lane & 15, fq2 = lane >> 4, row0 = u.pm * 256 + wr * 64 + fr2, col0 = u.pn * 256 + wc * 32 + 8 * fq2;
          f32x4 gv[2][2];
#pragma unroll
          for (int bj = 0; bj < 2; ++bj) { gv[bj][0] = gld<f32x4>(gate, gb + (unsigned)(col0 + bj * 128) * 4u) * scale; gv[bj][1] = gld<f32x4>(gate, gb + (unsigned)(col0 + bj * 128) * 4u + 16) * scale; }
          float ssr[8];
          auto newh = [&](int k, int bj, f32x4 o0, f32x4 o1, float& ss) {
              const int ai = k >> 2, m = k & 3; const unsigned eo = (unsigned)((row0 + ai * 128 + m * 16) * D + col0 + bj * 128);
              const f32x4 h0 = o0 + gv[bj][0] * acc[ai][bj][m][0], h1 = o1 + gv[bj][1] * acc[ai][bj][m][1];
              if (fuse == 2) { gst<f32x4>(out, eo * 4u, h0); gst<f32x4>(out, eo * 4u + 16, h1); } else gst<u32x4>(H, eo * 2u, pack8v(h0, h1));
              ss += (h0[0] * h0[0] + h0[1] * h0[1]) + (h0[2] * h0[2] + h0[3] * h0[3]) + (h1[0] * h1[0] + h1[1] * h1[1]) + (h1[2] * h1[2] + h1[3] * h1[3]); };
          if (xin) {
#pragma unroll
            for (int am = 0; am < 4; ++am) { f32x4 hv[2][2][2];
#pragma unroll
              for (int mm = 0; mm < 2; ++mm)
#pragma unroll
                for (int bj = 0; bj < 2; ++bj) { const unsigned ho = (unsigned)((row0 + (am >> 1) * 128 + (2 * (am & 1) + mm) * 16) * D + col0 + bj * 128) * 4u; hv[mm][bj][0] = gld<f32x4>(p.x, ho); hv[mm][bj][1] = gld<f32x4>(p.x, ho + 16); }
#pragma unroll
              for (int mm = 0; mm < 2; ++mm) { const int k = 4 * (am >> 1) + 2 * (am & 1) + mm; float ss = 0.f;
#pragma unroll
                for (int bj = 0; bj < 2; ++bj) newh(k, bj, hv[mm][bj][0], hv[mm][bj][1], ss);
                ss += shx(ss, 16, lane); ss += shx(ss, 32, lane); ssr[k] = ss; } }
          } else {
#pragma unroll
            for (int kh = 0; kh < 2; ++kh) { u32x4 hr[4][2];
#pragma unroll
              for (int m = 0; m < 4; ++m)
#pragma unroll
                for (int bj = 0; bj < 2; ++bj) hr[m][bj] = gld<u32x4>(H, (unsigned)((row0 + kh * 128 + m * 16) * D + col0 + bj * 128) * 2u);
#pragma unroll
              for (int m = 0; m < 4; ++m) { const int k = 4 * kh + m; float ss = 0.f;
#pragma unroll
                for (int bj = 0; bj < 2; ++bj) { f32x4 o0, o1; unpack8v(hr[m][bj], o0, o1); newh(k, bj, o0, o1, ss); }
                ss += shx(ss, 16, lane); ss += shx(ss, 32, lane); ssr[k] = ss; } }
          }
#pragma unroll
          for (int k = 0; k < 8; ++k)
              if (fq2 == 0) __hip_atomic_store((GAS float*)xs + ((row0 + (k >> 2) * 128 + (k & 3) * 16) * 32 + u.pn * 4 + wc), ssr[k], __ATOMIC_RELAXED, __HIP_MEMORY_SCOPE_AGENT); }
        asm volatile("s_waitcnt vmcnt(0)" ::: "memory");
        __builtin_amdgcn_s_barrier();
        if (lane == 0 && wr == 0 && wc == 0) {
            GAS unsigned* pc = (GAS unsigned*)cnt + 64 * u.pm;
            (void)__hip_atomic_fetch_add(pc, 1u, __ATOMIC_RELAXED, __HIP_MEMORY_SCOPE_AGENT);
            unsigned spins = 0;
#pragma nounroll
            while (__hip_atomic_load(pc, __ATOMIC_RELAXED, __HIP_MEMORY_SCOPE_AGENT) < 8u && ++spins < (1u << 22)) __builtin_amdgcn_s_sleep(1);
        }
        __builtin_amdgcn_s_barrier();
        __builtin_amdgcn_fence(__ATOMIC_ACQUIRE, "agent");
        { const int hl = lane & 31, row0 = u.pm * 256 + (wr * 4 + wc) * 32 + (lane >> 5), col = u.pn * 256 + hl * 8;
          const unsigned mo = (unsigned)(u.pm >> 3) * (6 * D) * 4u, co = (unsigned)col * 4u;
          const f32x4 w0 = gld<f32x4>(nw, co), w1 = gld<f32x4>(nw, co + 16);
          if (fuse == 2) {
#pragma unroll
            for (int ib = 0; ib < 4; ++ib) { float tt[4]; f32x4 ha[4], hb[4];
#pragma unroll
              for (int i = 0; i < 4; ++i) { const int row = row0 + 2 * (4 * ib + i); const unsigned ho = (unsigned)(row * D + col) * 4u;
                  tt[i] = gld<float>(xs, (unsigned)(row * 32 + hl) * 4u); ha[i] = gld<f32x4>(out, ho); hb[i] = gld<f32x4>(out, ho + 16); }
#pragma unroll
              for (int i = 0; i < 4; ++i) { const int row = row0 + 2 * (4 * ib + i); const unsigned ho = (unsigned)(row * D + col) * 4u; float tot = tt[i];
#pragma unroll
                  for (int o = 1; o < 32; o <<= 1) tot += shx(tot, o, lane);
                  const float rstd = rsqrtf(tot * (1.f / D) + EPS);
                  gst<f32x4>(out, ho, ha[i] * rstd * w0); gst<f32x4>(out, ho + 16, hb[i] * rstd * w1); } }
            return; }
          const f32x4 sh0 = gld<f32x4>(nmod, mo + co), sh1 = gld<f32x4>(nmod, mo + co + 16);
          const f32x4 sc0 = gld<f32x4>(nmod, mo + D * 4 + co) + 1.f, sc1 = gld<f32x4>(nmod, mo + D * 4 + co + 16) + 1.f;
#pragma unroll
          for (int ib = 0; ib < 2; ++ib) { float tt[8]; u32x4 hq[8];
#pragma unroll
            for (int i = 0; i < 8; ++i) { const int row = row0 + 2 * (8 * ib + i);
                tt[i] = gld<float>(xs, (unsigned)(row * 32 + hl) * 4u); hq[i] = gld<u32x4>(H, (unsigned)(row * D + col) * 2u); }
#pragma unroll
            for (int i = 0; i < 8; ++i) { const int row = row0 + 2 * (8 * ib + i); float tot = tt[i];
#pragma unroll
                for (int o = 1; o < 32; o <<= 1) tot += shx(tot, o, lane);
                const float rstd = rsqrtf(tot * (1.f / D) + EPS);
                f32x4 ha, hb; unpack8v(hq[i], ha, hb);
                const f32x4 y0 = (ha * rstd * w0) * sc0 + sh0, y1 = (hb * rstd * w1) * sc1 + sh1;
                gst<u32x4>(XN, (unsigned)(row * D + col) * 2u, pack8v(y0, y1)); } } }
    }
};

__device__ __forceinline__ bf16x8 gather8(const bf16_t* p, size_t stride) {
    bf16x8 v;
#pragma unroll
    for (int j = 0; j < 8; ++j) v[j] = (short)p[(size_t)j * stride];
    return v;
}
template <bool AV, bool BV>
__device__ __forceinline__ void wave_mm32(const bf16_t* A, size_t sam, size_t sak, const bf16_t* B, size_t sbk, size_t sbn, int K, f32x4 (&acc)[2][2], int lane) {
    const int fr = lane & 15, fq = lane >> 4;
    for (int k0 = 0; k0 < K; k0 += 32) {
        bf16x8 a[2], b[2];
#pragma unroll
        for (int mi = 0; mi < 2; ++mi) { const bf16_t* q = A + (size_t)(16 * mi + fr) * sam + (size_t)(k0 + 8 * fq) * sak; a[mi] = AV ? *(const bf16x8*)q : gather8(q, sak); }
#pragma unroll
        for (int ni = 0; ni < 2; ++ni) { const bf16_t* q = B + (size_t)(16 * ni + fr) * sbn + (size_t)(k0 + 8 * fq) * sbk; b[ni] = BV ? *(const bf16x8*)q : gather8(q, sbk); }
#pragma unroll
        for (int mi = 0; mi < 2; ++mi)
#pragma unroll
            for (int ni = 0; ni < 2; ++ni) acc[mi][ni] = __builtin_amdgcn_mfma_f32_16x16x32_bf16(a[mi], b[ni], acc[mi][ni], 0, 0, 0);
    }
}
#define ZERO_ACC22(acc) do { _Pragma("unroll") for (int _a = 0; _a < 2; ++_a) _Pragma("unroll") for (int _b = 0; _b < 2; ++_b) acc[_a][_b] = (f32x4){0.f, 0.f, 0.f, 0.f}; } while (0)

__device__ __forceinline__ void transpose_item(const float* W, int N, int pitch, int kdst0, bf16_t* WT, int dst_row0, int src_col0, int nvalid, int k0, LAS float* scr, int lane) {
    const int n4 = (lane & 15) * 4, kq = lane >> 4;
    f32x4 v[16];
#pragma unroll
    for (int i = 0; i < 16; ++i) v[i] = n4 < nvalid ? gld<f32x4>(W, (unsigned)((k0 + 4 * i + kq) * N + src_col0 + n4) * 4u) : (f32x4){0.f, 0.f, 0.f, 0.f};
#pragma unroll
    for (int i = 0; i < 16; ++i) { LAS float* d = scr + (4 * i + kq) * 65 + n4; d[0] = v[i][0]; d[1] = v[i][1]; d[2] = v[i][2]; d[3] = v[i][3]; }
    asm volatile("s_waitcnt lgkmcnt(0)" ::: "memory");
    const int c = lane & 7;
#pragma unroll
    for (int j8 = 0; j8 < 8; ++j8) { const int n = (lane >> 3) + 8 * j8; const LAS float* sp = scr + (8 * c) * 65 + n;
        u32x4 o; o.x = pk2(sp[0 * 65], sp[1 * 65]); o.y = pk2(sp[2 * 65], sp[3 * 65]); o.z = pk2(sp[4 * 65], sp[5 * 65]); o.w = pk2(sp[6 * 65], sp[7 * 65]);
        gst<u32x4>(WT, (unsigned)((dst_row0 + n) * pitch + kdst0 + k0 + 8 * c) * 2u, o); }
    asm volatile("s_waitcnt lgkmcnt(0)" ::: "memory");
}
constexpr int I_IN = (NINP / 64) * (D / 64), I_PM = (D / 64) * (DM / 64), I_PF = (D / 64) * (DF / 64), I_PC = (D / 64) * (DC / 64), I_O = (D / 64) * (D / 64),
              I_UP = (NUP / 64) * (D / 64), I_DN = (D / 64) * (DFF / 64), I_LAYER = I_IN + I_PM + I_PF + I_PC + I_O + I_UP + I_DN;
__device__ __forceinline__ void ph_convert(int wv, LAS unsigned char* lds, int l, int widx, int nwg, int it_lo, int it_hi) {
    CParams& p = *okp();
    unsigned char* const wsb = ows(p.ws);
    const int TIDX = otid(wv);
    const int lane = TIDX & 63, wave = wv;
    LAS float* scr = (LAS float*)lds + wave * 64 * 65;
    const int gw = widx * 8 + wave, NGW = nwg * 8;
    for (int it = it_lo + gw; it < it_hi; it += NGW) {
        int r = it;
        if (r < I_IN) { const int nkb = D / 64, kb = r % nkb, grp = r / nkb, j0 = 64 * grp; int src0, nv;
            if (j0 < 2048) { src0 = j0; nv = 64; } else if (j0 < NP) { src0 = j0 + 16; nv = 64; } else if (j0 == NP) { src0 = 2048; nv = 16; } else { src0 = 0; nv = 0; }
            transpose_item(p.w_in + (size_t)l * D * NIN, NIN, D, 0, WSP(bf16_t, OFF_WIN) + (size_t)l * NINP * D, j0, src0, nv, 64 * kb, scr, lane); continue; } r -= I_IN;
        if (r < I_PM) { const int nkb = DM / 64, kb = r % nkb, grp = r / nkb;
            transpose_item(p.w_pm + (size_t)l * DM * D, D, D, 0, WSP(bf16_t, OFF_WPM) + (size_t)l * D * D, 64 * grp, 64 * grp, 64, 64 * kb, scr, lane); continue; } r -= I_PM;
        if (r < I_PF) { const int nkb = DF / 64, kb = r % nkb, grp = r / nkb;
            transpose_item(p.w_pf + (size_t)l * DF * D, D, D, DM, WSP(bf16_t, OFF_WPM) + (size_t)l * D * D, 64 * grp, 64 * grp, 64, 64 * kb, scr, lane); continue; } r -= I_PF;
        if (r < I_PC) { const int nkb = DC / 64, kb = r % nkb, grp = r / nkb;
            transpose_item(p.w_pc + (size_t)l * DC * D, D, D, DM + DF, WSP(bf16_t, OFF_WPM) + (size_t)l * D * D, 64 * grp, 64 * grp, 64, 64 * kb, scr, lane); continue; } r -= I_PC;
        if (r < I_O) { const int nkb = D / 64, kb = r % nkb, grp = r / nkb;
            transpose_item(p.w_o + (size_t)l * D * D, D, D, 0, WSP(bf16_t, OFF_WO) + (size_t)l * D * D, 64 * grp, 64 * grp, 64, 64 * kb, scr, lane); continue; } r -= I_O;
        if (r < I_UP) { const int nkb = D / 64, kb = r % nkb, grp = r / nkb, j0 = 64 * grp, tile = j0 >> 8, w0 = j0 & 255;
            transpose_item(p.w_up + (size_t)l * D * NUP, NUP, D, 0, WSP(bf16_t, OFF_WUP) + (size_t)l * NUP * D, j0, w0 < 128 ? 128 * tile + w0 : DFF + 128 * tile + (w0 - 128), 64, 64 * kb, scr, lane); continue; } r -= I_UP;
        { const int nkb = DFF / 64, kb = r % nkb, grp = r / nkb;
            transpose_item(p.w_down + (size_t)l * DFF * D, D, DFF, 0, WSP(bf16_t, OFF_WDN) + (size_t)l * D * DFF, 64 * grp, 64 * grp, 64, 64 * kb, scr, lane); }
    }
}
__device__ __forceinline__ void ph_tables(int wv) {
    CParams& p = *okp();
    unsigned char* const wsb = ows(p.ws);
    const int TIDX = otid(wv), BIDX = obid(); (void)TIDX; (void)BIDX;
    const size_t gt = (size_t)BIDX * 512 + TIDX, NT = (size_t)gridDim.x * 512;
    bf16_t* ma = WSP(bf16_t, OFF_MA);
    for (size_t i = gt; i < (size_t)64 * 64; i += NT) { const int row = (int)(i >> 6), col = (int)(i & 63), ro = row >> 5, tau1 = row & 31, ri = col >> 5, t1 = col & 31;
        const float a = (float)((t1 * tau1) & 31) * (1.0f / 16.0f); const float cv = cospif(a), sv = sinpif(a);
        ma[i] = (bf16_t)f2bf(ro == ri ? cv : (ro == 0 ? sv : -sv)); }
    bf16_t* mc = WSP(bf16_t, OFF_MC);
    for (size_t i = gt; i < (size_t)32 * 64 * 128; i += NT) { const int k = (int)(i & 127), tau2 = (int)(i >> 7) & 63, tau1 = (int)(i >> 13), ri = k >> 6, t2 = k & 63, tau = tau1 + 32 * tau2;
        const float a = (float)((t2 * tau) & 2047) * (1.0f / 1024.0f); mc[i] = (bf16_t)f2bf((ri ? sinpif(a) : cospif(a)) * (1.0f / 512.0f)); }
    bf16_t* csc = WSP(bf16_t, OFF_CSC);
    for (size_t i = gt; i < (size_t)256 * 512; i += NT) { const int tau = (int)(i >> 9), k = (int)(i & 511), t = k & 255; const int idx = (tau * t) & 255;
        const float a = (float)idx * (1.0f / 128.0f); const float v = (k < 256 ? cospif(a) : -sinpif(a)) * 0.005524271728019903f  ; csc[i] = (bf16_t)f2bf(v); }
    bf16_t* ft = WSP(bf16_t, OFF_FT);
    for (size_t i = gt; i < (size_t)256 * 128; i += NT) { const int kp = (int)(i >> 7), c = (int)(i & 127), kap = kp & 127; const int idx = (c * kap) & 127;
        const float a = (float)idx * (1.0f / 64.0f); ft[i] = (bf16_t)f2bf(kp < 128 ? cospif(a) : sinpif(a)); }
    float* binr = WSP(float, OFF_BINR);
    for (size_t i = gt; i < (size_t)DEPTH * NINP; i += NT) { const int l = (int)(i / NINP), j = (int)(i % NINP);
        float v = 0.f; if (j < 2048) v = p.b_in[(size_t)l * NIN + j]; else if (j < NP) v = p.b_in[(size_t)l * NIN + j + 16]; else if (j < NP + 16) v = p.b_in[(size_t)l * NIN + 2048 + (j - NP)];
        binr[i] = v; }

}
__device__ __forceinline__ void ph_mod(int wv, LAS unsigned char* lds, int l0, int l1, int widx, int nwg) {
    CParams& p = *okp();
    unsigned char* const wsb = ows(p.ws);
    const int TIDX = otid(wv), BIDX = obid(); (void)TIDX; (void)BIDX;
    typedef float sc_row_t[D]; typedef f32x4 red_t[5][16];
    LAS sc_row_t* sc = (LAS sc_row_t*)lds; LAS red_t* red = (LAS red_t*)(lds + 5 * D * 4);
    const int tid = TIDX;
    for (int i = tid; i < 5 * D; i += 512) { const int j = i / D, k = i % D; const float v = j < 4 ? p.c[(size_t)j * D + k] : p.c_ctx[k]; sc[j][k] = siluf_(v); }
    __syncthreads();
    float* mod = WSP(float, OFF_MOD);
    const int cl = tid & 15, kg = tid >> 4;
    for (int unit = widx; unit < (l1 - l0) * (6 * D / 64); unit += nwg) {
        const int l = l0 + unit / (6 * D / 64), n0 = (unit % (6 * D / 64)) * 64;
        f32x4 a[5];
#pragma unroll
        for (int j = 0; j < 5; ++j) a[j] = (f32x4){0.f, 0.f, 0.f, 0.f};
        const float* wp = p.w_mod + (size_t)l * D * 6 * D + n0 + 4 * cl;
        for (int k0 = kg; k0 < D; k0 += 32 * 8) { f32x4 w8[8];
#pragma unroll
            for (int i = 0; i < 8; ++i) w8[i] = *(const f32x4*)(wp + (size_t)(k0 + 32 * i) * 6 * D);
#pragma unroll
            for (int i = 0; i < 8; ++i)
#pragma unroll
                for (int j = 0; j < 5; ++j) a[j] += sc[j][k0 + 32 * i] * w8[i]; }
#pragma unroll
        for (int j = 0; j < 5; ++j) {
#pragma unroll
            for (int e = 0; e < 4; ++e) { float v = a[j][e]; v += shx(v, 16, tid & 63); v += shx(v, 32, tid & 63); a[j][e] = v; }
            if ((tid & 63) < 16) red[tid >> 6][j][cl] = a[j]; }
        __syncthreads();
        if (tid < 5 * 64) { const int j = tid / 64, cc = tid % 64; float s = 0.f;
            for (int g = 0; g < 8; ++g) s += ((const LAS float*)&red[g][j][0])[cc];
            mod[((size_t)l * 5 + j) * 6 * D + n0 + cc] = s + p.b_mod[(size_t)l * 6 * D + n0 + cc]; }
        __syncthreads();
    }
}

template <bool F32> __device__ __forceinline__ void ph_norm(int wv, int l, int which, const float* fixgate, int row_lo, int nrows, const void* hlat, const void* hctx) {
    CParams& p = *okp();
    unsigned char* const wsb = ows(p.ws);
    const int TIDX = otid(wv), BIDX = obid();
    const int lane = TIDX & 63, gw = BIDX * 8 + (TIDX >> 6), NGW = gridDim.x * 8;
    const float* nw = (which ? p.norm2_w : p.norm1_w) + (size_t)l * D;
    const float* mod = WSP(float, OFF_MOD) + (size_t)l * 5 * 6 * D;
    bf16_t* H = WSP(bf16_t, OFF_H); bf16_t* XN = WSP(bf16_t, OFF_XN); const float* SL = WSP(float, OFF_SLAB);
    for (int r = row_lo + gw; r < nrows; r += NGW) {
        int mj, t, T; rowinfo(r, mj, t, T);
        const unsigned so = (unsigned)(mj * 6 * D + (which ? 3 : 0) * D) * 4u;
        const unsigned ho = (unsigned)(r * D + 4 * lane) * 2u;
        const void* rd = r < RL ? hlat : hctx; const unsigned re = (unsigned)((r < RL ? r : r - RL) * D + 4 * lane);
        f32x4 v[8]; float ss = 0.f;
        if constexpr (F32) {
#pragma unroll
            for (int j = 0; j < 8; ++j) v[j] = gld<f32x4>(rd, re * 4u + (unsigned)j * 1024u);
        } else { u32x2 q[8];
#pragma unroll
            for (int j = 0; j < 8; ++j) q[j] = gld<u32x2>(rd, re * 2u + (unsigned)j * 512u);
#pragma unroll
            for (int j = 0; j < 8; ++j) { v[j][0] = __uint_as_float(q[j].x << 16); v[j][1] = __uint_as_float(q[j].x & 0xffff0000u); v[j][2] = __uint_as_float(q[j].y << 16); v[j][3] = __uint_as_float(q[j].y & 0xffff0000u); } }
#pragma unroll
        for (int j = 0; j < 8; ++j) ss += (v[j][0] * v[j][0] + v[j][1] * v[j][1]) + (v[j][2] * v[j][2] + v[j][3] * v[j][3]);
        const float rstd = rsqrtf(wave_sum(ss, lane) * (1.f / D) + EPS);
#pragma unroll
        for (int jh = 0; jh < 2; ++jh) { f32x4 wq[4], scq[4], shq[4];
#pragma unroll
          for (int jj = 0; jj < 4; ++jj) { const unsigned co = (unsigned)(4 * (lane + 64 * (4 * jh + jj))) * 4u; wq[jj] = gld<f32x4>(nw, co); scq[jj] = gld<f32x4>(mod, so + D * 4 + co); shq[jj] = gld<f32x4>(mod, so + co); }
#pragma unroll
          for (int jj = 0; jj < 4; ++jj) { const int j = 4 * jh + jj;
            const f32x4 y = (v[j] * rstd * wq[jj]) * (1.f + scq[jj]) + shq[jj];
            u32x2 q; q.x = pk2(y[0], y[1]); q.y = pk2(y[2], y[3]); gst<u32x2>(XN, (unsigned)(r * D + 4 * (lane + 64 * j)) * 2u, q); } }
    }
}
__device__ __forceinline__ void ph_norm_lat(int wv, int l, int which) {
    CParams& p = *okp();
    unsigned char* const wsb = ows(p.ws);
    const int TIDX = otid(wv), lane = TIDX & 63, gw = obid() * 8 + (TIDX >> 6), NGW = gridDim.x * 8;
    const float* nw = (which ? p.norm2_w : p.norm1_w) + (size_t)l * D;
    const float* mod = WSP(float, OFF_MOD) + (size_t)l * 5 * 6 * D;
    const bf16_t* H = WSP(bf16_t, OFF_H); bf16_t* XN = WSP(bf16_t, OFF_XN);
    for (int g = gw; g < RL / 4; g += NGW) {
        const int r0 = 4 * g; const unsigned so = (unsigned)((r0 >> 11) * 6 * D + (which ? 3 : 0) * D) * 4u;
        u32x2 q[4][8]; f32x4 wq[8], scq[8], shq[8];
#pragma unroll
        for (int k = 0; k < 4; ++k)
#pragma unroll
            for (int j = 0; j < 8; ++j) q[k][j] = gld<u32x2>(H, (unsigned)((r0 + k) * D + 4 * lane + 256 * j) * 2u);
#pragma unroll
        for (int j = 0; j < 8; ++j) { const unsigned co = (unsigned)(4 * lane + 256 * j) * 4u; wq[j] = gld<f32x4>(nw, co); scq[j] = gld<f32x4>(mod, so + D * 4 + co) + 1.f; shq[j] = gld<f32x4>(mod, so + co); }
#pragma unroll
        for (int j = 0; j < 8; ++j) wq[j] = wq[j] * scq[j];
#pragma unroll
        for (int k = 0; k < 4; ++k) { f32x4 v[8]; float ss = 0.f;
#pragma unroll
            for (int j = 0; j < 8; ++j) { v[j][0] = __uint_as_float(q[k][j].x << 16); v[j][1] = __uint_as_float(q[k][j].x & 0xffff0000u); v[j][2] = __uint_as_float(q[k][j].y << 16); v[j][3] = __uint_as_float(q[k][j].y & 0xffff0000u);
                ss += (v[j][0] * v[j][0] + v[j][1] * v[j][1]) + (v[j][2] * v[j][2] + v[j][3] * v[j][3]); }
            const float rstd = rsqrtf(wave_sum(ss, lane) * (1.f / D) + EPS);
#pragma unroll
            for (int j = 0; j < 8; ++j) { const f32x4 y = (v[j] * rstd) * wq[j] + shq[j];
                u32x2 o; o.x = pk2(y[0], y[1]); o.y = pk2(y[2], y[3]); gst<u32x2>(XN, (unsigned)((r0 + k) * D + 4 * lane + 256 * j) * 2u, o); } }
    }
}
template <bool F32> __device__ __forceinline__ void ph_norm_ctx(int wv, LAS unsigned char* lds, int l, int which) {
    CParams& p = *okp();
    unsigned char* const wsb = ows(p.ws);
    const int TIDX = otid(wv), lane = TIDX & 63, wave = wv, half = wave & 1;
    const float* nw = (which ? p.norm2_w : p.norm1_w) + (size_t)l * D;
    const float* mod = WSP(float, OFF_MOD) + (size_t)l * 5 * 6 * D;
    bf16_t* H = WSP(bf16_t, OFF_H); bf16_t* XN = WSP(bf16_t, OFF_XN); const float* SL = WSP(float, OFF_SLAB);
    const void* hctx = F32 ? (const void*)p.ctx : (const void*)(H + (size_t)RL * D);
    const float* fixgate = which ? mod + 4 * 6 * D + 2 * D : mod - 5 * 6 * D + 4 * 6 * D + 5 * D;
    LAS float* red = (LAS float*)lds;
    const unsigned so = (unsigned)(4 * 6 * D + (which ? 3 : 0) * D) * 4u;
    for (int rb = obid(); rb < RC / 4; rb += gridDim.x) {
        const int rc = 4 * rb + (wave >> 1), r = RL + rc;
        f32x4 v[4]; float ss = 0.f;
#pragma unroll
        for (int jp = 0; jp < 2; ++jp) { f32x4 sp[2][8], fg[2]; u32x2 q[2];
#pragma unroll
            for (int jj = 0; jj < 2; ++jj) { const int j = 4 * half + 2 * jp + jj; const unsigned e = (unsigned)(rc * D + 4 * lane + 256 * j);
                if constexpr (F32) v[2 * jp + jj] = gld<f32x4>(hctx, e * 4u); else q[jj] = gld<u32x2>(hctx, e * 2u);
#pragma unroll
                for (int sl = 0; sl < 8; ++sl) sp[jj][sl] = gld<f32x4>(SL, ((unsigned)(sl * RC) * D + e) * 4u);
                fg[jj] = gld<f32x4>(fixgate, (unsigned)(4 * lane + 256 * j) * 4u); }
#pragma unroll
            for (int jj = 0; jj < 2; ++jj) { const int j = 4 * half + 2 * jp + jj; f32x4& vv = v[2 * jp + jj];
                if constexpr (!F32) { vv[0] = __uint_as_float(q[jj].x << 16); vv[1] = __uint_as_float(q[jj].x & 0xffff0000u); vv[2] = __uint_as_float(q[jj].y << 16); vv[3] = __uint_as_float(q[jj].y & 0xffff0000u); }
                f32x4 a = sp[jj][0];
#pragma unroll
                for (int sl = 1; sl < 8; ++sl) a += sp[jj][sl];
                vv += fg[jj] * a;
                u32x2 hq; hq.x = pk2(vv[0], vv[1]); hq.y = pk2(vv[2], vv[3]); gst<u32x2>(H, (unsigned)(r * D + 4 * lane + 256 * j) * 2u, hq);
                ss += (vv[0] * vv[0] + vv[1] * vv[1]) + (vv[2] * vv[2] + vv[3] * vv[3]); } }
        f32x4 wq[4], scq[4], shq[4];
#pragma unroll
        for (int jj = 0; jj < 4; ++jj) { const unsigned co = (unsigned)(4 * lane + 256 * (4 * half + jj)) * 4u; wq[jj] = gld<f32x4>(nw, co); scq[jj] = gld<f32x4>(mod, so + D * 4 + co); shq[jj] = gld<f32x4>(mod, so + co); }
        ss = wave_sum(ss, lane);
        if (lane == 0) red[wave] = ss;
        __syncthreads();
        const float rstd = rsqrtf((red[wave & ~1] + red[wave | 1]) * (1.f / D) + EPS);
#pragma unroll
        for (int jj = 0; jj < 4; ++jj) { const int j = 4 * half + jj;
            const f32x4 y = (v[jj] * rstd * wq[jj]) * (1.f + scq[jj]) + shq[jj];
            u32x2 qq; qq.x = pk2(y[0], y[1]); qq.y = pk2(y[2], y[3]); gst<u32x2>(XN, (unsigned)(r * D + 4 * lane + 256 * j) * 2u, qq); }
        __syncthreads();
    }
}
__device__ __forceinline__ void ph_final(int wv) {
    CParams& p = *okp();
    unsigned char* const wsb = ows(p.ws);
    const int TIDX = otid(wv), BIDX = obid(); (void)TIDX; (void)BIDX;
    const int lane = TIDX & 63, gw = BIDX * 8 + (TIDX >> 6), NGW = gridDim.x * 8;
    const bf16_t* H = WSP(bf16_t, OFF_H);
    for (int r = gw; r < RL; r += NGW) {
        f32x4 v[8]; float ss = 0.f;
#pragma unroll
        for (int j = 0; j < 8; ++j) { const u32x2 q = gld<u32x2>(H, (unsigned)(r * D + 4 * (lane + 64 * j)) * 2u); v[j][0] = __uint_as_float(q.x << 16); v[j][1] = __uint_as_float(q.x & 0xffff0000u); v[j][2] = __uint_as_float(q.y << 16); v[j][3] = __uint_as_float(q.y & 0xffff0000u); ss += (v[j][0] * v[j][0] + v[j][1] * v[j][1]) + (v[j][2] * v[j][2] + v[j][3] * v[j][3]); }
        const float rstd = rsqrtf(wave_sum(ss, lane) * (1.f / D) + EPS);
        f32x4* o = (f32x4*)(p.out + (size_t)r * D) + lane;
#pragma unroll
        for (int j = 0; j < 8; ++j) { const f32x4 w = *(const f32x4*)(p.final_norm_w + 4 * (lane + 64 * j)); o[64 * j] = v[j] * rstd * w; }
    }
}

__device__ __forceinline__ float wave_incl_sum(float v, int lane) {
#pragma unroll
    for (int o = 1; o < 64; o <<= 1) { const float t = shl_(v, lane >= o ? lane - o : lane); if (lane >= o) v += t; }
    return v;
}
__device__ __forceinline__ float wave_incl_max(float v, int lane) {
#pragma unroll
    for (int o = 1; o < 64; o <<= 1) { const float t = shl_(v, lane >= o ? lane - o : lane); if (lane >= o) v = fmaxf(v, t); }
    return v;
}
__device__ __forceinline__ float logsigmoidf_(float x) { return fminf(x, 0.f) - log1pf(__expf(-fabsf(x))); }
struct GateV { float b0, b1, c0, c1, m0, m1, bend, cend; int s0, s1; };
__device__ __forceinline__ GateV gate_vectors(const float* G, int row0, int h, int dir, int lane) {
    GateV g; g.s0 = dir ? 127 - lane : lane; g.s1 = dir ? 63 - lane : lane + 64;
    const unsigned o0 = (unsigned)((row0 + g.s0) * 16 + dir * 8 + h) * 4u, o1 = (unsigned)((row0 + g.s1) * 16 + dir * 8 + h) * 4u;
    const float i0 = gld<float>(G, o0), f0 = gld<float>(G, o0 + 16), i1 = gld<float>(G, o1), f1 = gld<float>(G, o1 + 16);
    g.b0 = wave_incl_sum(logsigmoidf_(f0), lane); const float tot0 = shl_(g.b0, 63 + (lane & 0));
    g.b1 = wave_incl_sum(logsigmoidf_(f1), lane) + tot0;
    g.c0 = i0 - g.b0; g.c1 = i1 - g.b1;
    g.m0 = wave_incl_max(g.c0, lane); const float mx0 = shl_(g.m0, 63 + (lane & 0));
    g.m1 = fmaxf(wave_incl_max(g.c1, lane), mx0);
    g.bend = shl_(g.b1, 63 + (lane & 0)); g.cend = shl_(g.m1, 63 + (lane & 0));
    return g;
}
__device__ __forceinline__ void ph_convc(int wv, int l, int nrows, int widx, int nwg) {
    CParams& p = *okp();
    unsigned char* const wsb = ows(p.ws);
    const unsigned gt = (unsigned)widx * 512u + otid(wv), NT = (unsigned)nwg * 512u;
    const bf16_t* P = WSP(bf16_t, OFF_P); bf16_t* YC = WSP(bf16_t, OFF_HM) + (DM + DF);
    const float* wc = p.conv_c_w + (size_t)l * 3 * DC;
    for (unsigned i = gt; i < (unsigned)nrows * 64u; i += NT) {
        const int r = (int)(i >> 6), c = (int)(i & 63) * 8; int mj, t, T; rowinfo(r, mj, t, T);
        const unsigned pr = (unsigned)(r * NP) * 2u;
        const bool cp = r < RL ? (t & 63) > 0 : t > 0, cn = r < RL ? (t & 63) < 63 : t < T - 1;
        float x0[8], x1[8], y0[8], y1[8], z0[8], z1[8], cb[8], o[8];
        unpack8(gld<u32x4>(P, pr + (PCC + c) * 2), x0); unpack8(gld<u32x4>(P, pr + (PCX + c) * 2), x1); unpack8(gld<u32x4>(P, pr + (PCB + c) * 2), cb);
        const unsigned pp = cp ? pr - NP * 2 : pr, pn = cn ? pr + NP * 2 : pr;
        unpack8(gld<u32x4>(P, pp + (PCC + c) * 2), y0); unpack8(gld<u32x4>(P, pp + (PCX + c) * 2), y1);
        unpack8(gld<u32x4>(P, pn + (PCC + c) * 2), z0); unpack8(gld<u32x4>(P, pn + (PCX + c) * 2), z1);
        const f32x4 w00 = gld<f32x4>(wc, (unsigned)c * 4u), w01 = gld<f32x4>(wc, (unsigned)c * 4u + 16), w10 = gld<f32x4>(wc, (unsigned)(DC + c) * 4u), w11 = gld<f32x4>(wc, (unsigned)(DC + c) * 4u + 16),
                    w20 = gld<f32x4>(wc, (unsigned)(2 * DC + c) * 4u), w21 = gld<f32x4>(wc, (unsigned)(2 * DC + c) * 4u + 16);
#pragma unroll
        for (int j = 0; j < 8; ++j) { const float w0 = j < 4 ? w00[j & 3] : w01[j & 3], w1 = j < 4 ? w10[j & 3] : w11[j & 3], w2 = j < 4 ? w20[j & 3] : w21[j & 3];
            float v = w1 * (x0[j] * x1[j]); if (cp) v += w0 * (y0[j] * y1[j]); if (cn) v += w2 * (z0[j] * z1[j]); o[j] = cb[j] * v; }
        gst<u32x4>(YC, (unsigned)(r * D + c) * 2u, pack8(o));
    }
}
__device__ __forceinline__ void ph_fourier1(int wv, int widx, int nwg) {
    CParams& p = *okp();
    unsigned char* const wsb = ows(p.ws);
    const int TIDX = otid(wv), BIDX = obid(); (void)TIDX; (void)BIDX;
    const int lane = TIDX & 63, gw = widx * 8 + (TIDX >> 6), NGW = nwg * 8, fr = lane & 15, fq = lane >> 4;
    const bf16_t* P = WSP(bf16_t, OFF_P); const bf16_t* FT = WSP(bf16_t, OFF_FT);
    bf16_t* ZTC = WSP(bf16_t, OFF_ZTC);
    for (int task = gw; task < (RC / 32) * 4 * 8; task += NGW) {
        const int kb = task & 7, g = (task >> 3) & 3, rb = task >> 5, r0 = RL + rb * 32;
        f32x4 acc[2][2]; ZERO_ACC22(acc);
        wave_mm32<true, true>(P + (size_t)r0 * NP + PF + g * 128, NP, 1, FT + (size_t)(kb * 32) * 128, 1, 128, 128, acc, lane);
#pragma unroll
        for (int mi = 0; mi < 2; ++mi)
#pragma unroll
            for (int ni = 0; ni < 2; ++ni) {
                const int r = r0 + 16 * mi + 4 * fq, kp = kb * 32 + 16 * ni + fr, comp = kp >> 7, kap = kp & 127;
                u32x2 w; w.x = pk2(acc[mi][ni][0], acc[mi][ni][1]); w.y = pk2(acc[mi][ni][2], acc[mi][ni][3]);
                { const int q = r - RL, b = q >> 8, t = q & 255; *(u32x2*)(ZTC + (size_t)((b * 4 + g) * 128 + kap) * 512 + comp * 256 + t) = w; }
            }
    }
}
template <bool FIRST> __device__ __forceinline__ f32x4 mma16(bf16x8 a, bf16x8 b, f32x4 c) {
    if constexpr (FIRST) return __builtin_amdgcn_mfma_f32_16x16x32_bf16(a, b, (f32x4){0.f, 0.f, 0.f, 0.f}, 0, 0, 0);
    else return __builtin_amdgcn_mfma_f32_16x16x32_bf16(a, b, c, 0, 0, 0);
}
typedef short s16x4 __attribute__((ext_vector_type(4)));
constexpr int PIT_T = 544;
constexpr int PIT_R = 528;
constexpr int PIT_P = 272;
__device__ __forceinline__ bf16x8 tr_frag(LAS unsigned char* img, int pitchB, int r0, int c0, int lane) {
    const int g = lane >> 4, q = (lane & 15) >> 2, pp = lane & 3;
    LAS unsigned char* a = img + (r0 + 8 * g + q) * pitchB + (c0 + 4 * pp) * 2;
    const s16x4 lo = __builtin_amdgcn_ds_read_tr16_b64_v4i16((LAS s16x4*)a);
    const s16x4 hi = __builtin_amdgcn_ds_read_tr16_b64_v4i16((LAS s16x4*)(a + 4 * pitchB));
    return (bf16x8){lo[0], lo[1], lo[2], lo[3], hi[0], hi[1], hi[2], hi[3]};
}
template <class F> __device__ __forceinline__ void conv_silu_rows(const u32x4 (&raw)[10], const float (&w0)[8], const float (&w1)[8], const float (&w2)[8], F&& f) {
    float a[8], b[8], c[8];
    unpack8(raw[0], a); unpack8(raw[1], b);
#pragma unroll
    for (int i = 0; i < 8; ++i) {
        unpack8(raw[i + 2], c);
        float o[8];
#pragma unroll
        for (int j = 0; j < 8; ++j) o[j] = siluf_(w0[j] * a[j] + w1[j] * b[j] + w2[j] * c[j]);
        f(i, o);
#pragma unroll
        for (int j = 0; j < 8; ++j) { a[j] = b[j]; b[j] = c[j]; }
    }
}
constexpr int FPIT = 2336;
__device__ __forceinline__ void ph_fft(int wv, LAS unsigned char* lds, int u0, int ustride) {
    CParams& p = *okp();
    unsigned char* const wsb = ows(p.ws);
    const bf16_t* P = WSP(bf16_t, OFF_P); const bf16_t* FT = WSP(bf16_t, OFF_FT); const bf16_t* MA = WSP(bf16_t, OFF_MA); const bf16_t* MC = WSP(bf16_t, OFF_MC); bf16_t* HM = WSP(bf16_t, OFF_HM);
    LAS unsigned char* IMG = lds;
    const int wave = wv;
    for (int unit = u0; unit < NB * 4 * 8; unit += ustride) {
        const int kb = unit & 7, g = (unit >> 3) & 3, b = unit >> 5, kap0 = 16 * kb;
        {
            const int tid = otid(wv), lane = tid & 63, fr = lane & 15, fq = lane >> 4;
            bf16x8 fb[2][4];
#pragma unroll
            for (int ni = 0; ni < 2; ++ni)
#pragma unroll
                for (int ks = 0; ks < 4; ++ks) fb[ni][ks] = gld<bf16x8>(FT, (unsigned)((ni * 128 + kap0 + fr) * 128 + 32 * ks + 8 * fq) * 2u);
#pragma unroll 1
            for (int mi8 = 0; mi8 < 2; ++mi8) {
                bf16x8 xa[8][4];
#pragma unroll
                for (int m = 0; m < 8; ++m)
#pragma unroll
                    for (int ks = 0; ks < 4; ++ks) xa[m][ks] = gld<bf16x8>(P, (unsigned)((b * 2048 + 256 * wave + 16 * (8 * mi8 + m) + fr) * NP + PF + g * 128 + 32 * ks + 8 * fq) * 2u);
#pragma unroll
                for (int m = 0; m < 8; ++m) {
                    f32x4 zr = mma16<true>(xa[m][0], fb[0][0], zr), zi = mma16<true>(xa[m][0], fb[1][0], zi);
#pragma unroll
                    for (int ks = 1; ks < 4; ++ks) { zr = mma16<false>(xa[m][ks], fb[0][ks], zr); zi = mma16<false>(xa[m][ks], fb[1][ks], zi); }
                    const int tb = 256 * wave + 16 * (8 * mi8 + m) + 4 * fq, t1 = tb >> 6, t2 = tb & 63;
                    u32x2 wr_, wi_; wr_.x = pk2(zr[0], zr[1]); wr_.y = pk2(zr[2], zr[3]); wi_.x = pk2(-zi[0], -zi[1]); wi_.y = pk2(-zi[2], -zi[3]);
                    *(LAS u32x2*)(IMG + t1 * FPIT + fr * 144 + t2 * 2) = wr_;
                    *(LAS u32x2*)(IMG + (32 + t1) * FPIT + fr * 144 + t2 * 2) = wi_;
                }
            }
        }
        __syncthreads();
        {
            const int tid = otid(wv), lane = tid & 63, fr = lane & 15, fq = lane >> 4;
            bf16x8 ya[4][2];
#pragma unroll
            for (int mt = 0; mt < 4; ++mt)
#pragma unroll
                for (int ks = 0; ks < 2; ++ks) ya[mt][ks] = gld<bf16x8>(MA, (unsigned)((16 * mt + fr) * 64 + 32 * ks + 8 * fq) * 2u);
#pragma unroll 2
            for (int j = 0; j < 8; ++j) {
                const int grp = 8 * wave + j, c0 = (grp >> 2) * 72 + (grp & 3) * 16;
                const bf16x8 x0 = tr_frag(IMG, FPIT, 0, c0, lane), x1 = tr_frag(IMG, FPIT, 32, c0, lane);
                f32x4 d[4];
#pragma unroll
                for (int mt = 0; mt < 4; ++mt) { d[mt] = mma16<true>(x0, ya[mt][0], d[mt]); d[mt] = mma16<false>(x1, ya[mt][1], d[mt]); }
#pragma unroll
                for (int mt = 0; mt < 4; ++mt) { u32x2 w; w.x = pk2(d[mt][0], d[mt][1]); w.y = pk2(d[mt][2], d[mt][3]);
                    *(LAS u32x2*)(IMG + (16 * mt + fr) * FPIT + (c0 + 4 * fq) * 2) = w; }
            }
        }
        __syncthreads();
        {
            const int tid = otid(wv), lane = tid & 63, fr = lane & 15, fq = lane >> 4;
            bf16x8 y[4][4];
#pragma unroll
            for (int mt = 0; mt < 4; ++mt)
#pragma unroll
                for (int ks = 0; ks < 4; ++ks) y[mt][ks] = gld<bf16x8>(MC, (unsigned)((4 * wave * 64 + 16 * mt + fr) * 128 + 32 * ks + 8 * fq) * 2u);
#pragma unroll 1
            for (int q = 0; q < 4; ++q) {
                const int tau1 = 4 * wave + q, tn = q < 3 ? tau1 + 1 : tau1;
                bf16x8 yn[4][4];
#pragma unroll
                for (int mt = 0; mt < 4; ++mt)
#pragma unroll
                    for (int ks = 0; ks < 4; ++ks) yn[mt][ks] = gld<bf16x8>(MC, (unsigned)((tn * 64 + 16 * mt + fr) * 128 + 32 * ks + 8 * fq) * 2u);
                f32x4 acc[4];
#pragma unroll
                for (int ks = 0; ks < 4; ++ks) { const bf16x8 x = *(const LAS bf16x8*)(IMG + ((ks >> 1) * 32 + tau1) * FPIT + fr * 144 + (32 * (ks & 1) + 8 * fq) * 2);
#pragma unroll
                    for (int mt = 0; mt < 4; ++mt) { if (ks == 0) acc[mt] = mma16<true>(x, y[mt][ks], acc[mt]); else acc[mt] = mma16<false>(x, y[mt][ks], acc[mt]); } }
#pragma unroll
                for (int mt = 0; mt < 4; ++mt) { const int tau = tau1 + 32 * (16 * mt + fr);
                    u32x2 w; w.x = pk2(acc[mt][0], acc[mt][1]); w.y = pk2(acc[mt][2], acc[mt][3]);
                    gst<u32x2>(HM, (unsigned)((b * 2048 + tau) * D + DM + g * 128 + kap0 + 4 * fq) * 2u, w); }
#pragma unroll
                for (int mt = 0; mt < 4; ++mt)
#pragma unroll
                    for (int ks = 0; ks < 4; ++ks) y[mt][ks] = yn[mt][ks];
            }
        }
        __syncthreads();
    }
}
__device__ __forceinline__ void ph_mlstm1(int wv, int l, LAS unsigned char* lds) {
    CParams& p = *okp();
    unsigned char* const wsb = ows(p.ws);
    const int wave = wv;
    LAS unsigned char* KWs = lds; LAS unsigned char* Vs = lds + 128 * PIT_T; LAS float* vW = (LAS float*)(lds + 2 * 128 * PIT_T);
    const bf16_t* P = WSP(bf16_t, OFF_P); const float* G = WSP(float, OFF_G);
    bf16_t* UT = WSP(bf16_t, OFF_UT); float* NV = WSP(float, OFF_NV); float* CHS = WSP(float, OFF_CHS);
    const float* wk = p.conv_k_w + (size_t)l * 3 * DM;
    for (int unit = obid(); unit < NCHUNK * NH * 2; unit += gridDim.x) {
        const int tid = otid(wv), lane = tid & 63, fr = lane & 15, fq = lane >> 4, dg = tid & 31, sg = tid >> 5;
        const int dir = unit & 1, h = (unit >> 1) & 3, cidx = unit >> 3, row0 = chunk_row0(cidx);
        const bool first = cidx < 64 ? (cidx & 15) == 0 : ((cidx - 64) & 1) == 0, last = cidx < 64 ? (cidx & 15) == 15 : ((cidx - 64) & 1) == 1;
        const bf16_t* kp = P + (size_t)(row0 + 8 * sg) * NP + PK + h * DH + 8 * dg;
        u32x4 kr[10], vr[8];
#pragma unroll
        for (int i = 0; i < 10; ++i) { const int s = 8 * sg - 1 + i; const bool ok = (s >= 0 || !first) && (s < CHUNK || !last);
            kr[i] = ok ? *(const u32x4*)(kp + (ptrdiff_t)(i - 1) * NP) : (u32x4){0u, 0u, 0u, 0u}; }
#pragma unroll
        for (int i = 0; i < 8; ++i) vr[i] = *(const u32x4*)(kp + (PV - PK) + (size_t)i * NP);
        float w0[8], w1[8], w2[8];
#pragma unroll
        for (int j = 0; j < 8; ++j) { w0[j] = wk[h * DH + 8 * dg + j]; w1[j] = wk[DM + h * DH + 8 * dg + j]; w2[j] = wk[2 * DM + h * DH + 8 * dg + j]; }
        if (wave == 0)     { const GateV g = gate_vectors(G, row0, h, dir, lane); vW[g.s0] = __expf(g.c0 - g.cend); vW[g.s1] = __expf(g.c1 - g.cend);
            if (lane == 0) { CHS[(size_t)(cidx * 8 + dir * 4 + h) * 2] = g.bend; CHS[(size_t)(cidx * 8 + dir * 4 + h) * 2 + 1] = g.bend + g.cend; } }
        __syncthreads();
        conv_silu_rows(kr, w0, w1, w2, [&](int i, float (&o)[8]) { const float ws = vW[8 * sg + i];
#pragma unroll
            for (int j = 0; j < 8; ++j) o[j] *= ws;
            *(LAS u32x4*)(KWs + (8 * sg + i) * PIT_T + dg * 16) = pack8(o); });
#pragma unroll
        for (int i = 0; i < 8; ++i) *(LAS u32x4*)(Vs + (8 * sg + i) * PIT_T + dg * 16) = vr[i];
        __syncthreads();
        f32x4 acc[2][16];
        auto kstep1 = [&](int k0, auto first) {
            bf16x8 fv[2];
#pragma unroll
            for (int mi = 0; mi < 2; ++mi) fv[mi] = tr_frag(Vs, PIT_T, k0, 32 * wave + 16 * mi, lane);
#pragma unroll
            for (int ni = 0; ni < 16; ++ni) { const bf16x8 fk = tr_frag(KWs, PIT_T, k0, 16 * ni, lane);
#pragma unroll
                for (int mi = 0; mi < 2; ++mi) acc[mi][ni] = mma16<decltype(first)::value>(fk, fv[mi], acc[mi][ni]); }
        };
        kstep1(0, std::true_type{});
#pragma unroll 1
        for (int k0 = 32; k0 < CHUNK; k0 += 32) kstep1(k0, std::false_type{});
        bf16_t* out = UT + ((size_t)(cidx * NH + h) * 2 + dir) * DH * DH;
#pragma unroll
        for (int mi = 0; mi < 2; ++mi)
#pragma unroll
            for (int ni = 0; ni < 16; ++ni) { u32x2 w; w.x = pk2(acc[mi][ni][0], acc[mi][ni][1]); w.y = pk2(acc[mi][ni][2], acc[mi][ni][3]);
                *(u32x2*)(out + (size_t)(32 * wave + 16 * mi + fr) * DH + 16 * ni + 4 * fq) = w; }
        if (tid < DH) { float sum = 0.f;
#pragma unroll 8
            for (int s2 = 0; s2 < CHUNK; ++s2) sum += bf2f(*(const LAS bf16_t*)(KWs + s2 * PIT_T + tid * 2));
            NV[((size_t)(cidx * NH + h) * 2 + dir) * DH + tid] = sum; }
        __syncthreads();
    }
}
__device__ __forceinline__ void ph_mlstm2(int wv) {
    CParams& p = *okp();
    unsigned char* const wsb = ows(p.ws);
    const int tid = otid(wv);
    const bf16_t* UT = WSP(bf16_t, OFF_UT); bf16_t* CT = WSP(bf16_t, OFF_CT);
    const float *NV = WSP(float, OFF_NV), *CHS = WSP(float, OFF_CHS); float *NS = WSP(float, OFF_NS), *MST = WSP(float, OFF_MST);
    for (int task = obid(); task < NB * NH * 2 * 16; task += gridDim.x) {
        const int part = task & 15, scan = task >> 4, dir = scan & 1, h = (scan >> 1) & 3, b = scan >> 3, dh = dir * 4 + h;
        const unsigned e0 = (unsigned)(part * 4096 + olaunder(tid) * 8) * 2u;
        u32x4 u[18];
#pragma unroll
        for (int step = 0; step < 18; ++step) { const int cidx = scan_chunk(b, dir, step); u[step] = gld<u32x4>(UT, (unsigned)(((cidx * NH + h) * 2 + dir) * DH * DH) * 2u + e0); }
        float cb[18], cm[18];
#pragma unroll
        for (int step = 0; step < 18; ++step) { const int cidx = scan_chunk(b, dir, step); const f32x2 cc = gld<f32x2>(CHS, (unsigned)((cidx * 8 + dh) * 2) * 4u); cb[step] = cc[0]; cm[step] = cc[1]; }
        float C[8], m = 0.f;
        { const f32x4 z0 = zero4(), z1 = zero4();
#pragma unroll
          for (int j = 0; j < 4; ++j) { C[j] = z0[j]; C[4 + j] = z1[j]; } }
#pragma unroll
        for (int step = 0; step < 18; ++step) {
            const int cidx = scan_chunk(b, dir, step);
            gst<u32x4>(CT, (unsigned)(((cidx * NH + h) * 2 + dir) * DH * DH) * 2u + e0, pack8(C));
            const float bend = cb[step], mloc = cm[step];
            const float mn = fmaxf(bend + m, mloc), al = __expf(bend + m - mn), be = __expf(mloc - mn);
            float uu[8]; unpack8(u[step], uu);
#pragma unroll
            for (int j = 0; j < 8; ++j) C[j] = al * C[j] + be * uu[j];
            m = mn;
        }
        if (part == 0 && tid < DH) {
            float n = 0.f; m = 0.f;
            float nv[18];
#pragma unroll
            for (int step = 0; step < 18; ++step) { const int cidx = scan_chunk(b, dir, step); nv[step] = gld<float>(NV, (unsigned)(((cidx * NH + h) * 2 + dir) * DH + tid) * 4u); }
#pragma unroll
            for (int step = 0; step < 18; ++step) {
                const int cidx = scan_chunk(b, dir, step); const unsigned base = (unsigned)(((cidx * NH + h) * 2 + dir) * DH + tid) * 4u;
                gst<float>(NS, base, n); if (tid == 0) MST[cidx * 8 + dh] = m;
                const float bend = cb[step], mloc = cm[step];
                const float mn = fmaxf(bend + m, mloc), al = __expf(bend + m - mn), be = __expf(mloc - mn);
                n = al * n + be * nv[step]; m = mn;
            }
        }
    }
}
#define SECTION_LANES() const int tid = otid(wv), lane = tid & 63, fr = lane & 15, fq = lane >> 4; (void)fr; (void)fq; __builtin_amdgcn_sched_barrier(0)
__device__ __forceinline__ void ph_mlstm3(int wv, int l, LAS unsigned char* lds, int nunits) {
    CParams& p = *okp();
    unsigned char* const wsb = ows(p.ws);
    const int wave = wv;
    LAS unsigned char* Qs = lds;
    LAS unsigned char* Ks = lds + 128 * PIT_T;
    LAS unsigned char* Vs = Qs; LAS unsigned char* Ps = Ks;
    LAS float* vec = (LAS float*)(lds + 2 * 128 * PIT_T);
    LAS float *vB = vec, *vC = vec + 256, *vM = vec + 512, *nS = vec + 768, *rS = vec + 1280, *ssq = vec + 1536;
    const bf16_t* P = WSP(bf16_t, OFF_P); const float* G = WSP(float, OFF_G); const bf16_t* CT = WSP(bf16_t, OFF_CT);
    const float *NS = WSP(float, OFF_NS), *MST = WSP(float, OFF_MST); bf16_t* HM = WSP(bf16_t, OFF_HM);
    const float *wk = p.conv_k_w + (size_t)l * 3 * DM, *wq = p.conv_q_w + (size_t)l * 3 * DM, *nw = p.mlstm_norm_w + (size_t)l * DM;
    for (int unit = obid(); unit < nunits; unit += gridDim.x) {
        const int h = unit & 3, cidx = unit >> 2, row0 = chunk_row0(cidx);
        const bool first = cidx < 64 ? (cidx & 15) == 0 : ((cidx - 64) & 1) == 0, last = cidx < 64 ? (cidx & 15) == 15 : ((cidx - 64) & 1) == 1;
        {
            SECTION_LANES(); const int dg = tid & 31, sg = tid >> 5;
            nS[tid] = gld<float>(NS, (unsigned)((cidx * NH + h) * 2 * DH + tid) * 4u);
            const unsigned kp = (unsigned)((row0 + 8 * sg - 1) * NP + PK + h * DH + 8 * dg) * 2u;
            u32x4 raw[10], rawq[10]; float w0[8], w1[8], w2[8];
#pragma unroll
            for (int i = 0; i < 10; ++i) { const int s = 8 * sg - 1 + i; const bool ok = (s >= 0 || !first) && (s < CHUNK || !last);
                raw[i] = gld<u32x4>(P, ok ? kp + (unsigned)i * (NP * 2) : kp + (unsigned)(NP * 2)); if (!ok) raw[i] = (u32x4){0u, 0u, 0u, 0u}; }
#pragma unroll
            for (int i = 0; i < 10; ++i) { const int s = 8 * sg - 1 + i; const bool ok = (s >= 0 || !first) && (s < CHUNK || !last);
                rawq[i] = gld<u32x4>(P, (ok ? kp + (unsigned)i * (NP * 2) : kp + (unsigned)(NP * 2)) + (PQ - PK) * 2); if (!ok) rawq[i] = (u32x4){0u, 0u, 0u, 0u}; }
            { const unsigned wo = (unsigned)(h * DH + 8 * dg) * 4u;
              const f32x4 a0 = gld<f32x4>(wk, wo), a1 = gld<f32x4>(wk, wo + 16), b0 = gld<f32x4>(wk, wo + DM * 4), b1 = gld<f32x4>(wk, wo + DM * 4 + 16), c0 = gld<f32x4>(wk, wo + 2 * DM * 4), c1 = gld<f32x4>(wk, wo + 2 * DM * 4 + 16);
#pragma unroll
              for (int j = 0; j < 4; ++j) { w0[j] = a0[j]; w0[4 + j] = a1[j]; w1[j] = b0[j]; w1[4 + j] = b1[j]; w2[j] = c0[j]; w2[4 + j] = c1[j]; } }
            if (wave < 2) { const GateV g = gate_vectors(G, row0, h, wave, lane);
                vB[wave * 128 + g.s0] = g.b0; vB[wave * 128 + g.s1] = g.b1; vC[wave * 128 + g.s0] = g.c0; vC[wave * 128 + g.s1] = g.c1; vM[wave * 128 + g.s0] = g.m0; vM[wave * 128 + g.s1] = g.m1; }
            conv_silu_rows(raw, w0, w1, w2, [&](int i, float (&o)[8]) { *(LAS u32x4*)(Ks + (8 * sg + i) * PIT_R + dg * 16) = pack8(o); });
            { const unsigned wo = (unsigned)(h * DH + 8 * dg) * 4u;
              const f32x4 a0 = gld<f32x4>(wq, wo), a1 = gld<f32x4>(wq, wo + 16), b0 = gld<f32x4>(wq, wo + DM * 4), b1 = gld<f32x4>(wq, wo + DM * 4 + 16), c0 = gld<f32x4>(wq, wo + 2 * DM * 4), c1 = gld<f32x4>(wq, wo + 2 * DM * 4 + 16);
#pragma unroll
              for (int j = 0; j < 4; ++j) { w0[j] = a0[j]; w0[4 + j] = a1[j]; w1[j] = b0[j]; w1[4 + j] = b1[j]; w2[j] = c0[j]; w2[4 + j] = c1[j]; } }
            conv_silu_rows(rawq, w0, w1, w2, [&](int i, float (&o)[8]) {
#pragma unroll
                for (int j = 0; j < 8; ++j) o[j] *= 0.0625f;
                *(LAS u32x4*)(Qs + (8 * sg + i) * PIT_R + dg * 16) = pack8(o); });
        }
        __syncthreads();
        {
            SECTION_LANES();
            f32x4 sacc[8];
            auto kstepS = [&](int k0, auto first) {
                const bf16x8 yq = *(const LAS bf16x8*)(Qs + (16 * wave + fr) * PIT_R + (k0 + 8 * fq) * 2);
#pragma unroll
                for (int ni = 0; ni < 8; ++ni) { const bf16x8 xk = *(const LAS bf16x8*)(Ks + (16 * ni + fr) * PIT_R + (k0 + 8 * fq) * 2);
                    sacc[ni] = mma16<decltype(first)::value>(xk, yq, sacc[ni]); }
            };
            kstepS(0, std::true_type{});
#pragma unroll 1
            for (int k0 = 32; k0 < DH; k0 += 32) kstepS(k0, std::false_type{});
            const int t = 16 * wave + fr;
            const float mF = gld<float>(MST, (unsigned)(cidx * 8 + h) * 4u), mB = gld<float>(MST, (unsigned)(cidx * 8 + 4 + h) * 4u);
            const float MF = fmaxf(mF, vM[t]), MB = fmaxf(mB, vM[128 + t]);
            const float gF = __expf(mF - MF), gB = __expf(mB - MB);
            const float flF = __expf(-(vB[t] + MF)), flB = __expf(-(vB[128 + t] + MB));
            float qnF = 0.f, qnB = 0.f;
#pragma unroll
            for (int c8 = 0; c8 < 8; ++c8) { float q8[8]; unpack8(*(const LAS u32x4*)(Qs + t * PIT_R + (64 * fq + 8 * c8) * 2), q8);
                const f32x4 a0 = *(const LAS f32x4*)(nS + 64 * fq + 8 * c8), a1 = *(const LAS f32x4*)(nS + 64 * fq + 8 * c8 + 4);
                const f32x4 b0 = *(const LAS f32x4*)(nS + 256 + 64 * fq + 8 * c8), b1 = *(const LAS f32x4*)(nS + 256 + 64 * fq + 8 * c8 + 4);
#pragma unroll
                for (int j = 0; j < 4; ++j) { qnF += q8[j] * a0[j] + q8[4 + j] * a1[j]; qnB += q8[j] * b0[j] + q8[4 + j] * b1[j]; } }
            qnF += shx(qnF, 16, lane); qnF += shx(qnF, 32, lane); qnB += shx(qnB, 16, lane); qnB += shx(qnB, 32, lane);
            float sF = 0.f, sB = 0.f;
#pragma unroll
            for (int ni = 0; ni < 8; ++ni) { const f32x4 cF = *(const LAS f32x4*)(vC + 16 * ni + 4 * fq), cB = *(const LAS f32x4*)(vC + 128 + 16 * ni + 4 * fq);
#pragma unroll
                for (int rg = 0; rg < 4; ++rg) { const int s = 16 * ni + 4 * fq + rg;
                    sF += s <= t ? sacc[ni][rg] * __expf(cF[rg] - MF) : 0.f; sB += s >= t ? sacc[ni][rg] * __expf(cB[rg] - MB) : 0.f; }
                asm volatile("" : "+v"(sF), "+v"(sB)); }
            sF += shx(sF, 16, lane); sF += shx(sF, 32, lane); sB += shx(sB, 16, lane); sB += shx(sB, 32, lane);
            const float iF = 1.f / fmaxf(fabsf(gF * qnF + sF), flF), iB = 1.f / fmaxf(fabsf(gB * qnB + sB), flB);
            __syncthreads();
#pragma unroll
            for (int ni = 0; ni < 8; ++ni) { const f32x4 cF = *(const LAS f32x4*)(vC + 16 * ni + 4 * fq), cB = *(const LAS f32x4*)(vC + 128 + 16 * ni + 4 * fq);
                float pc[4];
#pragma unroll
                for (int rg = 0; rg < 4; ++rg) { const int s = 16 * ni + 4 * fq + rg;
                    pc[rg] = (s <= t ? sacc[ni][rg] * __expf(cF[rg] - MF) * iF : 0.f) + (s >= t ? sacc[ni][rg] * __expf(cB[rg] - MB) * iB : 0.f); }
                u32x2 w; w.x = pk2(pc[0], pc[1]); w.y = pk2(pc[2], pc[3]);
                *(LAS u32x2*)(Ps + t * PIT_P + (16 * ni + 4 * fq) * 2) = w; }
            if (fq == 0) { rS[t] = gF * iF; rS[128 + t] = gB * iB; }
        }
        __syncthreads();
        f32x4 tot[2][8];
        u32x4 vr[8];
        {
            SECTION_LANES();
#pragma unroll
            for (int ni = 0; ni < 2; ++ni) {
                if (ni == 1) { const int s8 = lane & 15, vq = lane >> 4; const unsigned vp = (unsigned)((row0 + 8 * s8) * NP + PV + h * DH + 32 * wave + 8 * vq) * 2u;
#pragma unroll
                    for (int i = 0; i < 8; ++i) vr[i] = gld<u32x4>(P, vp + (unsigned)i * (NP * 2)); }
                f32x4 a1[8];
                const unsigned ctf = (unsigned)((cidx * NH + h) * 2 * DH * DH + (32 * wave + 16 * ni + fr) * DH + 8 * fq) * 2u;
                bf16x8 xf = gld<bf16x8>(CT, ctf), xb = gld<bf16x8>(CT, ctf + (unsigned)(DH * DH) * 2u);
                bf16x8 xf1 = gld<bf16x8>(CT, ctf + 64u), xb1 = gld<bf16x8>(CT, ctf + (unsigned)(DH * DH) * 2u + 64u);
                auto kstepQ = [&](int k0, auto first) {
                    const unsigned kn = (unsigned)(k0 + 64 < DH ? k0 + 64 : DH - 32);
                    const bf16x8 xfn = gld<bf16x8>(CT, ctf + kn * 2u), xbn = gld<bf16x8>(CT, ctf + (unsigned)(DH * DH) * 2u + kn * 2u);
#pragma unroll
                    for (int mi = 0; mi < 8; ++mi) { const bf16x8 yq = *(const LAS bf16x8*)(Qs + (16 * mi + fr) * PIT_R + (k0 + 8 * fq) * 2);
                        tot[ni][mi] = mma16<decltype(first)::value>(xf, yq, tot[ni][mi]);
                        a1[mi] = mma16<decltype(first)::value>(xb, yq, a1[mi]); }
                    xf = xf1; xb = xb1; xf1 = xfn; xb1 = xbn;
                };
                kstepQ(0, std::true_type{});
#pragma unroll 1
                for (int k0 = 32; k0 < DH; k0 += 32) kstepQ(k0, std::false_type{});
#pragma unroll
                for (int mi = 0; mi < 8; ++mi) { const float rf = rS[16 * mi + fr], rb = rS[128 + 16 * mi + fr]; tot[ni][mi] = rf * tot[ni][mi] + rb * a1[mi]; }
            }
        }
        __syncthreads();
        u32x2 og[8][2]; f32x4 gw[2];
        {
            SECTION_LANES();
            { const int s8 = lane & 15, vq = lane >> 4;
#pragma unroll
              for (int i = 0; i < 8; ++i) *(LAS u32x4*)(Vs + (8 * s8 + i) * PIT_T + (32 * wave + 8 * vq) * 2) = vr[i]; }
            asm volatile("s_waitcnt lgkmcnt(0)" ::: "memory");
#pragma unroll
            for (int mi = 0; mi < 8; ++mi)
#pragma unroll
                for (int ni = 0; ni < 2; ++ni) og[mi][ni] = gld<u32x2>(P, (unsigned)((row0 + 16 * mi + fr) * NP + PO + h * DH + 32 * wave + 16 * ni + 4 * fq) * 2u);
#pragma unroll
            for (int ni = 0; ni < 2; ++ni) gw[ni] = gld<f32x4>(nw, (unsigned)(h * DH + 32 * wave + 16 * ni + 4 * fq) * 4u);
#pragma unroll 1
            for (int k0 = 0; k0 < CHUNK; k0 += 32) {
                bf16x8 xv[2];
#pragma unroll
                for (int ni = 0; ni < 2; ++ni) xv[ni] = tr_frag(Vs, PIT_T, k0, 32 * wave + 16 * ni, lane);
#pragma unroll
                for (int mi = 0; mi < 8; ++mi) { const bf16x8 yp = *(const LAS bf16x8*)(Ps + (16 * mi + fr) * PIT_P + (k0 + 8 * fq) * 2);
#pragma unroll
                    for (int ni = 0; ni < 2; ++ni) tot[ni][mi] = __builtin_amdgcn_mfma_f32_16x16x32_bf16(xv[ni], yp, tot[ni][mi], 0, 0, 0); }
            }
        }
        {
            SECTION_LANES();
#pragma unroll
            for (int mi = 0; mi < 8; ++mi) { float ss = 0.f;
#pragma unroll
                for (int ni = 0; ni < 2; ++ni) ss += (tot[ni][mi][0] * tot[ni][mi][0] + tot[ni][mi][1] * tot[ni][mi][1]) + (tot[ni][mi][2] * tot[ni][mi][2] + tot[ni][mi][3] * tot[ni][mi][3]);
                ss += shx(ss, 16, lane); ss += shx(ss, 32, lane);
                if (fq == 0) ssq[wave * 128 + 16 * mi + fr] = ss; }
            __syncthreads();
#pragma unroll
            for (int mi = 0; mi < 8; ++mi) { const int tt = 16 * mi + fr; float ss = 0.f;
#pragma unroll
                for (int w8 = 0; w8 < 8; ++w8) ss += ssq[w8 * 128 + tt];
                const float rstd = rsqrtf(ss * (1.f / DH) + EPS);
#pragma unroll
                for (int ni = 0; ni < 2; ++ni) { const int vd = 32 * wave + 16 * ni + 4 * fq;
                    const u32x2 ow = og[mi][ni]; const f32x4 w4 = gw[ni];
                    const float o0 = __uint_as_float(ow.x << 16), o1 = __uint_as_float(ow.x & 0xffff0000u), o2 = __uint_as_float(ow.y << 16), o3 = __uint_as_float(ow.y & 0xffff0000u);
                    u32x2 q; q.x = pk2(sigmoidf_(o0) * (tot[ni][mi][0] * rstd * w4[0]), sigmoidf_(o1) * (tot[ni][mi][1] * rstd * w4[1]));
                    q.y = pk2(sigmoidf_(o2) * (tot[ni][mi][2] * rstd * w4[2]), sigmoidf_(o3) * (tot[ni][mi][3] * rstd * w4[3]));
                    gst<u32x2>(HM, (unsigned)((row0 + tt) * D + h * DH + vd) * 2u, q); }
            }
        }
        __syncthreads();
    }
}
__device__ __forceinline__ void ph_mgctx(int wv) {
    unsigned char* const wsb = ows(okp()->ws);
    const float* SL = WSP(float, OFF_SLAB); bf16_t* MG = WSP(bf16_t, OFF_MG);
    const unsigned gt = (unsigned)obid() * 512u + otid(wv), NT = gridDim.x * 512u;
    for (unsigned i = gt; i < (unsigned)RC * D / 8; i += 2 * NT) { const bool two = i + NT < (unsigned)RC * D / 8; const unsigned j = two ? i + NT : i;
        const f32x4 a0 = gld<f32x4>(SL, i * 32u), a1 = gld<f32x4>(SL, i * 32u + 16), b0 = gld<f32x4>(SL, (unsigned)(RC * D) * 4u + i * 32u), b1 = gld<f32x4>(SL, (unsigned)(RC * D) * 4u + i * 32u + 16);
        const f32x4 c0 = gld<f32x4>(SL, j * 32u), c1 = gld<f32x4>(SL, j * 32u + 16), d0 = gld<f32x4>(SL, (unsigned)(RC * D) * 4u + j * 32u), d1 = gld<f32x4>(SL, (unsigned)(RC * D) * 4u + j * 32u + 16);
        gst<u32x4>(MG, (unsigned)(RL * D) * 2u + i * 16u, pack8v(a0 + b0, a1 + b1));
        if (two) gst<u32x4>(MG, (unsigned)(RL * D) * 2u + j * 16u, pack8v(c0 + d0, c1 + d1)); }
}
__device__ __forceinline__ void ph_ffnact(int wv, int l) {
    CParams& p = *okp();
    unsigned char* const wsb = ows(p.ws);
    const int TIDX = otid(wv), BIDX = obid();
    const unsigned gt = (unsigned)BIDX * 512u + TIDX, NT = gridDim.x * 512u;
    const bf16_t* U = WSP(bf16_t, OFF_P); bf16_t* ACT = WSP(bf16_t, OFF_ACT); const float* SL = WSP(float, OFF_SLAB);
    const float* wf = p.conv_ff_w + (size_t)l * 3 * DFF;
    auto ldu = [&](int r, int col, float (&o)[8]) {
        if (col >= 32 * 256) { f32x4 g0 = {0.f, 0.f, 0.f, 0.f}, g1 = {0.f, 0.f, 0.f, 0.f};
#pragma unroll
            for (int sl = 0; sl < 4; ++sl) { const unsigned o4 = (unsigned)((sl * RC + (r - RL)) * NUP + col) * 4u; g0 += gld<f32x4>(SL, o4); g1 += gld<f32x4>(SL, o4 + 16); }
#pragma unroll
            for (int j = 0; j < 4; ++j) { o[j] = g0[j]; o[4 + j] = g1[j]; } }
        else unpack8(gld<u32x4>(U, (unsigned)(r * NUP + col) * 2u), o);
    };
    struct Item { float a0[8], a1[8], a2[8], g[8]; f32x4 w[6]; int r, c; bool hp, hn; };
    auto load_item = [&](unsigned i, Item& it) {
        it.r = RL + (int)(i / (DFF / 8)); it.c = (int)(i % (DFF / 8)) * 8; const int t = (it.r - RL) & (CTX - 1), ca = 256 * (it.c >> 7) + (it.c & 127);
        it.hp = t > 0; it.hn = t < CTX - 1;
        ldu(it.r, ca, it.a1); ldu(it.r, ca + 128, it.g); ldu(it.hp ? it.r - 1 : it.r, ca, it.a0); ldu(it.hn ? it.r + 1 : it.r, ca, it.a2);
#pragma unroll
        for (int k = 0; k < 3; ++k) { it.w[2 * k] = gld<f32x4>(wf, (unsigned)(k * DFF + it.c) * 4u); it.w[2 * k + 1] = gld<f32x4>(wf, (unsigned)(k * DFF + it.c) * 4u + 16); } };
    auto finish_item = [&](const Item& it) { float o[8];
#pragma unroll
        for (int j = 0; j < 8; ++j) { const float w0 = it.w[j >> 2][j & 3], w1 = it.w[2 + (j >> 2)][j & 3], w2 = it.w[4 + (j >> 2)][j & 3];
            float v = w1 * it.a1[j]; if (it.hp) v += w0 * it.a0[j]; if (it.hn) v += w2 * it.a2[j]; o[j] = siluf_(v) * it.g[j]; }
        gst<u32x4>(ACT, (unsigned)(it.r * DFF + it.c) * 2u, pack8(o)); };
    for (unsigned i = gt; i < (unsigned)RC * (DFF / 8); i += 2 * NT) {
        const bool two = i + NT < (unsigned)RC * (DFF / 8);
        Item A, B; load_item(i, A); if (two) load_item(i + NT, B);
        finish_item(A); if (two) finish_item(B);
    }
}

#define XB_TMO      128
#define XB_XCNT(j)  (256  + 64 * (j))
#define XB_XSUB(j)  (1280 + 64 * (j))
#define XB_XGEN(j)  (2304 + 64 * (j))
#define XB_TOP      3328
#define XB_TOPGEN   3392
#define XCD_BAR_WORDS 3456
#define XB_SPIN_CAP (1u << 18)
__device__ __forceinline__ unsigned xb_ld(unsigned* p)              { return __hip_atomic_load(p, __ATOMIC_RELAXED, __HIP_MEMORY_SCOPE_AGENT); }
__device__ __forceinline__ unsigned xb_add(unsigned* p, unsigned v) { return __hip_atomic_fetch_add(p, v, __ATOMIC_RELAXED, __HIP_MEMORY_SCOPE_AGENT); }
__device__ __forceinline__ unsigned xb_xcc_id() { return (unsigned)__builtin_amdgcn_s_getreg((3 << 11) | 20) & 0xFu; }
#define XB_SPIN(cond, bar) do { unsigned _sp = 0; while (cond) { __builtin_amdgcn_s_sleep(1); \
    if ((++_sp & 255u) == 0u) { if (xb_ld(&(bar)[XB_TMO])) break; if (_sp > XB_SPIN_CAP) { atomicAdd(&(bar)[XB_TMO], 1u); break; } } } } while (0)
struct XcdBarrier { unsigned* bar; unsigned x; volatile LAS unsigned* st; };
__device__ __forceinline__ XcdBarrier xcd_barrier_post(unsigned* bar, volatile LAS unsigned* st) {
    XcdBarrier b; b.bar = bar; b.x = xb_xcc_id(); b.st = st;
    if (threadIdx.x == 0) (void)xb_add(&bar[XB_XCNT(b.x)], 1u);
    return b;
}
__device__ __forceinline__ void xcd_barrier_complete(unsigned* bar, unsigned x, unsigned& nloc, unsigned& nx) {
    const unsigned G = gridDim.x * gridDim.y * gridDim.z;
    unsigned sum, cnt, mine, sp = 0u;
    for (;;) {
        sum = 0u; cnt = 0u; mine = 0u;
#pragma unroll
        for (unsigned j = 0; j < 16; ++j) { const unsigned c = xb_ld(&bar[XB_XCNT(j)]); sum += c; cnt += (c > 0u) ? 1u : 0u; mine = (j == x) ? c : mine; }
        if (sum == G) break;
        __builtin_amdgcn_s_sleep(1);
        if ((++sp & 255u) == 0u) { if (xb_ld(&bar[XB_TMO])) break; if (sp > XB_SPIN_CAP) { atomicAdd(&bar[XB_TMO], 1u); break; } }
    }
    nloc = mine > 0u ? mine : 1u; nx = cnt > 0u ? cnt : 1u;
}
__device__ __forceinline__ void xcd_barrier(const XcdBarrier& b, int wv) {
    asm volatile("s_waitcnt vmcnt(0)" ::: "memory");
    __syncthreads();
    if (otid(wv) == 0) {
        unsigned long long bw = (unsigned long long)b.bar; asm volatile("" : "+s"(bw));
        unsigned* bar = (unsigned*)bw;
        __builtin_amdgcn_s_waitcnt(0);
        unsigned nloc = b.st[0], nx = b.st[1];
        if (nloc == 0u) { xcd_barrier_complete(bar, b.x, nloc, nx); b.st[0] = nloc; b.st[1] = nx; }
        const unsigned old = xb_add(&bar[XB_XSUB(b.x)], 1u);
        const unsigned gen = old / nloc;
        if (old + 1u == (gen + 1u) * nloc) {
            __builtin_amdgcn_fence(__ATOMIC_RELEASE, "agent");
            asm volatile("s_waitcnt vmcnt(0)" ::: "memory");
            const unsigned og = xb_add(&bar[XB_TOP], 1u);
            const unsigned tg = og / nx;
            if (og + 1u == (tg + 1u) * nx) xb_add(&bar[XB_TOPGEN], 1u);
            else XB_SPIN(xb_ld(&bar[XB_TOPGEN]) == tg, bar);
            __builtin_amdgcn_fence(__ATOMIC_ACQUIRE, "agent");
            xb_add(&bar[XB_XGEN(b.x)], 1u);
            asm volatile("s_waitcnt vmcnt(0)" ::: "memory");
        } else {
            XB_SPIN(xb_ld(&bar[XB_XGEN(b.x)]) == gen, bar);
            __builtin_amdgcn_fence(__ATOMIC_ACQUIRE, "agent");
            asm volatile("s_waitcnt vmcnt(0)" ::: "memory");
        }
    }
    __syncthreads();
}

constexpr int I_CUT = (I_LAYER * 2 / 5 / 64) * 64;
#define REPW 3456
#define REPN(k) (1 + __builtin_amdgcn_readfirstlane(((const int*)(okp()->ws + OFF_CTL))[REPW + (k)]))
constexpr int LDS_BYTES = 163840;
constexpr int MISC_OFF = 163840 - 256;
template <class Epi, class Sched, bool AMAP = false> __device__ __forceinline__ void run_gemm(int wv, LAS unsigned char* lds, const bf16_t* A, int lda, const bf16_t* Bt, int ldb, int K, const Sched& S, const Epi& E) {
    pg8::Gemm g; g.A = A; g.Bt = Bt; g.M = 0; g.N = 0; g.K = K; g.lda = lda; g.ldb = ldb; g.pad = wv;
    pg8::gemm_phase<Epi, Sched, AMAP>((PG8_LAS unsigned char*)lds, g, S, E);
}
__global__ void __launch_bounds__(512, 2) mega_fwd(Params p_kernarg) {
    extern __shared__ __attribute__((aligned(16))) unsigned char dyn_lds[];
    LAS unsigned char* lds = (LAS unsigned char*)dyn_lds;
    const int wv = __builtin_amdgcn_readfirstlane(threadIdx.x >> 6);
    volatile LAS unsigned* MISC = (volatile LAS unsigned*)(lds + MISC_OFF);
    if (threadIdx.x < 32) MISC[threadIdx.x] = 0u;
    __syncthreads();
    (void)xcd_barrier_post((unsigned*)(okp()->ws + OFF_CTL), MISC + 8);
#define GRID_BAR() for (int rpb = 0, nrpb = REPN(10); rpb < nrpb; ++rpb) { XcdBarrier bar_; bar_.bar = (unsigned*)(okp()->ws + OFF_CTL); bar_.x = xb_xcc_id(); bar_.st = (volatile LAS unsigned*)(lds + MISC_OFF) + 8; xcd_barrier(bar_, wv); }
    for (int rp = 0, nrp = REPN(13); rp < nrp; ++rp) { ph_convert(wv, lds, 0, obid(), (int)gridDim.x, 0, I_LAYER); __syncthreads(); }
    for (int rp = 0, nrp = REPN(0); rp < nrp; ++rp) { ph_tables(wv); __syncthreads(); ph_mod(wv, lds, 0, 1, obid(), (int)gridDim.x); __syncthreads(); }
    GRID_BAR();
    for (int l = 0; l < DEPTH; ++l) {
        unsigned char* ws = ows(okp()->ws);
        const int G = (int)gridDim.x;
        const int fz = 0;
        const bool lastl = (l == DEPTH - 1);
        if (l == 0) ph_norm<true>(wv, 0, 0, nullptr, 0, R, okp()->x, okp()->ctx);
        else { if (!fz) ph_norm_lat(wv, l, 0); ph_norm_ctx<false>(wv, lds, l, 0); }
        GRID_BAR();
        for (int rp = 0, nrp = REPN(1); rp < nrp; ++rp) { EpiInProj E{(bf16_t*)(ws + OFF_P), (float*)(ws + OFF_G), (const float*)(ws + OFF_BINR) + (size_t)l * NINP};
          pg8::StaticOrder S; S.init(R, NINP, D, G, obid());
          run_gemm(wv, lds, (const bf16_t*)(ws + OFF_XN), D, (const bf16_t*)(ws + OFF_WIN) + (size_t)l * NINP * D, D, D, S, E); }
        GRID_BAR();
        for (int rp = 0, nrp = REPN(2); rp < nrp; ++rp) ph_mlstm1(wv, l, lds);
        { const int f0 = G / 4, fn = G / 2;
          for (int rp = 0, nrp = REPN(9); rp < nrp; ++rp) if (obid() >= f0 && obid() < f0 + fn) ph_fft(wv, lds, obid() - f0, fn);
          for (int rp = 0, nrp = REPN(3); rp < nrp; ++rp) if (obid() < f0 || obid() >= f0 + fn) { const int wi = obid() < f0 ? obid() : obid() - fn;
              if (!lastl) ph_fourier1(wv, wi, G - fn); ph_convc(wv, l, lastl ? RL : R, wi, G - fn); } }
        GRID_BAR();
        for (int rp = 0, nrp = REPN(4); rp < nrp; ++rp) ph_mlstm2(wv);
        GRID_BAR();
        for (int rp = 0, nrp = REPN(5); rp < nrp; ++rp) ph_mlstm3(wv, l, lds, lastl ? 64 * NH : NCHUNK * NH);
        if (!lastl && obid() >= 32) { EpiBf16 E{(bf16_t*)(ws + OFF_HM) + (size_t)RL * D + DM, D, DF, (unsigned)(CTX * D), 0, (float*)(ows(okp()->ws) + OFF_SLAB)};
          pg8::StaticOrder S; S.init(256, 2048, 512, G - 32, obid() - 32);
          run_gemm(wv, lds, (const bf16_t*)(ws + OFF_CSC), 512, (const bf16_t*)(ws + OFF_ZTC), 512, 512, S, E); }
        if (!lastl && obid() >= 32) { ph_convert(wv, lds, l + 1, obid() - 32, G - 32, 0, I_CUT); }
        GRID_BAR();
        for (int rp = 0, nrp = REPN(8); rp < nrp; ++rp) { EpiMerge E{(const bf16_t*)(ows(okp()->ws) + OFF_P), (bf16_t*)(ows(okp()->ws) + OFF_MG), (float*)(ows(okp()->ws) + OFF_SLAB)}; pg8::TailOrder S; S.init(D, D, G, obid(), lastl ? 0 : 32, 0, 2);
          run_gemm(wv, lds, (const bf16_t*)(ws + OFF_HM), D, (const bf16_t*)(ws + OFF_WPM) + (size_t)l * D * D, D, D, S, E); }
        if (!lastl && obid() >= 64) { ph_convert(wv, lds, l + 1, obid() - 64, G - 64, I_CUT, I_LAYER); __syncthreads(); ph_mod(wv, lds, l + 1, l + 2, obid() - 64, G - 64); }
        GRID_BAR();
        if (!lastl) { ph_mgctx(wv); GRID_BAR(); }
        for (int rp = 0, nrp = REPN(11); rp < nrp; ++rp) { EpiResid E{l, 0, fz, rp == 0 ? 1.f : 0.f};
          pg8::TailOrder S; S.init(D, D, G, obid(), lastl ? 0 : 32, 0, 8);
          run_gemm(wv, lds, (const bf16_t*)(ws + OFF_MG), D, (const bf16_t*)(ws + OFF_WO) + (size_t)l * D * D, D, D, S, E); }
        GRID_BAR();
        if (!lastl || !fz) {
          if (!fz) ph_norm_lat(wv, l, 1);
          if (!lastl) { if (l == 0) ph_norm_ctx<true>(wv, lds, 0, 1); else ph_norm_ctx<false>(wv, lds, l, 1); }
          GRID_BAR(); }
        for (int rp = 0, nrp = REPN(7); rp < nrp; ++rp) { EpiUp E{(bf16_t*)(ows(okp()->ws) + OFF_P), (float*)(ows(okp()->ws) + OFF_SLAB), (bf16_t*)(ows(okp()->ws) + OFF_ACT), okp()->conv_ff_w + (size_t)l * 3 * DFF};
          pg8::TailOrder S; S.init(NUP, D, G, obid(), lastl ? 0 : 176, lastl ? 0 : 128, 4);
          run_gemm<EpiUp, pg8::TailOrder, true>(wv, lds, (const bf16_t*)(ows(okp()->ws) + OFF_XN), D, (const bf16_t*)(ws + OFF_WUP) + (size_t)l * NUP * D, D, D, S, E); }
        GRID_BAR();
        if (!lastl) { for (int rp = 0, nrp = REPN(6); rp < nrp; ++rp) ph_ffnact(wv, l);
          GRID_BAR(); }
        for (int rp = 0, nrp = REPN(12); rp < nrp; ++rp) { EpiResid E{l, 1, lastl ? 2 * fz : fz, rp == 0 ? 1.f : 0.f};
          pg8::TailOrder S; S.init(D, DFF, G, obid(), lastl ? 0 : 32, 0, 8);
          run_gemm(wv, lds, (const bf16_t*)(ws + OFF_ACT), DFF, (const bf16_t*)(ws + OFF_WDN) + (size_t)l * D * DFF, DFF, DFF, S, E); }
        if (!(lastl && fz)) { GRID_BAR(); }
    }
    ph_final(wv);
}

extern "C" void kernel_launch(void* const* d_in, const int* in_sizes, int n_in, void* d_out, int out_size, void* d_ws, size_t ws_size, hipStream_t stream) {
    static int grid = 0;
    if (grid == 0) {
        if (n_in != 22 || ws_size < WS_END || out_size != RL * D) { fprintf(stderr, "kernel_launch: unexpected problem (n_in %d, ws %zu < %zu, out %d)\n", n_in, ws_size, (size_t)WS_END, out_size); grid = -1; return; }
        int dev = 0, cus = 0, per_cu = 0;
        if (hipGetDevice(&dev) != hipSuccess || hipDeviceGetAttribute(&cus, hipDeviceAttributeMultiprocessorCount, dev) != hipSuccess) { grid = -1; return; }
        if (hipFuncSetAttribute((const void*)mega_fwd, hipFuncAttributeMaxDynamicSharedMemorySize, LDS_BYTES) != hipSuccess) { fprintf(stderr, "kernel_launch: hipFuncSetAttribute failed\n"); grid = -1; return; }
        if (hipOccupancyMaxActiveBlocksPerMultiprocessor(&per_cu, (const void*)mega_fwd, 512, LDS_BYTES) != hipSuccess || per_cu < 1) { fprintf(stderr, "kernel_launch: occupancy query says %d\n", per_cu); per_cu = 1; }
        (void)hipGetLastError();
        grid = cus;
    }
    if (grid < 0) return;
    Params p{};
    const float** pp = (const float**)&p;
    for (int i = 0; i < 22; ++i) pp[i] = (const float*)d_in[i];
    p.out = (float*)d_out; p.ws = (unsigned char*)d_ws;
    (void)hipMemsetAsync((char*)d_ws + OFF_CTL, 0, (size_t)(XCD_BAR_WORDS + 16) * sizeof(unsigned), stream);
    hipLaunchKernelGGL(mega_fwd, dim3(grid), dim3(512), LDS_BYTES, stream, p);
}
```

```cpp
#include <hip/hip_runtime.h>
#include <cstdio>
#include <cstdint>
#include <type_traits>

#define LAS __attribute__((address_space(3)))
typedef unsigned short bf16_t;
typedef short bf16x8 __attribute__((ext_vector_type(8)));
typedef float f32x4 __attribute__((ext_vector_type(4)));
typedef unsigned u32x4 __attribute__((ext_vector_type(4)));
typedef unsigned u32x2 __attribute__((ext_vector_type(2)));
typedef float f32x2 __attribute__((ext_vector_type(2)));

constexpr int D = 2048, NB = 4, SEQ = 2048, DEPTH = 4, CTX = 256;
constexpr int DM = 1024, NH = 4, DH = 256, DF = 512, DC = 512, DFF = 5632, CHUNK = 128;
constexpr int NIN = 12304;
constexpr int RL = NB * SEQ, RC = NB * CTX, R = RL + RC;
constexpr int NP = 12288;
constexpr int NINP = 12544;
constexpr int PK = 0, PV = 1024, PQ = 2048, PO = 3072, PF = 4096, PCB = 4608, PCC = 5120, PCX = 5632, PGM = 6144;
constexpr int NCHUNK = 72;
constexpr int NUP = 2 * DFF;
constexpr float EPS = 1e-6f;

constexpr size_t al256(size_t x) { return (x + 255) & ~(size_t)255; }
constexpr size_t OFF_CTL = 0;
constexpr size_t OFF_WIN = 1u << 20;
constexpr size_t SZ_WIN = (size_t)NINP * D * 2;            constexpr size_t OFF_WPM = OFF_WIN + DEPTH * SZ_WIN;
constexpr size_t SZ_WPM = (size_t)D * D * 2;               constexpr size_t OFF_WO = OFF_WPM + DEPTH * SZ_WPM;
constexpr size_t SZ_WO = (size_t)D * D * 2;                constexpr size_t OFF_WUP = OFF_WO + DEPTH * SZ_WO;
constexpr size_t SZ_WUP = (size_t)NUP * D * 2;             constexpr size_t OFF_WDN = OFF_WUP + DEPTH * SZ_WUP;
constexpr size_t SZ_WDN = (size_t)D * DFF * 2;             constexpr size_t OFF_BINR = OFF_WDN + DEPTH * SZ_WDN;
constexpr size_t OFF_MA = al256(OFF_BINR + (size_t)DEPTH * NINP * 4);
constexpr size_t OFF_MC = OFF_MA + (size_t)64 * 64 * 2;
constexpr size_t OFF_CSC = OFF_MC + (size_t)32 * 64 * 128 * 2;
constexpr size_t OFF_FT = OFF_CSC + (size_t)256 * 512 * 2;
constexpr size_t OFF_MOD = OFF_FT + (size_t)256 * 128 * 2;
constexpr size_t OFF_H = al256(OFF_MOD + (size_t)DEPTH * 5 * 6 * D * 4);
constexpr size_t OFF_XN = OFF_H + (size_t)R * D * 4;
constexpr size_t OFF_P = OFF_XN + (size_t)R * D * 2;
constexpr size_t OFF_G = OFF_P + (size_t)R * NP * 2;
constexpr size_t OFF_CHS = OFF_G + (size_t)R * 16 * 4;
constexpr size_t OFF_MST = al256(OFF_CHS + (size_t)NCHUNK * 8 * 2 * 4);
constexpr size_t OFF_UT = al256(OFF_MST + (size_t)NCHUNK * 8 * 4);
constexpr size_t SZ_UT = (size_t)NCHUNK * NH * 2 * DH * DH * 2;
constexpr size_t OFF_CT = OFF_UT + SZ_UT;
constexpr size_t OFF_NV = OFF_CT + SZ_UT;
constexpr size_t OFF_NS = OFF_NV + (size_t)NCHUNK * NH * 2 * DH * 4;
constexpr size_t OFF_HM = OFF_NS + (size_t)NCHUNK * NH * 2 * DH * 4;
constexpr size_t OFF_ZTC = OFF_HM + (size_t)R * D * 2;
constexpr size_t OFF_MG = OFF_ZTC + (size_t)2048 * 512 * 2;
constexpr size_t OFF_ACT = OFF_MG + (size_t)R * D * 2;
constexpr size_t OFF_SLAB = OFF_ACT + (size_t)R * DFF * 2;
constexpr size_t OFF_XS = OFF_SLAB + (size_t)4 * RC * NUP * 4;
constexpr size_t WS_END = OFF_XS + (size_t)8 * RL * 32 * 4;
constexpr int CNTW = 4096;
constexpr int CTL_ZERO_WORDS = CNTW + 8 * 32 * 64;
static_assert(WS_END <= (size_t)4 * DEPTH * D * NIN * 4, "workspace map exceeds the guaranteed d_ws size");
static_assert((size_t)R * NUP * 2 <= (size_t)R * NP * 2, "u overlays P");

struct Params {
    const float *x, *c, *ctx, *c_ctx, *w_mod, *b_mod, *norm1_w, *norm2_w, *w_in, *b_in, *conv_q_w, *conv_k_w, *mlstm_norm_w, *w_pm, *w_pf, *w_pc, *conv_c_w, *w_o, *w_up,
        *conv_ff_w, *w_down, *final_norm_w;
    float* out; unsigned char* ws;
};
#define WSP(T, off) ((T*)(wsb + (off)))
typedef const __attribute__((address_space(4))) Params CParams;
__device__ __forceinline__ CParams* okp() { CParams* k = (CParams*)__builtin_amdgcn_kernarg_segment_ptr(); asm volatile("" : "+s"(k)); return k; }

#define GAS __attribute__((address_space(1)))
template <class T> __device__ __forceinline__ T gld(const void* base, unsigned byte_off) { return *(const GAS T*)((const GAS unsigned char*)base + byte_off); }
template <class T> __device__ __forceinline__ void gst(void* base, unsigned byte_off, T v) { *(GAS T*)((GAS unsigned char*)base + byte_off) = v; }
__device__ __forceinline__ int otid(int wv) { int t; asm volatile("v_mbcnt_lo_u32_b32 %0, -1, 0\n\tv_mbcnt_hi_u32_b32 %0, -1, %0" : "=v"(t)); return (wv << 6) | t; }
__device__ __forceinline__ int olaunder(int v) { asm volatile("" : "+v"(v)); return v; }
__device__ __forceinline__ f32x4 zero4() { float a, b, c, d; asm volatile("v_mov_b32 %0, 0\n\tv_mov_b32 %1, 0\n\tv_mov_b32 %2, 0\n\tv_mov_b32 %3, 0" : "=v"(a), "=v"(b), "=v"(c), "=v"(d)); return (f32x4){a, b, c, d}; }
__device__ __forceinline__ int obid() { int b = blockIdx.x; asm volatile("" : "+s"(b)); return b; }
__device__ __forceinline__ float bf2f(bf16_t v) { return __uint_as_float(((unsigned)v) << 16); }
__device__ __forceinline__ unsigned f2bf(float f) { unsigned u = __float_as_uint(f); return (u + 0x7fffu + ((u >> 16) & 1u)) >> 16; }
typedef float f32x2c __attribute__((ext_vector_type(2))); typedef __bf16 bf16x2c __attribute__((ext_vector_type(2)));
__device__ __forceinline__ unsigned pk2(float lo, float hi) { const f32x2c f = {lo, hi}; return __builtin_bit_cast(unsigned, __builtin_convertvector(f, bf16x2c)); }
__device__ __forceinline__ float sigmoidf_(float x) { return __builtin_amdgcn_rcpf(1.f + __expf(-x)); }
__device__ __forceinline__ float siluf_(float x) { return x * __builtin_amdgcn_rcpf(1.f + __expf(-x)); }
__device__ __forceinline__ float shx(float v, int k, int lane) { return __int_as_float(__builtin_amdgcn_ds_bpermute((lane ^ k) << 2, __float_as_int(v))); }
__device__ __forceinline__ float shl_(float v, int src) { return __int_as_float(__builtin_amdgcn_ds_bpermute(src << 2, __float_as_int(v))); }
__device__ __forceinline__ float dpp_ror1(float v)  { return __int_as_float(__builtin_amdgcn_update_dpp(0, __float_as_int(v), 0x121, 0xF, 0xF, true)); }
__device__ __forceinline__ float dpp_ror15(float v) { return __int_as_float(__builtin_amdgcn_update_dpp(0, __float_as_int(v), 0x12F, 0xF, 0xF, true)); }
__device__ __forceinline__ unsigned char* ows(unsigned char* w) { asm volatile("" : "+s"(w)); return w; }
__device__ __forceinline__ float wave_sum(float v, int lane) {
#pragma unroll
    for (int o = 1; o < 64; o <<= 1) v += shx(v, o, lane);
    return v;
}
__device__ __forceinline__ void unpack8(u32x4 w, float (&f)[8]) {
    f[0] = __uint_as_float(w.x << 16); f[1] = __uint_as_float(w.x & 0xffff0000u); f[2] = __uint_as_float(w.y << 16); f[3] = __uint_as_float(w.y & 0xffff0000u);
    f[4] = __uint_as_float(w.z << 16); f[5] = __uint_as_float(w.z & 0xffff0000u); f[6] = __uint_as_float(w.w << 16); f[7] = __uint_as_float(w.w & 0xffff0000u);
}
__device__ __forceinline__ u32x4 pack8(const float (&f)[8]) { u32x4 w; w.x = pk2(f[0], f[1]); w.y = pk2(f[2], f[3]); w.z = pk2(f[4], f[5]); w.w = pk2(f[6], f[7]); return w; }
__device__ __forceinline__ void rowinfo(int r, int& mj, int& t, int& T) { const int c = r >= RL ? 1 : 0; mj = r >> 11; T = SEQ >> (3 * c); t = r & (T - 1); }
__device__ __forceinline__ int chunk_row0(int cidx) { return cidx < 64 ? (cidx >> 4) * SEQ + (cidx & 15) * CHUNK : RL + ((cidx - 64) >> 1) * CTX + ((cidx - 64) & 1) * CHUNK; }
__device__ __forceinline__ int scan_chunk(int b, int dir, int step) {
    if (step < 2) { const int j = dir ? 1 - step : step; return 64 + b * 2 + j; }
    const int jj = step - 2, j = dir ? 15 - jj : jj; return b * 16 + j;
}

namespace pg8 {
#define PG8_LAS __attribute__((address_space(3)))
constexpr int BM = 256, BK = 64, HALF = 128, HTB = HALF * BK * 2, STAGE_BYTES = 8 * HTB, NXCD = 8, WGM = 8;
__host__ __device__ __forceinline__ int lds_byte(int r, int c) { const int st = (r >> 4) * 2 + (c >> 5), rr = r & 15, cc = c & 31, ob = rr * 64 + cc * 2; return st * 1024 + (ob ^ (((ob >> 9) & 1) << 5)); }
__host__ __device__ __forceinline__ void stage_rc(int b, int& Rr, int& C) { const int st = b / 1024, sb = b % 1024, swz = sb ^ (((sb >> 9) & 1) << 5); Rr = (st >> 1) * 16 + swz / 64; C = (st & 1) * 32 + (swz % 64) / 2; }
__host__ __device__ __forceinline__ int perm32(int rho) { const int n = rho >> 4, i = rho & 15; return 8 * (i >> 2) + 4 * n + (i & 3); }
struct Unit { int pm, pn, k0, nt, ks; };
struct Gemm { const bf16_t* A; const bf16_t* Bt; int M, N, K, lda, ldb, pad; };
__host__ __device__ __forceinline__ void tile_of(int wgid, int nM, int nN, int& pm, int& pn) {
    const int nwg = nM * nN; { const int q = nwg / NXCD, r = nwg % NXCD, xcd = wgid % NXCD, off = wgid / NXCD; wgid = (xcd < r ? xcd * (q + 1) : r * (q + 1) + (xcd - r) * q) + off; }
    const int nig = WGM * nN, gid = wgid / nig, fm = gid * WGM, gsz = (nM - fm) < WGM ? (nM - fm) : WGM;
    pm = fm + ((wgid % nig) % gsz); pn = (wgid % nig) / gsz;
}
struct StaticOrder {
    int nM, nN, nwg, G, c, K;
    __host__ __device__ void init(int M, int N, int K_, int G_, int c_) { nM = M / BM; nN = N / BM; nwg = nM * nN; G = G_; c = c_; K = K_; }
    __host__ __device__ bool next(int i, Unit& u) const {
        const long L = (long)i * G + c; if (L >= nwg) return false;
        tile_of((int)L, nM, nN, u.pm, u.pn); u.k0 = 0; u.nt = K / BK; u.ks = -1; return true;
    }
    __device__ __forceinline__ void a_ready(const Unit&) const {}
    __device__ __forceinline__ void done(const Unit&) const {}
};
struct TailOrder {
    int nN, G, c, K, nLat, nWhole, nTot, nsl;
    __host__ __device__ void init(int N, int K_, int G_, int c_, int nCtxTiles, int nCtxWhole, int nsl_) { nN = N / BM; G = G_; c = c_; K = K_; nLat = 32 * nN; nWhole = nLat + nCtxWhole; nTot = nLat + nCtxTiles; nsl = nsl_; }
    __host__ __device__ bool next(int i, Unit& u) const {
        const long L = (long)i * G + c; if (L >= (long)nWhole + (long)(nTot - nWhole) * nsl) return false;
        int tile, ks; if (L < nWhole) { tile = (int)L; ks = -1; } else { const int Lp = (int)L - nWhole; tile = nWhole + Lp / nsl; ks = Lp % nsl; }
        if (tile < nLat) tile_of(tile, 32, nN, u.pm, u.pn); else { const int tp = tile - nLat; u.pm = 32 + (tp & 3); u.pn = tp >> 2; }
        if (ks < 0) { u.k0 = 0; u.nt = K / BK; } else { const int n128 = K / 128, base = n128 / nsl, rem = n128 % nsl; u.k0 = 128 * (ks * base + (ks < rem ? ks : rem)); u.nt = 2 * (base + (ks < rem ? 1 : 0)); }
        u.ks = ks; return true;
    }
    __device__ __forceinline__ void a_ready(const Unit&) const {}
    __device__ __forceinline__ void done(const Unit&) const {}
};
template <bool AMAP> __device__ __forceinline__ void a_geom(const Gemm& g, const Unit& u, int R0, int C0, int R1, int C1, size_t& base, size_t& hstep, unsigned (&vo)[2]) {
    if (AMAP && u.pm < 32) { base = (size_t)((u.pm >> 3) * 2048 + (u.pm & 7) * 8) * g.lda * 2; hstep = (size_t)4 * g.lda * 2;
        vo[0] = (unsigned)(((R0 & 31) * 64 + (R0 >> 5)) * g.lda + C0) * 2u; vo[1] = (unsigned)(((R1 & 31) * 64 + (R1 >> 5)) * g.lda + C1) * 2u; }
    else { base = (size_t)u.pm * 256 * g.lda * 2; hstep = (size_t)HALF * g.lda * 2; vo[0] = (unsigned)(R0 * g.lda + C0) * 2u; vo[1] = (unsigned)(R1 * g.lda + C1) * 2u; }
}
template <class Epi, class Sched, bool AMAP = false>
__device__ __forceinline__ void gemm_phase(PG8_LAS unsigned char* lds, const Gemm g, const Sched& S, const Epi& E) {
    const int tid = otid(g.pad), wid = __builtin_amdgcn_readfirstlane(tid >> 6), lane = tid & 63, wr = wid >> 2, wc = wid & 3, fr = lane & 15, fq = lane >> 4;
    int R0, C0, R1, C1; stage_rc(tid * 16, R0, C0); stage_rc(tid * 16 + 8192, R1, C1);
    unsigned voffB[2];
    { const int Rb0 = Epi::PERM ? ((R0 & ~31) + perm32(R0 & 31)) : R0, Rb1 = Epi::PERM ? ((R1 & ~31) + perm32(R1 & 31)) : R1;
      voffB[0] = (unsigned)(Rb0 * g.ldb + C0) * 2u; voffB[1] = (unsigned)(Rb1 * g.ldb + C1) * 2u; }
    const size_t kstep = (size_t)(BK * 2);
    const size_t hstepB = (size_t)HALF * g.ldb * 2, tstepB = 2 * hstepB;
    const unsigned ldsw = (unsigned)wid * 1024u;
    const int aoff = lds_byte(wr * 64 + fr, fq * 8), boff = lds_byte(wc * 32 + fr, fq * 8);
#define PG8_SA(b, h) (((b) * 2 + (h)) * HTB)
#define PG8_SB(b, h) ((4 + (b) * 2 + (h)) * HTB)
#define PG8_STAGE(bufoff, gbase, voff) do { _Pragma("unroll") for (int _i = 0; _i < 2; ++_i) \
        __builtin_amdgcn_global_load_lds((const unsigned*)((const char*)(gbase) + (voff)[_i]), (PG8_LAS unsigned*)(lds + (bufoff) + ldsw + _i * 8192), 16, 0, 0); } while (0)
#define PG8_LDA(dst, b, h) do { _Pragma("unroll") for (int m = 0; m < 4; ++m) _Pragma("unroll") for (int k = 0; k < 2; ++k) dst[m][k] = *(const PG8_LAS bf16x8*)(lds + PG8_SA(b, h) + aoff + m * 2048 + k * 1024); } while (0)
#define PG8_LDB(dst, b, h) do { _Pragma("unroll") for (int n = 0; n < 2; ++n) _Pragma("unroll") for (int k = 0; k < 2; ++k) dst[n][k] = *(const PG8_LAS bf16x8*)(lds + PG8_SB(b, h) + boff + n * 2048 + k * 1024); } while (0)
#define PG8_MMA(ai, bj, At, Bt) do { __builtin_amdgcn_s_setprio(1); _Pragma("unroll") for (int m = 0; m < 4; ++m) _Pragma("unroll") for (int n = 0; n < 2; ++n) _Pragma("unroll") for (int k = 0; k < 2; ++k) \
        acc[ai][bj][m][n] = __builtin_amdgcn_mfma_f32_16x16x32_bf16(Bt[n][k], At[m][k], acc[ai][bj][m][n], 0, 0, 0); __builtin_amdgcn_s_setprio(0); } while (0)
#define PG8_WAIT_V(n) asm volatile("s_waitcnt vmcnt(" #n ")" ::: "memory")
#define PG8_WAIT_L(n) asm volatile("s_waitcnt lgkmcnt(" #n ")" ::: "memory")
#define PG8_BAR __builtin_amdgcn_s_barrier()
#define PG8_SCHED __builtin_amdgcn_sched_barrier(0)
    Unit cur, nxt; int ui = 0;
    if (!S.next(0, cur)) return;
    f32x4 acc[2][2][4][2];
#pragma unroll
    for (int a = 0; a < 2; ++a)
#pragma unroll
        for (int b = 0; b < 2; ++b)
#pragma unroll
            for (int m = 0; m < 4; ++m)
#pragma unroll
                for (int n = 0; n < 2; ++n) acc[a][b][m][n] = zero4();
    bf16x8 At[4][2], B0[2][2], B1[2][2];
    size_t baseC, hsC; unsigned voC[2]; a_geom<AMAP>(g, cur, R0, C0, R1, C1, baseC, hsC, voC);
    const char* cA = (const char*)g.A + baseC + (size_t)cur.k0 * 2; const char* cB = (const char*)g.Bt + (size_t)cur.pn * tstepB + (size_t)cur.k0 * 2;
    S.a_ready(cur);
    PG8_STAGE(PG8_SB(0, 0), cB, voffB); PG8_STAGE(PG8_SB(0, 1), cB + hstepB, voffB); PG8_STAGE(PG8_SA(0, 0), cA, voC); PG8_STAGE(PG8_SA(0, 1), cA + hsC, voC);
    if (wr == 1) PG8_BAR;
    PG8_WAIT_V(2); PG8_BAR;
    PG8_STAGE(PG8_SB(1, 0), cB + kstep, voffB); PG8_STAGE(PG8_SA(1, 0), cA + kstep, voC); PG8_STAGE(PG8_SB(1, 1), cB + hstepB + kstep, voffB);
    PG8_WAIT_V(6); PG8_BAR;
    for (;;) {
        const bool has_next = S.next(ui + 1, nxt);
        size_t baseN = baseC, hsN = hsC; unsigned voN[2] = {voC[0], voC[1]};
        if (AMAP && has_next) a_geom<AMAP>(g, nxt, R0, C0, R1, C1, baseN, hsN, voN); else if (has_next) baseN = (size_t)nxt.pm * 256 * g.lda * 2;
        const char* nA = has_next ? (const char*)g.A + baseN + (size_t)nxt.k0 * 2 : cA; const char* nB = has_next ? (const char*)g.Bt + (size_t)nxt.pn * tstepB + (size_t)nxt.k0 * 2 : cB;
        const int nt = cur.nt;
        for (int t = 0; t < nt; t += 2) {
            if constexpr (Epi::HOOK) E.hook(acc, cur, t, wr, wc, fr, fq, At, B0, B1);
            const bool last = (t == nt - 2);
            const char* a1 = cA + (size_t)(t + 1) * kstep;
            const char* a2 = last ? nA : cA + (size_t)(t + 2) * kstep; const char* b2 = last ? nB : cB + (size_t)(t + 2) * kstep;
            const char* a3 = a2 + kstep; const char* b3 = b2 + kstep;
            const size_t hs2 = (AMAP && last) ? hsN : hsC; unsigned vo2[2] = {(AMAP && last) ? voN[0] : voC[0], (AMAP && last) ? voN[1] : voC[1]};
            if (last && has_next) S.a_ready(nxt);
            PG8_LDB(B0, 0, 0); PG8_LDB(B1, 0, 1); PG8_SCHED; PG8_LDA(At, 0, 0); PG8_STAGE(PG8_SA(1, 1), a1 + hsC, voC);
            PG8_WAIT_V(8); PG8_WAIT_L(0); PG8_BAR; PG8_MMA(0, 0, At, B0); PG8_MMA(0, 1, At, B1); PG8_BAR; PG8_SCHED;
            PG8_LDA(At, 0, 1); PG8_STAGE(PG8_SB(0, 0), b2, voffB); PG8_STAGE(PG8_SB(0, 1), b2 + hstepB, voffB); PG8_STAGE(PG8_SA(0, 0), a2, vo2);
            PG8_WAIT_V(8); PG8_WAIT_L(0); PG8_BAR; PG8_MMA(1, 0, At, B0); PG8_MMA(1, 1, At, B1); PG8_BAR; PG8_SCHED;
            PG8_LDB(B0, 1, 0); PG8_LDB(B1, 1, 1); PG8_SCHED; PG8_LDA(At, 1, 0); PG8_STAGE(PG8_SA(0, 1), a2 + hs2, vo2);
            PG8_WAIT_V(8); PG8_WAIT_L(0); PG8_BAR; PG8_MMA(0, 0, At, B0); PG8_MMA(0, 1, At, B1); PG8_BAR; PG8_SCHED;
            PG8_LDA(At, 1, 1); PG8_STAGE(PG8_SB(1, 0), b3, voffB); PG8_STAGE(PG8_SB(1, 1), b3 + hstepB, voffB); PG8_STAGE(PG8_SA(1, 0), a3, vo2);
            PG8_WAIT_V(8); PG8_WAIT_L(0); PG8_BAR; PG8_MMA(1, 0, At, B0); PG8_MMA(1, 1, At, B1); PG8_BAR; PG8_SCHED;
        }
        if (wr == 0) PG8_BAR;
        E(acc, cur, wr, wc, fr, fq); S.done(cur);
        if (!has_next) break;
#pragma unroll
        for (int a = 0; a < 2; ++a)
#pragma unroll
            for (int b = 0; b < 2; ++b)
#pragma unroll
                for (int m = 0; m < 4; ++m)
#pragma unroll
                    for (int n = 0; n < 2; ++n) acc[a][b][m][n] = zero4();
        cur = nxt; cA = nA; cB = nB; ++ui;
        if constexpr (AMAP) { hsC = hsN; voC[0] = voN[0]; voC[1] = voN[1]; }
        if (wr == 1) PG8_BAR;
    }
    PG8_WAIT_V(0);
    PG8_BAR;
#undef PG8_SA
#undef PG8_SB
#undef PG8_STAGE
#undef PG8_LDA
#undef PG8_LDB
#undef PG8_MMA
#undef PG8_WAIT_V
#undef PG8_WAIT_L
#undef PG8_BAR
#undef PG8_SCHED
}
}

template <class F> __device__ __forceinline__ void epi_foreach(const f32x4 (&acc)[2][2][4][2], const pg8::Unit& u, int wr, int wc, int fr, int fq, F&& f) {
    const int row0 = u.pm * 256 + wr * 64 + fr, col0 = u.pn * 256 + wc * 32 + 8 * fq;
#pragma unroll
    for (int ai = 0; ai < 2; ++ai)
#pragma unroll
        for (int m = 0; m < 4; ++m)
#pragma unroll
            for (int bj = 0; bj < 2; ++bj) f(row0 + ai * 128 + m * 16, col0 + bj * 128, acc[ai][bj][m][0], acc[ai][bj][m][1]);
}
__device__ __forceinline__ void unpack8v(u32x4 w, f32x4& v0, f32x4& v1) {
    v0[0] = __uint_as_float(w.x << 16); v0[1] = __uint_as_float(w.x & 0xffff0000u); v0[2] = __uint_as_float(w.y << 16); v0[3] = __uint_as_float(w.y & 0xffff0000u);
    v1[0] = __uint_as_float(w.z << 16); v1[1] = __uint_as_float(w.z & 0xffff0000u); v1[2] = __uint_as_float(w.w << 16); v1[3] = __uint_as_float(w.w & 0xffff0000u);
}
__device__ __forceinline__ u32x4 pack8v(f32x4 v0, f32x4 v1) { u32x4 w; w.x = pk2(v0[0], v0[1]); w.y = pk2(v0[2], v0[3]); w.z = pk2(v1[0], v1[1]); w.w = pk2(v1[2], v1[3]); return w; }

struct EpiInProj {
    static constexpr bool PERM = true, HOOK = false;
    bf16_t* P; float* G; const float* bias;
    __device__ __forceinline__ void operator()(const f32x4 (&acc)[2][2][4][2], const pg8::Unit& u, int wr, int wc, int fr, int fq) const {
        if (u.pn < 48) {
            f32x4 bv[2][2];
#pragma unroll
            for (int bj = 0; bj < 2; ++bj) { const unsigned bo = (unsigned)(u.pn * 256 + wc * 32 + 8 * fq + bj * 128) * 4u; bv[bj][0] = gld<f32x4>(bias, bo); bv[bj][1] = gld<f32x4>(bias, bo + 16); }
            epi_foreach(acc, u, wr, wc, fr, fq, [&](int row, int col, f32x4 v0, f32x4 v1) {
                const int bj = (col >> 7) & 1;
                f32x4 o0 = v0 + bv[bj][0], o1 = v1 + bv[bj][1];
                if (u.pn >= PGM / 256) {
#pragma unroll
                    for (int j = 0; j < 4; ++j) { o0[j] = 1.f + __expf(-fminf(fmaxf(o0[j], -30.f), 30.f)); o1[j] = 1.f + __expf(-fminf(fmaxf(o1[j], -30.f), 30.f)); } }
                gst<u32x4>(P, (unsigned)(row * NP + col) * 2u, pack8v(o0, o1)); });
        } else if (wc == 0 && fq < 2) {
            const int row0 = u.pm * 256 + wr * 64 + fr;
            const f32x4 b0 = gld<f32x4>(bias, (unsigned)(NP + 8 * fq) * 4u), b1 = gld<f32x4>(bias, (unsigned)(NP + 8 * fq) * 4u + 16);
#pragma unroll
            for (int ai = 0; ai < 2; ++ai)
#pragma unroll
                for (int m = 0; m < 4; ++m) { const unsigned go = (unsigned)((row0 + ai * 128 + m * 16) * 16 + 8 * fq) * 4u;
                    gst<f32x4>(G, go, acc[ai][0][m][0] + b0); gst<f32x4>(G, go + 16, acc[ai][0][m][1] + b1); }
        }
    }
};
struct EpiBf16 {
    static constexpr bool PERM = true, HOOK = false;
    bf16_t* O; int ldc; int split_cols; unsigned split_stride; int pad; float* slab;
    __device__ __forceinline__ void operator()(const f32x4 (&acc)[2][2][4][2], const pg8::Unit& u, int wr, int wc, int fr, int fq) const {
        if (u.ks >= 0) { const unsigned sb = (unsigned)u.ks * (unsigned)(RC * ldc);
            epi_foreach(acc, u, wr, wc, fr, fq, [&](int row, int col, f32x4 v0, f32x4 v1) { const unsigned o = (sb + (unsigned)((row - RL) * ldc + col)) * 4u; gst<f32x4>(slab, o, v0); gst<f32x4>(slab, o + 16, v1); });
            return; }
        int colt = u.pn * 256; unsigned base = 0;
        if (split_cols) { const int t = colt / split_cols; base = (unsigned)t * split_stride; colt -= t * split_cols; }
        const int cshift = colt - u.pn * 256;
        epi_foreach(acc, u, wr, wc, fr, fq, [&](int row, int col, f32x4 v0, f32x4 v1) { gst<u32x4>(O, (base + (unsigned)(row * ldc + col + cshift)) * 2u, pack8v(v0, v1)); });
    }
};
struct EpiMerge {
    static constexpr bool PERM = true, HOOK = true;
    const bf16_t* P; bf16_t* MG; float* slab;
    __device__ __forceinline__ void hook(f32x4 (&acc)[2][2][4][2], const pg8::Unit& u, int t, int wr, int wc, int fr, int fq, bf16x8 (&At)[4][2], bf16x8 (&B0)[2][2], bf16x8 (&B1)[2][2]) const {
        const int tg = t + (u.k0 >> 6);
        if ((tg != 16 && tg != 24) || t == 0) return;
        const int b = tg == 16 ? 0 : 1;
        const unsigned o0 = (unsigned)((u.pm * 256 + wr * 64 + fr) * NP + PGM + b * D + u.pn * 256 + wc * 32 + 8 * fq) * 2u;
#pragma unroll
        for (int ai = 0; ai < 2; ++ai) {
#pragma unroll
            for (int m = 0; m < 4; ++m) { const unsigned o = o0 + (unsigned)((ai * 128 + m * 16) * NP) * 2u;
                At[m][0] = gld<bf16x8>(P, o); At[m][1] = gld<bf16x8>(P, o + 256u);
                if (m < 2) { B0[m][0] = gld<bf16x8>(P, o + D * 2); B0[m][1] = gld<bf16x8>(P, o + D * 2 + 256u); }
                else { B1[m - 2][0] = gld<bf16x8>(P, o + D * 2); B1[m - 2][1] = gld<bf16x8>(P, o + D * 2 + 256u); } }
#pragma unroll
            for (int m = 0; m < 4; ++m)
#pragma unroll
                for (int bj = 0; bj < 2; ++bj) { float xa[8], xb[8]; unpack8(__builtin_bit_cast(u32x4, At[m][bj]), xa); unpack8(__builtin_bit_cast(u32x4, m < 2 ? B0[m][bj] : B1[m - 2][bj]), xb);
#pragma unroll
                    for (int j = 0; j < 8; ++j) acc[ai][bj][m][j >> 2][j & 3] *= xb[j] * __builtin_amdgcn_rcpf(xa[j]); }
        }
    }
    __device__ __forceinline__ void operator()(const f32x4 (&acc)[2][2][4][2], const pg8::Unit& u, int wr, int wc, int fr, int fq) const {
        const int row0 = u.pm * 256 + wr * 64 + fr, col0 = u.pn * 256 + wc * 32 + 8 * fq;
        const int gsec = u.ks == 0 ? 0 : 2;
#pragma unroll
        for (int ai = 0; ai < 2; ++ai) { u32x4 gr[4][2];
#pragma unroll
            for (int m = 0; m < 4; ++m)
#pragma unroll
                for (int bj = 0; bj < 2; ++bj) gr[m][bj] = gld<u32x4>(P, (unsigned)((row0 + ai * 128 + m * 16) * NP + PGM + gsec * D + col0 + bj * 128) * 2u);
#pragma unroll
            for (int m = 0; m < 4; ++m)
#pragma unroll
                for (int bj = 0; bj < 2; ++bj) { float g[8]; unpack8(gr[m][bj], g);
                    const f32x4 g0 = {__builtin_amdgcn_rcpf(g[0]), __builtin_amdgcn_rcpf(g[1]), __builtin_amdgcn_rcpf(g[2]), __builtin_amdgcn_rcpf(g[3])},
                                g1 = {__builtin_amdgcn_rcpf(g[4]), __builtin_amdgcn_rcpf(g[5]), __builtin_amdgcn_rcpf(g[6]), __builtin_amdgcn_rcpf(g[7])};
                    if (u.ks < 0) gst<u32x4>(MG, (unsigned)((row0 + ai * 128 + m * 16) * D + col0 + bj * 128) * 2u, pack8v(g0 * acc[ai][bj][m][0], g1 * acc[ai][bj][m][1]));
                    else { const unsigned so = (unsigned)((u.ks * RC + (row0 + ai * 128 + m * 16 - RL)) * D + col0 + bj * 128) * 4u; gst<f32x4>(slab, so, g0 * acc[ai][bj][m][0]); gst<f32x4>(slab, so + 16, g1 * acc[ai][bj][m][1]); } }
        }
    }
};
struct EpiUp {
    static constexpr bool PERM = true, HOOK = false;
    bf16_t* U; float* slab; bf16_t* ACT; const float* wf;
    __device__ __forceinline__ void operator()(const f32x4 (&acc)[2][2][4][2], const pg8::Unit& u, int wr, int wc, int fr, int fq) const {
        if (u.ks >= 0) { const unsigned sb = (unsigned)u.ks * (unsigned)(RC * NUP);
            epi_foreach(acc, u, wr, wc, fr, fq, [&](int row, int col, f32x4 v0, f32x4 v1) { const unsigned o = (sb + (unsigned)((row - RL) * NUP + col)) * 2u; gst<u32x4>(slab, o, pack8v(v0, v1)); });
            return; }
        if (u.pm >= 32) { epi_foreach(acc, u, wr, wc, fr, fq, [&](int row, int col, f32x4 v0, f32x4 v1) { gst<u32x4>(U, (unsigned)(row * NUP + col) * 2u, pack8v(v0, v1)); }); return; }
        const int c0 = 128 * u.pn + 32 * wc + 8 * fq;
        float w0[8], w1[8], w2[8];
        { const f32x4 a0 = gld<f32x4>(wf, (unsigned)c0 * 4u), a1 = gld<f32x4>(wf, (unsigned)c0 * 4u + 16), b0 = gld<f32x4>(wf, (unsigned)(DFF + c0) * 4u), b1 = gld<f32x4>(wf, (unsigned)(DFF + c0) * 4u + 16),
                      d0 = gld<f32x4>(wf, (unsigned)(2 * DFF + c0) * 4u), d1 = gld<f32x4>(wf, (unsigned)(2 * DFF + c0) * 4u + 16);
#pragma unroll
          for (int j = 0; j < 4; ++j) { w0[j] = a0[j]; w0[4 + j] = a1[j]; w1[j] = b0[j]; w1[4 + j] = b1[j]; w2[j] = d0[j]; w2[4 + j] = d1[j]; } }
        const unsigned rowb = (unsigned)((u.pm >> 3) * 2048 + (u.pm & 7) * 8 + 2 * wr);
#pragma unroll
        for (int ai = 0; ai < 2; ++ai)
#pragma unroll
            for (int m = 0; m < 4; ++m) {
                float o[8];
#pragma unroll
                for (int n = 0; n < 2; ++n)
#pragma unroll
                    for (int e = 0; e < 4; ++e) {
                        const float a = acc[ai][0][m][n][e];
                        const float oprev = (m & 1) ? acc[ai][0][m - 1 < 0 ? 0 : m - 1][n][e] : 0.f, onext = (m & 1) ? 0.f : acc[ai][0][m + 1 > 3 ? 3 : m + 1][n][e];
                        const float pv = dpp_ror1(fr == 15 ? oprev : a), nx = dpp_ror15(fr == 0 ? onext : a);
                        o[4 * n + e] = siluf_(w0[4 * n + e] * pv + w1[4 * n + e] * a + w2[4 * n + e] * nx) * acc[ai][1][m][n][e];
                    }
                const unsigned row = rowb + (unsigned)((16 * (m & 1) + fr) * 64 + 4 * ai + (m >> 1));
                gst<u32x4>(ACT, (row * (unsigned)DFF + (unsigned)c0) * 2u, pack8(o));
            }
    }
};
struct EpiResid {
    static constexpr bool PERM = true, HOOK = false;
    int l, which, fuse; float scale;
    __device__ __forceinline__ void operator()(f32x4 (&acc)[2][2][4][2], const pg8::Unit& u, int wr, int wc, int fr, int fq) const {
        CParams& p = *okp(); unsigned char* const ws = ows(p.ws);
        bf16_t* H = (bf16_t*)(ws + OFF_H); const bool xin = (l == 0 && which == 0);
        const float* mod = (const float*)(ws + OFF_MOD) + (size_t)l * 5 * 6 * D; const float* gate = mod + (which ? 5 : 2) * D;
        if (u.ks >= 0) { float* slab = (float*)(ws + OFF_SLAB); const unsigned sb = (unsigned)u.ks * (unsigned)(RC * D);
            epi_foreach(acc, u, wr, wc, fr, fq, [&](int row, int col, f32x4 v0, f32x4 v1) { const unsigned o = (sb + (unsigned)((row - RL) * D + col)) * 2u; gst<u32x4>(slab, o, pack8v(v0, v1)); });
            return; }
        const unsigned gb = (unsigned)(u.pm < 32 ? (u.pm >> 3) : 4) * (6 * D) * 4u;
        if (!fuse || u.pm >= 32) {
            const int row0 = u.pm * 256 + wr * 64 + fr, col0 = u.pn * 256 + wc * 32 + 8 * fq;
            f32x4 gv[2][2];
#pragma unroll
            for (int bj = 0; bj < 2; ++bj) { gv[bj][0] = gld<f32x4>(gate, gb + (unsigned)(col0 + bj * 128) * 4u) * scale; gv[bj][1] = gld<f32x4>(gate, gb + (unsigned)(col0 + bj * 128) * 4u + 16) * scale; }
            if (xin) {
#pragma unroll
              for (int am = 0; am < 4; ++am) { f32x4 hv[2][2][2];
#pragma unroll
                for (int mm = 0; mm < 2; ++mm)
#pragma unroll
                  for (int bj = 0; bj < 2; ++bj) { const unsigned ho = (unsigned)((row0 + (am >> 1) * 128 + (2 * (am & 1) + mm) * 16) * D + col0 + bj * 128) * 4u; hv[mm][bj][0] = gld<f32x4>(p.x, ho); hv[mm][bj][1] = gld<f32x4>(p.x, ho + 16); }
#pragma unroll
                for (int mm = 0; mm < 2; ++mm)
#pragma unroll
                  for (int bj = 0; bj < 2; ++bj) { const int ai = am >> 1, m = 2 * (am & 1) + mm; const unsigned eo = (unsigned)((row0 + ai * 128 + m * 16) * D + col0 + bj * 128);
                      gst<u32x4>(H, eo * 2u, pack8v(hv[mm][bj][0] + gv[bj][0] * acc[ai][bj][m][0], hv[mm][bj][1] + gv[bj][1] * acc[ai][bj][m][1])); } }
            } else {
#pragma unroll
              for (int ai = 0; ai < 2; ++ai) { u32x4 hr[4][2];
#pragma unroll
                for (int m = 0; m < 4; ++m)
#pragma unroll
                  for (int bj = 0; bj < 2; ++bj) hr[m][bj] = gld<u32x4>(H, (unsigned)((row0 + ai * 128 + m * 16) * D + col0 + bj * 128) * 2u);
#pragma unroll
                for (int m = 0; m < 4; ++m)
#pragma unroll
                  for (int bj = 0; bj < 2; ++bj) { f32x4 o0, o1; unpack8v(hr[m][bj], o0, o1);
                      gst<u32x4>(H, (unsigned)((row0 + ai * 128 + m * 16) * D + col0 + bj * 128) * 2u, pack8v(o0 + gv[bj][0] * acc[ai][bj][m][0], o1 + gv[bj][1] * acc[ai][bj][m][1])); } }
            }
            return; }
        bf16_t* XN = (bf16_t*)(ws + OFF_XN); const float* nw = fuse == 2 ? p.final_norm_w : which ? p.norm1_w + (size_t)(l + 1) * D : p.norm2_w + (size_t)l * D;
        const float* nmod = which ? mod + 5 * 6 * D : mod + 3 * D;
        float* xs = (float*)(ws + OFF_XS) + (size_t)(2 * l + which) * RL * 32; unsigned* cnt = (unsigned*)(ws + OFF_CTL) + CNTW + (2 * l + which) * 32 * 64;
        float* out = p.out;
        int lane; asm volatile("v_mbcnt_lo_u32_b32 %0, -1, 0\n\tv_mbcnt_hi_u32_b32 %0, -1, %0" : "=v"(lane));
        { const int fr2 = lane & 15, fq2 = lane >> 4, row0 = u.pm * 256 + wr * 64 + fr2, col0 = u.pn * 256 + wc * 32 + 8 * fq2;
          f32x4 gv[2][2];
#pragma unroll
          for (int bj = 0; bj < 2; ++bj) { gv[bj][0] = gld<f32x4>(gate, gb + (unsigned)(col0 + bj * 128) * 4u) * scale; gv[bj][1] = gld<f32x4>(gate, gb + (unsigned)(col0 + bj * 128) * 4u + 16) * scale; }
          float ssr[8];
          auto newh = [&](int k, int bj, f32x4 o0, f32x4 o1, float& ss) {
              const int ai = k >> 2, m = k & 3; const unsigned eo = (unsigned)((row0 + ai * 128 + m * 16) * D + col0 + bj * 128);
              const f32x4 h0 = o0 + gv[bj][0] * acc[ai][bj][m][0], h1 = o1 + gv[bj][1] * acc[ai][bj][m][1];
              if (fuse == 2) { gst<f32x4>(out, eo * 4u, h0); gst<f32x4>(out, eo * 4u + 16, h1); } else gst<u32x4>(H, eo * 2u, pack8v(h0, h1));
              ss += (h0[0] * h0[0] + h0[1] * h0[1]) + (h0[2] * h0[2] + h0[3] * h0[3]) + (h1[0] * h1[0] + h1[1] * h1[1]) + (h1[2] * h1[2] + h1[3] * h1[3]); };
          if (xin) {
#pragma unroll
            for (int am = 0; am < 4; ++am) { f32x4 hv[2][2][2];
#pragma unroll
              for (int mm = 0; mm < 2; ++mm)
#pragma unroll
                for (int bj = 0; bj < 2; ++bj) { const unsigned ho = (unsigned)((row0 + (am >> 1) * 128 + (2 * (am & 1) + mm) * 16) * D + col0 + bj * 128) * 4u; hv[mm][bj][0] = gld<f32x4>(p.x, ho); hv[mm][bj][1] = gld<f32x4>(p.x, ho + 16); }
#pragma unroll
              for (int mm = 0; mm < 2; ++mm) { const int k = 4 * (am >> 1) + 2 * (am & 1) + mm; float ss = 0.f;
#pragma unroll
                for (int bj = 0; bj < 2; ++bj) newh(k, bj, hv[mm][bj][0], hv[mm][bj][1], ss);
                ss += shx(ss, 16, lane); ss += shx(ss, 32, lane); ssr[k] = ss; } }
          } else {
#pragma unroll
            for (int kh = 0; kh < 2; ++kh) { u32x4 hr[4][2];
#pragma unroll
              for (int m = 0; m < 4; ++m)
#pragma unroll
                for (int bj = 0; bj < 2; ++bj) hr[m][bj] = gld<u32x4>(H, (unsigned)((row0 + kh * 128 + m * 16) * D + col0 + bj * 128) * 2u);
#pragma unroll
              for (int m = 0; m < 4; ++m) { const int k = 4 * kh + m; float ss = 0.f;
#pragma unroll
                for (int bj = 0; bj < 2; ++bj) { f32x4 o0, o1; unpack8v(hr[m][bj], o0, o1); newh(k, bj, o0, o1, ss); }
                ss += shx(ss, 16, lane); ss += shx(ss, 32, lane); ssr[k] = ss; } }
          }
#pragma unroll
          for (int k = 0; k < 8; ++k)
              if (fq2 == 0) __hip_atomic_store((GAS float*)xs + ((row0 + (k >> 2) * 128 + (k & 3) * 16) * 32 + u.pn * 4 + wc), ssr[k], __ATOMIC_RELAXED, __HIP_MEMORY_SCOPE_AGENT); }
        asm volatile("s_waitcnt vmcnt(0)" ::: "memory");
        __builtin_amdgcn_s_barrier();
        if (lane == 0 && wr == 0 && wc == 0) {
            GAS unsigned* pc = (GAS unsigned*)cnt + 64 * u.pm;
            (void)__hip_atomic_fetch_add(pc, 1u, __ATOMIC_RELAXED, __HIP_MEMORY_SCOPE_AGENT);
            unsigned spins = 0;
#pragma nounroll
            while (__hip_atomic_load(pc, __ATOMIC_RELAXED, __HIP_MEMORY_SCOPE_AGENT) < 8u && ++spins < (1u << 22)) __builtin_amdgcn_s_sleep(1);
        }
        __builtin_amdgcn_s_barrier();
        __builtin_amdgcn_fence(__ATOMIC_ACQUIRE, "agent");
        { const int hl = lane & 31, row0 = u.pm * 256 + (wr * 4 + wc) * 32 + (lane >> 5), col = u.pn * 256 + hl * 8;
          const unsigned mo = (unsigned)(u.pm >> 3) * (6 * D) * 4u, co = (unsigned)col * 4u;
          const f32x4 w0 = gld<f32x4>(nw, co), w1 = gld<f32x4>(nw, co + 16);
          if (fuse == 2) {
#pragma unroll
            for (int ib = 0; ib < 4; ++ib) { float tt[4]; f32x4 ha[4], hb[4];
#pragma unroll
              for (int i = 0; i < 4; ++i) { const int row = row0 + 2 * (4 * ib + i); const unsigned ho = (unsigned)(row * D + col) * 4u;
                  tt[i] = gld<float>(xs, (unsigned)(row * 32 + hl) * 4u); ha[i] = gld<f32x4>(out, ho); hb[i] = gld<f32x4>(out, ho + 16); }
#pragma unroll
              for (int i = 0; i < 4; ++i) { const int row = row0 + 2 * (4 * ib + i); const unsigned ho = (unsigned)(row * D + col) * 4u; float tot = tt[i];
#pragma unroll
                  for (int o = 1; o < 32; o <<= 1) tot += shx(tot, o, lane);
                  const float rstd = rsqrtf(tot * (1.f / D) + EPS);
                  gst<f32x4>(out, ho, ha[i] * rstd * w0); gst<f32x4>(out, ho + 16, hb[i] * rstd * w1); } }
            return; }
          const f32x4 sh0 = gld<f32x4>(nmod, mo + co), sh1 = gld<f32x4>(nmod, mo + co + 16);
          const f32x4 sc0 = gld<f32x4>(nmod, mo + D * 4 + co) + 1.f, sc1 = gld<f32x4>(nmod, mo + D * 4 + co + 16) + 1.f;
#pragma unroll
          for (int ib = 0; ib < 2; ++ib) { float tt[8]; u32x4 hq[8];
#pragma unroll
            for (int i = 0; i < 8; ++i) { const int row = row0 + 2 * (8 * ib + i);
                tt[i] = gld<float>(xs, (unsigned)(row * 32 + hl) * 4u); hq[i] = gld<u32x4>(H, (unsigned)(row * D + col) * 2u); }
#pragma unroll
            for (int i = 0; i < 8; ++i) { const int row = row0 + 2 * (8 * ib + i); float tot = tt[i];
#pragma unroll
                for (int o = 1; o < 32; o <<= 1) tot += shx(tot, o, lane);
                const float rstd = rsqrtf(tot * (1.f / D) + EPS);
                f32x4 ha, hb; unpack8v(hq[i], ha, hb);
                const f32x4 y0 = (ha * rstd * w0) * sc0 + sh0, y1 = (hb * rstd * w1) * sc1 + sh1;
                gst<u32x4>(XN, (unsigned)(row * D + col) * 2u, pack8v(y0, y1)); } } }
    }
};

__device__ __forceinline__ bf16x8 gather8(const bf16_t* p, size_t stride) {
    bf16x8 v;
#pragma unroll
    for (int j = 0; j < 8; ++j) v[j] = (short)p[(size_t)j * stride];
    return v;
}
template <bool AV, bool BV>
__device__ __forceinline__ void wave_mm32(const bf16_t* A, size_t sam, size_t sak, const bf16_t* B, size_t sbk, size_t sbn, int K, f32x4 (&acc)[2][2], int lane) {
    const int fr = lane & 15, fq = lane >> 4;
    for (int k0 = 0; k0 < K; k0 += 32) {
        bf16x8 a[2], b[2];
#pragma unroll
        for (int mi = 0; mi < 2; ++mi) { const bf16_t* q = A + (size_t)(16 * mi + fr) * sam + (size_t)(k0 + 8 * fq) * sak; a[mi] = AV ? *(const bf16x8*)q : gather8(q, sak); }
#pragma unroll
        for (int ni = 0; ni < 2; ++ni) { const bf16_t* q = B + (size_t)(16 * ni + fr) * sbn + (size_t)(k0 + 8 * fq) * sbk; b[ni] = BV ? *(const bf16x8*)q : gather8(q, sbk); }
#pragma unroll
        for (int mi = 0; mi < 2; ++mi)
#pragma unroll
            for (int ni = 0; ni < 2; ++ni) acc[mi][ni] = __builtin_amdgcn_mfma_f32_16x16x32_bf16(a[mi], b[ni], acc[mi][ni], 0, 0, 0);
    }
}
#define ZERO_ACC22(acc) do { _Pragma("unroll") for (int _a = 0; _a < 2; ++_a) _Pragma("unroll") for (int _b = 0; _b < 2; ++_b) acc[_a][_b] = (f32x4){0.f, 0.f, 0.f, 0.f}; } while (0)

__device__ __forceinline__ void transpose_item(const float* W, int N, int pitch, int kdst0, bf16_t* WT, int dst_row0, int src_col0, int nvalid, int k0, LAS float* scr, int lane) {
    const int n4 = (lane & 15) * 4, kq = lane >> 4;
    f32x4 v[16];
#pragma unroll
    for (int i = 0; i < 16; ++i) v[i] = n4 < nvalid ? gld<f32x4>(W, (unsigned)((k0 + 4 * i + kq) * N + src_col0 + n4) * 4u) : (f32x4){0.f, 0.f, 0.f, 0.f};
#pragma unroll
    for (int i = 0; i < 16; ++i) { LAS float* d = scr + (4 * i + kq) * 65 + n4; d[0] = v[i][0]; d[1] = v[i][1]; d[2] = v[i][2]; d[3] = v[i][3]; }
    asm volatile("s_waitcnt lgkmcnt(0)" ::: "memory");
    const int c = lane & 7;
#pragma unroll
    for (int j8 = 0; j8 < 8; ++j8) { const int n = (lane >> 3) + 8 * j8; const LAS float* sp = scr + (8 * c) * 65 + n;
        u32x4 o; o.x = pk2(sp[0 * 65], sp[1 * 65]); o.y = pk2(sp[2 * 65], sp[3 * 65]); o.z = pk2(sp[4 * 65], sp[5 * 65]); o.w = pk2(sp[6 * 65], sp[7 * 65]);
        gst<u32x4>(WT, (unsigned)((dst_row0 + n) * pitch + kdst0 + k0 + 8 * c) * 2u, o); }
    asm volatile("s_waitcnt lgkmcnt(0)" ::: "memory");
}
constexpr int I_IN = (NINP / 64) * (D / 64), I_PM = (D / 64) * (DM / 64), I_PF = (D / 64) * (DF / 64), I_PC = (D / 64) * (DC / 64), I_O = (D / 64) * (D / 64),
              I_UP = (NUP / 64) * (D / 64), I_DN = (D / 64) * (DFF / 64), I_LAYER = I_IN + I_PM + I_PF + I_PC + I_O + I_UP + I_DN;
__device__ __forceinline__ void ph_convert(int wv, LAS unsigned char* lds, int l, int widx, int nwg, int it_lo, int it_hi) {
    CParams& p = *okp();
    unsigned char* const wsb = ows(p.ws);
    const int TIDX = otid(wv);
    const int lane = TIDX & 63, wave = wv;
    LAS float* scr = (LAS float*)lds + wave * 64 * 65;
    const int gw = widx * 8 + wave, NGW = nwg * 8;
    for (int it = it_lo + gw; it < it_hi; it += NGW) {
        int r = it;
        if (r < I_IN) { const int nkb = D / 64, kb = r % nkb, grp = r / nkb, j0 = 64 * grp; int src0, nv;
            if (j0 < 2048) { src0 = j0; nv = 64; } else if (j0 < NP) { src0 = j0 + 16; nv = 64; } else if (j0 == NP) { src0 = 2048; nv = 16; } else { src0 = 0; nv = 0; }
            transpose_item(p.w_in + (size_t)l * D * NIN, NIN, D, 0, WSP(bf16_t, OFF_WIN) + (size_t)l * NINP * D, j0, src0, nv, 64 * kb, scr, lane); continue; } r -= I_IN;
        if (r < I_PM) { const int nkb = DM / 64, kb = r % nkb, grp = r / nkb;
            transpose_item(p.w_pm + (size_t)l * DM * D, D, D, 0, WSP(bf16_t, OFF_WPM) + (size_t)l * D * D, 64 * grp, 64 * grp, 64, 64 * kb, scr, lane); continue; } r -= I_PM;
        if (r < I_PF) { const int nkb = DF / 64, kb = r % nkb, grp = r / nkb;
            transpose_item(p.w_pf + (size_t)l * DF * D, D, D, DM, WSP(bf16_t, OFF_WPM) + (size_t)l * D * D, 64 * grp, 64 * grp, 64, 64 * kb, scr, lane); continue; } r -= I_PF;
        if (r < I_PC) { const int nkb = DC / 64, kb = r % nkb, grp = r / nkb;
            transpose_item(p.w_pc + (size_t)l * DC * D, D, D, DM + DF, WSP(bf16_t, OFF_WPM) + (size_t)l * D * D, 64 * grp, 64 * grp, 64, 64 * kb, scr, lane); continue; } r -= I_PC;
        if (r < I_O) { const int nkb = D / 64, kb = r % nkb, grp = r / nkb;
            transpose_item(p.w_o + (size_t)l * D * D, D, D, 0, WSP(bf16_t, OFF_WO) + (size_t)l * D * D, 64 * grp, 64 * grp, 64, 64 * kb, scr, lane); continue; } r -= I_O;
        if (r < I_UP) { const int nkb = D / 64, kb = r % nkb, grp = r / nkb, j0 = 64 * grp, tile = j0 >> 8, w0 = j0 & 255;
            transpose_item(p.w_up + (size_t)l * D * NUP, NUP, D, 0, WSP(bf16_t, OFF_WUP) + (size_t)l * NUP * D, j0, w0 < 128 ? 128 * tile + w0 : DFF + 128 * tile + (w0 - 128), 64, 64 * kb, scr, lane); continue; } r -= I_UP;
        { const int nkb = DFF / 64, kb = r % nkb, grp = r / nkb;
            transpose_item(p.w_down + (size_t)l * DFF * D, D, DFF, 0, WSP(bf16_t, OFF_WDN) + (size_t)l * D * DFF, 64 * grp, 64 * grp, 64, 64 * kb, scr, lane); }
    }
}
__device__ __forceinline__ void ph_tables(int wv) {
    CParams& p = *okp();
    unsigned char* const wsb = ows(p.ws);
    const int TIDX = otid(wv), BIDX = obid(); (void)TIDX; (void)BIDX;
    const size_t gt = (size_t)BIDX * 512 + TIDX, NT = (size_t)gridDim.x * 512;
    bf16_t* ma = WSP(bf16_t, OFF_MA);
    for (size_t i = gt; i < (size_t)64 * 64; i += NT) { const int row = (int)(i >> 6), col = (int)(i & 63), ro = row >> 5, tau1 = row & 31, ri = col >> 5, t1 = col & 31;
        const float a = (float)((t1 * tau1) & 31) * (1.0f / 16.0f); const float cv = cospif(a), sv = sinpif(a);
        ma[i] = (bf16_t)f2bf(ro == ri ? cv : (ro == 0 ? sv : -sv)); }
    bf16_t* mc = WSP(bf16_t, OFF_MC);
    for (size_t i = gt; i < (size_t)32 * 64 * 128; i += NT) { const int k = (int)(i & 127), tau2 = (int)(i >> 7) & 63, tau1 = (int)(i >> 13), ri = k >> 6, t2 = k & 63, tau = tau1 + 32 * tau2;
        const float a = (float)((t2 * tau) & 2047) * (1.0f / 1024.0f); mc[i] = (bf16_t)f2bf((ri ? sinpif(a) : cospif(a)) * (1.0f / 512.0f)); }
    bf16_t* csc = WSP(bf16_t, OFF_CSC);
    for (size_t i = gt; i < (size_t)256 * 512; i += NT) { const int tau = (int)(i >> 9), k = (int)(i & 511), t = k & 255; const int idx = (tau * t) & 255;
        const float a = (float)idx * (1.0f / 128.0f); const float v = (k < 256 ? cospif(a) : -sinpif(a)) * 0.005524271728019903f  ; csc[i] = (bf16_t)f2bf(v); }
    bf16_t* ft = WSP(bf16_t, OFF_FT);
    for (size_t i = gt; i < (size_t)256 * 128; i += NT) { const int kp = (int)(i >> 7), c = (int)(i & 127), kap = kp & 127; const int idx = (c * kap) & 127;
        const float a = (float)idx * (1.0f / 64.0f); ft[i] = (bf16_t)f2bf(kp < 128 ? cospif(a) : sinpif(a)); }
    float* binr = WSP(float, OFF_BINR);
    for (size_t i = gt; i < (size_t)DEPTH * NINP; i += NT) { const int l = (int)(i / NINP), j = (int)(i % NINP);
        float v = 0.f; if (j < 2048) v = p.b_in[(size_t)l * NIN + j]; else if (j < NP) v = p.b_in[(size_t)l * NIN + j + 16]; else if (j < NP + 16) v = p.b_in[(size_t)l * NIN + 2048 + (j - NP)];
        binr[i] = v; }

}
template <int DEEP> __device__ __forceinline__ void ph_mod(int wv, LAS unsigned char* lds, int l0, int l1, int widx, int nwg) {
    CParams& p = *okp();
    unsigned char* const wsb = ows(p.ws);
    const int TIDX = otid(wv), BIDX = obid(); (void)TIDX; (void)BIDX;
    typedef float sc_row_t[D]; typedef f32x4 red_t[5][16];
    LAS sc_row_t* sc = (LAS sc_row_t*)lds; LAS red_t* red = (LAS red_t*)(lds + 5 * D * 4);
    const int tid = TIDX;
    for (int i = tid; i < 5 * D; i += 512) { const int j = i / D, k = i % D; const float v = j < 4 ? p.c[(size_t)j * D + k] : p.c_ctx[k]; sc[j][k] = siluf_(v); }
    __syncthreads();
    float* mod = WSP(float, OFF_MOD);
    const int cl = tid & 15, kg = tid >> 4;
    for (int unit = widx; unit < (l1 - l0) * (6 * D / 64); unit += nwg) {
        const int l = l0 + unit / (6 * D / 64), n0 = (unit % (6 * D / 64)) * 64;
        f32x4 a[5];
#pragma unroll
        for (int j = 0; j < 5; ++j) a[j] = (f32x4){0.f, 0.f, 0.f, 0.f};
        const float* wl = p.w_mod + (size_t)l * D * 6 * D; const unsigned wo = (unsigned)(n0 + 4 * cl) * 4u;
        for (int k0 = kg; k0 < D; k0 += 32 * DEEP) { f32x4 w8[DEEP];
#pragma unroll
            for (int i = 0; i < DEEP; ++i) w8[i] = gld<f32x4>(wl, wo + (unsigned)((k0 + 32 * i) * 6 * D) * 4u);
#pragma unroll
            for (int i = 0; i < DEEP; ++i)
#pragma unroll
                for (int j = 0; j < 5; ++j) a[j] += sc[j][k0 + 32 * i] * w8[i]; }
#pragma unroll
        for (int j = 0; j < 5; ++j) {
#pragma unroll
            for (int e = 0; e < 4; ++e) { float v = a[j][e]; v += shx(v, 16, tid & 63); v += shx(v, 32, tid & 63); a[j][e] = v; }
            if ((tid & 63) < 16) red[tid >> 6][j][cl] = a[j]; }
        __syncthreads();
        if (tid < 5 * 64) { const int j = tid / 64, cc = tid % 64; float s = 0.f;
            for (int g = 0; g < 8; ++g) s += ((const LAS float*)&red[g][j][0])[cc];
            gst<float>(mod, (unsigned)((l * 5 + j) * 6 * D + n0 + cc) * 4u, s + gld<float>(p.b_mod, (unsigned)(l * 6 * D + n0 + cc) * 4u)); }
        __syncthreads();
    }
}

template <bool F32> __device__ __forceinline__ void ph_norm(int wv, int l, int which, const float* fixgate, int row_lo, int nrows, const void* hlat, const void* hctx) {
    CParams& p = *okp();
    unsigned char* const wsb = ows(p.ws);
    const int TIDX = otid(wv), BIDX = obid();
    const int lane = TIDX & 63, gw = BIDX * 8 + (TIDX >> 6), NGW = gridDim.x * 8;
    const float* nw = (which ? p.norm2_w : p.norm1_w) + (size_t)l * D;
    const float* mod = WSP(float, OFF_MOD) + (size_t)l * 5 * 6 * D;
    bf16_t* H = WSP(bf16_t, OFF_H); bf16_t* XN = WSP(bf16_t, OFF_XN); const float* SL = WSP(float, OFF_SLAB);
    for (int r = row_lo + gw; r < nrows; r += NGW) {
        int mj, t, T; rowinfo(r, mj, t, T);
        const unsigned so = (unsigned)(mj * 6 * D + (which ? 3 : 0) * D) * 4u;
        const unsigned ho = (unsigned)(r * D + 4 * lane) * 2u;
        const void* rd = r < RL ? hlat : hctx; const unsigned re = (unsigned)((r < RL ? r : r - RL) * D + 4 * lane);
        f32x4 v[8]; float ss = 0.f;
        if constexpr (F32) {
#pragma unroll
            for (int j = 0; j < 8; ++j) v[j] = gld<f32x4>(rd, re * 4u + (unsigned)j * 1024u);
        } else { u32x2 q[8];
#pragma unroll
            for (int j = 0; j < 8; ++j) q[j] = gld<u32x2>(rd, re * 2u + (unsigned)j * 512u);
#pragma unroll
            for (int j = 0; j < 8; ++j) { v[j][0] = __uint_as_float(q[j].x << 16); v[j][1] = __uint_as_float(q[j].x & 0xffff0000u); v[j][2] = __uint_as_float(q[j].y << 16); v[j][3] = __uint_as_float(q[j].y & 0xffff0000u); } }
#pragma unroll
        for (int j = 0; j < 8; ++j) ss += (v[j][0] * v[j][0] + v[j][1] * v[j][1]) + (v[j][2] * v[j][2] + v[j][3] * v[j][3]);
        const float rstd = rsqrtf(wave_sum(ss, lane) * (1.f / D) + EPS);
#pragma unroll
        for (int jh = 0; jh < 2; ++jh) { f32x4 wq[4], scq[4], shq[4];
#pragma unroll
          for (int jj = 0; jj < 4; ++jj) { const unsigned co = (unsigned)(4 * (lane + 64 * (4 * jh + jj))) * 4u; wq[jj] = gld<f32x4>(nw, co); scq[jj] = gld<f32x4>(mod, so + D * 4 + co); shq[jj] = gld<f32x4>(mod, so + co); }
#pragma unroll
          for (int jj = 0; jj < 4; ++jj) { const int j = 4 * jh + jj;
            const f32x4 y = (v[j] * rstd * wq[jj]) * (1.f + scq[jj]) + shq[jj];
            u32x2 q; q.x = pk2(y[0], y[1]); q.y = pk2(y[2], y[3]); gst<u32x2>(XN, (unsigned)(r * D + 4 * (lane + 64 * j)) * 2u, q); } }
    }
}
__device__ __forceinline__ void ph_norm_lat(int wv, int l, int which) {
    CParams& p = *okp();
    unsigned char* const wsb = ows(p.ws);
    const int TIDX = otid(wv), lane = TIDX & 63, gw = obid() * 8 + (TIDX >> 6), NGW = gridDim.x * 8;
    const float* nw = (which ? p.norm2_w : p.norm1_w) + (size_t)l * D;
    const float* mod = WSP(float, OFF_MOD) + (size_t)l * 5 * 6 * D;
    const bf16_t* H = WSP(bf16_t, OFF_H); bf16_t* XN = WSP(bf16_t, OFF_XN);
    for (int g = gw; g < RL / 4; g += NGW) {
        const int r0 = 4 * g; const unsigned so = (unsigned)((r0 >> 11) * 6 * D + (which ? 3 : 0) * D) * 4u;
        u32x2 q[4][8]; f32x4 wq[8], scq[8], shq[8];
#pragma unroll
        for (int k = 0; k < 4; ++k)
#pragma unroll
            for (int j = 0; j < 8; ++j) q[k][j] = gld<u32x2>(H, (unsigned)((r0 + k) * D + 4 * lane + 256 * j) * 2u);
#pragma unroll
        for (int j = 0; j < 8; ++j) { const unsigned co = (unsigned)(4 * lane + 256 * j) * 4u; wq[j] = gld<f32x4>(nw, co); scq[j] = gld<f32x4>(mod, so + D * 4 + co) + 1.f; shq[j] = gld<f32x4>(mod, so + co); }
#pragma unroll
        for (int j = 0; j < 8; ++j) wq[j] = wq[j] * scq[j];
#pragma unroll
        for (int k = 0; k < 4; ++k) { f32x4 v[8]; float ss = 0.f;
#pragma unroll
            for (int j = 0; j < 8; ++j) { v[j][0] = __uint_as_float(q[k][j].x << 16); v[j][1] = __uint_as_float(q[k][j].x & 0xffff0000u); v[j][2] = __uint_as_float(q[k][j].y << 16); v[j][3] = __uint_as_float(q[k][j].y & 0xffff0000u);
                ss += (v[j][0] * v[j][0] + v[j][1] * v[j][1]) + (v[j][2] * v[j][2] + v[j][3] * v[j][3]); }
            const float rstd = rsqrtf(wave_sum(ss, lane) * (1.f / D) + EPS);
#pragma unroll
            for (int j = 0; j < 8; ++j) { const f32x4 y = (v[j] * rstd) * wq[j] + shq[j];
                u32x2 o; o.x = pk2(y[0], y[1]); o.y = pk2(y[2], y[3]); gst<u32x2>(XN, (unsigned)((r0 + k) * D + 4 * lane + 256 * j) * 2u, o); } }
    }
}
template <bool F32> __device__ __forceinline__ void ph_norm_ctx(int wv, LAS unsigned char* lds, int l, int which) {
    CParams& p = *okp();
    unsigned char* const wsb = ows(p.ws);
    const int TIDX = otid(wv), lane = TIDX & 63, wave = wv, half = wave & 1;
    const float* nw = (which ? p.norm2_w : p.norm1_w) + (size_t)l * D;
    const float* mod = WSP(float, OFF_MOD) + (size_t)l * 5 * 6 * D;
    bf16_t* H = WSP(bf16_t, OFF_H); bf16_t* XN = WSP(bf16_t, OFF_XN); const float* SL = WSP(float, OFF_SLAB);
    const void* hctx = F32 ? (const void*)p.ctx : (const void*)(H + (size_t)RL * D);
    const float* fixgate = which ? mod + 4 * 6 * D + 2 * D : mod - 5 * 6 * D + 4 * 6 * D + 5 * D;
    LAS float* red = (LAS float*)lds;
    const unsigned so = (unsigned)(4 * 6 * D + (which ? 3 : 0) * D) * 4u;
    for (int rb = obid(); rb < RC / 4; rb += gridDim.x) {
        const int rc = 4 * rb + (wave >> 1), r = RL + rc;
        f32x4 v[4]; float ss = 0.f;
#pragma unroll
        for (int jp = 0; jp < 2; ++jp) { u32x2 sp[2][8]; f32x4 fg[2]; u32x2 q[2];
#pragma unroll
            for (int jj = 0; jj < 2; ++jj) { const int j = 4 * half + 2 * jp + jj; const unsigned e = (unsigned)(rc * D + 4 * lane + 256 * j);
                if constexpr (F32) v[2 * jp + jj] = gld<f32x4>(hctx, e * 4u); else q[jj] = gld<u32x2>(hctx, e * 2u);
#pragma unroll
                for (int sl = 0; sl < 8; ++sl) sp[jj][sl] = gld<u32x2>(SL, ((unsigned)(sl * RC) * D + e) * 2u);
                fg[jj] = gld<f32x4>(fixgate, (unsigned)(4 * lane + 256 * j) * 4u); }
#pragma unroll
            for (int jj = 0; jj < 2; ++jj) { const int j = 4 * half + 2 * jp + jj; f32x4& vv = v[2 * jp + jj];
                if constexpr (!F32) { vv[0] = __uint_as_float(q[jj].x << 16); vv[1] = __uint_as_float(q[jj].x & 0xffff0000u); vv[2] = __uint_as_float(q[jj].y << 16); vv[3] = __uint_as_float(q[jj].y & 0xffff0000u); }
                f32x4 a = {0.f, 0.f, 0.f, 0.f};
#pragma unroll
                for (int sl = 0; sl < 8; ++sl) { a[0] += __uint_as_float(sp[jj][sl].x << 16); a[1] += __uint_as_float(sp[jj][sl].x & 0xffff0000u); a[2] += __uint_as_float(sp[jj][sl].y << 16); a[3] += __uint_as_float(sp[jj][sl].y & 0xffff0000u); }
                vv += fg[jj] * a;
                u32x2 hq; hq.x = pk2(vv[0], vv[1]); hq.y = pk2(vv[2], vv[3]); gst<u32x2>(H, (unsigned)(r * D + 4 * lane + 256 * j) * 2u, hq);
                ss += (vv[0] * vv[0] + vv[1] * vv[1]) + (vv[2] * vv[2] + vv[3] * vv[3]); } }
        f32x4 wq[4], scq[4], shq[4];
#pragma unroll
        for (int jj = 0; jj < 4; ++jj) { const unsigned co = (unsigned)(4 * lane + 256 * (4 * half + jj)) * 4u; wq[jj] = gld<f32x4>(nw, co); scq[jj] = gld<f32x4>(mod, so + D * 4 + co); shq[jj] = gld<f32x4>(mod, so + co); }
        ss = wave_sum(ss, lane);
        if (lane == 0) red[wave] = ss;
        __syncthreads();
        const float rstd = rsqrtf((red[wave & ~1] + red[wave | 1]) * (1.f / D) + EPS);
#pragma unroll
        for (int jj = 0; jj < 4; ++jj) { const int j = 4 * half + jj;
            const f32x4 y = (v[jj] * rstd * wq[jj]) * (1.f + scq[jj]) + shq[jj];
            u32x2 qq; qq.x = pk2(y[0], y[1]); qq.y = pk2(y[2], y[3]); gst<u32x2>(XN, (unsigned)(r * D + 4 * lane + 256 * j) * 2u, qq); }
        __syncthreads();
    }
}
__device__ __forceinline__ void ph_final(int wv) {
    CParams& p = *okp();
    unsigned char* const wsb = ows(p.ws);
    const int TIDX = otid(wv), BIDX = obid(); (void)TIDX; (void)BIDX;
    const int lane = TIDX & 63, gw = BIDX * 8 + (TIDX >> 6), NGW = gridDim.x * 8;
    const bf16_t* H = WSP(bf16_t, OFF_H);
    for (int r = gw; r < RL; r += NGW) {
        f32x4 v[8]; float ss = 0.f;
#pragma unroll
        for (int j = 0; j < 8; ++j) { const u32x2 q = gld<u32x2>(H, (unsigned)(r * D + 4 * (lane + 64 * j)) * 2u); v[j][0] = __uint_as_float(q.x << 16); v[j][1] = __uint_as_float(q.x & 0xffff0000u); v[j][2] = __uint_as_float(q.y << 16); v[j][3] = __uint_as_float(q.y & 0xffff0000u); ss += (v[j][0] * v[j][0] + v[j][1] * v[j][1]) + (v[j][2] * v[j][2] + v[j][3] * v[j][3]); }
        const float rstd = rsqrtf(wave_sum(ss, lane) * (1.f / D) + EPS);
        f32x4* o = (f32x4*)(p.out + (size_t)r * D) + lane;
#pragma unroll
        for (int j = 0; j < 8; ++j) { const f32x4 w = *(const f32x4*)(p.final_norm_w + 4 * (lane + 64 * j)); o[64 * j] = v[j] * rstd * w; }
    }
}

__device__ __forceinline__ float wave_incl_sum(float v, int lane) {
#pragma unroll
    for (int o = 1; o < 64; o <<= 1) { const float t = shl_(v, lane >= o ? lane - o : lane); if (lane >= o) v += t; }
    return v;
}
__device__ __forceinline__ float wave_incl_max(float v, int lane) {
#pragma unroll
    for (int o = 1; o < 64; o <<= 1) { const float t = shl_(v, lane >= o ? lane - o : lane); if (lane >= o) v = fmaxf(v, t); }
    return v;
}
__device__ __forceinline__ float logsigmoidf_(float x) { return fminf(x, 0.f) - log1pf(__expf(-fabsf(x))); }
struct GateV { float b0, b1, c0, c1, m0, m1, bend, cend; int s0, s1; };
__device__ __forceinline__ GateV gate_vectors(const float* G, int row0, int h, int dir, int lane) {
    GateV g; g.s0 = dir ? 127 - lane : lane; g.s1 = dir ? 63 - lane : lane + 64;
    const unsigned o0 = (unsigned)((row0 + g.s0) * 16 + dir * 8 + h) * 4u, o1 = (unsigned)((row0 + g.s1) * 16 + dir * 8 + h) * 4u;
    const float i0 = gld<float>(G, o0), f0 = gld<float>(G, o0 + 16), i1 = gld<float>(G, o1), f1 = gld<float>(G, o1 + 16);
    g.b0 = wave_incl_sum(logsigmoidf_(f0), lane); const float tot0 = shl_(g.b0, 63 + (lane & 0));
    g.b1 = wave_incl_sum(logsigmoidf_(f1), lane) + tot0;
    g.c0 = i0 - g.b0; g.c1 = i1 - g.b1;
    g.m0 = wave_incl_max(g.c0, lane); const float mx0 = shl_(g.m0, 63 + (lane & 0));
    g.m1 = fmaxf(wave_incl_max(g.c1, lane), mx0);
    g.bend = shl_(g.b1, 63 + (lane & 0)); g.cend = shl_(g.m1, 63 + (lane & 0));
    return g;
}
__device__ __forceinline__ void ph_convc(int wv, int l, int nrows, int widx, int nwg) {
    CParams& p = *okp();
    unsigned char* const wsb = ows(p.ws);
    const unsigned gt = (unsigned)widx * 512u + otid(wv), NT = (unsigned)nwg * 512u;
    const bf16_t* P = WSP(bf16_t, OFF_P); bf16_t* YC = WSP(bf16_t, OFF_HM) + (DM + DF);
    const float* wc = p.conv_c_w + (size_t)l * 3 * DC;
    for (unsigned i = gt; i < (unsigned)nrows * 64u; i += NT) {
        const int r = (int)(i >> 6), c = (int)(i & 63) * 8; int mj, t, T; rowinfo(r, mj, t, T);
        const unsigned pr = (unsigned)(r * NP) * 2u;
        const bool cp = r < RL ? (t & 63) > 0 : t > 0, cn = r < RL ? (t & 63) < 63 : t < T - 1;
        float x0[8], x1[8], y0[8], y1[8], z0[8], z1[8], cb[8], o[8];
        unpack8(gld<u32x4>(P, pr + (PCC + c) * 2), x0); unpack8(gld<u32x4>(P, pr + (PCX + c) * 2), x1); unpack8(gld<u32x4>(P, pr + (PCB + c) * 2), cb);
        const unsigned pp = cp ? pr - NP * 2 : pr, pn = cn ? pr + NP * 2 : pr;
        unpack8(gld<u32x4>(P, pp + (PCC + c) * 2), y0); unpack8(gld<u32x4>(P, pp + (PCX + c) * 2), y1);
        unpack8(gld<u32x4>(P, pn + (PCC + c) * 2), z0); unpack8(gld<u32x4>(P, pn + (PCX + c) * 2), z1);
        const f32x4 w00 = gld<f32x4>(wc, (unsigned)c * 4u), w01 = gld<f32x4>(wc, (unsigned)c * 4u + 16), w10 = gld<f32x4>(wc, (unsigned)(DC + c) * 4u), w11 = gld<f32x4>(wc, (unsigned)(DC + c) * 4u + 16),
                    w20 = gld<f32x4>(wc, (unsigned)(2 * DC + c) * 4u), w21 = gld<f32x4>(wc, (unsigned)(2 * DC + c) * 4u + 16);
#pragma unroll
        for (int j = 0; j < 8; ++j) { const float w0 = j < 4 ? w00[j & 3] : w01[j & 3], w1 = j < 4 ? w10[j & 3] : w11[j & 3], w2 = j < 4 ? w20[j & 3] : w21[j & 3];
            float v = w1 * (x0[j] * x1[j]); if (cp) v += w0 * (y0[j] * y1[j]); if (cn) v += w2 * (z0[j] * z1[j]); o[j] = cb[j] * v; }
        gst<u32x4>(YC, (unsigned)(r * D + c) * 2u, pack8(o));
    }
}
__device__ __forceinline__ void ph_fourier1(int wv, int widx, int nwg) {
    CParams& p = *okp();
    unsigned char* const wsb = ows(p.ws);
    const int TIDX = otid(wv), BIDX = obid(); (void)TIDX; (void)BIDX;
    const int lane = TIDX & 63, gw = widx * 8 + (TIDX >> 6), NGW = nwg * 8, fr = lane & 15, fq = lane >> 4;
    const bf16_t* P = WSP(bf16_t, OFF_P); const bf16_t* FT = WSP(bf16_t, OFF_FT);
    bf16_t* ZTC = WSP(bf16_t, OFF_ZTC);
    for (int task = gw; task < (RC / 32) * 4 * 8; task += NGW) {
        const int kb = task & 7, g = (task >> 3) & 3, rb = task >> 5, r0 = RL + rb * 32;
        f32x4 acc[2][2]; ZERO_ACC22(acc);
        wave_mm32<true, true>(P + (size_t)r0 * NP + PF + g * 128, NP, 1, FT + (size_t)(kb * 32) * 128, 1, 128, 128, acc, lane);
#pragma unroll
        for (int mi = 0; mi < 2; ++mi)
#pragma unroll
            for (int ni = 0; ni < 2; ++ni) {
                const int r = r0 + 16 * mi + 4 * fq, kp = kb * 32 + 16 * ni + fr, comp = kp >> 7, kap = kp & 127;
                u32x2 w; w.x = pk2(acc[mi][ni][0], acc[mi][ni][1]); w.y = pk2(acc[mi][ni][2], acc[mi][ni][3]);
                { const int q = r - RL, b = q >> 8, t = q & 255; *(u32x2*)(ZTC + (size_t)((b * 4 + g) * 128 + kap) * 512 + comp * 256 + t) = w; }
            }
    }
}
template <bool FIRST> __device__ __forceinline__ f32x4 mma16(bf16x8 a, bf16x8 b, f32x4 c) {
    if constexpr (FIRST) return __builtin_amdgcn_mfma_f32_16x16x32_bf16(a, b, (f32x4){0.f, 0.f, 0.f, 0.f}, 0, 0, 0);
    else return __builtin_amdgcn_mfma_f32_16x16x32_bf16(a, b, c, 0, 0, 0);
}
typedef short s16x4 __attribute__((ext_vector_type(4)));
constexpr int PIT_T = 544;
constexpr int PIT_R = 528;
constexpr int PIT_P = 272;
__device__ __forceinline__ bf16x8 tr_frag(LAS unsigned char* img, int pitchB, int r0, int c0, int lane) {
    const int g = lane >> 4, q = (lane & 15) >> 2, pp = lane & 3;
    LAS unsigned char* a = img + (r0 + 8 * g + q) * pitchB + (c0 + 4 * pp) * 2;
    const s16x4 lo = __builtin_amdgcn_ds_read_tr16_b64_v4i16((LAS s16x4*)a);
    const s16x4 hi = __builtin_amdgcn_ds_read_tr16_b64_v4i16((LAS s16x4*)(a + 4 * pitchB));
    return (bf16x8){lo[0], lo[1], lo[2], lo[3], hi[0], hi[1], hi[2], hi[3]};
}
template <class F> __device__ __forceinline__ void conv_silu_rows(const u32x4 (&raw)[10], const float (&w0)[8], const float (&w1)[8], const float (&w2)[8], F&& f) {
    float a[8], b[8], c[8];
    unpack8(raw[0], a); unpack8(raw[1], b);
#pragma unroll
    for (int i = 0; i < 8; ++i) {
        unpack8(raw[i + 2], c);
        float o[8];
#pragma unroll
        for (int j = 0; j < 8; ++j) o[j] = siluf_(w0[j] * a[j] + w1[j] * b[j] + w2[j] * c[j]);
        f(i, o);
#pragma unroll
        for (int j = 0; j < 8; ++j) { a[j] = b[j]; b[j] = c[j]; }
    }
}
constexpr int FPIT = 2336;
__device__ __forceinline__ void ph_fft(int wv, LAS unsigned char* lds, int u0, int ustride) {
    CParams& p = *okp();
    unsigned char* const wsb = ows(p.ws);
    const bf16_t* P = WSP(bf16_t, OFF_P); const bf16_t* FT = WSP(bf16_t, OFF_FT); const bf16_t* MA = WSP(bf16_t, OFF_MA); const bf16_t* MC = WSP(bf16_t, OFF_MC); bf16_t* HM = WSP(bf16_t, OFF_HM);
    LAS unsigned char* IMG = lds;
    const int wave = wv;
    for (int unit = u0; unit < NB * 4 * 8; unit += ustride) {
        const int kb = unit & 7, g = (unit >> 3) & 3, b = unit >> 5, kap0 = 16 * kb;
        {
            const int tid = otid(wv), lane = tid & 63, fr = lane & 15, fq = lane >> 4;
            bf16x8 fb[2][4];
#pragma unroll
            for (int ni = 0; ni < 2; ++ni)
#pragma unroll
                for (int ks = 0; ks < 4; ++ks) fb[ni][ks] = gld<bf16x8>(FT, (unsigned)((ni * 128 + kap0 + fr) * 128 + 32 * ks + 8 * fq) * 2u);
            bf16x8 xb[2][4][4];
            auto ldx = [&](int q, int buf) {
#pragma unroll
                for (int mm = 0; mm < 4; ++mm)
#pragma unroll
                    for (int ks = 0; ks < 4; ++ks) xb[buf][mm][ks] = gld<bf16x8>(P, (unsigned)((b * 2048 + 256 * wave + 16 * (4 * q + mm) + fr) * NP + PF + g * 128 + 32 * ks + 8 * fq) * 2u); };
            ldx(0, 0);
#pragma unroll
            for (int q = 0; q < 4; ++q) {
                if (q < 3) ldx(q + 1, (q + 1) & 1);
#pragma unroll
                for (int mm = 0; mm < 4; ++mm) { const int mg = 4 * q + mm;
                    f32x4 zr = mma16<true>(xb[q & 1][mm][0], fb[0][0], zr), zi = mma16<true>(xb[q & 1][mm][0], fb[1][0], zi);
#pragma unroll
                    for (int ks = 1; ks < 4; ++ks) { zr = mma16<false>(xb[q & 1][mm][ks], fb[0][ks], zr); zi = mma16<false>(xb[q & 1][mm][ks], fb[1][ks], zi); }
                    const int tb = 256 * wave + 16 * mg + 4 * fq, t1 = tb >> 6, t2 = tb & 63;
                    u32x2 wr_, wi_; wr_.x = pk2(zr[0], zr[1]); wr_.y = pk2(zr[2], zr[3]); wi_.x = pk2(-zi[0], -zi[1]); wi_.y = pk2(-zi[2], -zi[3]);
                    *(LAS u32x2*)(IMG + t1 * FPIT + fr * 144 + t2 * 2) = wr_;
                    *(LAS u32x2*)(IMG + (32 + t1) * FPIT + fr * 144 + t2 * 2) = wi_;
                }
            }
        }
        __syncthreads();
        {
            const int tid = otid(wv), lane = tid & 63, fr = lane & 15, fq = lane >> 4;
            bf16x8 ya[4][2];
#pragma unroll
            for (int mt = 0; mt < 4; ++mt)
#pragma unroll
                for (int ks = 0; ks < 2; ++ks) ya[mt][ks] = gld<bf16x8>(MA, (unsigned)((16 * mt + fr) * 64 + 32 * ks + 8 * fq) * 2u);
#pragma unroll 2
            for (int j = 0; j < 8; ++j) {
                const int grp = 8 * wave + j, c0 = (grp >> 2) * 72 + (grp & 3) * 16;
                const bf16x8 x0 = tr_frag(IMG, FPIT, 0, c0, lane), x1 = tr_frag(IMG, FPIT, 32, c0, lane);
                f32x4 d[4];
#pragma unroll
                for (int mt = 0; mt < 4; ++mt) { d[mt] = mma16<true>(x0, ya[mt][0], d[mt]); d[mt] = mma16<false>(x1, ya[mt][1], d[mt]); }
#pragma unroll
                for (int mt = 0; mt < 4; ++mt) { u32x2 w; w.x = pk2(d[mt][0], d[mt][1]); w.y = pk2(d[mt][2], d[mt][3]);
                    *(LAS u32x2*)(IMG + (16 * mt + fr) * FPIT + (c0 + 4 * fq) * 2) = w; }
            }
        }
        __syncthreads();
        {
            const int tid = otid(wv), lane = tid & 63, fr = lane & 15, fq = lane >> 4;
            bf16x8 y[4][4];
#pragma unroll
            for (int mt = 0; mt < 4; ++mt)
#pragma unroll
                for (int ks = 0; ks < 4; ++ks) y[mt][ks] = gld<bf16x8>(MC, (unsigned)((4 * wave * 64 + 16 * mt + fr) * 128 + 32 * ks + 8 * fq) * 2u);
#pragma unroll 1
            for (int q = 0; q < 4; ++q) {
                const int tau1 = 4 * wave + q, tn = q < 3 ? tau1 + 1 : tau1;
                bf16x8 yn[4][4];
#pragma unroll
                for (int mt = 0; mt < 4; ++mt)
#pragma unroll
                    for (int ks = 0; ks < 4; ++ks) yn[mt][ks] = gld<bf16x8>(MC, (unsigned)((tn * 64 + 16 * mt + fr) * 128 + 32 * ks + 8 * fq) * 2u);
                f32x4 acc[4];
#pragma unroll
                for (int ks = 0; ks < 4; ++ks) { const bf16x8 x = *(const LAS bf16x8*)(IMG + ((ks >> 1) * 32 + tau1) * FPIT + fr * 144 + (32 * (ks & 1) + 8 * fq) * 2);
#pragma unroll
                    for (int mt = 0; mt < 4; ++mt) { if (ks == 0) acc[mt] = mma16<true>(x, y[mt][ks], acc[mt]); else acc[mt] = mma16<false>(x, y[mt][ks], acc[mt]); } }
#pragma unroll
                for (int mt = 0; mt < 4; ++mt) { const int tau = tau1 + 32 * (16 * mt + fr);
                    u32x2 w; w.x = pk2(acc[mt][0], acc[mt][1]); w.y = pk2(acc[mt][2], acc[mt][3]);
                    gst<u32x2>(HM, (unsigned)((b * 2048 + tau) * D + DM + g * 128 + kap0 + 4 * fq) * 2u, w); }
#pragma unroll
                for (int mt = 0; mt < 4; ++mt)
#pragma unroll
                    for (int ks = 0; ks < 4; ++ks) y[mt][ks] = yn[mt][ks];
            }
        }
        __syncthreads();
    }
}
__device__ __forceinline__ void ph_mlstm1(int wv, int l, LAS unsigned char* lds) {
    CParams& p = *okp();
    unsigned char* const wsb = ows(p.ws);
    const int wave = wv;
    LAS unsigned char* KWs = lds; LAS unsigned char* Vs = lds + 128 * PIT_T; LAS float* vW = (LAS float*)(lds + 2 * 128 * PIT_T);
    const bf16_t* P = WSP(bf16_t, OFF_P); const float* G = WSP(float, OFF_G);
    bf16_t* UT = WSP(bf16_t, OFF_UT); float* NV = WSP(float, OFF_NV); float* CHS = WSP(float, OFF_CHS);
    const float* wk = p.conv_k_w + (size_t)l * 3 * DM;
    for (int unit = obid(); unit < NCHUNK * NH * 2; unit += gridDim.x) {
        const int tid = otid(wv), lane = tid & 63, fr = lane & 15, fq = lane >> 4, dg = tid & 31, sg = tid >> 5;
        const int dir = unit & 1, h = (unit >> 1) & 3, cidx = unit >> 3, row0 = chunk_row0(cidx);
        const bool first = cidx < 64 ? (cidx & 15) == 0 : ((cidx - 64) & 1) == 0, last = cidx < 64 ? (cidx & 15) == 15 : ((cidx - 64) & 1) == 1;
        const bf16_t* kp = P + (size_t)(row0 + 8 * sg) * NP + PK + h * DH + 8 * dg;
        u32x4 kr[10], vr[8];
#pragma unroll
        for (int i = 0; i < 10; ++i) { const int s = 8 * sg - 1 + i; const bool ok = (s >= 0 || !first) && (s < CHUNK || !last);
            kr[i] = ok ? *(const u32x4*)(kp + (ptrdiff_t)(i - 1) * NP) : (u32x4){0u, 0u, 0u, 0u}; }
#pragma unroll
        for (int i = 0; i < 8; ++i) vr[i] = *(const u32x4*)(kp + (PV - PK) + (size_t)i * NP);
        float w0[8], w1[8], w2[8];
#pragma unroll
        for (int j = 0; j < 8; ++j) { w0[j] = wk[h * DH + 8 * dg + j]; w1[j] = wk[DM + h * DH + 8 * dg + j]; w2[j] = wk[2 * DM + h * DH + 8 * dg + j]; }
        if (wave == 0)     { const GateV g = gate_vectors(G, row0, h, dir, lane); vW[g.s0] = __expf(g.c0 - g.cend); vW[g.s1] = __expf(g.c1 - g.cend);
            if (lane == 0) { CHS[(size_t)(cidx * 8 + dir * 4 + h) * 2] = g.bend; CHS[(size_t)(cidx * 8 + dir * 4 + h) * 2 + 1] = g.bend + g.cend; } }
        float kc[8][8];
        conv_silu_rows(kr, w0, w1, w2, [&](int i, float (&o)[8]) {
#pragma unroll
            for (int j = 0; j < 8; ++j) kc[i][j] = o[j]; });
#pragma unroll
        for (int i = 0; i < 8; ++i) *(LAS u32x4*)(Vs + (8 * sg + i) * PIT_T + dg * 16) = vr[i];
        __syncthreads();
#pragma unroll
        for (int i = 0; i < 8; ++i) { const float ws = vW[8 * sg + i]; float o[8];
#pragma unroll
            for (int j = 0; j < 8; ++j) o[j] = kc[i][j] * ws;
            *(LAS u32x4*)(KWs + (8 * sg + i) * PIT_T + dg * 16) = pack8(o); }
        __syncthreads();
        f32x4 acc[2][16];
        auto kstep1 = [&](int k0, auto first) {
            bf16x8 fv[2];
#pragma unroll
            for (int mi = 0; mi < 2; ++mi) fv[mi] = tr_frag(Vs, PIT_T, k0, 32 * wave + 16 * mi, lane);
#pragma unroll
            for (int ni = 0; ni < 16; ++ni) { const bf16x8 fk = tr_frag(KWs, PIT_T, k0, 16 * ni, lane);
#pragma unroll
                for (int mi = 0; mi < 2; ++mi) acc[mi][ni] = mma16<decltype(first)::value>(fk, fv[mi], acc[mi][ni]); }
        };
        kstep1(0, std::true_type{});
#pragma unroll 1
        for (int k0 = 32; k0 < CHUNK; k0 += 32) kstep1(k0, std::false_type{});
        bf16_t* out = UT + ((size_t)(cidx * NH + h) * 2 + dir) * DH * DH;
        if (tid < DH) { float sum = 0.f;
#pragma unroll 8
            for (int s2 = 0; s2 < CHUNK; ++s2) sum += bf2f(*(const LAS bf16_t*)(KWs + s2 * PIT_T + tid * 2));
            NV[((size_t)(cidx * NH + h) * 2 + dir) * DH + tid] = sum; }
        __syncthreads();
        { LAS unsigned char* T = lds + wave * (32 * 528);
#pragma unroll
          for (int mi = 0; mi < 2; ++mi)
#pragma unroll
            for (int ni = 0; ni < 16; ++ni) { u32x2 w; w.x = pk2(acc[mi][ni][0], acc[mi][ni][1]); w.y = pk2(acc[mi][ni][2], acc[mi][ni][3]);
                *(LAS u32x2*)(T + (16 * mi + fr) * 528 + (16 * ni + 4 * fq) * 2) = w; }
          asm volatile("s_waitcnt lgkmcnt(0)" ::: "memory");
#pragma unroll
          for (int j = 0; j < 16; ++j) { const int rr = 2 * j + (lane >> 5);
              const u32x4 v = *(const LAS u32x4*)(T + rr * 528 + (lane & 31) * 16);
              gst<u32x4>(out, (unsigned)((32 * wave + rr) * DH) * 2u + (unsigned)(lane & 31) * 16u, v); } }
        __syncthreads();
    }
}
__device__ __forceinline__ void ph_mlstm2(int wv) {
    CParams& p = *okp();
    unsigned char* const wsb = ows(p.ws);
    const int tid = otid(wv);
    const bf16_t* UT = WSP(bf16_t, OFF_UT); bf16_t* CT = WSP(bf16_t, OFF_CT);
    const float *NV = WSP(float, OFF_NV), *CHS = WSP(float, OFF_CHS); float *NS = WSP(float, OFF_NS), *MST = WSP(float, OFF_MST);
    for (int task = obid(); task < NB * NH * 2 * 16; task += gridDim.x) {
        const int part = task & 15, scan = task >> 4, dir = scan & 1, h = (scan >> 1) & 3, b = scan >> 3, dh = dir * 4 + h;
        const unsigned e0 = (unsigned)(part * 4096 + olaunder(tid) * 8) * 2u;
        u32x4 u[18];
#pragma unroll
        for (int step = 0; step < 18; ++step) { const int cidx = scan_chunk(b, dir, step); u[step] = gld<u32x4>(UT, (unsigned)(((cidx * NH + h) * 2 + dir) * DH * DH) * 2u + e0); }
        float cb[18], cm[18];
#pragma unroll
        for (int step = 0; step < 18; ++step) { const int cidx = scan_chunk(b, dir, step); const f32x2 cc = gld<f32x2>(CHS, (unsigned)((cidx * 8 + dh) * 2) * 4u); cb[step] = cc[0]; cm[step] = cc[1]; }
        float C[8], m = 0.f;
        { const f32x4 z0 = zero4(), z1 = zero4();
#pragma unroll
          for (int j = 0; j < 4; ++j) { C[j] = z0[j]; C[4 + j] = z1[j]; } }
#pragma unroll
        for (int step = 0; step < 18; ++step) {
            const int cidx = scan_chunk(b, dir, step);
            gst<u32x4>(CT, (unsigned)(((cidx * NH + h) * 2 + dir) * DH * DH) * 2u + e0, pack8(C));
            const float bend = cb[step], mloc = cm[step];
            const float mn = fmaxf(bend + m, mloc), al = __expf(bend + m - mn), be = __expf(mloc - mn);
            float uu[8]; unpack8(u[step], uu);
#pragma unroll
            for (int j = 0; j < 8; ++j) C[j] = al * C[j] + be * uu[j];
            m = mn;
        }
        if (part == 0 && tid < DH) {
            float n = 0.f; m = 0.f;
            float nv[18];
#pragma unroll
            for (int step = 0; step < 18; ++step) { const int cidx = scan_chunk(b, dir, step); nv[step] = gld<float>(NV, (unsigned)(((cidx * NH + h) * 2 + dir) * DH + tid) * 4u); }
#pragma unroll
            for (int step = 0; step < 18; ++step) {
                const int cidx = scan_chunk(b, dir, step); const unsigned base = (unsigned)(((cidx * NH + h) * 2 + dir) * DH + tid) * 4u;
                gst<float>(NS, base, n); if (tid == 0) MST[cidx * 8 + dh] = m;
                const float bend = cb[step], mloc = cm[step];
                const float mn = fmaxf(bend + m, mloc), al = __expf(bend + m - mn), be = __expf(mloc - mn);
                n = al * n + be * nv[step]; m = mn;
            }
        }
    }
}
#define SECTION_LANES() const int tid = otid(wv), lane = tid & 63, fr = lane & 15, fq = lane >> 4; (void)fr; (void)fq; __builtin_amdgcn_sched_barrier(0)
__device__ __forceinline__ void ph_mlstm3(int wv, int l, LAS unsigned char* lds, int nunits) {
    CParams& p = *okp();
    unsigned char* const wsb = ows(p.ws);
    const int wave = wv;
    LAS unsigned char* Qs = lds;
    LAS unsigned char* Ks = lds + 128 * PIT_T;
    LAS unsigned char* Vs = Qs; LAS unsigned char* Ps = Ks;
    LAS float* vec = (LAS float*)(lds + 2 * 128 * PIT_T);
    LAS float *vB = vec, *vC = vec + 256, *vM = vec + 512, *nS = vec + 768, *rS = vec + 1280, *ssq = vec + 1536;
    const bf16_t* P = WSP(bf16_t, OFF_P); const float* G = WSP(float, OFF_G); const bf16_t* CT = WSP(bf16_t, OFF_CT);
    const float *NS = WSP(float, OFF_NS), *MST = WSP(float, OFF_MST); bf16_t* HM = WSP(bf16_t, OFF_HM);
    const float *wk = p.conv_k_w + (size_t)l * 3 * DM, *wq = p.conv_q_w + (size_t)l * 3 * DM, *nw = p.mlstm_norm_w + (size_t)l * DM;
    for (int unit = obid(); unit < nunits; unit += gridDim.x) {
        const int h = unit & 3, cidx = unit >> 2, row0 = chunk_row0(cidx);
        const bool first = cidx < 64 ? (cidx & 15) == 0 : ((cidx - 64) & 1) == 0, last = cidx < 64 ? (cidx & 15) == 15 : ((cidx - 64) & 1) == 1;
        {
            SECTION_LANES(); const int dg = tid & 31, sg = tid >> 5;
            nS[tid] = gld<float>(NS, (unsigned)((cidx * NH + h) * 2 * DH + tid) * 4u);
            const unsigned kp = (unsigned)((row0 + 8 * sg - 1) * NP + PK + h * DH + 8 * dg) * 2u;
            u32x4 raw[10], rawq[10]; float w0[8], w1[8], w2[8];
#pragma unroll
            for (int i = 0; i < 10; ++i) { const int s = 8 * sg - 1 + i; const bool ok = (s >= 0 || !first) && (s < CHUNK || !last);
                raw[i] = gld<u32x4>(P, ok ? kp + (unsigned)i * (NP * 2) : kp + (unsigned)(NP * 2)); if (!ok) raw[i] = (u32x4){0u, 0u, 0u, 0u}; }
#pragma unroll
            for (int i = 0; i < 10; ++i) { const int s = 8 * sg - 1 + i; const bool ok = (s >= 0 || !first) && (s < CHUNK || !last);
                rawq[i] = gld<u32x4>(P, (ok ? kp + (unsigned)i * (NP * 2) : kp + (unsigned)(NP * 2)) + (PQ - PK) * 2); if (!ok) rawq[i] = (u32x4){0u, 0u, 0u, 0u}; }
            { const unsigned wo = (unsigned)(h * DH + 8 * dg) * 4u;
              const f32x4 a0 = gld<f32x4>(wk, wo), a1 = gld<f32x4>(wk, wo + 16), b0 = gld<f32x4>(wk, wo + DM * 4), b1 = gld<f32x4>(wk, wo + DM * 4 + 16), c0 = gld<f32x4>(wk, wo + 2 * DM * 4), c1 = gld<f32x4>(wk, wo + 2 * DM * 4 + 16);
#pragma unroll
              for (int j = 0; j < 4; ++j) { w0[j] = a0[j]; w0[4 + j] = a1[j]; w1[j] = b0[j]; w1[4 + j] = b1[j]; w2[j] = c0[j]; w2[4 + j] = c1[j]; } }
            if (wave < 2) { const GateV g = gate_vectors(G, row0, h, wave, lane);
                vB[wave * 128 + g.s0] = g.b0; vB[wave * 128 + g.s1] = g.b1; vC[wave * 128 + g.s0] = g.c0; vC[wave * 128 + g.s1] = g.c1; vM[wave * 128 + g.s0] = g.m0; vM[wave * 128 + g.s1] = g.m1; }
            conv_silu_rows(raw, w0, w1, w2, [&](int i, float (&o)[8]) { *(LAS u32x4*)(Ks + (8 * sg + i) * PIT_R + dg * 16) = pack8(o); });
            { const unsigned wo = (unsigned)(h * DH + 8 * dg) * 4u;
              const f32x4 a0 = gld<f32x4>(wq, wo), a1 = gld<f32x4>(wq, wo + 16), b0 = gld<f32x4>(wq, wo + DM * 4), b1 = gld<f32x4>(wq, wo + DM * 4 + 16), c0 = gld<f32x4>(wq, wo + 2 * DM * 4), c1 = gld<f32x4>(wq, wo + 2 * DM * 4 + 16);
#pragma unroll
              for (int j = 0; j < 4; ++j) { w0[j] = a0[j]; w0[4 + j] = a1[j]; w1[j] = b0[j]; w1[4 + j] = b1[j]; w2[j] = c0[j]; w2[4 + j] = c1[j]; } }
            conv_silu_rows(rawq, w0, w1, w2, [&](int i, float (&o)[8]) {
#pragma unroll
                for (int j = 0; j < 8; ++j) o[j] *= 0.0625f;
                *(LAS u32x4*)(Qs + (8 * sg + i) * PIT_R + dg * 16) = pack8(o); });
        }
        __syncthreads();
        {
            SECTION_LANES();
            f32x4 sacc[8];
            auto kstepS = [&](int k0, auto first) {
                const bf16x8 yq = *(const LAS bf16x8*)(Qs + (16 * wave + fr) * PIT_R + (k0 + 8 * fq) * 2);
#pragma unroll
                for (int ni = 0; ni < 8; ++ni) { const bf16x8 xk = *(const LAS bf16x8*)(Ks + (16 * ni + fr) * PIT_R + (k0 + 8 * fq) * 2);
                    sacc[ni] = mma16<decltype(first)::value>(xk, yq, sacc[ni]); }
            };
            kstepS(0, std::true_type{});
#pragma unroll 1
            for (int k0 = 32; k0 < DH; k0 += 32) kstepS(k0, std::false_type{});
            const int t = 16 * wave + fr;
            const float mF = gld<float>(MST, (unsigned)(cidx * 8 + h) * 4u), mB = gld<float>(MST, (unsigned)(cidx * 8 + 4 + h) * 4u);
            const float MF = fmaxf(mF, vM[t]), MB = fmaxf(mB, vM[128 + t]);
            const float gF = __expf(mF - MF), gB = __expf(mB - MB);
            const float flF = __expf(-(vB[t] + MF)), flB = __expf(-(vB[128 + t] + MB));
            float qnF = 0.f, qnB = 0.f;
#pragma unroll
            for (int c8 = 0; c8 < 8; ++c8) { float q8[8]; unpack8(*(const LAS u32x4*)(Qs + t * PIT_R + (64 * fq + 8 * c8) * 2), q8);
                const f32x4 a0 = *(const LAS f32x4*)(nS + 64 * fq + 8 * c8), a1 = *(const LAS f32x4*)(nS + 64 * fq + 8 * c8 + 4);
                const f32x4 b0 = *(const LAS f32x4*)(nS + 256 + 64 * fq + 8 * c8), b1 = *(const LAS f32x4*)(nS + 256 + 64 * fq + 8 * c8 + 4);
#pragma unroll
                for (int j = 0; j < 4; ++j) { qnF += q8[j] * a0[j] + q8[4 + j] * a1[j]; qnB += q8[j] * b0[j] + q8[4 + j] * b1[j]; } }
            qnF += shx(qnF, 16, lane); qnF += shx(qnF, 32, lane); qnB += shx(qnB, 16, lane); qnB += shx(qnB, 32, lane);
            float sF = 0.f, sB = 0.f;
#pragma unroll
            for (int ni = 0; ni < 8; ++ni) { const f32x4 cF = *(const LAS f32x4*)(vC + 16 * ni + 4 * fq), cB = *(const LAS f32x4*)(vC + 128 + 16 * ni + 4 * fq);
#pragma unroll
                for (int rg = 0; rg < 4; ++rg) { const int s = 16 * ni + 4 * fq + rg;
                    sF += s <= t ? sacc[ni][rg] * __expf(cF[rg] - MF) : 0.f; sB += s >= t ? sacc[ni][rg] * __expf(cB[rg] - MB) : 0.f; }
                asm volatile("" : "+v"(sF), "+v"(sB)); }
            sF += shx(sF, 16, lane); sF += shx(sF, 32, lane); sB += shx(sB, 16, lane); sB += shx(sB, 32, lane);
            const float iF = __builtin_amdgcn_rcpf(fmaxf(fabsf(gF * qnF + sF), flF)), iB = __builtin_amdgcn_rcpf(fmaxf(fabsf(gB * qnB + sB), flB));
            __syncthreads();
#pragma unroll
            for (int ni = 0; ni < 8; ++ni) { const f32x4 cF = *(const LAS f32x4*)(vC + 16 * ni + 4 * fq), cB = *(const LAS f32x4*)(vC + 128 + 16 * ni + 4 * fq);
                float pc[4];
#pragma unroll
                for (int rg = 0; rg < 4; ++rg) { const int s = 16 * ni + 4 * fq + rg;
                    pc[rg] = (s <= t ? sacc[ni][rg] * __expf(cF[rg] - MF) * iF : 0.f) + (s >= t ? sacc[ni][rg] * __expf(cB[rg] - MB) * iB : 0.f); }
                u32x2 w; w.x = pk2(pc[0], pc[1]); w.y = pk2(pc[2], pc[3]);
                *(LAS u32x2*)(Ps + t * PIT_P + (16 * ni + 4 * fq) * 2) = w; }
            if (fq == 0) { rS[t] = gF * iF; rS[128 + t] = gB * iB; }
        }
        __syncthreads();
        f32x4 tot[2][8];
        u32x4 vr[8];
        {
            SECTION_LANES();
#pragma unroll
            for (int ni = 0; ni < 2; ++ni) {
                if (ni == 1) { const int s8 = lane & 15, vq = lane >> 4; const unsigned vp = (unsigned)((row0 + 8 * s8) * NP + PV + h * DH + 32 * wave + 8 * vq) * 2u;
#pragma unroll
                    for (int i = 0; i < 8; ++i) vr[i] = gld<u32x4>(P, vp + (unsigned)i * (NP * 2)); }
                f32x4 a1[8];
                const unsigned ctf = (unsigned)((cidx * NH + h) * 2 * DH * DH + (32 * wave + 16 * ni + fr) * DH + 8 * fq) * 2u;
                bf16x8 xf = gld<bf16x8>(CT, ctf), xb = gld<bf16x8>(CT, ctf + (unsigned)(DH * DH) * 2u);
                bf16x8 xf1 = gld<bf16x8>(CT, ctf + 64u), xb1 = gld<bf16x8>(CT, ctf + (unsigned)(DH * DH) * 2u + 64u);
                auto kstepQ = [&](int k0, auto first) {
                    const unsigned kn = (unsigned)(k0 + 64 < DH ? k0 + 64 : DH - 32);
                    const bf16x8 xfn = gld<bf16x8>(CT, ctf + kn * 2u), xbn = gld<bf16x8>(CT, ctf + (unsigned)(DH * DH) * 2u + kn * 2u);
#pragma unroll
                    for (int mi = 0; mi < 8; ++mi) { const bf16x8 yq = *(const LAS bf16x8*)(Qs + (16 * mi + fr) * PIT_R + (k0 + 8 * fq) * 2);
                        tot[ni][mi] = mma16<decltype(first)::value>(xf, yq, tot[ni][mi]);
                        a1[mi] = mma16<decltype(first)::value>(xb, yq, a1[mi]); }
                    xf = xf1; xb = xb1; xf1 = xfn; xb1 = xbn;
                };
                kstepQ(0, std::true_type{});
#pragma unroll 1
                for (int k0 = 32; k0 < DH; k0 += 32) kstepQ(k0, std::false_type{});
#pragma unroll
                for (int mi = 0; mi < 8; ++mi) { const float rf = rS[16 * mi + fr], rb = rS[128 + 16 * mi + fr]; tot[ni][mi] = rf * tot[ni][mi] + rb * a1[mi]; }
            }
        }
        __syncthreads();
        u32x2 og[8][2]; f32x4 gw[2];
        {
            SECTION_LANES();
            { const int s8 = lane & 15, vq = lane >> 4;
#pragma unroll
              for (int i = 0; i < 8; ++i) *(LAS u32x4*)(Vs + (8 * s8 + i) * PIT_T + (32 * wave + 8 * vq) * 2) = vr[i]; }
            asm volatile("s_waitcnt lgkmcnt(0)" ::: "memory");
#pragma unroll
            for (int mi = 0; mi < 8; ++mi)
#pragma unroll
                for (int ni = 0; ni < 2; ++ni) og[mi][ni] = gld<u32x2>(P, (unsigned)((row0 + 16 * mi + fr) * NP + PO + h * DH + 32 * wave + 16 * ni + 4 * fq) * 2u);
#pragma unroll
            for (int ni = 0; ni < 2; ++ni) gw[ni] = gld<f32x4>(nw, (unsigned)(h * DH + 32 * wave + 16 * ni + 4 * fq) * 4u);
#pragma unroll 1
            for (int k0 = 0; k0 < CHUNK; k0 += 32) {
                bf16x8 xv[2];
#pragma unroll
                for (int ni = 0; ni < 2; ++ni) xv[ni] = tr_frag(Vs, PIT_T, k0, 32 * wave + 16 * ni, lane);
#pragma unroll
                for (int mi = 0; mi < 8; ++mi) { const bf16x8 yp = *(const LAS bf16x8*)(Ps + (16 * mi + fr) * PIT_P + (k0 + 8 * fq) * 2);
#pragma unroll
                    for (int ni = 0; ni < 2; ++ni) tot[ni][mi] = __builtin_amdgcn_mfma_f32_16x16x32_bf16(xv[ni], yp, tot[ni][mi], 0, 0, 0); }
            }
        }
        {
            SECTION_LANES();
#pragma unroll
            for (int mi = 0; mi < 8; ++mi) { float ss = 0.f;
#pragma unroll
                for (int ni = 0; ni < 2; ++ni) ss += (tot[ni][mi][0] * tot[ni][mi][0] + tot[ni][mi][1] * tot[ni][mi][1]) + (tot[ni][mi][2] * tot[ni][mi][2] + tot[ni][mi][3] * tot[ni][mi][3]);
                ss += shx(ss, 16, lane); ss += shx(ss, 32, lane);
                if (fq == 0) ssq[wave * 128 + 16 * mi + fr] = ss; }
            __syncthreads();
#pragma unroll
            for (int mi = 0; mi < 8; ++mi) { const int tt = 16 * mi + fr; float ss = 0.f;
#pragma unroll
                for (int w8 = 0; w8 < 8; ++w8) ss += ssq[w8 * 128 + tt];
                const float rstd = rsqrtf(ss * (1.f / DH) + EPS);
#pragma unroll
                for (int ni = 0; ni < 2; ++ni) { const int vd = 32 * wave + 16 * ni + 4 * fq;
                    const u32x2 ow = og[mi][ni]; const f32x4 w4 = gw[ni];
                    const float o0 = __uint_as_float(ow.x << 16), o1 = __uint_as_float(ow.x & 0xffff0000u), o2 = __uint_as_float(ow.y << 16), o3 = __uint_as_float(ow.y & 0xffff0000u);
                    u32x2 q; q.x = pk2(sigmoidf_(o0) * (tot[ni][mi][0] * rstd * w4[0]), sigmoidf_(o1) * (tot[ni][mi][1] * rstd * w4[1]));
                    q.y = pk2(sigmoidf_(o2) * (tot[ni][mi][2] * rstd * w4[2]), sigmoidf_(o3) * (tot[ni][mi][3] * rstd * w4[3]));
                    gst<u32x2>(HM, (unsigned)((row0 + tt) * D + h * DH + vd) * 2u, q); }
            }
        }
        __syncthreads();
    }
}
__device__ __forceinline__ void ph_mgctx(int wv) {
    unsigned char* const wsb = ows(okp()->ws);
    const float* SL = WSP(float, OFF_SLAB); bf16_t* MG = WSP(bf16_t, OFF_MG);
    const unsigned gt = (unsigned)obid() * 512u + otid(wv), NT = gridDim.x * 512u;
    for (unsigned i = gt; i < (unsigned)RC * D / 8; i += 2 * NT) { const bool two = i + NT < (unsigned)RC * D / 8; const unsigned j = two ? i + NT : i;
        const f32x4 a0 = gld<f32x4>(SL, i * 32u), a1 = gld<f32x4>(SL, i * 32u + 16), b0 = gld<f32x4>(SL, (unsigned)(RC * D) * 4u + i * 32u), b1 = gld<f32x4>(SL, (unsigned)(RC * D) * 4u + i * 32u + 16);
        const f32x4 c0 = gld<f32x4>(SL, j * 32u), c1 = gld<f32x4>(SL, j * 32u + 16), d0 = gld<f32x4>(SL, (unsigned)(RC * D) * 4u + j * 32u), d1 = gld<f32x4>(SL, (unsigned)(RC * D) * 4u + j * 32u + 16);
        gst<u32x4>(MG, (unsigned)(RL * D) * 2u + i * 16u, pack8v(a0 + b0, a1 + b1));
        if (two) gst<u32x4>(MG, (unsigned)(RL * D) * 2u + j * 16u, pack8v(c0 + d0, c1 + d1)); }
}
__device__ __forceinline__ void ph_ffnact(int wv, int l) {
    CParams& p = *okp();
    unsigned char* const wsb = ows(p.ws);
    const int TIDX = otid(wv), BIDX = obid();
    const unsigned gt = (unsigned)BIDX * 512u + TIDX, NT = gridDim.x * 512u;
    const bf16_t* U = WSP(bf16_t, OFF_P); bf16_t* ACT = WSP(bf16_t, OFF_ACT); const float* SL = WSP(float, OFF_SLAB);
    const float* wf = p.conv_ff_w + (size_t)l * 3 * DFF;
    auto ldu = [&](int r, int col, float (&o)[8]) {
        if (col >= 32 * 256) { f32x4 g0 = {0.f, 0.f, 0.f, 0.f}, g1 = {0.f, 0.f, 0.f, 0.f};
            u32x4 sq[4];
#pragma unroll
            for (int sl = 0; sl < 4; ++sl) sq[sl] = gld<u32x4>(SL, (unsigned)((sl * RC + (r - RL)) * NUP + col) * 2u);
#pragma unroll
            for (int sl = 0; sl < 4; ++sl) { f32x4 t0, t1; unpack8v(sq[sl], t0, t1); g0 += t0; g1 += t1; }
#pragma unroll
            for (int j = 0; j < 4; ++j) { o[j] = g0[j]; o[4 + j] = g1[j]; } }
        else unpack8(gld<u32x4>(U, (unsigned)(r * NUP + col) * 2u), o);
    };
    struct Item { float a0[8], a1[8], a2[8], g[8]; f32x4 w[6]; int r, c; bool hp, hn; };
    auto load_item = [&](unsigned i, Item& it) {
        it.r = RL + (int)(i / (DFF / 8)); it.c = (int)(i % (DFF / 8)) * 8; const int t = (it.r - RL) & (CTX - 1), ca = 256 * (it.c >> 7) + (it.c & 127);
        it.hp = t > 0; it.hn = t < CTX - 1;
        ldu(it.r, ca, it.a1); ldu(it.r, ca + 128, it.g); ldu(it.hp ? it.r - 1 : it.r, ca, it.a0); ldu(it.hn ? it.r + 1 : it.r, ca, it.a2);
#pragma unroll
        for (int k = 0; k < 3; ++k) { it.w[2 * k] = gld<f32x4>(wf, (unsigned)(k * DFF + it.c) * 4u); it.w[2 * k + 1] = gld<f32x4>(wf, (unsigned)(k * DFF + it.c) * 4u + 16); } };
    auto finish_item = [&](const Item& it) { float o[8];
#pragma unroll
        for (int j = 0; j < 8; ++j) { const float w0 = it.w[j >> 2][j & 3], w1 = it.w[2 + (j >> 2)][j & 3], w2 = it.w[4 + (j >> 2)][j & 3];
            float v = w1 * it.a1[j]; if (it.hp) v += w0 * it.a0[j]; if (it.hn) v += w2 * it.a2[j]; o[j] = siluf_(v) * it.g[j]; }
        gst<u32x4>(ACT, (unsigned)(it.r * DFF + it.c) * 2u, pack8(o)); };
    for (unsigned i = gt; i < (unsigned)RC * (DFF / 8); i += 2 * NT) {
        const bool two = i + NT < (unsigned)RC * (DFF / 8);
        Item A, B; load_item(i, A); if (two) load_item(i + NT, B);
        finish_item(A); if (two) finish_item(B);
    }
}

#define XB_TMO      128
#define XB_XCNT(j)  (256  + 64 * (j))
#define XB_XSUB(j)  (1280 + 64 * (j))
#define XB_XGEN(j)  (2304 + 64 * (j))
#define XB_TOP      3328
#define XB_TOPGEN   3392
#define XCD_BAR_WORDS 3456
#define XB_SPIN_CAP (1u << 18)
__device__ __forceinline__ unsigned xb_ld(unsigned* p)              { return __hip_atomic_load(p, __ATOMIC_RELAXED, __HIP_MEMORY_SCOPE_AGENT); }
__device__ __forceinline__ unsigned xb_add(unsigned* p, unsigned v) { return __hip_atomic_fetch_add(p, v, __ATOMIC_RELAXED, __HIP_MEMORY_SCOPE_AGENT); }
__device__ __forceinline__ unsigned xb_xcc_id() { return (unsigned)__builtin_amdgcn_s_getreg((3 << 11) | 20) & 0xFu; }
#define XB_SPIN(cond, bar) do { unsigned _sp = 0; while (cond) { __builtin_amdgcn_s_sleep(1); \
    if ((++_sp & 255u) == 0u) { if (xb_ld(&(bar)[XB_TMO])) break; if (_sp > XB_SPIN_CAP) { atomicAdd(&(bar)[XB_TMO], 1u); break; } } } } while (0)
struct XcdBarrier { unsigned* bar; unsigned x; volatile LAS unsigned* st; };
__device__ __forceinline__ XcdBarrier xcd_barrier_post(unsigned* bar, volatile LAS unsigned* st) {
    XcdBarrier b; b.bar = bar; b.x = xb_xcc_id(); b.st = st;
    if (threadIdx.x == 0) (void)xb_add(&bar[XB_XCNT(b.x)], 1u);
    return b;
}
__device__ __forceinline__ void xcd_barrier_complete(unsigned* bar, unsigned x, unsigned& nloc, unsigned& nx) {
    const unsigned G = gridDim.x * gridDim.y * gridDim.z;
    unsigned sum, cnt, mine, sp = 0u;
    for (;;) {
        sum = 0u; cnt = 0u; mine = 0u;
#pragma unroll
        for (unsigned j = 0; j < 16; ++j) { const unsigned c = xb_ld(&bar[XB_XCNT(j)]); sum += c; cnt += (c > 0u) ? 1u : 0u; mine = (j == x) ? c : mine; }
        if (sum == G) break;
        __builtin_amdgcn_s_sleep(1);
        if ((++sp & 255u) == 0u) { if (xb_ld(&bar[XB_TMO])) break; if (sp > XB_SPIN_CAP) { atomicAdd(&bar[XB_TMO], 1u); break; } }
    }
    nloc = mine > 0u ? mine : 1u; nx = cnt > 0u ? cnt : 1u;
}
__device__ __forceinline__ void xcd_barrier(const XcdBarrier& b, int wv) {
    asm volatile("s_waitcnt vmcnt(0)" ::: "memory");
    __syncthreads();
    if (otid(wv) == 0) {
        unsigned long long bw = (unsigned long long)b.bar; asm volatile("" : "+s"(bw));
        unsigned* bar = (unsigned*)bw;
        __builtin_amdgcn_s_waitcnt(0);
        unsigned nloc = b.st[0], nx = b.st[1];
        if (nloc == 0u) { xcd_barrier_complete(bar, b.x, nloc, nx); b.st[0] = nloc; b.st[1] = nx; }
        const unsigned old = xb_add(&bar[XB_XSUB(b.x)], 1u);
        const unsigned gen = old / nloc;
        if (old + 1u == (gen + 1u) * nloc) {
            __builtin_amdgcn_fence(__ATOMIC_RELEASE, "agent");
            asm volatile("s_waitcnt vmcnt(0)" ::: "memory");
            const unsigned og = xb_add(&bar[XB_TOP], 1u);
            const unsigned tg = og / nx;
            if (og + 1u == (tg + 1u) * nx) xb_add(&bar[XB_TOPGEN], 1u);
            else XB_SPIN(xb_ld(&bar[XB_TOPGEN]) == tg, bar);
            __builtin_amdgcn_fence(__ATOMIC_ACQUIRE, "agent");
            xb_add(&bar[XB_XGEN(b.x)], 1u);
            asm volatile("s_waitcnt vmcnt(0)" ::: "memory");
        } else {
            XB_SPIN(xb_ld(&bar[XB_XGEN(b.x)]) == gen, bar);
            __builtin_amdgcn_fence(__ATOMIC_ACQUIRE, "agent");
            asm volatile("s_waitcnt vmcnt(0)" ::: "memory");
        }
    }
    __syncthreads();
}

constexpr int I_CUT = (I_LAYER * 2 / 5 / 64) * 64;
#define REPW 3456
#define REPN(k) (1 + __builtin_amdgcn_readfirstlane(((const int*)(okp()->ws + OFF_CTL))[REPW + (k)]))
constexpr int LDS_BYTES = 163840;
constexpr int MISC_OFF = 163840 - 256;
template <class Epi, class Sched, bool AMAP = false> __device__ __forceinline__ void run_gemm(int wv, LAS unsigned char* lds, const bf16_t* A, int lda, const bf16_t* Bt, int ldb, int K, const Sched& S, const Epi& E) {
    pg8::Gemm g; g.A = A; g.Bt = Bt; g.M = 0; g.N = 0; g.K = K; g.lda = lda; g.ldb = ldb; g.pad = wv;
    pg8::gemm_phase<Epi, Sched, AMAP>((PG8_LAS unsigned char*)lds, g, S, E);
}
__global__ void __launch_bounds__(512, 2) mega_fwd(Params p_kernarg) {
    extern __shared__ __attribute__((aligned(16))) unsigned char dyn_lds[];
    LAS unsigned char* lds = (LAS unsigned char*)dyn_lds;
    const int wv = __builtin_amdgcn_readfirstlane(threadIdx.x >> 6);
    volatile LAS unsigned* MISC = (volatile LAS unsigned*)(lds + MISC_OFF);
    if (threadIdx.x < 32) MISC[threadIdx.x] = 0u;
    __syncthreads();
    (void)xcd_barrier_post((unsigned*)(okp()->ws + OFF_CTL), MISC + 8);
#define GRID_BAR() for (int rpb = 0, nrpb = REPN(10); rpb < nrpb; ++rpb) { XcdBarrier bar_; bar_.bar = (unsigned*)(okp()->ws + OFF_CTL); bar_.x = xb_xcc_id(); bar_.st = (volatile LAS unsigned*)(lds + MISC_OFF) + 8; xcd_barrier(bar_, wv); }
    for (int rp = 0, nrp = REPN(13); rp < nrp; ++rp) { ph_convert(wv, lds, 0, obid(), (int)gridDim.x, 0, I_LAYER); __syncthreads(); }
    for (int rp = 0, nrp = REPN(0); rp < nrp; ++rp) { ph_tables(wv); __syncthreads(); ph_mod<8>(wv, lds, 0, 1, obid(), (int)gridDim.x); __syncthreads(); }
    GRID_BAR();
    for (int l = 0; l < DEPTH; ++l) {
        unsigned char* ws = ows(okp()->ws);
        const int G = (int)gridDim.x;
        const int fz = 0;
        const bool lastl = (l == DEPTH - 1);
        if (l == 0) ph_norm<true>(wv, 0, 0, nullptr, 0, R, okp()->x, okp()->ctx);
        else { if (!fz) ph_norm_lat(wv, l, 0); ph_norm_ctx<false>(wv, lds, l, 0); }
        GRID_BAR();
        for (int rp = 0, nrp = REPN(1); rp < nrp; ++rp) { EpiInProj E{(bf16_t*)(ws + OFF_P), (float*)(ws + OFF_G), (const float*)(ws + OFF_BINR) + (size_t)l * NINP};
          pg8::StaticOrder S; S.init(R, NINP, D, G, obid());
          run_gemm(wv, lds, (const bf16_t*)(ws + OFF_XN), D, (const bf16_t*)(ws + OFF_WIN) + (size_t)l * NINP * D, D, D, S, E); }
        GRID_BAR();
        for (int rp = 0, nrp = REPN(2); rp < nrp; ++rp) ph_mlstm1(wv, l, lds);
        { const int f0 = G / 4, fn = G / 2;
          for (int rp = 0, nrp = REPN(9); rp < nrp; ++rp) if (obid() >= f0 && obid() < f0 + fn) ph_fft(wv, lds, obid() - f0, fn);
          for (int rp = 0, nrp = REPN(3); rp < nrp; ++rp) if (obid() < f0 || obid() >= f0 + fn) { const int wi = obid() < f0 ? obid() : obid() - fn;
              if (!lastl) ph_fourier1(wv, wi, G - fn); ph_convc(wv, l, lastl ? RL : R, wi, G - fn); } }
        GRID_BAR();
        for (int rp = 0, nrp = REPN(4); rp < nrp; ++rp) ph_mlstm2(wv);
        GRID_BAR();
        for (int rp = 0, nrp = REPN(5); rp < nrp; ++rp) ph_mlstm3(wv, l, lds, lastl ? 64 * NH : NCHUNK * NH);
        if (!lastl && obid() >= 32) { EpiBf16 E{(bf16_t*)(ws + OFF_HM) + (size_t)RL * D + DM, D, DF, (unsigned)(CTX * D), 0, (float*)(ows(okp()->ws) + OFF_SLAB)};
          pg8::StaticOrder S; S.init(256, 2048, 512, G - 32, obid() - 32);
          run_gemm(wv, lds, (const bf16_t*)(ws + OFF_CSC), 512, (const bf16_t*)(ws + OFF_ZTC), 512, 512, S, E); }
        if (!lastl && obid() >= 32) { ph_convert(wv, lds, l + 1, obid() - 32, G - 32, 0, I_CUT); }
        GRID_BAR();
        for (int rp = 0, nrp = REPN(8); rp < nrp; ++rp) { EpiMerge E{(const bf16_t*)(ows(okp()->ws) + OFF_P), (bf16_t*)(ows(okp()->ws) + OFF_MG), (float*)(ows(okp()->ws) + OFF_SLAB)}; pg8::TailOrder S; S.init(D, D, G, obid(), lastl ? 0 : 32, 0, 2);
          run_gemm(wv, lds, (const bf16_t*)(ws + OFF_HM), D, (const bf16_t*)(ws + OFF_WPM) + (size_t)l * D * D, D, D, S, E); }
        if (!lastl && obid() >= 64) { ph_convert(wv, lds, l + 1, obid() - 64, G - 64, I_CUT, I_LAYER); __syncthreads(); ph_mod<16>(wv, lds, l + 1, l + 2, obid() - 64, G - 64); }
        GRID_BAR();
        if (!lastl) { ph_mgctx(wv); GRID_BAR(); }
        for (int rp = 0, nrp = REPN(11); rp < nrp; ++rp) { EpiResid E{l, 0, fz, rp == 0 ? 1.f : 0.f};
          pg8::TailOrder S; S.init(D, D, G, obid(), lastl ? 0 : 32, 0, 8);
          run_gemm(wv, lds, (const bf16_t*)(ws + OFF_MG), D, (const bf16_t*)(ws + OFF_WO) + (size_t)l * D * D, D, D, S, E); }
        GRID_BAR();
        if (!lastl || !fz) {
          if (!fz) ph_norm_lat(wv, l, 1);
          if (!lastl) { if (l == 0) ph_norm_ctx<true>(wv, lds, 0, 1); else ph_norm_ctx<false>(wv, lds, l, 1); }
          GRID_BAR(); }
        for (int rp = 0, nrp = REPN(7); rp < nrp; ++rp) { EpiUp E{(bf16_t*)(ows(okp()->ws) + OFF_P), (float*)(ows(okp()->ws) + OFF_SLAB), (bf16_t*)(ows(okp()->ws) + OFF_ACT), okp()->conv_ff_w + (size_t)l * 3 * DFF};
          pg8::TailOrder S; S.init(NUP, D, G, obid(), lastl ? 0 : 176, lastl ? 0 : 128, 4);
          run_gemm<EpiUp, pg8::TailOrder, true>(wv, lds, (const bf16_t*)(ows(okp()->ws) + OFF_XN), D, (const bf16_t*)(ws + OFF_WUP) + (size_t)l * NUP * D, D, D, S, E); }
        GRID_BAR();
        if (!lastl) { for (int rp = 0, nrp = REPN(6); rp < nrp; ++rp) ph_ffnact(wv, l);
          GRID_BAR(); }
        for (int rp = 0, nrp = REPN(12); rp < nrp; ++rp) { EpiResid E{l, 1, lastl ? 2 * fz : fz, rp == 0 ? 1.f : 0.f};
          pg8::TailOrder S; S.init(D, DFF, G, obid(), lastl ? 0 : 32, 0, 8);
          run_gemm(wv, lds, (const bf16_t*)(ws + OFF_ACT), DFF, (const bf16_t*)(ws + OFF_WDN) + (size_t)l * D * DFF, DFF, DFF, S, E); }
        if (!(lastl && fz)) { GRID_BAR(); }
    }
    ph_final(wv);
}

extern "C" void kernel_launch(void* const* d_in, const int* in_sizes, int n_in, void* d_out, int out_size, void* d_ws, size_t ws_size, hipStream_t stream) {
    static int grid = 0;
    if (grid == 0) {
        if (n_in != 22 || ws_size < WS_END || out_size != RL * D) { fprintf(stderr, "kernel_launch: unexpected problem (n_in %d, ws %zu < %zu, out %d)\n", n_in, ws_size, (size_t)WS_END, out_size); grid = -1; return; }
        int dev = 0, cus = 0, per_cu = 0;
        if (hipGetDevice(&dev) != hipSuccess || hipDeviceGetAttribute(&cus, hipDeviceAttributeMultiprocessorCount, dev) != hipSuccess) { grid = -1; return; }
        if (hipFuncSetAttribute((const void*)mega_fwd, hipFuncAttributeMaxDynamicSharedMemorySize, LDS_BYTES) != hipSuccess) { fprintf(stderr, "kernel_launch: hipFuncSetAttribute failed\n"); grid = -1; return; }
        if (hipOccupancyMaxActiveBlocksPerMultiprocessor(&per_cu, (const void*)mega_fwd, 512, LDS_BYTES) != hipSuccess || per_cu < 1) { fprintf(stderr, "kernel_launch: occupancy query says %d\n", per_cu); per_cu = 1; }
        (void)hipGetLastError();
        grid = cus;
    }
    if (grid < 0) return;
    Params p{};
    const float** pp = (const float**)&p;
    for (int i = 0; i < 22; ++i) pp[i] = (const float*)d_in[i];
    p.out = (float*)d_out; p.ws = (unsigned char*)d_ws;
    (void)hipMemsetAsync((char*)d_ws + OFF_CTL, 0, (size_t)(XCD_BAR_WORDS + 16) * sizeof(unsigned), stream);
    hipLaunchKernelGGL(mega_fwd, dim3(grid), dim3(512), LDS_BYTES, stream, p);
}
```
